# Optimizing an MI355X kernel written in HIP

```python
import jax, jax.numpy as jnp
from jax import lax
import numpy as np

D_MODEL = 1024
BATCH = 8
SEQ = 4096
DEPTH = 1

N_META = 16
BLOCK = 128
N_PAD = BLOCK - N_META
HG_HEADS = 4
HG_DK = 128
HG_DV = 128
HG_WIDTH = HG_HEADS * HG_DK
AT_QHEADS = 8
AT_KVHEADS = 2
AT_GROUP = AT_QHEADS // AT_KVHEADS
AT_HDIM = 64
AT_WIDTH = AT_QHEADS * AT_HDIM
AT_KV_WIDTH = AT_KVHEADS * AT_HDIM
WINDOW = 128
IN_COLS = 4 * HG_WIDTH + AT_WIDTH + 2 * AT_KV_WIDTH + 2 * D_MODEL
PK_HEADS = 8
N_KEYS = 128
N_EXPERTS = N_KEYS * N_KEYS
D_QUERY = 256
D_HALF = D_QUERY // 2
TOPK = 16
TOK_BLOCK = 256
EPS = 1e-6

kernel_name = "hybrid_hgrn2_swa_sink_peer_block"


def _rmsnorm(x, g):
    xf = x.astype(jnp.float32)
    y = xf * lax.rsqrt(jnp.mean(xf * xf, axis=-1, keepdims=True) + EPS)
    return (y * g.astype(jnp.float32)).astype(x.dtype)


def _hgrn2(q, f_logit, v, lb):
    B, L = q.shape[:2]
    lb = lb.reshape(HG_HEADS, HG_DK).astype(jnp.float32)
    f = lb + (1.0 - lb) * jax.nn.sigmoid(f_logit.astype(jnp.float32))
    logf = jnp.log(f)
    k = 1.0 - f
    pad = ((0, 0), (N_PAD, 0), (0, 0), (0, 0))
    qf = jnp.pad(q.astype(jnp.float32), pad)
    logf = jnp.pad(logf, pad)
    k = jnp.pad(k, pad)
    vf = jnp.pad(v.astype(jnp.float32), pad)
    nc = (L + N_PAD) // BLOCK

    def to_chunks(t):
        return t.reshape(B, nc, BLOCK, HG_HEADS, t.shape[-1]).transpose(1, 0, 3, 2, 4)

    causal = jnp.tril(jnp.ones((BLOCK, BLOCK), dtype=bool))[:, :, None]

    def step(S, inp):
        qc, lc, kc, vc = inp
        A = jnp.cumsum(lc, axis=2)
        diff = A[:, :, :, None, :] - A[:, :, None, :, :]
        decay = jnp.where(causal, jnp.exp(jnp.where(causal, diff, 0.0)), 0.0)
        scores = jnp.einsum('bhtsd,bhsd->bhts', qc[:, :, :, None, :] * decay, kc)
        o = (jnp.einsum('bhts,bhse->bhte', scores, vc)
             + jnp.einsum('bhtd,bhde->bhte', qc * jnp.exp(A), S))
        A_end = A[:, :, -1:, :]
        S = (jnp.exp(A_end[:, :, 0, :])[..., None] * S
             + jnp.einsum('bhsd,bhse->bhde', kc * jnp.exp(A_end - A), vc))
        return S, o

    S0 = jnp.zeros((B, HG_HEADS, HG_DK, HG_DV), jnp.float32)
    _, o = lax.scan(step, S0, (to_chunks(qf), to_chunks(logf), to_chunks(k), to_chunks(vf)))
    o = o.transpose(1, 0, 3, 2, 4).reshape(B, nc * BLOCK, HG_HEADS, HG_DV)
    return o[:, N_PAD:]


def _swa_sinks(q, k, v, sinks):
    B, L = q.shape[:2]
    P = L + N_PAD
    nb = P // BLOCK
    pad = ((0, 0), (N_PAD, 0), (0, 0), (0, 0))
    qb = jnp.pad(q, pad).reshape(B, nb, BLOCK, AT_KVHEADS, AT_GROUP, AT_HDIM)
    kp = jnp.pad(k, pad).reshape(B, nb, BLOCK, AT_KVHEADS, AT_HDIM)
    vp = jnp.pad(v, pad).reshape(B, nb, BLOCK, AT_KVHEADS, AT_HDIM)

    def band(t):
        prev = jnp.pad(t, ((0, 0), (1, 0), (0, 0), (0, 0), (0, 0)))[:, :-1]
        return jnp.concatenate([prev, t], axis=2)

    kb, vb = band(kp), band(vp)
    km, vm = k[:, :N_META], v[:, :N_META]
    scale = AT_HDIM ** -0.5
    s_band = jnp.einsum('bnqhgd,bnshd->bnhgqs', qb, kb).astype(jnp.float32) * scale
    s_meta = jnp.einsum('bnqhgd,bmhd->bnhgqm', qb, km).astype(jnp.float32) * scale
    qpos = jnp.arange(nb * BLOCK).reshape(nb, BLOCK) - N_PAD
    kpos = qpos[:, :1] - BLOCK + jnp.arange(2 * BLOCK)[None, :]
    band_mask = ((kpos[:, None, :] >= N_META)
                 & (kpos[:, None, :] <= qpos[:, :, None])
                 & (qpos[:, :, None] - kpos[:, None, :] < WINDOW))
    meta_mask = jnp.arange(N_META)[None, None, :] <= qpos[:, :, None]
    neg = jnp.finfo(jnp.float32).min
    s_band = jnp.where(band_mask[None, :, None, None], s_band, neg)
    s_meta = jnp.where(meta_mask[None, :, None, None], s_meta, neg)
    s_sink = jnp.broadcast_to(
        sinks.reshape(AT_KVHEADS, AT_GROUP).astype(jnp.float32)[None, None, :, :, None, None],
        s_band.shape[:-1] + (1,))
    p = jax.nn.softmax(jnp.concatenate([s_band, s_meta, s_sink], axis=-1), axis=-1)
    p_band = p[..., :2 * BLOCK].astype(v.dtype)
    p_meta = p[..., 2 * BLOCK:2 * BLOCK + N_META].astype(v.dtype)
    o = (jnp.einsum('bnhgqs,bnshd->bnqhgd', p_band, vb)
         + jnp.einsum('bnhgqm,bmhd->bnqhgd', p_meta, vm))
    return o.reshape(B, P, AT_WIDTH)[:, N_PAD:]


def _peer(h, w_q, subkeys, u, v):
    B, L, D = h.shape
    T = B * L
    Tp = -(-T // TOK_BLOCK) * TOK_BLOCK
    t = jnp.pad(h.reshape(T, D), ((0, Tp - T), (0, 0))).reshape(Tp // TOK_BLOCK, TOK_BLOCK, D)

    def block(xb):
        q = (xb @ w_q).reshape(TOK_BLOCK, PK_HEADS, 2, D_HALF)
        s = jnp.einsum('thcd,hcnd->thcn', q, subkeys).astype(jnp.float32)
        sv, si = lax.top_k(s, TOPK)
        cand = sv[:, :, 0, :, None] + sv[:, :, 1, None, :]
        cand_idx = si[:, :, 0, :, None] * N_KEYS + si[:, :, 1, None, :]
        top_s, pos = lax.top_k(cand.reshape(TOK_BLOCK, PK_HEADS, TOPK * TOPK), TOPK)
        idx = jnp.take_along_axis(cand_idx.reshape(TOK_BLOCK, PK_HEADS, TOPK * TOPK), pos, axis=-1)
        g = jax.nn.softmax(top_s, axis=-1)
        a = jax.nn.gelu(jnp.einsum('td,thkd->thk', xb, u[idx]).astype(jnp.float32), approximate=False)
        w = (g * a).astype(xb.dtype)
        return jnp.einsum('thk,thkd->td', w, v[idx])

    out = lax.map(block, t)
    return out.reshape(Tp, D)[:T].reshape(B, L, D)


def setup_inputs(seed: int = 0) -> dict:
    key = jax.random.key(seed)
    ks = jax.random.split(key, 17)
    f32 = jnp.float32
    nrm = lambda k, shape, s: jax.random.normal(k, shape, f32) * s
    return {
        "x": nrm(ks[0], (BATCH, SEQ, D_MODEL), 1.0),
        "meta_tokens": nrm(ks[1], (N_META, D_MODEL), 1.0),
        "mix_norm_g": 1.0 + nrm(ks[2], (DEPTH, D_MODEL), 0.02),
        "w_in": nrm(ks[3], (DEPTH, D_MODEL, IN_COLS), D_MODEL ** -0.5),
        "b_gate": nrm(ks[4], (DEPTH, 2 * D_MODEL), 0.02),
        "hg_lb_logits": nrm(ks[5], (DEPTH + 1, HG_WIDTH), 0.1),
        "hg_norm_g": 1.0 + nrm(ks[6], (DEPTH, HG_HEADS * HG_DV), 0.02),
        "attn_sinks": nrm(ks[7], (DEPTH, AT_QHEADS), 0.5),
        "w_branch_hg": nrm(ks[8], (DEPTH, HG_HEADS * HG_DV, D_MODEL), (HG_HEADS * HG_DV) ** -0.5),
        "w_branch_attn": nrm(ks[9], (DEPTH, AT_WIDTH, D_MODEL), AT_WIDTH ** -0.5),
        "w_out": nrm(ks[10], (DEPTH, D_MODEL, D_MODEL), D_MODEL ** -0.5),
        "ffn_norm_g": 1.0 + nrm(ks[11], (DEPTH, D_MODEL), 0.02),
        "peer_w_q": nrm(ks[12], (DEPTH, D_MODEL, PK_HEADS * D_QUERY), D_MODEL ** -0.5),
        "peer_subkeys": nrm(ks[13], (DEPTH, PK_HEADS, 2, N_KEYS, D_HALF), D_HALF ** -0.5),
        "peer_u": nrm(ks[14], (DEPTH, N_EXPERTS, D_MODEL), D_MODEL ** -0.5),
        "peer_v": nrm(ks[15], (DEPTH, N_EXPERTS, D_MODEL), 0.5),
        "final_norm_g": 1.0 + nrm(ks[16], (D_MODEL,), 0.02),
    }


def reference(x, meta_tokens, mix_norm_g, w_in, b_gate, hg_lb_logits, hg_norm_g, attn_sinks,
              w_branch_hg, w_branch_attn, w_out, ffn_norm_g, peer_w_q, peer_subkeys,
              peer_u, peer_v, final_norm_g):
    B = x.shape[0]
    h = jnp.concatenate(
        [jnp.broadcast_to(meta_tokens[None].astype(x.dtype), (B, N_META, D_MODEL)), x], axis=1)
    L = h.shape[1]
    lbs = jnp.cumsum(jax.nn.softmax(hg_lb_logits.astype(jnp.float32), axis=0), axis=0)
    sizes = (HG_WIDTH, HG_WIDTH, HG_WIDTH, HG_HEADS * HG_DV, AT_WIDTH, AT_KV_WIDTH, AT_KV_WIDTH, D_MODEL, D_MODEL)
    offsets = [int(o) for o in np.cumsum(sizes)[:-1]]
    for l in range(DEPTH):
        y = _rmsnorm(h, mix_norm_g[l])
        z = y @ w_in[l]
        hq, hf, hi, hgate, aq, ak, av, ga, gb = jnp.split(z, offsets, axis=-1)
        o_hg = _hgrn2(hq.reshape(B, L, HG_HEADS, HG_DK), hf.reshape(B, L, HG_HEADS, HG_DK),
                      hi.reshape(B, L, HG_HEADS, HG_DV), lbs[l])
        o_hg = _rmsnorm(o_hg, hg_norm_g[l].reshape(HG_HEADS, HG_DV)).astype(h.dtype)
        o_hg = o_hg.reshape(B, L, HG_HEADS * HG_DV) * jax.nn.silu(hgate)
        o_at = _swa_sinks(aq.reshape(B, L, AT_QHEADS, AT_HDIM), ak.reshape(B, L, AT_KVHEADS, AT_HDIM),
                          av.reshape(B, L, AT_KVHEADS, AT_HDIM), attn_sinks[l])
        gl = (jnp.concatenate([ga, gb], axis=-1) + b_gate[l]).astype(jnp.float32)
        g_hg = jax.nn.sigmoid(gl[..., :D_MODEL]).astype(h.dtype)
        g_at = jax.nn.sigmoid(gl[..., D_MODEL:]).astype(h.dtype)
        m = g_hg * (o_hg @ w_branch_hg[l]) + g_at * (o_at @ w_branch_attn[l])
        h = h + m @ w_out[l]
        h = h + _peer(_rmsnorm(h, ffn_norm_g[l]), peer_w_q[l], peer_subkeys[l], peer_u[l], peer_v[l])
    return _rmsnorm(h, final_norm_g)[:, N_META:]
```

```cpp
#include <hip/hip_runtime.h>
#include <hip/hip_cooperative_groups.h>
#include <cstdio>
#include <cstdint>
namespace cg = cooperative_groups;

#ifndef MK_ONE_LAUNCH
#define MK_ONE_LAUNCH 1
#endif

constexpr int DM = 1024, NB = 8, SEQ = 4096, NMETA = 16, LTOK = SEQ + NMETA;
constexpr int MA_REAL = NB * LTOK;
constexpr int MA = 33024;
constexpr int MC = NB * SEQ;
constexpr int LPAD = 4224;
constexpr float EPS = 1e-6f;

namespace pg8 {
#define PG8_LAS __attribute__((address_space(3)))
typedef unsigned short bf16_t;
typedef short bf16x8 __attribute__((ext_vector_type(8)));
typedef float f32x4 __attribute__((ext_vector_type(4)));
typedef unsigned u32x4 __attribute__((ext_vector_type(4)));
constexpr int BM = 256, BK = 64, HALF = 128, HTB = HALF * BK * 2  , STAGE_BYTES = 8 * HTB, NXCD = 8, WGM = 8;

__host__ __device__ __forceinline__ int lds_byte(int r, int c) { const int st = (r >> 4) * 2 + (c >> 5), rr = r & 15, cc = c & 31, ob = rr * 64 + cc * 2; return st * 1024 + (ob ^ (((ob >> 9) & 1) << 5)); }
__host__ __device__ __forceinline__ void stage_rc(int b, int& R, int& C) { const int st = b / 1024, sb = b % 1024, swz = sb ^ (((sb >> 9) & 1) << 5); R = (st >> 1) * 16 + swz / 64; C = (st & 1) * 32 + (swz % 64) / 2; }
__host__ __device__ __forceinline__ int perm32(int rho) { const int n = rho >> 4, i = rho & 15; return 8 * (i >> 2) + 4 * n + (i & 3); }

struct Unit { int pm, pn; };
struct Gemm { const bf16_t* A; const bf16_t* Bt; int M, N, K, lda, ldb; };

struct StaticOrder {
    int nM, nN, nwg, G, c;
    __host__ __device__ void init(int M, int N, int G_, int c_) { nM = M / BM; nN = N / BM; nwg = nM * nN; G = G_; c = c_; }
    __host__ __device__ bool next(int i, Unit& u) const {
        const long L = (long)i * G + c; if (L >= nwg) return false;
        int wgid = (int)L; { const int q = nwg / NXCD, r = nwg % NXCD, xcd = wgid % NXCD, off = wgid / NXCD; wgid = (xcd < r ? xcd * (q + 1) : r * (q + 1) + (xcd - r) * q) + off; }
        const int nig = WGM * nN, gid = wgid / nig, fm = gid * WGM, gsz = (nM - fm) < WGM ? (nM - fm) : WGM;
        u.pm = fm + ((wgid % nig) % gsz); u.pn = (wgid % nig) / gsz; return true;
    }
    __device__ __forceinline__ void a_ready(const Unit&) const {}
    __device__ __forceinline__ void done(const Unit&) const {}
};

__device__ __forceinline__ unsigned cvt_pk_bf16(float lo, float hi) { unsigned r; asm volatile("v_cvt_pk_bf16_f32 %0, %1, %2" : "=v"(r) : "v"(lo), "v"(hi)); return r; }
typedef float f32x2 __attribute__((ext_vector_type(2)));
typedef float f32x2_t __attribute__((ext_vector_type(2))); typedef __bf16 bf16x2_t __attribute__((ext_vector_type(2)));
typedef unsigned u32x2 __attribute__((ext_vector_type(2)));
__device__ __forceinline__ unsigned cvtpk(float lo, float hi) { f32x2_t v = {lo, hi}; bf16x2_t b = __builtin_convertvector(v, bf16x2_t); return __builtin_bit_cast(unsigned, b); }
__device__ __forceinline__ bf16_t f2bf(float x) { return (bf16_t)(cvtpk(x, 0.f) & 0xffffu); }
__device__ __forceinline__ float bf2f(bf16_t v) { return __uint_as_float((unsigned)v << 16); }
__device__ __forceinline__ float bflo(unsigned w) { return __uint_as_float(w << 16); }
__device__ __forceinline__ float bfhi(unsigned w) { return __uint_as_float(w & 0xffff0000u); }
__device__ __forceinline__ float sigm(float x) { return 1.f / (1.f + __expf(-x)); }

struct EpiZ {
    static constexpr bool PERM = true, AFTER_DRAIN = false;
    bf16_t *Zh, *Za, *Zg, *Vt;
    __device__ __forceinline__ void operator()(const f32x4 (&acc)[2][2][4][2], const Unit& u, int wr, int wc, int fr, int fq) const {
        const int pn = u.pn; bf16_t* base; int ldc, colt;
        if (pn < 8) { base = Zh; ldc = 2048; colt = pn * 256; } else if (pn < 11) { base = Za; ldc = 768; colt = (pn - 8) * 256; } else { base = Zg; ldc = 2048; colt = (pn - 11) * 256; }
        const int row0 = u.pm * BM + wr * 64 + fr, col0 = colt + wc * 32 + 8 * fq;
#pragma unroll
        for (int ai = 0; ai < 2; ++ai)
#pragma unroll
            for (int m = 0; m < 4; ++m) { const int row = row0 + ai * HALF + m * 16; bf16_t* rowp = base + (size_t)row * ldc + col0;
#pragma unroll
                for (int bj = 0; bj < 2; ++bj) { const f32x4 v0 = acc[ai][bj][m][0], v1 = acc[ai][bj][m][1];
                    if (pn == 10 && bj == 1) {
                        if (row < MA_REAL) { const int b = row / LTOK, pos = row - b * LTOK; bf16_t* vp = Vt + ((size_t)(b * 128 + wc * 32 + 8 * fq) * LPAD + 112 + pos);
                            vp[0] = f2bf(v0[0]); vp[LPAD] = f2bf(v0[1]); vp[2 * LPAD] = f2bf(v0[2]); vp[3 * LPAD] = f2bf(v0[3]);
                            vp[4 * LPAD] = f2bf(v1[0]); vp[5 * LPAD] = f2bf(v1[1]); vp[6 * LPAD] = f2bf(v1[2]); vp[7 * LPAD] = f2bf(v1[3]); }
                    } else { u32x4 w; w.x = cvtpk(v0[0], v0[1]); w.y = cvtpk(v0[2], v0[3]); w.z = cvtpk(v1[0], v1[1]); w.w = cvtpk(v1[2], v1[3]); *(u32x4*)(rowp + bj * HALF) = w; } } }
    }
};
template <int PASS> struct EpiGate {
    static constexpr bool PERM = true, AFTER_DRAIN = false;
    bf16_t* Mb; const bf16_t* Zg; const float* bgate;
    __device__ __forceinline__ void operator()(const f32x4 (&acc)[2][2][4][2], const Unit& u, int wr, int wc, int fr, int fq) const {
        const int row0 = u.pm * BM + wr * 64 + fr, col0 = u.pn * BM + wc * 32 + 8 * fq;
        f32x4 bv[2][2];
#pragma unroll
        for (int bj = 0; bj < 2; ++bj)
#pragma unroll
            for (int n = 0; n < 2; ++n) bv[bj][n] = *(const f32x4*)(bgate + PASS * 1024 + col0 + bj * HALF + 4 * n);
#pragma unroll
        for (int ai = 0; ai < 2; ++ai)
#pragma unroll
            for (int m = 0; m < 4; ++m) { const int rc = row0 + ai * HALF + m * 16, ra = (rc >> 12) * LTOK + NMETA + (rc & 4095);
                const bf16_t* zp = Zg + (size_t)ra * 2048 + PASS * 1024 + col0; bf16_t* mp = Mb + (size_t)rc * 1024 + col0;
#pragma unroll
                for (int bj = 0; bj < 2; ++bj) { const u32x4 z = *(const u32x4*)(zp + bj * HALF); f32x4 v0 = acc[ai][bj][m][0], v1 = acc[ai][bj][m][1];
                    v0[0] *= sigm(bflo(z.x) + bv[bj][0][0]); v0[1] *= sigm(bfhi(z.x) + bv[bj][0][1]); v0[2] *= sigm(bflo(z.y) + bv[bj][0][2]); v0[3] *= sigm(bfhi(z.y) + bv[bj][0][3]);
                    v1[0] *= sigm(bflo(z.z) + bv[bj][1][0]); v1[1] *= sigm(bfhi(z.z) + bv[bj][1][1]); v1[2] *= sigm(bflo(z.w) + bv[bj][1][2]); v1[3] *= sigm(bfhi(z.w) + bv[bj][1][3]);
                    if (PASS == 1) { const u32x4 o = *(const u32x4*)(mp + bj * HALF);
                        v0[0] += bflo(o.x); v0[1] += bfhi(o.x); v0[2] += bflo(o.y); v0[3] += bfhi(o.y); v1[0] += bflo(o.z); v1[1] += bfhi(o.z); v1[2] += bflo(o.w); v1[3] += bfhi(o.w); }
                    u32x4 w; w.x = cvtpk(v0[0], v0[1]); w.y = cvtpk(v0[2], v0[3]); w.z = cvtpk(v1[0], v1[1]); w.w = cvtpk(v1[2], v1[3]); *(u32x4*)(mp + bj * HALF) = w; } }
    }
};
struct EpiH1 {
    static constexpr bool PERM = false, AFTER_DRAIN = false;
    const float* x; float* h1; bf16_t* A2; const float* gffn; float* rowssp;
    __device__ __forceinline__ void operator()(const f32x4 (&acc)[2][2][4][2], const Unit& u, int wr, int wc, int fr, int fq) const {
        const int row0 = u.pm * BM + wr * 64 + fr, col0 = u.pn * BM + wc * 32 + 4 * fq;
        f32x4 gv[2][2];
#pragma unroll
        for (int bj = 0; bj < 2; ++bj)
#pragma unroll
            for (int n = 0; n < 2; ++n) gv[bj][n] = *(const f32x4*)(gffn + col0 + bj * HALF + n * 16);
#pragma unroll
        for (int ai = 0; ai < 2; ++ai)
#pragma unroll
            for (int m = 0; m < 4; ++m) { const int rc = row0 + ai * HALF + m * 16; float ss = 0.f;
#pragma unroll
                for (int bj = 0; bj < 2; ++bj)
#pragma unroll
                    for (int n = 0; n < 2; ++n) { const size_t off = (size_t)rc * 1024 + col0 + bj * HALF + n * 16;
                        const f32x4 h = *(const f32x4*)(x + off) + acc[ai][bj][m][n]; *(f32x4*)(h1 + off) = h;
                        ss += (h[0] * h[0] + h[1] * h[1]) + (h[2] * h[2] + h[3] * h[3]);
                        const f32x4 y = h * gv[bj][n]; u32x2 w; w.x = cvtpk(y[0], y[1]); w.y = cvtpk(y[2], y[3]); *(u32x2*)(A2 + off) = w; }
                ss += __shfl_xor(ss, 16); ss += __shfl_xor(ss, 32);
                if (fq == 0) rowssp[(size_t)rc * 16 + u.pn * 4 + wc] = ss; }
    }
};
struct EpiQ {
    static constexpr bool PERM = true, AFTER_DRAIN = false;
    bf16_t* Q; const float* rowssp;
    __device__ __forceinline__ void operator()(const f32x4 (&acc)[2][2][4][2], const Unit& u, int wr, int wc, int fr, int fq) const {
        const int row0 = u.pm * BM + wr * 64 + fr, col0 = u.pn * BM + wc * 32 + 8 * fq;
#pragma unroll
        for (int ai = 0; ai < 2; ++ai)
#pragma unroll
            for (int m = 0; m < 4; ++m) { const int rc = row0 + ai * HALF + m * 16;
                const f32x4* rp = (const f32x4*)(rowssp + (size_t)rc * 16); const f32x4 s4 = (rp[0] + rp[1]) + (rp[2] + rp[3]);
                const float rstd = __builtin_amdgcn_rsqf(((s4[0] + s4[1]) + (s4[2] + s4[3])) * (1.0f / 1024.0f) + 1e-6f);
#pragma unroll
                for (int bj = 0; bj < 2; ++bj) { const f32x4 v0 = acc[ai][bj][m][0] * rstd, v1 = acc[ai][bj][m][1] * rstd;
                    u32x4 w; w.x = cvtpk(v0[0], v0[1]); w.y = cvtpk(v0[2], v0[3]); w.z = cvtpk(v1[0], v1[1]); w.w = cvtpk(v1[2], v1[3]); *(u32x4*)(Q + (size_t)rc * 2048 + col0 + bj * HALF) = w; } }
    }
};
template <class Epi, class Sched, bool ALIGN_EPI = false, bool SP2 = false>
__device__ __forceinline__ void gemm_phase(PG8_LAS unsigned char* lds, const Gemm g, const Sched& S, const Epi& E) {
    const int tid = threadIdx.x, wid = __builtin_amdgcn_readfirstlane(tid >> 6), lane = tid & 63, wr = wid >> 2, wc = wid & 3, fr = lane & 15, fq = lane >> 4;
    const int K = g.K, nt = K / BK;
    unsigned voffA[2], voffB[2];
#pragma unroll
    for (int i = 0; i < 2; ++i) { int R, C; stage_rc(tid * 16 + i * 8192, R, C); const int Rb = Epi::PERM ? ((R & ~31) + perm32(R & 31)) : R;
        voffA[i] = (unsigned)(R * g.lda + C) * 2u; voffB[i] = (unsigned)(Rb * g.ldb + C) * 2u; }
    const size_t kstep = (size_t)(BK * 2);
    const size_t hstepA = (size_t)HALF * g.lda * 2, hstepB = (size_t)HALF * g.ldb * 2;
    const size_t tstepA = 2 * hstepA, tstepB = 2 * hstepB;
    const unsigned ldsw = (unsigned)wid * 1024u;
    const int aoff = lds_byte(wr * 64 + fr, fq * 8), boff = lds_byte(wc * 32 + fr, fq * 8);
#define PG8_SA(b, h) (((b) * 2 + (h)) * HTB)
#define PG8_SB(b, h) ((4 + (b) * 2 + (h)) * HTB)
#define PG8_STAGE(bufoff, gbase, voff) do { _Pragma("unroll") for (int _i = 0; _i < 2; ++_i) \
        __builtin_amdgcn_global_load_lds((const unsigned*)((const char*)(gbase) + (voff)[_i]), (PG8_LAS unsigned*)(lds + (bufoff) + ldsw + _i * 8192), 16, 0, 0); } while (0)
#define PG8_LDA(dst, b, h) do { _Pragma("unroll") for (int m = 0; m < 4; ++m) _Pragma("unroll") for (int k = 0; k < 2; ++k) dst[m][k] = *(const PG8_LAS bf16x8*)(lds + PG8_SA(b, h) + aoff + m * 2048 + k * 1024); } while (0)
#define PG8_LDB(dst, b, h) do { _Pragma("unroll") for (int n = 0; n < 2; ++n) _Pragma("unroll") for (int k = 0; k < 2; ++k) dst[n][k] = *(const PG8_LAS bf16x8*)(lds + PG8_SB(b, h) + boff + n * 2048 + k * 1024); } while (0)
#define PG8_MMA(ai, bj, At, Bt) do { __builtin_amdgcn_s_setprio(1); _Pragma("unroll") for (int m = 0; m < 4; ++m) _Pragma("unroll") for (int n = 0; n < 2; ++n) _Pragma("unroll") for (int k = 0; k < 2; ++k) \
        acc[ai][bj][m][n] = __builtin_amdgcn_mfma_f32_16x16x32_bf16(Bt[n][k], At[m][k], acc[ai][bj][m][n], 0, 0, 0); __builtin_amdgcn_s_setprio(0); } while (0)
#define PG8_WAIT_V(n) asm volatile("s_waitcnt vmcnt(" #n ")" ::: "memory")
#define PG8_WAIT_L(n) asm volatile("s_waitcnt lgkmcnt(" #n ")" ::: "memory")
#define PG8_BAR __builtin_amdgcn_s_barrier()
#define PG8_SCHED __builtin_amdgcn_sched_barrier(0)
    Unit cur, nxt; int ui = 0;
    if (!S.next(0, cur)) return;
    f32x4 acc[2][2][4][2];
#pragma unroll
    for (int a = 0; a < 2; ++a)
#pragma unroll
        for (int b = 0; b < 2; ++b)
#pragma unroll
            for (int m = 0; m < 4; ++m)
#pragma unroll
                for (int n = 0; n < 2; ++n) acc[a][b][m][n] = (f32x4){0.f, 0.f, 0.f, 0.f};
    bf16x8 At[4][2], B0[2][2], B1[2][2];
    const char* cA = (const char*)g.A + (size_t)cur.pm * tstepA; const char* cB = (const char*)g.Bt + (size_t)cur.pn * tstepB;
    S.a_ready(cur);
    if constexpr (SP2) {
        PG8_STAGE(PG8_SB(0, 0), cB, voffB); PG8_STAGE(PG8_SB(0, 1), cB + hstepB, voffB); PG8_STAGE(PG8_SA(0, 0), cA, voffA); PG8_STAGE(PG8_SA(0, 1), cA + hstepA, voffA);
        if (wr == 1) PG8_BAR;
        PG8_WAIT_V(2); PG8_BAR;
        PG8_STAGE(PG8_SB(1, 0), cB + kstep, voffB); PG8_STAGE(PG8_SA(1, 0), cA + kstep, voffA); PG8_STAGE(PG8_SB(1, 1), cB + hstepB + kstep, voffB);
        PG8_WAIT_V(6); PG8_BAR;
    } else {
        PG8_STAGE(PG8_SB(0, 0), cB, voffB); PG8_STAGE(PG8_SA(0, 0), cA, voffA); PG8_STAGE(PG8_SB(0, 1), cB + hstepB, voffB); PG8_STAGE(PG8_SA(0, 1), cA + hstepA, voffA);
        if (wr == 1) PG8_BAR;
        PG8_WAIT_V(4); PG8_BAR;
        PG8_STAGE(PG8_SB(1, 0), cB + kstep, voffB); PG8_STAGE(PG8_SA(1, 0), cA + kstep, voffA); PG8_STAGE(PG8_SB(1, 1), cB + hstepB + kstep, voffB);
        PG8_WAIT_V(6); PG8_BAR;
    }
    for (;;) {
        const bool has_next = S.next(ui + 1, nxt);
        const char* nA = has_next ? (const char*)g.A + (size_t)nxt.pm * tstepA : cA; const char* nB = has_next ? (const char*)g.Bt + (size_t)nxt.pn * tstepB : cB;
        for (int t = 0; t < nt; t += 2) {
            const bool last = (t == nt - 2);
            const char* a1 = cA + (size_t)(t + 1) * kstep;
            const char* a2 = last ? nA : cA + (size_t)(t + 2) * kstep; const char* b2 = last ? nB : cB + (size_t)(t + 2) * kstep;
            const char* a3 = a2 + kstep; const char* b3 = b2 + kstep;
            if (last && has_next) S.a_ready(nxt);
            if constexpr (SP2) {
            PG8_LDB(B0, 0, 0); PG8_LDB(B1, 0, 1); PG8_SCHED; PG8_LDA(At, 0, 0); PG8_STAGE(PG8_SA(1, 1), a1 + hstepA, voffA);
            PG8_WAIT_V(8); PG8_WAIT_L(0); PG8_BAR; PG8_MMA(0, 0, At, B0); PG8_MMA(0, 1, At, B1); PG8_BAR; PG8_SCHED;
            PG8_LDA(At, 0, 1); PG8_STAGE(PG8_SB(0, 0), b2, voffB); PG8_STAGE(PG8_SB(0, 1), b2 + hstepB, voffB); PG8_STAGE(PG8_SA(0, 0), a2, voffA);
            PG8_WAIT_V(8); PG8_WAIT_L(0); PG8_BAR; PG8_MMA(1, 0, At, B0); PG8_MMA(1, 1, At, B1); PG8_BAR; PG8_SCHED;
            PG8_LDB(B0, 1, 0); PG8_LDB(B1, 1, 1); PG8_SCHED; PG8_LDA(At, 1, 0); PG8_STAGE(PG8_SA(0, 1), a2 + hstepA, voffA);
            PG8_WAIT_V(8); PG8_WAIT_L(0); PG8_BAR; PG8_MMA(0, 0, At, B0); PG8_MMA(0, 1, At, B1); PG8_BAR; PG8_SCHED;
            PG8_LDA(At, 1, 1); PG8_STAGE(PG8_SB(1, 0), b3, voffB); PG8_STAGE(PG8_SB(1, 1), b3 + hstepB, voffB); PG8_STAGE(PG8_SA(1, 0), a3, voffA);
            PG8_WAIT_V(8); PG8_WAIT_L(0); PG8_BAR; PG8_MMA(1, 0, At, B0); PG8_MMA(1, 1, At, B1); PG8_BAR; PG8_SCHED;
            } else {
            PG8_LDB(B0, 0, 0); PG8_SCHED; PG8_LDA(At, 0, 0); PG8_STAGE(PG8_SA(1, 1), a1 + hstepA, voffA);
            PG8_WAIT_L(8); PG8_BAR; PG8_WAIT_L(0); PG8_MMA(0, 0, At, B0); PG8_BAR; PG8_SCHED;
            PG8_LDB(B1, 0, 1); PG8_STAGE(PG8_SB(0, 0), b2, voffB);
            PG8_BAR; PG8_WAIT_L(0); PG8_MMA(0, 1, At, B1); PG8_BAR;
            PG8_LDA(At, 0, 1); PG8_STAGE(PG8_SA(0, 0), a2, voffA);
            PG8_BAR; PG8_WAIT_L(0); PG8_MMA(1, 0, At, B0); PG8_BAR; PG8_SCHED;
            PG8_STAGE(PG8_SB(0, 1), b2 + hstepB, voffB);
            PG8_WAIT_V(6); PG8_BAR; PG8_MMA(1, 1, At, B1); PG8_BAR;
            PG8_LDB(B0, 1, 0); PG8_SCHED; PG8_LDA(At, 1, 0); PG8_STAGE(PG8_SA(0, 1), a2 + hstepA, voffA);
            PG8_WAIT_L(8); PG8_BAR; PG8_WAIT_L(0); PG8_MMA(0, 0, At, B0); PG8_BAR; PG8_SCHED;
            PG8_LDB(B1, 1, 1); PG8_STAGE(PG8_SB(1, 0), b3, voffB);
            PG8_BAR; PG8_WAIT_L(0); PG8_MMA(0, 1, At, B1); PG8_BAR;
            PG8_LDA(At, 1, 1); PG8_STAGE(PG8_SA(1, 0), a3, voffA);
            PG8_BAR; PG8_WAIT_L(0); PG8_MMA(1, 0, At, B0); PG8_BAR; PG8_SCHED;
            PG8_STAGE(PG8_SB(1, 1), b3 + hstepB, voffB);
            PG8_WAIT_V(6); PG8_BAR; PG8_MMA(1, 1, At, B1); PG8_BAR;
            }
        }
        if constexpr (ALIGN_EPI) { if (wr == 0) PG8_BAR; }
        if constexpr (!Epi::AFTER_DRAIN) { E(acc, cur, wr, wc, fr, fq); S.done(cur); }
        if (!has_next) break;
#pragma unroll
        for (int a = 0; a < 2; ++a)
#pragma unroll
            for (int b = 0; b < 2; ++b)
#pragma unroll
                for (int m = 0; m < 4; ++m)
#pragma unroll
                    for (int n = 0; n < 2; ++n) acc[a][b][m][n] = (f32x4){0.f, 0.f, 0.f, 0.f};
        cur = nxt; cA = nA; cB = nB; ++ui;
        if constexpr (ALIGN_EPI) { if (wr == 1) PG8_BAR; }
    }
    PG8_WAIT_V(0);
    if constexpr (!ALIGN_EPI) { if (wr == 0) PG8_BAR; }
    PG8_BAR;
    if constexpr (Epi::AFTER_DRAIN) { E.fused(acc, cur, wr, wc, fr, fq, lds, wid, lane); S.done(cur); }
#undef PG8_SA
#undef PG8_SB
#undef PG8_STAGE
#undef PG8_LDA
#undef PG8_LDB
#undef PG8_MMA
#undef PG8_WAIT_V
#undef PG8_WAIT_L
#undef PG8_BAR
#undef PG8_SCHED
}
}
using pg8::bf16_t; using pg8::bf16x8; using pg8::f32x4; using pg8::u32x4; using pg8::u32x2; using pg8::cvtpk; using pg8::f2bf; using pg8::bf2f; using pg8::bflo; using pg8::bfhi; using pg8::sigm;
#define LAS __attribute__((address_space(3)))
typedef float f32x16 __attribute__((ext_vector_type(16)));
#define MFMA32(a, b, c) __builtin_amdgcn_mfma_f32_32x32x16_bf16((a), (b), (c), 0, 0, 0)

constexpr size_t MiB = 1u << 20;
constexpr size_t WS_ZH = 0;
constexpr size_t WS_MB = WS_ZH, WS_U16 = WS_ZH + 64 * MiB, WS_V16 = WS_ZH + 96 * MiB;
constexpr size_t WS_ZA = 129 * MiB;
constexpr size_t WS_ZG = 178 * MiB;
constexpr size_t WS_QB = WS_ZG;
constexpr size_t WS_A1 = 307 * MiB;
constexpr size_t WS_OM = WS_A1, WS_A2 = WS_A1;
constexpr size_t WS_UB = 372 * MiB;
constexpr size_t WS_DV = 436 * MiB;
constexpr size_t WS_VT = 437 * MiB;
constexpr size_t WS_WIN = 446 * MiB;
constexpr size_t WS_WBH = 456 * MiB, WS_WBA = 457 * MiB, WS_WOUT = 458 * MiB, WS_WQ = 460 * MiB, WS_SK = 464 * MiB;
constexpr size_t WS_RS = 465 * MiB;
constexpr size_t WS_END = 467 * MiB;
constexpr int LDS_BYTES = 147456;

__device__ __forceinline__ float wave_sum(float v) {
#pragma unroll
    for (int o = 1; o < 64; o <<= 1) v += __shfl_xor(v, o);
    return v;
}
__device__ __forceinline__ void p0_transpose_item(const float* __restrict__ W, int K, int N, bf16_t* __restrict__ WT, LAS float* scr, int item, int lane) {
    const int nblk = N / 32, kb = item / nblk, nb = item % nblk, k0 = 64 * kb, n0 = 32 * nb;
#pragma unroll 8
    for (int i = 0; i < 32; ++i) { const int kk = 2 * i + (lane >> 5); scr[kk * 33 + (lane & 31)] = W[(size_t)(k0 + kk) * N + n0 + (lane & 31)]; }
    asm volatile("s_waitcnt lgkmcnt(0)" ::: "memory");
    const int c = lane & 7;
#pragma unroll
    for (int j = 0; j < 4; ++j) { const int n = (lane >> 3) + 8 * j; const LAS float* s = scr + (8 * c) * 33 + n;
        u32x4 o; o.x = cvtpk(s[0 * 33], s[1 * 33]); o.y = cvtpk(s[2 * 33], s[3 * 33]); o.z = cvtpk(s[4 * 33], s[5 * 33]); o.w = cvtpk(s[6 * 33], s[7 * 33]);
        *(u32x4*)(WT + (size_t)(n0 + n) * K + k0 + 8 * c) = o; }
    asm volatile("s_waitcnt lgkmcnt(0)" ::: "memory");
}
struct P0Args { const float *x, *meta, *gmix, *w_in, *w_bh, *w_ba, *w_out, *w_q, *subk; bf16_t *A1, *WinT, *WbhT, *WbaT, *WoutT, *WqT, *SK; };
__device__ __forceinline__ void p0_prologue(LAS unsigned char* lds, const P0Args& p) {
    const int tid = threadIdx.x, lane = tid & 63, wave = tid >> 6;
    LAS float* scr = (LAS float*)(lds + wave * 16384);
    const int gw = blockIdx.x * 8 + wave, NGW = gridDim.x * 8;
    constexpr int I_IN = 16 * 152, I_B = 8 * 32, I_O = 16 * 32, I_Q = 16 * 64, NITEMS = I_IN + 2 * I_B + I_O + I_Q;
    for (int it = gw; it < NITEMS; it += NGW) {
        int r = it;
        if (r < I_IN) { p0_transpose_item(p.w_in, 1024, 4864, p.WinT, scr, r, lane); continue; } r -= I_IN;
        if (r < I_B) { p0_transpose_item(p.w_bh, 512, 1024, p.WbhT, scr, r, lane); continue; } r -= I_B;
        if (r < I_B) { p0_transpose_item(p.w_ba, 512, 1024, p.WbaT, scr, r, lane); continue; } r -= I_B;
        if (r < I_O) { p0_transpose_item(p.w_out, 1024, 1024, p.WoutT, scr, r, lane); continue; } r -= I_O;
        p0_transpose_item(p.w_q, 1024, 2048, p.WqT, scr, r, lane);
    }
    for (int i = blockIdx.x * 512 + tid; i < 262144 / 8; i += gridDim.x * 512) {
        const f32x4 a = *(const f32x4*)(p.subk + (size_t)i * 8), b = *(const f32x4*)(p.subk + (size_t)i * 8 + 4);
        u32x4 o; o.x = cvtpk(a[0], a[1]); o.y = cvtpk(a[2], a[3]); o.z = cvtpk(b[0], b[1]); o.w = cvtpk(b[2], b[3]); *(u32x4*)(p.SK + (size_t)i * 8) = o; }
    f32x4 g[4];
#pragma unroll
    for (int j = 0; j < 4; ++j) g[j] = *((const f32x4*)p.gmix + lane + 64 * j);
    for (int m = gw; m < MA; m += NGW) {
        unsigned long long* o8 = (unsigned long long*)(p.A1 + (size_t)m * 1024) + lane;
        if (m >= MA_REAL) {
#pragma unroll
            for (int j = 0; j < 4; ++j) o8[64 * j] = 0ull;
            continue; }
        const int b = m / LTOK, pos = m - b * LTOK;
        const float* src = pos < NMETA ? p.meta + (size_t)pos * 1024 : p.x + ((size_t)b * SEQ + (pos - NMETA)) * 1024;
        const f32x4* xr = (const f32x4*)src + lane; f32x4 v[4]; float s = 0.f;
#pragma unroll
        for (int j = 0; j < 4; ++j) { v[j] = xr[64 * j]; s += (v[j][0] * v[j][0] + v[j][1] * v[j][1]) + (v[j][2] * v[j][2] + v[j][3] * v[j][3]); }
        const float rstd = 1.f / sqrtf(wave_sum(s) * (1.f / 1024.f) + EPS);
#pragma unroll
        for (int j = 0; j < 4; ++j) { const f32x4 y = v[j] * rstd * g[j]; o8[64 * j] = (unsigned long long)cvtpk(y[0], y[1]) | ((unsigned long long)cvtpk(y[2], y[3]) << 32); }
    }
}

constexpr int SR = 272;
constexpr int OFF_Q = 0, OFF_K = 34816, OFF_V = 69632, OFF_S = 104448, OFF_VEC = 139264;
__device__ __forceinline__ bf16x8 ldfrag(const LAS unsigned char* base, int row, int kk8, int h2) { return *(const LAS bf16x8*)(base + row * SR + (kk8 * 16 + 8 * h2) * 2); }

template <bool WITH_Q>
__device__ __forceinline__ void hgrn_front(LAS unsigned char* lds, const bf16_t* __restrict__ Zh, const float* __restrict__ lblog, int b, int h, int c, float (&cs)[32], float (&kk)[32], float (&qq)[32], unsigned (&vv)[16]) {
    const int tid = threadIdx.x, d = tid & 127, seg = tid >> 7;
    const float lb = sigm(lblog[h * 128 + d] - lblog[512 + h * 128 + d]);
    LAS float* segtot = (LAS float*)(lds + OFF_VEC);
    float run = 0.f;
#pragma unroll
    for (int i = 0; i < 32; ++i) {
        const int pos = 128 * c - 112 + 32 * seg + i; const bool valid = pos >= 0;
        const bf16_t* zr = Zh + (size_t)(b * LTOK + (valid ? pos : 0)) * 2048 + h * 128 + d;
        const float hf = bf2f(zr[512]); const float sg = sigm(hf);
        const float f = lb + (1.f - lb) * sg;
        const float lf = valid ? __logf(f) : 0.f;
        kk[i] = valid ? (1.f - lb) * (1.f - sg) : 0.f;
        run += lf; cs[i] = run;
        if (WITH_Q) qq[i] = valid ? bf2f(zr[0]) : 0.f;
        const unsigned vb = valid ? (unsigned)zr[1024] : 0u;
        if (i & 1) vv[i >> 1] |= vb << 16; else vv[i >> 1] = vb;
    }
    segtot[seg * 128 + d] = run;
    __syncthreads();
}

__device__ __forceinline__ void hgrn_A(LAS unsigned char* lds, const bf16_t* __restrict__ Zh, const float* __restrict__ lblog, float* __restrict__ Ub, float* __restrict__ Dv, int item) {
    const int tid = threadIdx.x, lane = tid & 63, wid = tid >> 6, r32 = lane & 31, h2 = lane >> 5;
    const int c = item & 31, bh = item >> 5, b = bh >> 2, h = bh & 3;
    const int d = tid & 127, seg = tid >> 7;
    float cs[32], kk[32], qq[32]; unsigned vv[16];
    hgrn_front<false>(lds, Zh, lblog, b, h, c, cs, kk, qq, vv);
    const LAS float* segtot = (const LAS float*)(lds + OFF_VEC);
    { const float s0 = segtot[d], s1 = segtot[128 + d], s2 = segtot[256 + d];
      const float off = seg == 0 ? 0.f : seg == 1 ? s0 : seg == 2 ? s0 + s1 : s0 + s1 + s2; const float aref = s0 + s1;
      unsigned kw[16];
#pragma unroll
      for (int i = 0; i < 16; ++i) kw[i] = cvtpk(kk[2 * i] * __expf(aref - (off + cs[2 * i])), kk[2 * i + 1] * __expf(aref - (off + cs[2 * i + 1])));
      LAS u32x4* kd = (LAS u32x4*)(lds + OFF_K + d * SR + seg * 64); LAS u32x4* vd = (LAS u32x4*)(lds + OFF_V + d * SR + seg * 64);
#pragma unroll
      for (int i = 0; i < 4; ++i) { kd[i] = (u32x4){kw[4 * i], kw[4 * i + 1], kw[4 * i + 2], kw[4 * i + 3]}; vd[i] = (u32x4){vv[4 * i], vv[4 * i + 1], vv[4 * i + 2], vv[4 * i + 3]}; } }
    __syncthreads();
    const int e0 = 32 * (wid >> 1), d0 = 64 * (wid & 1);
    f32x16 acc[2]; acc[0] = f32x16{}; acc[1] = f32x16{};
#pragma unroll
    for (int k8 = 0; k8 < 8; ++k8) { const bf16x8 a = ldfrag(lds + OFF_V, e0 + r32, k8, h2);
#pragma unroll
        for (int j = 0; j < 2; ++j) acc[j] = MFMA32(a, ldfrag(lds + OFF_K, d0 + 32 * j + r32, k8, h2), acc[j]); }
#pragma unroll
    for (int j = 0; j < 2; ++j) { const int dc = d0 + 32 * j + r32; const float sc = __expf(segtot[256 + dc] + segtot[384 + dc]);
        float* up = Ub + ((size_t)item * 128 + e0 + 4 * h2) * 128 + dc;
#pragma unroll
        for (int r = 0; r < 16; ++r) up[(size_t)((r & 3) + 8 * (r >> 2)) * 128] = acc[j][r] * sc; }
    if (tid < 128) Dv[(size_t)item * 128 + tid] = __expf((segtot[tid] + segtot[128 + tid]) + (segtot[256 + tid] + segtot[384 + tid]));
    __syncthreads();
}

__device__ __forceinline__ void hgrn_C(LAS unsigned char* lds, const bf16_t* __restrict__ Zh, const float* __restrict__ lblog, const float* __restrict__ Ub, const float* __restrict__ hgn, bf16_t* __restrict__ OM, int item) {
    const int tid = threadIdx.x, lane = tid & 63, wid = tid >> 6, r32 = lane & 31, h2 = lane >> 5;
    const int c = (item & 31) + 1, bh = item >> 5, b = bh >> 2, h = bh & 3;
    const int d = tid & 127, seg = tid >> 7;
    float cs[32], kk[32], qq[32]; unsigned vv[16];
    hgrn_front<true>(lds, Zh, lblog, b, h, c, cs, kk, qq, vv);
    const LAS float* segtot = (const LAS float*)(lds + OFF_VEC);
    { const float s0 = segtot[d], s1 = segtot[128 + d], s2 = segtot[256 + d];
      const float off = seg == 0 ? 0.f : seg == 1 ? s0 : seg == 2 ? s0 + s1 : s0 + s1 + s2; const float aref = s0 + s1;
      LAS bf16_t* qd = (LAS bf16_t*)(lds + OFF_Q + (32 * seg) * SR + d * 2); LAS bf16_t* kd = (LAS bf16_t*)(lds + OFF_K + (32 * seg) * SR + d * 2);
#pragma unroll
      for (int i = 0; i < 32; ++i) { const float a = off + cs[i]; qd[i * (SR / 2)] = f2bf(qq[i] * __expf(a - aref)); kd[i * (SR / 2)] = f2bf(kk[i] * __expf(aref - a)); }
      LAS u32x4* vd = (LAS u32x4*)(lds + OFF_V + d * SR + seg * 64);
#pragma unroll
      for (int i = 0; i < 4; ++i) vd[i] = (u32x4){vv[4 * i], vv[4 * i + 1], vv[4 * i + 2], vv[4 * i + 3]}; }
    { const float* sp = Ub + (size_t)item * 16384;
#pragma unroll 4
      for (int idx = tid; idx < 4096; idx += 512) { const int e = idx >> 5, d4 = (idx & 31) * 4; const f32x4 s = *(const f32x4*)(sp + e * 128 + d4);
          const f32x4 t0 = *(const LAS f32x4*)(segtot + d4), t1 = *(const LAS f32x4*)(segtot + 128 + d4);
          u32x2 w; w.x = cvtpk(s[0] * __expf(t0[0] + t1[0]), s[1] * __expf(t0[1] + t1[1])); w.y = cvtpk(s[2] * __expf(t0[2] + t1[2]), s[3] * __expf(t0[3] + t1[3]));
          *(LAS u32x2*)(lds + OFF_S + e * SR + d4 * 2) = w; } }
    __syncthreads();
    const int tb = wid >> 1, wh = wid & 1;
    f32x16 sc[2]; sc[0] = f32x16{}; sc[1] = f32x16{};
#pragma unroll
    for (int j = 0; j < 2; ++j) { const int sb = 2 * wh + j;
        if (sb <= tb) {
#pragma unroll
            for (int k8 = 0; k8 < 8; ++k8) sc[j] = MFMA32(ldfrag(lds + OFF_K, 32 * sb + r32, k8, h2), ldfrag(lds + OFF_Q, 32 * tb + r32, k8, h2), sc[j]); } }
    __syncthreads();
    { const int t = 32 * tb + r32;
#pragma unroll
      for (int j = 0; j < 2; ++j) { const int sb = 2 * wh + j;
#pragma unroll
          for (int g = 0; g < 4; ++g) { const int s = 32 * sb + 8 * g + 4 * h2;
              const float p0 = (sb <= tb && s + 0 <= t) ? sc[j][4 * g + 0] : 0.f, p1 = (sb <= tb && s + 1 <= t) ? sc[j][4 * g + 1] : 0.f;
              const float p2 = (sb <= tb && s + 2 <= t) ? sc[j][4 * g + 2] : 0.f, p3 = (sb <= tb && s + 3 <= t) ? sc[j][4 * g + 3] : 0.f;
              u32x2 w; w.x = cvtpk(p0, p1); w.y = cvtpk(p2, p3); *(LAS u32x2*)(lds + OFF_K + t * SR + s * 2) = w; } } }
    __syncthreads();
    f32x16 oc[2]; oc[0] = f32x16{}; oc[1] = f32x16{};
    for (int k8 = 0; k8 < 2 * (tb + 1); ++k8) { const bf16x8 pb = ldfrag(lds + OFF_K, 32 * tb + r32, k8, h2);
#pragma unroll
        for (int j = 0; j < 2; ++j) oc[j] = MFMA32(ldfrag(lds + OFF_V, 64 * wh + 32 * j + r32, k8, h2), pb, oc[j]); }
#pragma unroll
    for (int k8 = 0; k8 < 8; ++k8) { const bf16x8 qb = ldfrag(lds + OFF_Q, 32 * tb + r32, k8, h2);
#pragma unroll
        for (int j = 0; j < 2; ++j) oc[j] = MFMA32(ldfrag(lds + OFF_S, 64 * wh + 32 * j + r32, k8, h2), qb, oc[j]); }
    LAS float* ssq = (LAS float*)(lds + OFF_VEC + 2048);
    { float ss = 0.f;
#pragma unroll
      for (int j = 0; j < 2; ++j)
#pragma unroll
          for (int r = 0; r < 16; ++r) ss += oc[j][r] * oc[j][r];
      ss += __shfl_xor(ss, 32);
      if (h2 == 0) ssq[wh * 128 + 32 * tb + r32] = ss; }
    __syncthreads();
    { const int t = 32 * tb + r32; const float rstd = 1.f / sqrtf((ssq[t] + ssq[128 + t]) * (1.f / 128.f) + EPS);
      const size_t rc = (size_t)b * SEQ + 128 * (c - 1) + t, ra = (size_t)b * LTOK + 128 * c - 112 + t;
#pragma unroll
      for (int j = 0; j < 2; ++j)
#pragma unroll
          for (int g = 0; g < 4; ++g) { const int e = 64 * wh + 32 * j + 8 * g + 4 * h2;
              const u32x2 gt = *(const u32x2*)(Zh + ra * 2048 + 1536 + h * 128 + e); const f32x4 gn = *(const f32x4*)(hgn + h * 128 + e);
              const float g0 = bflo(gt.x), g1 = bfhi(gt.x), g2 = bflo(gt.y), g3 = bfhi(gt.y);
              const float o0 = oc[j][4 * g + 0] * rstd * gn[0] * (g0 * sigm(g0)), o1 = oc[j][4 * g + 1] * rstd * gn[1] * (g1 * sigm(g1));
              const float o2 = oc[j][4 * g + 2] * rstd * gn[2] * (g2 * sigm(g2)), o3 = oc[j][4 * g + 3] * rstd * gn[3] * (g3 * sigm(g3));
              u32x2 w; w.x = cvtpk(o0, o1); w.y = cvtpk(o2, o3); *(u32x2*)(OM + rc * 1024 + h * 128 + e) = w; } }
    __syncthreads();
}

__device__ __forceinline__ void hgrn_scan(float* __restrict__ Ub, const float* __restrict__ Dv) {
    for (int v = blockIdx.x * 512 + threadIdx.x; v < 32 * 4096; v += gridDim.x * 512) {
        const int bh = v >> 12, i4 = v & 4095, e = i4 >> 5, d4 = (i4 & 31) * 4;
        f32x4 S = (f32x4){0.f, 0.f, 0.f, 0.f};
#pragma unroll 4
        for (int c = 0; c < 32; ++c) { const int item = bh * 32 + c; f32x4* up = (f32x4*)(Ub + ((size_t)item * 128 + e) * 128 + d4);
            const f32x4 dv = *(const f32x4*)(Dv + (size_t)item * 128 + d4); S = dv * S + *up; *up = S; }
    }
}

__device__ __forceinline__ f32x16 attn_tile(const bf16_t* __restrict__ kp, const bf16x8 (&qf)[4], int T, bool meta, int pq, int h2) {
    f32x16 S = f32x16{};
#pragma unroll
    for (int k = 0; k < 4; ++k) S = MFMA32(*(const bf16x8*)(kp + 16 * k), qf[k], S);
#pragma unroll
    for (int r = 0; r < 16; ++r) { const int kr = (r & 3) + 8 * (r >> 2) + 4 * h2; const int pk = 32 * T + kr;
        const bool ok = meta ? (kr < 16) : ((pk <= pq) && (pq - pk < 128));
        S[r] = ok ? S[r] * 0.125f : -INFINITY; }
    return S;
}
__device__ __forceinline__ void attn_sub(const bf16_t* __restrict__ Za, const bf16_t* __restrict__ Vt, const float* __restrict__ sinks, bf16_t* __restrict__ OM, int b, int n, int qh, int sb, int lane) {
    const int r32 = lane & 31, h2 = lane >> 5, kvh = qh >> 2;
    const int pq = 128 * n + 32 * sb + r32;
    const bf16_t* qp = Za + (size_t)(b * LTOK + pq - 112) * 768 + qh * 64 + 8 * h2;
    bf16x8 qf[4];
#pragma unroll
    for (int k = 0; k < 4; ++k) qf[k] = *(const bf16x8*)(qp + 16 * k);
    const int T0 = 4 * n + sb - 4;
    const int Tlo = T0 < 4 ? 4 : T0, Thi = T0 + 4;
    const bf16_t* kbase = Za + (size_t)(b * LTOK + r32 - 112) * 768 + 512 + kvh * 64 + 8 * h2;
    const bf16_t* kmeta = Za + (size_t)(b * LTOK + r32) * 768 + 512 + kvh * 64 + 8 * h2;
    const float sink = sinks[qh];
    float mx = sink;
#pragma unroll 1
    for (int T = Tlo; T <= Thi; ++T) { const f32x16 S = attn_tile(kbase + (size_t)T * (32 * 768), qf, T, false, pq, h2);
#pragma unroll
        for (int r = 0; r < 16; ++r) mx = fmaxf(mx, S[r]); }
    { const f32x16 S = attn_tile(kmeta, qf, 0, true, pq, h2);
#pragma unroll
        for (int r = 0; r < 16; ++r) mx = fmaxf(mx, S[r]); }
    mx = fmaxf(mx, __shfl_xor(mx, 32));
    float l = 0.f;
    f32x16 O[2]; O[0] = f32x16{}; O[1] = f32x16{};
    const bf16_t* vbase = Vt + (size_t)(b * 128 + kvh * 64 + r32) * LPAD + 4 * h2;
#pragma unroll 1
    for (int T = Tlo; T <= Thi + 1; ++T) {
        const bool meta = T > Thi;
        f32x16 S = attn_tile(meta ? kmeta : kbase + (size_t)T * (32 * 768), qf, T, meta, pq, h2);
#pragma unroll
        for (int r = 0; r < 16; ++r) { S[r] = __expf(S[r] - mx); l += S[r]; }
        const int kb0 = meta ? 112 : 32 * T;
#pragma unroll
        for (int s2 = 0; s2 < 2; ++s2) {
            u32x4 pw; pw.x = cvtpk(S[8 * s2 + 0], S[8 * s2 + 1]); pw.y = cvtpk(S[8 * s2 + 2], S[8 * s2 + 3]); pw.z = cvtpk(S[8 * s2 + 4], S[8 * s2 + 5]); pw.w = cvtpk(S[8 * s2 + 6], S[8 * s2 + 7]);
            const bf16x8 pb = __builtin_bit_cast(bf16x8, pw);
#pragma unroll
            for (int db = 0; db < 2; ++db) { const bf16_t* vp = vbase + (size_t)(32 * db) * LPAD + kb0 + 16 * s2;
                const u32x2 lo = *(const u32x2*)vp, hi = *(const u32x2*)(vp + 8);
                const u32x4 aw = (u32x4){lo.x, lo.y, hi.x, hi.y};
                O[db] = MFMA32(__builtin_bit_cast(bf16x8, aw), pb, O[db]); } } }
    l += __shfl_xor(l, 32); l += __expf(sink - mx);
    const float inv = 1.f / l;
    bf16_t* op = OM + ((size_t)b * SEQ + 128 * (n - 1) + 32 * sb + r32) * 1024 + 512 + qh * 64 + 4 * h2;
#pragma unroll
    for (int db = 0; db < 2; ++db)
#pragma unroll
        for (int g = 0; g < 4; ++g) { u32x2 w; w.x = cvtpk(O[db][4 * g] * inv, O[db][4 * g + 1] * inv); w.y = cvtpk(O[db][4 * g + 2] * inv, O[db][4 * g + 3] * inv);
            *(u32x2*)(op + 32 * db + 8 * g) = w; }
}
__device__ __forceinline__ unsigned f2ord(float f) { const unsigned u = __float_as_uint(f); return (u & 0x80000000u) ? ~u : (u | 0x80000000u); }
__device__ __forceinline__ float ord2f(unsigned u) { return __uint_as_float((u & 0x80000000u) ? (u & 0x7fffffffu) : ~u); }
__device__ __forceinline__ unsigned umax_(unsigned a, unsigned b) { return a > b ? a : b; }
__device__ __forceinline__ unsigned umin_(unsigned a, unsigned b) { return a < b ? a : b; }
template <int N> __device__ __forceinline__ void bitonic_desc(unsigned (&a)[N]) {
#pragma unroll
    for (int k = 2; k <= N; k <<= 1)
#pragma unroll
        for (int j = k >> 1; j > 0; j >>= 1)
#pragma unroll
            for (int i = 0; i < N; ++i) { const int l = i ^ j;
                if (l > i) { const unsigned hi = umax_(a[i], a[l]), lo = umin_(a[i], a[l]); if ((i & k) == 0) { a[i] = hi; a[l] = lo; } else { a[i] = lo; a[l] = hi; } } }
}
__device__ __forceinline__ void merge_top16(unsigned (&a)[16], const unsigned (&b)[16]) {
#pragma unroll
    for (int i = 0; i < 16; ++i) a[i] = umax_(a[i], b[15 - i]);
#pragma unroll
    for (int j = 8; j > 0; j >>= 1)
#pragma unroll
        for (int i = 0; i < 16; ++i) { const int l = i ^ j; if (l > i) { const unsigned hi = umax_(a[i], a[l]), lo = umin_(a[i], a[l]); a[i] = hi; a[l] = lo; } }
}
template <bool PAIR> __device__ __forceinline__ void top16_of(unsigned (&g)[4][16]) {
    bitonic_desc<16>(g[0]); bitonic_desc<16>(g[1]); bitonic_desc<16>(g[2]); bitonic_desc<16>(g[3]);
    merge_top16(g[0], g[1]); merge_top16(g[2], g[3]); merge_top16(g[0], g[2]);
    if (PAIR) { unsigned o[16];
#pragma unroll
        for (int i = 0; i < 16; ++i) o[i] = (unsigned)__shfl_xor((int)g[0][i], 32);
        merge_top16(g[0], o); }
}
__device__ __forceinline__ unsigned sel16p(unsigned long long lo, unsigned long long hi, int i) { const unsigned long long w = (i & 8) ? hi : lo; return (unsigned)(w >> ((i & 7) * 8)) & 0x7fu; }
struct CandTab { unsigned char i[50], j[50]; int n; };
constexpr CandTab make_cands() { CandTab t{}; int n = 0; for (int i = 0; i < 16; ++i) for (int j = 0; j < 16; ++j) if ((i + 1) * (j + 1) <= 16) { t.i[n] = (unsigned char)i; t.j[n] = (unsigned char)j; ++n; } t.n = n; return t; }
constexpr CandTab CT = make_cands();
static_assert(CT.n == 50, "candidate count");

constexpr int PL_IDX = 0, PL_G = 32768;
__device__ __forceinline__ void peer_list(const bf16_t* __restrict__ Qb, const bf16_t* __restrict__ SK, int rc0, int h, int c, int r32, int h2, unsigned (&top)[16]) {
    const bf16_t* qp = Qb + (size_t)(rc0 + r32) * 2048 + h * 256 + c * 128 + 8 * h2;
    bf16x8 qf[8];
#pragma unroll
    for (int k = 0; k < 8; ++k) qf[k] = *(const bf16x8*)(qp + 16 * k);
    unsigned g[4][16];
#pragma unroll
    for (int nb = 0; nb < 4; ++nb) {
        const bf16_t* kp = SK + (size_t)((h * 2 + c) * 128 + 32 * nb + r32) * 128 + 8 * h2;
        f32x16 acc = f32x16{};
#pragma unroll
        for (int k = 0; k < 8; ++k) acc = MFMA32(*(const bf16x8*)(kp + 16 * k), qf[k], acc);
#pragma unroll
        for (int r = 0; r < 16; ++r) g[nb][r] = (f2ord(acc[r]) & 0xffffff80u) | (unsigned)(32 * nb + (r & 3) + 8 * (r >> 2) + 4 * h2);
    }
    top16_of<true>(g);
#pragma unroll
    for (int k = 0; k < 16; ++k) top[k] = g[0][k];
}
__device__ __forceinline__ void peer_topk(LAS unsigned char* lds, const bf16_t* __restrict__ Qb, const bf16_t* __restrict__ SK, int rc0, int tl0, int h0, int lane) {
    const int r32 = lane & 31, h2 = lane >> 5;
#pragma unroll 1
    for (int hh = 0; hh < 4; ++hh) {
        const int h = h0 + hh;
        unsigned ta[16], tb[16];
        peer_list(Qb, SK, rc0, h, 0, r32, h2, ta);
        peer_list(Qb, SK, rc0, h, 1, r32, h2, tb);
        float av[16], bv[16]; unsigned long long ail = 0, aih = 0, bil = 0, bih = 0;
#pragma unroll
        for (int k = 0; k < 16; ++k) { av[k] = ord2f(ta[k] & 0xffffff80u); bv[k] = ord2f(tb[k] & 0xffffff80u);
            if (k < 8) { ail |= (unsigned long long)(ta[k] & 0x7fu) << (8 * k); bil |= (unsigned long long)(tb[k] & 0x7fu) << (8 * k); }
            else { aih |= (unsigned long long)(ta[k] & 0x7fu) << (8 * (k - 8)); bih |= (unsigned long long)(tb[k] & 0x7fu) << (8 * (k - 8)); } }
        unsigned k2[4][16];
#pragma unroll
        for (int k = 0; k < 64; ++k) { if (k < 50) k2[k >> 4][k & 15] = (f2ord(av[CT.i[k < 50 ? k : 0]] + bv[CT.j[k < 50 ? k : 0]]) & 0xffffff00u) | (unsigned)(CT.i[k < 50 ? k : 0] * 16 + CT.j[k < 50 ? k : 0]); else k2[k >> 4][k & 15] = 0u; }
        top16_of<false>(k2);
        float ev[16]; float es = 0.f; const float m0 = ord2f(k2[0][0] & 0xffffff00u);
#pragma unroll
        for (int k = 0; k < 16; ++k) { ev[k] = __expf(ord2f(k2[0][k] & 0xffffff00u) - m0); es += ev[k]; }
        const float inv = 1.f / es;
        LAS unsigned short* ip = (LAS unsigned short*)(lds + PL_IDX) + (tl0 + r32) * 128 + h * 16;
        LAS float* gp = (LAS float*)(lds + PL_G) + (tl0 + r32) * 128 + h * 16;
#pragma unroll
        for (int k = 0; k < 16; ++k) { const int code = (int)(k2[0][k] & 0xffu); const unsigned e = sel16p(ail, aih, code >> 4) * 128u + sel16p(bil, bih, code & 15);
            if ((k >> 3) == h2) { ip[k] = (unsigned short)e; gp[k] = ev[k] * inv; } }
    }
}
__device__ __forceinline__ float dot2bf(unsigned w, unsigned x, float acc) { return __builtin_amdgcn_fdot2_f32_bf16(__builtin_bit_cast(pg8::bf16x2_t, w), __builtin_bit_cast(pg8::bf16x2_t, x), acc, false); }
__device__ __forceinline__ void peer_token(LAS unsigned char* lds, int tl, size_t rc, const bf16_t* __restrict__ A2, const float* __restrict__ rowssp, const bf16_t* __restrict__ U16, const bf16_t* __restrict__ V16,
                                           float* __restrict__ dout, const float* __restrict__ gfin, int lane) {
    const u32x4 xa = *(const u32x4*)(A2 + rc * 1024 + 8 * lane), xb = *(const u32x4*)(A2 + rc * 1024 + 512 + 8 * lane);
    float rs = rowssp[rc * 16 + (lane & 15)];
    rs += __shfl_xor(rs, 1); rs += __shfl_xor(rs, 2); rs += __shfl_xor(rs, 4); rs += __shfl_xor(rs, 8);
    const float rstd = 1.f / sqrtf(rs * (1.f / 1024.f) + EPS);
    float out[16];
#pragma unroll
    for (int i = 0; i < 16; ++i) out[i] = 0.f;
    const LAS unsigned short* ip = (const LAS unsigned short*)(lds + PL_IDX) + tl * 128;
    const LAS float* gp = (const LAS float*)(lds + PL_G) + tl * 128;
    const bool b5 = lane & 32, b4 = lane & 16, b3 = lane & 8;
    for (int bt = 0; bt < 16; ++bt) {
        unsigned e[8];
#pragma unroll
        for (int j = 0; j < 8; ++j) e[j] = ip[bt * 8 + j];
        u32x4 ua[8], ub[8];
#pragma unroll
        for (int j = 0; j < 8; ++j) { const bf16_t* up = U16 + (size_t)e[j] * 1024 + 8 * lane; ua[j] = *(const u32x4*)up; ub[j] = *(const u32x4*)(up + 512); }
        float p[8];
#pragma unroll
        for (int j = 0; j < 8; ++j) { float s = dot2bf(ua[j].x, xa.x, 0.f); s = dot2bf(ua[j].y, xa.y, s); s = dot2bf(ua[j].z, xa.z, s); s = dot2bf(ua[j].w, xa.w, s);
            s = dot2bf(ub[j].x, xb.x, s); s = dot2bf(ub[j].y, xb.y, s); s = dot2bf(ub[j].z, xb.z, s); s = dot2bf(ub[j].w, xb.w, s); p[j] = s; }
#pragma unroll
        for (int j = 0; j < 4; ++j) { const float keep = b5 ? p[j + 4] : p[j], send = b5 ? p[j] : p[j + 4]; p[j] = keep + __shfl_xor(send, 32); }
#pragma unroll
        for (int j = 0; j < 2; ++j) { const float keep = b4 ? p[j + 2] : p[j], send = b4 ? p[j] : p[j + 2]; p[j] = keep + __shfl_xor(send, 16); }
        { const float keep = b3 ? p[1] : p[0], send = b3 ? p[0] : p[1]; p[0] = keep + __shfl_xor(send, 8); }
        float dv = p[0]; dv += __shfl_xor(dv, 4); dv += __shfl_xor(dv, 2); dv += __shfl_xor(dv, 1);
        const float z = dv * rstd; const float a = 0.5f * z * (1.f + erff(z * 0.70710678118654752f));
        const float wv = gp[bt * 8 + (lane >> 3)] * a;
#pragma unroll
        for (int j = 0; j < 8; ++j) { const bf16_t* vp = V16 + (size_t)e[j] * 1024 + 8 * lane; const u32x4 va = *(const u32x4*)vp, vb = *(const u32x4*)(vp + 512);
            const float w = __shfl(wv, 8 * j);
            out[0] += w * bflo(va.x); out[1] += w * bfhi(va.x); out[2] += w * bflo(va.y); out[3] += w * bfhi(va.y); out[4] += w * bflo(va.z); out[5] += w * bfhi(va.z); out[6] += w * bflo(va.w); out[7] += w * bfhi(va.w);
            out[8] += w * bflo(vb.x); out[9] += w * bfhi(vb.x); out[10] += w * bflo(vb.y); out[11] += w * bfhi(vb.y); out[12] += w * bflo(vb.z); out[13] += w * bfhi(vb.z); out[14] += w * bflo(vb.w); out[15] += w * bfhi(vb.w); }
    }
    float* hp = dout + rc * 1024 + 8 * lane;
    f32x4 h[4]; h[0] = *(const f32x4*)hp; h[1] = *(const f32x4*)(hp + 4); h[2] = *(const f32x4*)(hp + 512); h[3] = *(const f32x4*)(hp + 516);
    float ss = 0.f;
#pragma unroll
    for (int q = 0; q < 4; ++q)
#pragma unroll
        for (int i = 0; i < 4; ++i) { h[q][i] += out[4 * q + i]; ss += h[q][i] * h[q][i]; }
    ss = wave_sum(ss);
    const float rf = 1.f / sqrtf(ss * (1.f / 1024.f) + EPS);
    const float* gq = gfin + 8 * lane;
    *(f32x4*)hp = h[0] * rf * *(const f32x4*)gq; *(f32x4*)(hp + 4) = h[1] * rf * *(const f32x4*)(gq + 4);
    *(f32x4*)(hp + 512) = h[2] * rf * *(const f32x4*)(gq + 512); *(f32x4*)(hp + 516) = h[3] * rf * *(const f32x4*)(gq + 516);
}

constexpr int NPHASE = 9;
struct Args { const float* in[17]; float* out; unsigned char* ws; int ph_lo, ph_hi; };
__global__ void __launch_bounds__(512, 2) fwd_kernel(Args a) {
    extern __shared__ __attribute__((aligned(16))) unsigned char lds_raw[];
    LAS unsigned char* lds = (LAS unsigned char*)lds_raw;
    cg::grid_group grid = cg::this_grid();
    const int tid = threadIdx.x, lane = tid & 63, wave = __builtin_amdgcn_readfirstlane(tid >> 6);
    const int lo = a.ph_lo, hi = a.ph_hi, G = gridDim.x;
    unsigned char* ws = a.ws;
    const float *x = a.in[0], *meta = a.in[1], *gmix = a.in[2], *w_in = a.in[3], *bgate = a.in[4], *lblog = a.in[5], *hgn = a.in[6], *sinks = a.in[7], *w_bh = a.in[8], *w_ba = a.in[9],
                *w_out = a.in[10], *gffn = a.in[11], *w_q = a.in[12], *subk = a.in[13], *pu = a.in[14], *pv = a.in[15], *gfin = a.in[16];
    bf16_t *Zh = (bf16_t*)(ws + WS_ZH), *Za = (bf16_t*)(ws + WS_ZA), *Zg = (bf16_t*)(ws + WS_ZG), *A1 = (bf16_t*)(ws + WS_A1), *OM = (bf16_t*)(ws + WS_OM), *A2 = (bf16_t*)(ws + WS_A2);
    bf16_t *Mb = (bf16_t*)(ws + WS_MB), *U16 = (bf16_t*)(ws + WS_U16), *V16 = (bf16_t*)(ws + WS_V16), *Qb = (bf16_t*)(ws + WS_QB), *Vt = (bf16_t*)(ws + WS_VT);
    bf16_t *WinT = (bf16_t*)(ws + WS_WIN), *WbhT = (bf16_t*)(ws + WS_WBH), *WbaT = (bf16_t*)(ws + WS_WBA), *WoutT = (bf16_t*)(ws + WS_WOUT), *WqT = (bf16_t*)(ws + WS_WQ), *SK = (bf16_t*)(ws + WS_SK);
    float *Ub = (float*)(ws + WS_UB), *Dv = (float*)(ws + WS_DV), *rowssp = (float*)(ws + WS_RS);
#ifdef ONLY_PHASE
#define IN(k) ((k) == ONLY_PHASE && lo <= (k) && (k) < hi)
#else
#define IN(k) (lo <= (k) && (k) < hi)
#endif
#define SEAM(k) do { if (lo <= (k) && (k) + 1 < hi) grid.sync(); } while (0)

    if (IN(0)) { P0Args p{x, meta, gmix, w_in, w_bh, w_ba, w_out, w_q, subk, A1, WinT, WbhT, WbaT, WoutT, WqT, SK}; p0_prologue(lds, p); SEAM(0); }
    if (IN(1)) {
        pg8::Gemm g{A1, WinT, MA, 4864, 1024, 1024, 1024}; pg8::StaticOrder S; S.init(MA, 4864, G, (int)blockIdx.x);
        pg8::EpiZ E{Zh, Za, Zg, Vt};
        pg8::gemm_phase<pg8::EpiZ, pg8::StaticOrder, true, true>(lds, g, S, E);
        SEAM(1);
    }
    if (IN(2)) {
        for (int it = blockIdx.x; it < 1024 + 512; it += G) {
            if (it < 1024) {
#ifndef NO_HGA
 hgrn_A(lds, Zh, lblog, Ub, Dv, it);
#endif
 }
            else { const int ai = it - 1024, b = ai >> 6, n = ((ai & 63) >> 1) + 1, kvh = ai & 1;
#pragma unroll 1
                for (int si = wave; si < 16; si += 8) {
#ifndef NO_ATTN
 attn_sub(Za, Vt, sinks, OM, b, n, kvh * 4 + (si >> 2), si & 3, lane);
#endif
 } }
        }
        SEAM(2);
    }
    if (IN(3)) { hgrn_scan(Ub, Dv); SEAM(3); }
    if (IN(4)) { for (int it = blockIdx.x; it < 1024; it += G) hgrn_C(lds, Zh, lblog, Ub, hgn, OM, it); SEAM(4); }
    if (IN(5)) {
        for (size_t i = (size_t)blockIdx.x * 512 + tid; i < (size_t)2 * 16384 * 1024 / 8; i += (size_t)G * 512) {
            const float* src = i < 2097152 ? pu + i * 8 : pv + (i - 2097152) * 8;
            const f32x4 p0 = *(const f32x4*)src, p1 = *(const f32x4*)(src + 4);
            u32x4 o; o.x = cvtpk(p0[0], p0[1]); o.y = cvtpk(p0[2], p0[3]); o.z = cvtpk(p1[0], p1[1]); o.w = cvtpk(p1[2], p1[3]); *(u32x4*)(U16 + i * 8) = o; }
        __syncthreads();
        pg8::StaticOrder S; S.init(MC, 1024, G, (int)blockIdx.x);
        { pg8::Gemm g{OM, WbhT, MC, 1024, 512, 1024, 512}; pg8::EpiGate<0> E{Mb, Zg, bgate}; pg8::gemm_phase<pg8::EpiGate<0>, pg8::StaticOrder, true, true>(lds, g, S, E); }
        { pg8::Gemm g{OM + 512, WbaT, MC, 1024, 512, 1024, 512}; pg8::EpiGate<1> E{Mb, Zg, bgate}; pg8::gemm_phase<pg8::EpiGate<1>, pg8::StaticOrder, true, true>(lds, g, S, E); }
        SEAM(5);
    }
    if (IN(6)) {
        pg8::Gemm g{Mb, WoutT, MC, 1024, 1024, 1024, 1024}; pg8::StaticOrder S; S.init(MC, 1024, G, (int)blockIdx.x);
        pg8::EpiH1 E{x, a.out, A2, gffn, rowssp};
        pg8::gemm_phase<pg8::EpiH1, pg8::StaticOrder, true, true>(lds, g, S, E);
        SEAM(6);
    }
    if (IN(7)) {
        pg8::Gemm g{A2, WqT, MC, 2048, 1024, 1024, 1024}; pg8::StaticOrder S; S.init(MC, 2048, G, (int)blockIdx.x);
        pg8::EpiQ E{Qb, rowssp};
        pg8::gemm_phase<pg8::EpiQ, pg8::StaticOrder, true, true>(lds, g, S, E);
        SEAM(7);
    }
    if (IN(8)) {
        for (int grp = blockIdx.x; grp < MC / 128; grp += G) {
            const int rc0 = grp * 128;
#ifndef NO_TOPK
            peer_topk(lds, Qb, SK, rc0 + 32 * (wave >> 1), 32 * (wave >> 1), 4 * (wave & 1), lane);
#endif
            __syncthreads();
#pragma unroll 1
            for (int i = 0; i < 16; ++i) {
#ifndef NO_TOKEN
 peer_token(lds, 16 * wave + i, (size_t)rc0 + 16 * wave + i, A2, rowssp, U16, V16, a.out, gfin, lane);
#endif
 }
            __syncthreads();
        }
    }
#undef IN
#undef SEAM
}

extern "C" void kernel_launch(void* const* d_in, const int* in_sizes, int n_in, void* d_out, int out_size, void* d_ws, size_t ws_size, hipStream_t stream) {
    static int grid = 0;
    if (grid == 0) {
        if (n_in != 17 || out_size != MC * DM || ws_size < WS_END) { fprintf(stderr, "kernel_launch: unexpected shapes: n_in %d out %d ws %zu (need %zu)\n", n_in, out_size, ws_size, (size_t)WS_END); grid = -1; return; }
        int dev = 0, cus = 0, per_cu = 0;
        if (hipGetDevice(&dev) != hipSuccess || hipDeviceGetAttribute(&cus, hipDeviceAttributeMultiprocessorCount, dev) != hipSuccess) { fprintf(stderr, "kernel_launch: device query failed\n"); grid = -1; return; }
        if (hipFuncSetAttribute((const void*)fwd_kernel, hipFuncAttributeMaxDynamicSharedMemorySize, LDS_BYTES) != hipSuccess) { fprintf(stderr, "kernel_launch: hipFuncSetAttribute failed\n"); grid = -1; return; }
        if (hipOccupancyMaxActiveBlocksPerMultiprocessor(&per_cu, (const void*)fwd_kernel, 512, LDS_BYTES) != hipSuccess || per_cu < 1) { fprintf(stderr, "kernel_launch: occupancy query says %d blocks per CU\n", per_cu); per_cu = 1; }
        (void)hipGetLastError();
        grid = cus;
        fprintf(stderr, "kernel_launch: grid %d (occupancy %d per CU)\n", grid, per_cu);
    }
    if (grid < 0) return;
    Args a{};
    for (int i = 0; i < 17; ++i) a.in[i] = (const float*)d_in[i];
    a.out = (float*)d_out; a.ws = (unsigned char*)d_ws;
#if MK_ONE_LAUNCH
    a.ph_lo = 0; a.ph_hi = NPHASE;
    void* args[] = {&a};
    hipError_t e = hipLaunchCooperativeKernel((const void*)fwd_kernel, dim3(grid), dim3(512), args, LDS_BYTES, stream);
    if (e != hipSuccess) fprintf(stderr, "kernel_launch: cooperative launch failed: %s (grid %d)\n", hipGetErrorString(e), grid);
#else
    for (int p = 0; p < NPHASE; ++p) { a.ph_lo = p; a.ph_hi = p + 1; hipLaunchKernelGGL(fwd_kernel, dim3(grid), dim3(512), LDS_BYTES, stream, a); }
#endif
}
```

```cpp
#include <hip/hip_runtime.h>
#include <hip/hip_cooperative_groups.h>
#include <cstdio>
#include <cstdint>
namespace cg = cooperative_groups;

#ifndef MK_ONE_LAUNCH
#define MK_ONE_LAUNCH 1
#endif

constexpr int DM = 1024, NB = 8, SEQ = 4096, NMETA = 16, LTOK = SEQ + NMETA;
constexpr int MA_REAL = NB * LTOK;
constexpr int MA = 33024;
constexpr int MC = NB * SEQ;
constexpr int LPAD = 4224;
constexpr float EPS = 1e-6f;

namespace pg8 {
#define PG8_LAS __attribute__((address_space(3)))
typedef unsigned short bf16_t;
typedef short bf16x8 __attribute__((ext_vector_type(8)));
typedef float f32x4 __attribute__((ext_vector_type(4)));
typedef unsigned u32x4 __attribute__((ext_vector_type(4)));
constexpr int BM = 256, BK = 64, HALF = 128, HTB = HALF * BK * 2  , STAGE_BYTES = 8 * HTB, NXCD = 8, WGM = 8;

__host__ __device__ __forceinline__ int lds_byte(int r, int c) { const int st = (r >> 4) * 2 + (c >> 5), rr = r & 15, cc = c & 31, ob = rr * 64 + cc * 2; return st * 1024 + (ob ^ (((ob >> 9) & 1) << 5)); }
__host__ __device__ __forceinline__ void stage_rc(int b, int& R, int& C) { const int st = b / 1024, sb = b % 1024, swz = sb ^ (((sb >> 9) & 1) << 5); R = (st >> 1) * 16 + swz / 64; C = (st & 1) * 32 + (swz % 64) / 2; }
__host__ __device__ __forceinline__ int perm32(int rho) { const int n = rho >> 4, i = rho & 15; return 8 * (i >> 2) + 4 * n + (i & 3); }

struct Unit { int pm, pn; };
struct Gemm { const bf16_t* A; const bf16_t* Bt; int M, N, K, lda, ldb; };

struct StaticOrder {
    int nM, nN, nwg, G, c;
    __host__ __device__ void init(int M, int N, int G_, int c_) { nM = M / BM; nN = N / BM; nwg = nM * nN; G = G_; c = c_; }
    __host__ __device__ bool next(int i, Unit& u) const {
        const long L = (long)i * G + c; if (L >= nwg) return false;
        int wgid = (int)L; { const int q = nwg / NXCD, r = nwg % NXCD, xcd = wgid % NXCD, off = wgid / NXCD; wgid = (xcd < r ? xcd * (q + 1) : r * (q + 1) + (xcd - r) * q) + off; }
        const int nig = WGM * nN, gid = wgid / nig, fm = gid * WGM, gsz = (nM - fm) < WGM ? (nM - fm) : WGM;
        u.pm = fm + ((wgid % nig) % gsz); u.pn = (wgid % nig) / gsz; return true;
    }
    __device__ __forceinline__ void a_ready(const Unit&) const {}
    __device__ __forceinline__ void done(const Unit&) const {}
};

__device__ __forceinline__ unsigned cvt_pk_bf16(float lo, float hi) { unsigned r; asm volatile("v_cvt_pk_bf16_f32 %0, %1, %2" : "=v"(r) : "v"(lo), "v"(hi)); return r; }
typedef float f32x2 __attribute__((ext_vector_type(2)));
typedef float f32x2_t __attribute__((ext_vector_type(2))); typedef __bf16 bf16x2_t __attribute__((ext_vector_type(2)));
typedef unsigned u32x2 __attribute__((ext_vector_type(2)));
__device__ __forceinline__ unsigned cvtpk(float lo, float hi) { f32x2_t v = {lo, hi}; bf16x2_t b = __builtin_convertvector(v, bf16x2_t); return __builtin_bit_cast(unsigned, b); }
__device__ __forceinline__ bf16_t f2bf(float x) { return (bf16_t)(cvtpk(x, 0.f) & 0xffffu); }
__device__ __forceinline__ float bf2f(bf16_t v) { return __uint_as_float((unsigned)v << 16); }
__device__ __forceinline__ float bflo(unsigned w) { return __uint_as_float(w << 16); }
__device__ __forceinline__ float bfhi(unsigned w) { return __uint_as_float(w & 0xffff0000u); }
__device__ __forceinline__ float sigm(float x) { return 1.f / (1.f + __expf(-x)); }

struct EpiZ {
    static constexpr bool PERM = true, AFTER_DRAIN = false;
    bf16_t *Zh, *Za, *Zg, *Vt;
    __device__ __forceinline__ void operator()(const f32x4 (&acc)[2][2][4][2], const Unit& u, int wr, int wc, int fr, int fq) const {
        const int pn = u.pn; bf16_t* base; int ldc, colt;
        if (pn < 8) { base = Zh; ldc = 2048; colt = pn * 256; } else if (pn < 11) { base = Za; ldc = 768; colt = (pn - 8) * 256; } else { base = Zg; ldc = 2048; colt = (pn - 11) * 256; }
        const int row0 = u.pm * BM + wr * 64 + fr, col0 = colt + wc * 32 + 8 * fq;
#pragma unroll
        for (int ai = 0; ai < 2; ++ai)
#pragma unroll
            for (int m = 0; m < 4; ++m) { const int row = row0 + ai * HALF + m * 16; bf16_t* rowp = base + (size_t)row * ldc + col0;
#pragma unroll
                for (int bj = 0; bj < 2; ++bj) { const f32x4 v0 = acc[ai][bj][m][0], v1 = acc[ai][bj][m][1];
                    if (pn == 10 && bj == 1) {
                        if (row < MA_REAL) { const int b = row / LTOK, pos = row - b * LTOK; bf16_t* vp = Vt + ((size_t)(b * 128 + wc * 32 + 8 * fq) * LPAD + 112 + pos);
                            vp[0] = f2bf(v0[0]); vp[LPAD] = f2bf(v0[1]); vp[2 * LPAD] = f2bf(v0[2]); vp[3 * LPAD] = f2bf(v0[3]);
                            vp[4 * LPAD] = f2bf(v1[0]); vp[5 * LPAD] = f2bf(v1[1]); vp[6 * LPAD] = f2bf(v1[2]); vp[7 * LPAD] = f2bf(v1[3]); }
                    } else { u32x4 w; w.x = cvtpk(v0[0], v0[1]); w.y = cvtpk(v0[2], v0[3]); w.z = cvtpk(v1[0], v1[1]); w.w = cvtpk(v1[2], v1[3]); *(u32x4*)(rowp + bj * HALF) = w; } } }
    }
};
template <int PASS> struct EpiGate {
    static constexpr bool PERM = true, AFTER_DRAIN = false;
    bf16_t* Mb; const bf16_t* Zg; const float* bgate;
    __device__ __forceinline__ void operator()(const f32x4 (&acc)[2][2][4][2], const Unit& u, int wr, int wc, int fr, int fq) const {
        const int row0 = u.pm * BM + wr * 64 + fr, col0 = u.pn * BM + wc * 32 + 8 * fq;
        f32x4 bv[2][2];
#pragma unroll
        for (int bj = 0; bj < 2; ++bj)
#pragma unroll
            for (int n = 0; n < 2; ++n) bv[bj][n] = *(const f32x4*)(bgate + PASS * 1024 + col0 + bj * HALF + 4 * n);
#pragma unroll
        for (int ai = 0; ai < 2; ++ai)
#pragma unroll
            for (int m = 0; m < 4; ++m) { const int rc = row0 + ai * HALF + m * 16, ra = (rc >> 12) * LTOK + NMETA + (rc & 4095);
                const bf16_t* zp = Zg + (size_t)ra * 2048 + PASS * 1024 + col0; bf16_t* mp = Mb + (size_t)rc * 1024 + col0;
#pragma unroll
                for (int bj = 0; bj < 2; ++bj) { const u32x4 z = *(const u32x4*)(zp + bj * HALF); f32x4 v0 = acc[ai][bj][m][0], v1 = acc[ai][bj][m][1];
                    v0[0] *= sigm(bflo(z.x) + bv[bj][0][0]); v0[1] *= sigm(bfhi(z.x) + bv[bj][0][1]); v0[2] *= sigm(bflo(z.y) + bv[bj][0][2]); v0[3] *= sigm(bfhi(z.y) + bv[bj][0][3]);
                    v1[0] *= sigm(bflo(z.z) + bv[bj][1][0]); v1[1] *= sigm(bfhi(z.z) + bv[bj][1][1]); v1[2] *= sigm(bflo(z.w) + bv[bj][1][2]); v1[3] *= sigm(bfhi(z.w) + bv[bj][1][3]);
                    if (PASS == 1) { const u32x4 o = *(const u32x4*)(mp + bj * HALF);
                        v0[0] += bflo(o.x); v0[1] += bfhi(o.x); v0[2] += bflo(o.y); v0[3] += bfhi(o.y); v1[0] += bflo(o.z); v1[1] += bfhi(o.z); v1[2] += bflo(o.w); v1[3] += bfhi(o.w); }
                    u32x4 w; w.x = cvtpk(v0[0], v0[1]); w.y = cvtpk(v0[2], v0[3]); w.z = cvtpk(v1[0], v1[1]); w.w = cvtpk(v1[2], v1[3]); *(u32x4*)(mp + bj * HALF) = w; } }
    }
};
struct EpiH1 {
    static constexpr bool PERM = false, AFTER_DRAIN = false;
    const float* x; float* h1; bf16_t* A2; const float* gffn; float* rowssp;
    __device__ __forceinline__ void operator()(const f32x4 (&acc)[2][2][4][2], const Unit& u, int wr, int wc, int fr, int fq) const {
        const int row0 = u.pm * BM + wr * 64 + fr, col0 = u.pn * BM + wc * 32 + 4 * fq;
        f32x4 gv[2][2];
#pragma unroll
        for (int bj = 0; bj < 2; ++bj)
#pragma unroll
            for (int n = 0; n < 2; ++n) gv[bj][n] = *(const f32x4*)(gffn + col0 + bj * HALF + n * 16);
#pragma unroll
        for (int ai = 0; ai < 2; ++ai)
#pragma unroll
            for (int m = 0; m < 4; ++m) { const int rc = row0 + ai * HALF + m * 16; float ss = 0.f;
#pragma unroll
                for (int bj = 0; bj < 2; ++bj)
#pragma unroll
                    for (int n = 0; n < 2; ++n) { const size_t off = (size_t)rc * 1024 + col0 + bj * HALF + n * 16;
                        const f32x4 h = *(const f32x4*)(x + off) + acc[ai][bj][m][n]; *(f32x4*)(h1 + off) = h;
                        ss += (h[0] * h[0] + h[1] * h[1]) + (h[2] * h[2] + h[3] * h[3]);
                        const f32x4 y = h * gv[bj][n]; u32x2 w; w.x = cvtpk(y[0], y[1]); w.y = cvtpk(y[2], y[3]); *(u32x2*)(A2 + off) = w; }
                ss += __shfl_xor(ss, 16); ss += __shfl_xor(ss, 32);
                if (fq == 0) rowssp[(size_t)rc * 16 + u.pn * 4 + wc] = ss; }
    }
};
struct EpiQ {
    static constexpr bool PERM = true, AFTER_DRAIN = false;
    bf16_t* Q; const float* rowssp;
    __device__ __forceinline__ void operator()(const f32x4 (&acc)[2][2][4][2], const Unit& u, int wr, int wc, int fr, int fq) const {
        const int row0 = u.pm * BM + wr * 64 + fr, col0 = u.pn * BM + wc * 32 + 8 * fq;
#pragma unroll
        for (int ai = 0; ai < 2; ++ai)
#pragma unroll
            for (int m = 0; m < 4; ++m) { const int rc = row0 + ai * HALF + m * 16;
                const f32x4* rp = (const f32x4*)(rowssp + (size_t)rc * 16); const f32x4 s4 = (rp[0] + rp[1]) + (rp[2] + rp[3]);
                const float rstd = __builtin_amdgcn_rsqf(((s4[0] + s4[1]) + (s4[2] + s4[3])) * (1.0f / 1024.0f) + 1e-6f);
#pragma unroll
                for (int bj = 0; bj < 2; ++bj) { const f32x4 v0 = acc[ai][bj][m][0] * rstd, v1 = acc[ai][bj][m][1] * rstd;
                    u32x4 w; w.x = cvtpk(v0[0], v0[1]); w.y = cvtpk(v0[2], v0[3]); w.z = cvtpk(v1[0], v1[1]); w.w = cvtpk(v1[2], v1[3]); *(u32x4*)(Q + (size_t)rc * 2048 + col0 + bj * HALF) = w; } }
    }
};
template <class Epi, class Sched, bool ALIGN_EPI = false, bool SP2 = false>
__device__ __forceinline__ void gemm_phase(PG8_LAS unsigned char* lds, const Gemm g, const Sched& S, const Epi& E) {
    const int tid = threadIdx.x, wid = __builtin_amdgcn_readfirstlane(tid >> 6), lane = tid & 63, wr = wid >> 2, wc = wid & 3, fr = lane & 15, fq = lane >> 4;
    const int K = g.K, nt = K / BK;
    unsigned voffA[2], voffB[2];
#pragma unroll
    for (int i = 0; i < 2; ++i) { int R, C; stage_rc(tid * 16 + i * 8192, R, C); const int Rb = Epi::PERM ? ((R & ~31) + perm32(R & 31)) : R;
        voffA[i] = (unsigned)(R * g.lda + C) * 2u; voffB[i] = (unsigned)(Rb * g.ldb + C) * 2u; }
    const size_t kstep = (size_t)(BK * 2);
    const size_t hstepA = (size_t)HALF * g.lda * 2, hstepB = (size_t)HALF * g.ldb * 2;
    const size_t tstepA = 2 * hstepA, tstepB = 2 * hstepB;
    const unsigned ldsw = (unsigned)wid * 1024u;
    const int aoff = lds_byte(wr * 64 + fr, fq * 8), boff = lds_byte(wc * 32 + fr, fq * 8);
#define PG8_SA(b, h) (((b) * 2 + (h)) * HTB)
#define PG8_SB(b, h) ((4 + (b) * 2 + (h)) * HTB)
#define PG8_STAGE(bufoff, gbase, voff) do { _Pragma("unroll") for (int _i = 0; _i < 2; ++_i) \
        __builtin_amdgcn_global_load_lds((const unsigned*)((const char*)(gbase) + (voff)[_i]), (PG8_LAS unsigned*)(lds + (bufoff) + ldsw + _i * 8192), 16, 0, 0); } while (0)
#define PG8_LDA(dst, b, h) do { _Pragma("unroll") for (int m = 0; m < 4; ++m) _Pragma("unroll") for (int k = 0; k < 2; ++k) dst[m][k] = *(const PG8_LAS bf16x8*)(lds + PG8_SA(b, h) + aoff + m * 2048 + k * 1024); } while (0)
#define PG8_LDB(dst, b, h) do { _Pragma("unroll") for (int n = 0; n < 2; ++n) _Pragma("unroll") for (int k = 0; k < 2; ++k) dst[n][k] = *(const PG8_LAS bf16x8*)(lds + PG8_SB(b, h) + boff + n * 2048 + k * 1024); } while (0)
#define PG8_MMA(ai, bj, At, Bt) do { __builtin_amdgcn_s_setprio(1); _Pragma("unroll") for (int m = 0; m < 4; ++m) _Pragma("unroll") for (int n = 0; n < 2; ++n) _Pragma("unroll") for (int k = 0; k < 2; ++k) \
        acc[ai][bj][m][n] = __builtin_amdgcn_mfma_f32_16x16x32_bf16(Bt[n][k], At[m][k], acc[ai][bj][m][n], 0, 0, 0); __builtin_amdgcn_s_setprio(0); } while (0)
#define PG8_WAIT_V(n) asm volatile("s_waitcnt vmcnt(" #n ")" ::: "memory")
#define PG8_WAIT_L(n) asm volatile("s_waitcnt lgkmcnt(" #n ")" ::: "memory")
#define PG8_BAR __builtin_amdgcn_s_barrier()
#define PG8_SCHED __builtin_amdgcn_sched_barrier(0)
    Unit cur, nxt; int ui = 0;
    if (!S.next(0, cur)) return;
    f32x4 acc[2][2][4][2];
#pragma unroll
    for (int a = 0; a < 2; ++a)
#pragma unroll
        for (int b = 0; b < 2; ++b)
#pragma unroll
            for (int m = 0; m < 4; ++m)
#pragma unroll
                for (int n = 0; n < 2; ++n) acc[a][b][m][n] = (f32x4){0.f, 0.f, 0.f, 0.f};
    bf16x8 At[4][2], B0[2][2], B1[2][2];
    const char* cA = (const char*)g.A + (size_t)cur.pm * tstepA; const char* cB = (const char*)g.Bt + (size_t)cur.pn * tstepB;
    S.a_ready(cur);
    if constexpr (SP2) {
        PG8_STAGE(PG8_SB(0, 0), cB, voffB); PG8_STAGE(PG8_SB(0, 1), cB + hstepB, voffB); PG8_STAGE(PG8_SA(0, 0), cA, voffA); PG8_STAGE(PG8_SA(0, 1), cA + hstepA, voffA);
        if (wr == 1) PG8_BAR;
        PG8_WAIT_V(2); PG8_BAR;
        PG8_STAGE(PG8_SB(1, 0), cB + kstep, voffB); PG8_STAGE(PG8_SA(1, 0), cA + kstep, voffA); PG8_STAGE(PG8_SB(1, 1), cB + hstepB + kstep, voffB);
        PG8_WAIT_V(6); PG8_BAR;
    } else {
        PG8_STAGE(PG8_SB(0, 0), cB, voffB); PG8_STAGE(PG8_SA(0, 0), cA, voffA); PG8_STAGE(PG8_SB(0, 1), cB + hstepB, voffB); PG8_STAGE(PG8_SA(0, 1), cA + hstepA, voffA);
        if (wr == 1) PG8_BAR;
        PG8_WAIT_V(4); PG8_BAR;
        PG8_STAGE(PG8_SB(1, 0), cB + kstep, voffB); PG8_STAGE(PG8_SA(1, 0), cA + kstep, voffA); PG8_STAGE(PG8_SB(1, 1), cB + hstepB + kstep, voffB);
        PG8_WAIT_V(6); PG8_BAR;
    }
    for (;;) {
        const bool has_next = S.next(ui + 1, nxt);
        const char* nA = has_next ? (const char*)g.A + (size_t)nxt.pm * tstepA : cA; const char* nB = has_next ? (const char*)g.Bt + (size_t)nxt.pn * tstepB : cB;
        for (int t = 0; t < nt; t += 2) {
            const bool last = (t == nt - 2);
            const char* a1 = cA + (size_t)(t + 1) * kstep;
            const char* a2 = last ? nA : cA + (size_t)(t + 2) * kstep; const char* b2 = last ? nB : cB + (size_t)(t + 2) * kstep;
            const char* a3 = a2 + kstep; const char* b3 = b2 + kstep;
            if (last && has_next) S.a_ready(nxt);
            if constexpr (SP2) {
            PG8_LDB(B0, 0, 0); PG8_LDB(B1, 0, 1); PG8_SCHED; PG8_LDA(At, 0, 0); PG8_STAGE(PG8_SA(1, 1), a1 + hstepA, voffA);
            PG8_WAIT_V(8); PG8_WAIT_L(0); PG8_BAR; PG8_MMA(0, 0, At, B0); PG8_MMA(0, 1, At, B1); PG8_BAR; PG8_SCHED;
            PG8_LDA(At, 0, 1); PG8_STAGE(PG8_SB(0, 0), b2, voffB); PG8_STAGE(PG8_SB(0, 1), b2 + hstepB, voffB); PG8_STAGE(PG8_SA(0, 0), a2, voffA);
            PG8_WAIT_V(8); PG8_WAIT_L(0); PG8_BAR; PG8_MMA(1, 0, At, B0); PG8_MMA(1, 1, At, B1); PG8_BAR; PG8_SCHED;
            PG8_LDB(B0, 1, 0); PG8_LDB(B1, 1, 1); PG8_SCHED; PG8_LDA(At, 1, 0); PG8_STAGE(PG8_SA(0, 1), a2 + hstepA, voffA);
            PG8_WAIT_V(8); PG8_WAIT_L(0); PG8_BAR; PG8_MMA(0, 0, At, B0); PG8_MMA(0, 1, At, B1); PG8_BAR; PG8_SCHED;
            PG8_LDA(At, 1, 1); PG8_STAGE(PG8_SB(1, 0), b3, voffB); PG8_STAGE(PG8_SB(1, 1), b3 + hstepB, voffB); PG8_STAGE(PG8_SA(1, 0), a3, voffA);
            PG8_WAIT_V(8); PG8_WAIT_L(0); PG8_BAR; PG8_MMA(1, 0, At, B0); PG8_MMA(1, 1, At, B1); PG8_BAR; PG8_SCHED;
            } else {
            PG8_LDB(B0, 0, 0); PG8_SCHED; PG8_LDA(At, 0, 0); PG8_STAGE(PG8_SA(1, 1), a1 + hstepA, voffA);
            PG8_WAIT_L(8); PG8_BAR; PG8_WAIT_L(0); PG8_MMA(0, 0, At, B0); PG8_BAR; PG8_SCHED;
            PG8_LDB(B1, 0, 1); PG8_STAGE(PG8_SB(0, 0), b2, voffB);
            PG8_BAR; PG8_WAIT_L(0); PG8_MMA(0, 1, At, B1); PG8_BAR;
            PG8_LDA(At, 0, 1); PG8_STAGE(PG8_SA(0, 0), a2, voffA);
            PG8_BAR; PG8_WAIT_L(0); PG8_MMA(1, 0, At, B0); PG8_BAR; PG8_SCHED;
            PG8_STAGE(PG8_SB(0, 1), b2 + hstepB, voffB);
            PG8_WAIT_V(6); PG8_BAR; PG8_MMA(1, 1, At, B1); PG8_BAR;
            PG8_LDB(B0, 1, 0); PG8_SCHED; PG8_LDA(At, 1, 0); PG8_STAGE(PG8_SA(0, 1), a2 + hstepA, voffA);
            PG8_WAIT_L(8); PG8_BAR; PG8_WAIT_L(0); PG8_MMA(0, 0, At, B0); PG8_BAR; PG8_SCHED;
            PG8_LDB(B1, 1, 1); PG8_STAGE(PG8_SB(1, 0), b3, voffB);
            PG8_BAR; PG8_WAIT_L(0); PG8_MMA(0, 1, At, B1); PG8_BAR;
            PG8_LDA(At, 1, 1); PG8_STAGE(PG8_SA(1, 0), a3, voffA);
            PG8_BAR; PG8_WAIT_L(0); PG8_MMA(1, 0, At, B0); PG8_BAR; PG8_SCHED;
            PG8_STAGE(PG8_SB(1, 1), b3 + hstepB, voffB);
            PG8_WAIT_V(6); PG8_BAR; PG8_MMA(1, 1, At, B1); PG8_BAR;
            }
        }
        if constexpr (ALIGN_EPI) { if (wr == 0) PG8_BAR; }
        if constexpr (!Epi::AFTER_DRAIN) { E(acc, cur, wr, wc, fr, fq); S.done(cur); }
        if (!has_next) break;
#pragma unroll
        for (int a = 0; a < 2; ++a)
#pragma unroll
            for (int b = 0; b < 2; ++b)
#pragma unroll
                for (int m = 0; m < 4; ++m)
#pragma unroll
                    for (int n = 0; n < 2; ++n) acc[a][b][m][n] = (f32x4){0.f, 0.f, 0.f, 0.f};
        cur = nxt; cA = nA; cB = nB; ++ui;
        if constexpr (ALIGN_EPI) { if (wr == 1) PG8_BAR; }
    }
    PG8_WAIT_V(0);
    if constexpr (!ALIGN_EPI) { if (wr == 0) PG8_BAR; }
    PG8_BAR;
    if constexpr (Epi::AFTER_DRAIN) { E.fused(acc, cur, wr, wc, fr, fq, lds, wid, lane); S.done(cur); }
#undef PG8_SA
#undef PG8_SB
#undef PG8_STAGE
#undef PG8_LDA
#undef PG8_LDB
#undef PG8_MMA
#undef PG8_WAIT_V
#undef PG8_WAIT_L
#undef PG8_BAR
#undef PG8_SCHED
}
}
using pg8::bf16_t; using pg8::bf16x8; using pg8::f32x4; using pg8::u32x4; using pg8::u32x2; using pg8::cvtpk; using pg8::f2bf; using pg8::bf2f; using pg8::bflo; using pg8::bfhi; using pg8::sigm;
#define LAS __attribute__((address_space(3)))
typedef float f32x16 __attribute__((ext_vector_type(16)));
#define MFMA32(a, b, c) __builtin_amdgcn_mfma_f32_32x32x16_bf16((a), (b), (c), 0, 0, 0)

constexpr size_t MiB = 1u << 20;
constexpr size_t WS_ZH = 0;
constexpr size_t WS_MB = WS_ZH, WS_U8 = WS_ZH + 64 * MiB, WS_V8 = WS_ZH + 80 * MiB, WS_SUV = WS_ZH + 96 * MiB;
constexpr size_t WS_ZA = 129 * MiB;
constexpr size_t WS_ZG = 178 * MiB;
constexpr size_t WS_QB = WS_ZG;
constexpr size_t WS_A1 = 307 * MiB;
constexpr size_t WS_OM = WS_A1, WS_A2 = WS_A1;
constexpr size_t WS_UB = 372 * MiB;
constexpr size_t WS_DV = 436 * MiB;
constexpr size_t WS_VT = 437 * MiB;
constexpr size_t WS_WIN = 446 * MiB;
constexpr size_t WS_WBH = 456 * MiB, WS_WBA = 457 * MiB, WS_WOUT = 458 * MiB, WS_WQ = 460 * MiB, WS_SK = 464 * MiB;
constexpr size_t WS_RS = 465 * MiB;
constexpr size_t WS_END = 467 * MiB;
constexpr int LDS_BYTES = 147456;

__device__ __forceinline__ float wave_sum(float v) {
#pragma unroll
    for (int o = 1; o < 64; o <<= 1) v += __shfl_xor(v, o);
    return v;
}
__device__ __forceinline__ void p0_transpose_item(const float* __restrict__ W, int K, int N, bf16_t* __restrict__ WT, LAS float* scr, int item, int lane) {
    const int nblk = N / 32, kb = item / nblk, nb = item % nblk, k0 = 64 * kb, n0 = 32 * nb;
#pragma unroll 8
    for (int i = 0; i < 32; ++i) { const int kk = 2 * i + (lane >> 5); scr[kk * 33 + (lane & 31)] = W[(size_t)(k0 + kk) * N + n0 + (lane & 31)]; }
    asm volatile("s_waitcnt lgkmcnt(0)" ::: "memory");
    const int c = lane & 7;
#pragma unroll
    for (int j = 0; j < 4; ++j) { const int n = (lane >> 3) + 8 * j; const LAS float* s = scr + (8 * c) * 33 + n;
        u32x4 o; o.x = cvtpk(s[0 * 33], s[1 * 33]); o.y = cvtpk(s[2 * 33], s[3 * 33]); o.z = cvtpk(s[4 * 33], s[5 * 33]); o.w = cvtpk(s[6 * 33], s[7 * 33]);
        *(u32x4*)(WT + (size_t)(n0 + n) * K + k0 + 8 * c) = o; }
    asm volatile("s_waitcnt lgkmcnt(0)" ::: "memory");
}
struct P0Args { const float *x, *meta, *gmix, *w_in, *w_bh, *w_ba, *w_out, *w_q, *subk; bf16_t *A1, *WinT, *WbhT, *WbaT, *WoutT, *WqT, *SK; };
__device__ __forceinline__ void p0_prologue(LAS unsigned char* lds, const P0Args& p) {
    const int tid = threadIdx.x, lane = tid & 63, wave = tid >> 6;
    LAS float* scr = (LAS float*)(lds + wave * 16384);
    const int gw = blockIdx.x * 8 + wave, NGW = gridDim.x * 8;
    constexpr int I_IN = 16 * 152, I_B = 8 * 32, I_O = 16 * 32, I_Q = 16 * 64, NITEMS = I_IN + 2 * I_B + I_O + I_Q;
    for (int it = gw; it < NITEMS; it += NGW) {
        int r = it;
        if (r < I_IN) { p0_transpose_item(p.w_in, 1024, 4864, p.WinT, scr, r, lane); continue; } r -= I_IN;
        if (r < I_B) { p0_transpose_item(p.w_bh, 512, 1024, p.WbhT, scr, r, lane); continue; } r -= I_B;
        if (r < I_B) { p0_transpose_item(p.w_ba, 512, 1024, p.WbaT, scr, r, lane); continue; } r -= I_B;
        if (r < I_O) { p0_transpose_item(p.w_out, 1024, 1024, p.WoutT, scr, r, lane); continue; } r -= I_O;
        p0_transpose_item(p.w_q, 1024, 2048, p.WqT, scr, r, lane);
    }
    for (int i = blockIdx.x * 512 + tid; i < 262144 / 8; i += gridDim.x * 512) {
        const f32x4 a = *(const f32x4*)(p.subk + (size_t)i * 8), b = *(const f32x4*)(p.subk + (size_t)i * 8 + 4);
        u32x4 o; o.x = cvtpk(a[0], a[1]); o.y = cvtpk(a[2], a[3]); o.z = cvtpk(b[0], b[1]); o.w = cvtpk(b[2], b[3]); *(u32x4*)(p.SK + (size_t)i * 8) = o; }
    f32x4 g[4];
#pragma unroll
    for (int j = 0; j < 4; ++j) g[j] = *((const f32x4*)p.gmix + lane + 64 * j);
    for (int m = gw; m < MA; m += NGW) {
        unsigned long long* o8 = (unsigned long long*)(p.A1 + (size_t)m * 1024) + lane;
        if (m >= MA_REAL) {
#pragma unroll
            for (int j = 0; j < 4; ++j) o8[64 * j] = 0ull;
            continue; }
        const int b = m / LTOK, pos = m - b * LTOK;
        const float* src = pos < NMETA ? p.meta + (size_t)pos * 1024 : p.x + ((size_t)b * SEQ + (pos - NMETA)) * 1024;
        const f32x4* xr = (const f32x4*)src + lane; f32x4 v[4]; float s = 0.f;
#pragma unroll
        for (int j = 0; j < 4; ++j) { v[j] = xr[64 * j]; s += (v[j][0] * v[j][0] + v[j][1] * v[j][1]) + (v[j][2] * v[j][2] + v[j][3] * v[j][3]); }
        const float rstd = 1.f / sqrtf(wave_sum(s) * (1.f / 1024.f) + EPS);
#pragma unroll
        for (int j = 0; j < 4; ++j) { const f32x4 y = v[j] * rstd * g[j]; o8[64 * j] = (unsigned long long)cvtpk(y[0], y[1]) | ((unsigned long long)cvtpk(y[2], y[3]) << 32); }
    }
}

constexpr int SR = 272;
constexpr int OFF_Q = 0, OFF_K = 34816, OFF_V = 69632, OFF_S = 104448, OFF_VEC = 139264;
__device__ __forceinline__ bf16x8 ldfrag(const LAS unsigned char* base, int row, int kk8, int h2) { return *(const LAS bf16x8*)(base + row * SR + (kk8 * 16 + 8 * h2) * 2); }

template <bool WITH_Q>
__device__ __forceinline__ void hgrn_front(LAS unsigned char* lds, const bf16_t* __restrict__ Zh, const float* __restrict__ lblog, int b, int h, int c, float (&cs)[32], float (&kk)[32], float (&qq)[32], unsigned (&vv)[16]) {
    const int tid = threadIdx.x, d = tid & 127, seg = tid >> 7;
    const float lb = sigm(lblog[h * 128 + d] - lblog[512 + h * 128 + d]);
    LAS float* segtot = (LAS float*)(lds + OFF_VEC);
    float run = 0.f;
#pragma unroll
    for (int i = 0; i < 32; ++i) {
        const int pos = 128 * c - 112 + 32 * seg + i; const bool valid = pos >= 0;
        const bf16_t* zr = Zh + (size_t)(b * LTOK + (valid ? pos : 0)) * 2048 + h * 128 + d;
        const float hf = bf2f(zr[512]); const float sg = sigm(hf);
        const float f = lb + (1.f - lb) * sg;
        const float lf = valid ? __logf(f) : 0.f;
        kk[i] = valid ? (1.f - lb) * (1.f - sg) : 0.f;
        run += lf; cs[i] = run;
        if (WITH_Q) qq[i] = valid ? bf2f(zr[0]) : 0.f;
        const unsigned vb = valid ? (unsigned)zr[1024] : 0u;
        if (i & 1) vv[i >> 1] |= vb << 16; else vv[i >> 1] = vb;
    }
    segtot[seg * 128 + d] = run;
    __syncthreads();
}

__device__ __forceinline__ void hgrn_A(LAS unsigned char* lds, const bf16_t* __restrict__ Zh, const float* __restrict__ lblog, float* __restrict__ Ub, float* __restrict__ Dv, int item) {
    const int tid = threadIdx.x, lane = tid & 63, wid = tid >> 6, r32 = lane & 31, h2 = lane >> 5;
    const int c = item & 31, bh = item >> 5, b = bh >> 2, h = bh & 3;
    const int d = tid & 127, seg = tid >> 7;
    float cs[32], kk[32], qq[32]; unsigned vv[16];
    hgrn_front<false>(lds, Zh, lblog, b, h, c, cs, kk, qq, vv);
    const LAS float* segtot = (const LAS float*)(lds + OFF_VEC);
    { const float s0 = segtot[d], s1 = segtot[128 + d], s2 = segtot[256 + d];
      const float off = seg == 0 ? 0.f : seg == 1 ? s0 : seg == 2 ? s0 + s1 : s0 + s1 + s2; const float aref = s0 + s1;
      unsigned kw[16];
#pragma unroll
      for (int i = 0; i < 16; ++i) kw[i] = cvtpk(kk[2 * i] * __expf(aref - (off + cs[2 * i])), kk[2 * i + 1] * __expf(aref - (off + cs[2 * i + 1])));
      LAS u32x4* kd = (LAS u32x4*)(lds + OFF_K + d * SR + seg * 64); LAS u32x4* vd = (LAS u32x4*)(lds + OFF_V + d * SR + seg * 64);
#pragma unroll
      for (int i = 0; i < 4; ++i) { kd[i] = (u32x4){kw[4 * i], kw[4 * i + 1], kw[4 * i + 2], kw[4 * i + 3]}; vd[i] = (u32x4){vv[4 * i], vv[4 * i + 1], vv[4 * i + 2], vv[4 * i + 3]}; } }
    __syncthreads();
    const int e0 = 32 * (wid >> 1), d0 = 64 * (wid & 1);
    f32x16 acc[2]; acc[0] = f32x16{}; acc[1] = f32x16{};
#pragma unroll
    for (int k8 = 0; k8 < 8; ++k8) { const bf16x8 a = ldfrag(lds + OFF_V, e0 + r32, k8, h2);
#pragma unroll
        for (int j = 0; j < 2; ++j) acc[j] = MFMA32(a, ldfrag(lds + OFF_K, d0 + 32 * j + r32, k8, h2), acc[j]); }
#pragma unroll
    for (int j = 0; j < 2; ++j) { const int dc = d0 + 32 * j + r32; const float sc = __expf(segtot[256 + dc] + segtot[384 + dc]);
        float* up = Ub + ((size_t)item * 128 + e0 + 4 * h2) * 128 + dc;
#pragma unroll
        for (int r = 0; r < 16; ++r) up[(size_t)((r & 3) + 8 * (r >> 2)) * 128] = acc[j][r] * sc; }
    if (tid < 128) Dv[(size_t)item * 128 + tid] = __expf((segtot[tid] + segtot[128 + tid]) + (segtot[256 + tid] + segtot[384 + tid]));
    __syncthreads();
}

__device__ __forceinline__ void hgrn_C(LAS unsigned char* lds, const bf16_t* __restrict__ Zh, const float* __restrict__ lblog, const float* __restrict__ Ub, const float* __restrict__ hgn, bf16_t* __restrict__ OM, int item) {
    const int tid = threadIdx.x, lane = tid & 63, wid = tid >> 6, r32 = lane & 31, h2 = lane >> 5;
    const int c = (item & 31) + 1, bh = item >> 5, b = bh >> 2, h = bh & 3;
    const int d = tid & 127, seg = tid >> 7;
    float cs[32], kk[32], qq[32]; unsigned vv[16];
    hgrn_front<true>(lds, Zh, lblog, b, h, c, cs, kk, qq, vv);
    const LAS float* segtot = (const LAS float*)(lds + OFF_VEC);
    { const float s0 = segtot[d], s1 = segtot[128 + d], s2 = segtot[256 + d];
      const float off = seg == 0 ? 0.f : seg == 1 ? s0 : seg == 2 ? s0 + s1 : s0 + s1 + s2; const float aref = s0 + s1;
      LAS bf16_t* qd = (LAS bf16_t*)(lds + OFF_Q + (32 * seg) * SR + d * 2); LAS bf16_t* kd = (LAS bf16_t*)(lds + OFF_K + (32 * seg) * SR + d * 2);
#pragma unroll
      for (int i = 0; i < 32; ++i) { const float a = off + cs[i]; qd[i * (SR / 2)] = f2bf(qq[i] * __expf(a - aref)); kd[i * (SR / 2)] = f2bf(kk[i] * __expf(aref - a)); }
      LAS u32x4* vd = (LAS u32x4*)(lds + OFF_V + d * SR + seg * 64);
#pragma unroll
      for (int i = 0; i < 4; ++i) vd[i] = (u32x4){vv[4 * i], vv[4 * i + 1], vv[4 * i + 2], vv[4 * i + 3]}; }
    { const float* sp = Ub + (size_t)item * 16384;
#pragma unroll 4
      for (int idx = tid; idx < 4096; idx += 512) { const int e = idx >> 5, d4 = (idx & 31) * 4; const f32x4 s = *(const f32x4*)(sp + e * 128 + d4);
          const f32x4 t0 = *(const LAS f32x4*)(segtot + d4), t1 = *(const LAS f32x4*)(segtot + 128 + d4);
          u32x2 w; w.x = cvtpk(s[0] * __expf(t0[0] + t1[0]), s[1] * __expf(t0[1] + t1[1])); w.y = cvtpk(s[2] * __expf(t0[2] + t1[2]), s[3] * __expf(t0[3] + t1[3]));
          *(LAS u32x2*)(lds + OFF_S + e * SR + d4 * 2) = w; } }
    __syncthreads();
    const int tb = wid >> 1, wh = wid & 1;
    f32x16 sc[2]; sc[0] = f32x16{}; sc[1] = f32x16{};
#pragma unroll
    for (int j = 0; j < 2; ++j) { const int sb = 2 * wh + j;
        if (sb <= tb) {
#pragma unroll
            for (int k8 = 0; k8 < 8; ++k8) sc[j] = MFMA32(ldfrag(lds + OFF_K, 32 * sb + r32, k8, h2), ldfrag(lds + OFF_Q, 32 * tb + r32, k8, h2), sc[j]); } }
    __syncthreads();
    { const int t = 32 * tb + r32;
#pragma unroll
      for (int j = 0; j < 2; ++j) { const int sb = 2 * wh + j;
#pragma unroll
          for (int g = 0; g < 4; ++g) { const int s = 32 * sb + 8 * g + 4 * h2;
              const float p0 = (sb <= tb && s + 0 <= t) ? sc[j][4 * g + 0] : 0.f, p1 = (sb <= tb && s + 1 <= t) ? sc[j][4 * g + 1] : 0.f;
              const float p2 = (sb <= tb && s + 2 <= t) ? sc[j][4 * g + 2] : 0.f, p3 = (sb <= tb && s + 3 <= t) ? sc[j][4 * g + 3] : 0.f;
              u32x2 w; w.x = cvtpk(p0, p1); w.y = cvtpk(p2, p3); *(LAS u32x2*)(lds + OFF_K + t * SR + s * 2) = w; } } }
    __syncthreads();
    f32x16 oc[2]; oc[0] = f32x16{}; oc[1] = f32x16{};
    for (int k8 = 0; k8 < 2 * (tb + 1); ++k8) { const bf16x8 pb = ldfrag(lds + OFF_K, 32 * tb + r32, k8, h2);
#pragma unroll
        for (int j = 0; j < 2; ++j) oc[j] = MFMA32(ldfrag(lds + OFF_V, 64 * wh + 32 * j + r32, k8, h2), pb, oc[j]); }
#pragma unroll
    for (int k8 = 0; k8 < 8; ++k8) { const bf16x8 qb = ldfrag(lds + OFF_Q, 32 * tb + r32, k8, h2);
#pragma unroll
        for (int j = 0; j < 2; ++j) oc[j] = MFMA32(ldfrag(lds + OFF_S, 64 * wh + 32 * j + r32, k8, h2), qb, oc[j]); }
    LAS float* ssq = (LAS float*)(lds + OFF_VEC + 2048);
    { float ss = 0.f;
#pragma unroll
      for (int j = 0; j < 2; ++j)
#pragma unroll
          for (int r = 0; r < 16; ++r) ss += oc[j][r] * oc[j][r];
      ss += __shfl_xor(ss, 32);
      if (h2 == 0) ssq[wh * 128 + 32 * tb + r32] = ss; }
    __syncthreads();
    { const int t = 32 * tb + r32; const float rstd = 1.f / sqrtf((ssq[t] + ssq[128 + t]) * (1.f / 128.f) + EPS);
      const size_t rc = (size_t)b * SEQ + 128 * (c - 1) + t, ra = (size_t)b * LTOK + 128 * c - 112 + t;
#pragma unroll
      for (int j = 0; j < 2; ++j)
#pragma unroll
          for (int g = 0; g < 4; ++g) { const int e = 64 * wh + 32 * j + 8 * g + 4 * h2;
              const u32x2 gt = *(const u32x2*)(Zh + ra * 2048 + 1536 + h * 128 + e); const f32x4 gn = *(const f32x4*)(hgn + h * 128 + e);
              const float g0 = bflo(gt.x), g1 = bfhi(gt.x), g2 = bflo(gt.y), g3 = bfhi(gt.y);
              const float o0 = oc[j][4 * g + 0] * rstd * gn[0] * (g0 * sigm(g0)), o1 = oc[j][4 * g + 1] * rstd * gn[1] * (g1 * sigm(g1));
              const float o2 = oc[j][4 * g + 2] * rstd * gn[2] * (g2 * sigm(g2)), o3 = oc[j][4 * g + 3] * rstd * gn[3] * (g3 * sigm(g3));
              u32x2 w; w.x = cvtpk(o0, o1); w.y = cvtpk(o2, o3); *(u32x2*)(OM + rc * 1024 + h * 128 + e) = w; } }
    __syncthreads();
}

__device__ __forceinline__ void hgrn_scan(float* __restrict__ Ub, const float* __restrict__ Dv) {
    for (int v = blockIdx.x * 512 + threadIdx.x; v < 32 * 4096; v += gridDim.x * 512) {
        const int bh = v >> 12, i4 = v & 4095, e = i4 >> 5, d4 = (i4 & 31) * 4;
        f32x4 S = (f32x4){0.f, 0.f, 0.f, 0.f};
#pragma unroll 4
        for (int c = 0; c < 32; ++c) { const int item = bh * 32 + c; f32x4* up = (f32x4*)(Ub + ((size_t)item * 128 + e) * 128 + d4);
            const f32x4 dv = *(const f32x4*)(Dv + (size_t)item * 128 + d4); S = dv * S + *up; *up = S; }
    }
}

__device__ __forceinline__ f32x16 attn_tile(const bf16_t* __restrict__ kp, const bf16x8 (&qf)[4], int T, bool meta, int pq, int h2) {
    f32x16 S = f32x16{};
#pragma unroll
    for (int k = 0; k < 4; ++k) S = MFMA32(*(const bf16x8*)(kp + 16 * k), qf[k], S);
#pragma unroll
    for (int r = 0; r < 16; ++r) { const int kr = (r & 3) + 8 * (r >> 2) + 4 * h2; const int pk = 32 * T + kr;
        const bool ok = meta ? (kr < 16) : ((pk <= pq) && (pq - pk < 128));
        S[r] = ok ? S[r] * 0.125f : -INFINITY; }
    return S;
}
__device__ __forceinline__ void attn_sub(const bf16_t* __restrict__ Za, const bf16_t* __restrict__ Vt, const float* __restrict__ sinks, bf16_t* __restrict__ OM, int b, int n, int qh, int sb, int lane) {
    const int r32 = lane & 31, h2 = lane >> 5, kvh = qh >> 2;
    const int pq = 128 * n + 32 * sb + r32;
    const bf16_t* qp = Za + (size_t)(b * LTOK + pq - 112) * 768 + qh * 64 + 8 * h2;
    bf16x8 qf[4];
#pragma unroll
    for (int k = 0; k < 4; ++k) qf[k] = *(const bf16x8*)(qp + 16 * k);
    const int T0 = 4 * n + sb - 4;
    const int Tlo = T0 < 4 ? 4 : T0, Thi = T0 + 4;
    const bf16_t* kbase = Za + (size_t)(b * LTOK + r32 - 112) * 768 + 512 + kvh * 64 + 8 * h2;
    const bf16_t* kmeta = Za + (size_t)(b * LTOK + r32) * 768 + 512 + kvh * 64 + 8 * h2;
    const float sink = sinks[qh];
    float mx = sink;
#pragma unroll 1
    for (int T = Tlo; T <= Thi; ++T) { const f32x16 S = attn_tile(kbase + (size_t)T * (32 * 768), qf, T, false, pq, h2);
#pragma unroll
        for (int r = 0; r < 16; ++r) mx = fmaxf(mx, S[r]); }
    { const f32x16 S = attn_tile(kmeta, qf, 0, true, pq, h2);
#pragma unroll
        for (int r = 0; r < 16; ++r) mx = fmaxf(mx, S[r]); }
    mx = fmaxf(mx, __shfl_xor(mx, 32));
    float l = 0.f;
    f32x16 O[2]; O[0] = f32x16{}; O[1] = f32x16{};
    const bf16_t* vbase = Vt + (size_t)(b * 128 + kvh * 64 + r32) * LPAD + 4 * h2;
#pragma unroll 1
    for (int T = Tlo; T <= Thi + 1; ++T) {
        const bool meta = T > Thi;
        f32x16 S = attn_tile(meta ? kmeta : kbase + (size_t)T * (32 * 768), qf, T, meta, pq, h2);
#pragma unroll
        for (int r = 0; r < 16; ++r) { S[r] = __expf(S[r] - mx); l += S[r]; }
        const int kb0 = meta ? 112 : 32 * T;
#pragma unroll
        for (int s2 = 0; s2 < 2; ++s2) {
            u32x4 pw; pw.x = cvtpk(S[8 * s2 + 0], S[8 * s2 + 1]); pw.y = cvtpk(S[8 * s2 + 2], S[8 * s2 + 3]); pw.z = cvtpk(S[8 * s2 + 4], S[8 * s2 + 5]); pw.w = cvtpk(S[8 * s2 + 6], S[8 * s2 + 7]);
            const bf16x8 pb = __builtin_bit_cast(bf16x8, pw);
#pragma unroll
            for (int db = 0; db < 2; ++db) { const bf16_t* vp = vbase + (size_t)(32 * db) * LPAD + kb0 + 16 * s2;
                const u32x2 lo = *(const u32x2*)vp, hi = *(const u32x2*)(vp + 8);
                const u32x4 aw = (u32x4){lo.x, lo.y, hi.x, hi.y};
                O[db] = MFMA32(__builtin_bit_cast(bf16x8, aw), pb, O[db]); } } }
    l += __shfl_xor(l, 32); l += __expf(sink - mx);
    const float inv = 1.f / l;
    bf16_t* op = OM + ((size_t)b * SEQ + 128 * (n - 1) + 32 * sb + r32) * 1024 + 512 + qh * 64 + 4 * h2;
#pragma unroll
    for (int db = 0; db < 2; ++db)
#pragma unroll
        for (int g = 0; g < 4; ++g) { u32x2 w; w.x = cvtpk(O[db][4 * g] * inv, O[db][4 * g + 1] * inv); w.y = cvtpk(O[db][4 * g + 2] * inv, O[db][4 * g + 3] * inv);
            *(u32x2*)(op + 32 * db + 8 * g) = w; }
}
__device__ __forceinline__ unsigned f2ord(float f) { const unsigned u = __float_as_uint(f); return (u & 0x80000000u) ? ~u : (u | 0x80000000u); }
__device__ __forceinline__ float ord2f(unsigned u) { return __uint_as_float((u & 0x80000000u) ? (u & 0x7fffffffu) : ~u); }
__device__ __forceinline__ unsigned umax_(unsigned a, unsigned b) { return a > b ? a : b; }
__device__ __forceinline__ unsigned umin_(unsigned a, unsigned b) { return a < b ? a : b; }
template <int N> __device__ __forceinline__ void bitonic_desc(unsigned (&a)[N]) {
#pragma unroll
    for (int k = 2; k <= N; k <<= 1)
#pragma unroll
        for (int j = k >> 1; j > 0; j >>= 1)
#pragma unroll
            for (int i = 0; i < N; ++i) { const int l = i ^ j;
                if (l > i) { const unsigned hi = umax_(a[i], a[l]), lo = umin_(a[i], a[l]); if ((i & k) == 0) { a[i] = hi; a[l] = lo; } else { a[i] = lo; a[l] = hi; } } }
}
__device__ __forceinline__ void merge_top16(unsigned (&a)[16], const unsigned (&b)[16]) {
#pragma unroll
    for (int i = 0; i < 16; ++i) a[i] = umax_(a[i], b[15 - i]);
#pragma unroll
    for (int j = 8; j > 0; j >>= 1)
#pragma unroll
        for (int i = 0; i < 16; ++i) { const int l = i ^ j; if (l > i) { const unsigned hi = umax_(a[i], a[l]), lo = umin_(a[i], a[l]); a[i] = hi; a[l] = lo; } }
}
template <bool PAIR> __device__ __forceinline__ void top16_of(unsigned (&g)[4][16]) {
    bitonic_desc<16>(g[0]); bitonic_desc<16>(g[1]); bitonic_desc<16>(g[2]); bitonic_desc<16>(g[3]);
    merge_top16(g[0], g[1]); merge_top16(g[2], g[3]); merge_top16(g[0], g[2]);
    if (PAIR) { unsigned o[16];
#pragma unroll
        for (int i = 0; i < 16; ++i) o[i] = (unsigned)__shfl_xor((int)g[0][i], 32);
        merge_top16(g[0], o); }
}
__device__ __forceinline__ unsigned sel16p(unsigned long long lo, unsigned long long hi, int i) { const unsigned long long w = (i & 8) ? hi : lo; return (unsigned)(w >> ((i & 7) * 8)) & 0x7fu; }
struct CandTab { unsigned char i[50], j[50]; int n; };
constexpr CandTab make_cands() { CandTab t{}; int n = 0; for (int i = 0; i < 16; ++i) for (int j = 0; j < 16; ++j) if ((i + 1) * (j + 1) <= 16) { t.i[n] = (unsigned char)i; t.j[n] = (unsigned char)j; ++n; } t.n = n; return t; }
constexpr CandTab CT = make_cands();
static_assert(CT.n == 50, "candidate count");

constexpr int PL_IDX = 0, PL_G = 32768;
__device__ __forceinline__ void peer_list(const bf16_t* __restrict__ Qb, const bf16_t* __restrict__ SK, int rc0, int h, int c, int r32, int h2, unsigned (&top)[16]) {
    const bf16_t* qp = Qb + (size_t)(rc0 + r32) * 2048 + h * 256 + c * 128 + 8 * h2;
    bf16x8 qf[8];
#pragma unroll
    for (int k = 0; k < 8; ++k) qf[k] = *(const bf16x8*)(qp + 16 * k);
    unsigned g[4][16];
#pragma unroll
    for (int nb = 0; nb < 4; ++nb) {
        const bf16_t* kp = SK + (size_t)((h * 2 + c) * 128 + 32 * nb + r32) * 128 + 8 * h2;
        f32x16 acc = f32x16{};
#pragma unroll
        for (int k = 0; k < 8; ++k) acc = MFMA32(*(const bf16x8*)(kp + 16 * k), qf[k], acc);
#pragma unroll
        for (int r = 0; r < 16; ++r) g[nb][r] = (f2ord(acc[r]) & 0xffffff80u) | (unsigned)(32 * nb + (r & 3) + 8 * (r >> 2) + 4 * h2);
        __builtin_amdgcn_sched_barrier(0);
    }
    top16_of<true>(g);
#pragma unroll
    for (int k = 0; k < 16; ++k) top[k] = g[0][k];
}
__device__ __forceinline__ void peer_topk(LAS unsigned char* lds, const bf16_t* __restrict__ Qb, const bf16_t* __restrict__ SK, int rc0, int tl0, int h0, int lane) {
#pragma unroll 1
    for (int hh = 0; hh < 4; ++hh) {
        asm volatile("" : "+v"(lane));
        const int r32 = lane & 31, h2 = lane >> 5;
        const int h = h0 + hh;
        unsigned ta[16], tb[16];
        peer_list(Qb, SK, rc0, h, 0, r32, h2, ta);
        peer_list(Qb, SK, rc0, h, 1, r32, h2, tb);
        float av[16], bv[16]; unsigned long long ail = 0, aih = 0, bil = 0, bih = 0;
#pragma unroll
        for (int k = 0; k < 16; ++k) { av[k] = ord2f(ta[k] & 0xffffff80u); bv[k] = ord2f(tb[k] & 0xffffff80u);
            if (k < 8) { ail |= (unsigned long long)(ta[k] & 0x7fu) << (8 * k); bil |= (unsigned long long)(tb[k] & 0x7fu) << (8 * k); }
            else { aih |= (unsigned long long)(ta[k] & 0x7fu) << (8 * (k - 8)); bih |= (unsigned long long)(tb[k] & 0x7fu) << (8 * (k - 8)); } }
        unsigned k2[4][16];
#pragma unroll
        for (int k = 0; k < 64; ++k) { if (k < 50) k2[k >> 4][k & 15] = (f2ord(av[CT.i[k < 50 ? k : 0]] + bv[CT.j[k < 50 ? k : 0]]) & 0xffffff00u) | (unsigned)(CT.i[k < 50 ? k : 0] * 16 + CT.j[k < 50 ? k : 0]); else k2[k >> 4][k & 15] = 0u; }
        top16_of<false>(k2);
        float ev[16]; float es = 0.f; const float m0 = ord2f(k2[0][0] & 0xffffff00u);
#pragma unroll
        for (int k = 0; k < 16; ++k) { ev[k] = __expf(ord2f(k2[0][k] & 0xffffff00u) - m0); es += ev[k]; }
        const float inv = 1.f / es;
        LAS unsigned short* ip = (LAS unsigned short*)(lds + PL_IDX) + (tl0 + r32) * 128 + h * 16;
        LAS float* gp = (LAS float*)(lds + PL_G) + (tl0 + r32) * 128 + h * 16;
#pragma unroll
        for (int k = 0; k < 16; ++k) { const int code = (int)(k2[0][k] & 0xffu); const unsigned e = sel16p(ail, aih, code >> 4) * 128u + sel16p(bil, bih, code & 15);
            if ((k >> 3) == h2) { ip[k] = (unsigned short)e; gp[k] = ev[k] * inv; } }
    }
}
__device__ __forceinline__ pg8::f32x2_t fp8x2(unsigned w, bool hi) { return hi ? __builtin_amdgcn_cvt_pk_f32_fp8(w, true) : __builtin_amdgcn_cvt_pk_f32_fp8(w, false); }
template <bool STORE>
__device__ __forceinline__ void peer_token(LAS unsigned char* lds, int tl, size_t rc, const bf16_t* __restrict__ A2, const float* __restrict__ rowssp, const unsigned char* __restrict__ U8, const unsigned char* __restrict__ V8,
                                           const float* __restrict__ su, const float* __restrict__ sv, float* __restrict__ dout, const float* __restrict__ gfin, int lane) {
    asm volatile("" : "+v"(lane));
    float x[16];
    { const u32x4 xa = *(const u32x4*)(A2 + rc * 1024 + 16 * lane), xb = *(const u32x4*)(A2 + rc * 1024 + 16 * lane + 8);
      x[0] = bflo(xa.x); x[1] = bfhi(xa.x); x[2] = bflo(xa.y); x[3] = bfhi(xa.y); x[4] = bflo(xa.z); x[5] = bfhi(xa.z); x[6] = bflo(xa.w); x[7] = bfhi(xa.w);
      x[8] = bflo(xb.x); x[9] = bfhi(xb.x); x[10] = bflo(xb.y); x[11] = bfhi(xb.y); x[12] = bflo(xb.z); x[13] = bfhi(xb.z); x[14] = bflo(xb.w); x[15] = bfhi(xb.w); }
    float rs = rowssp[rc * 16 + (lane & 15)];
    rs += __shfl_xor(rs, 1); rs += __shfl_xor(rs, 2); rs += __shfl_xor(rs, 4); rs += __shfl_xor(rs, 8);
    const float rstd = 1.f / sqrtf(rs * (1.f / 1024.f) + EPS);
    float out[16];
#pragma unroll
    for (int i = 0; i < 16; ++i) out[i] = 0.f;
    const LAS unsigned short* ip = (const LAS unsigned short*)(lds + PL_IDX) + tl * 128;
    const LAS float* gp = (const LAS float*)(lds + PL_G) + tl * 128;
    const bool b5 = lane & 32, b4 = lane & 16, b3 = lane & 8;
    u32x4 uw[8], vw[8];
#pragma unroll
    for (int j = 0; j < 8; ++j) uw[j] = *(const u32x4*)(U8 + (size_t)ip[j] * 1024 + 16 * lane);
#pragma unroll 1
    for (int bt = 0; bt < 16; ++bt) {
#pragma unroll
        for (int j = 0; j < 8; ++j) vw[j] = *(const u32x4*)(V8 + (size_t)ip[bt * 8 + j] * 1024 + 16 * lane);
        const unsigned em = ip[bt * 8 + (lane >> 3)];
        const float sum = su[em], svm = sv[em], gm = gp[bt * 8 + (lane >> 3)];
        float p[8];
#pragma unroll
        for (int j = 0; j < 8; ++j) { float s = 0.f;
#pragma unroll
            for (int q = 0; q < 4; ++q) { const pg8::f32x2_t lo = fp8x2(uw[j][q], false), hi = fp8x2(uw[j][q], true);
                s += x[4 * q] * lo.x; s += x[4 * q + 1] * lo.y; s += x[4 * q + 2] * hi.x; s += x[4 * q + 3] * hi.y; }
            p[j] = s; __builtin_amdgcn_sched_barrier(0); }
        { const int nb = bt < 15 ? bt + 1 : 15;
#pragma unroll
          for (int j = 0; j < 8; ++j) uw[j] = *(const u32x4*)(U8 + (size_t)ip[nb * 8 + j] * 1024 + 16 * lane); }
#pragma unroll
        for (int j = 0; j < 4; ++j) { const float keep = b5 ? p[j + 4] : p[j], send = b5 ? p[j] : p[j + 4]; p[j] = keep + __shfl_xor(send, 32); }
#pragma unroll
        for (int j = 0; j < 2; ++j) { const float keep = b4 ? p[j + 2] : p[j], send = b4 ? p[j] : p[j + 2]; p[j] = keep + __shfl_xor(send, 16); }
        { const float keep = b3 ? p[1] : p[0], send = b3 ? p[0] : p[1]; p[0] = keep + __shfl_xor(send, 8); }
        float dv = p[0]; dv += __shfl_xor(dv, 4); dv += __shfl_xor(dv, 2); dv += __shfl_xor(dv, 1);
        const float z = dv * rstd * sum; const float a = 0.5f * z * (1.f + erff(z * 0.70710678118654752f));
        const float wv = gm * a * svm;
#pragma unroll
        for (int j = 0; j < 8; ++j) { const float w = __uint_as_float((unsigned)__builtin_amdgcn_readlane((int)__float_as_uint(wv), 8 * j));
#pragma unroll
            for (int q = 0; q < 4; ++q) { const pg8::f32x2_t lo = fp8x2(vw[j][q], false), hi = fp8x2(vw[j][q], true);
                out[4 * q] += w * lo.x; out[4 * q + 1] += w * lo.y; out[4 * q + 2] += w * hi.x; out[4 * q + 3] += w * hi.y; }
            __builtin_amdgcn_sched_barrier(0); }
    }
    float* hp = dout + rc * 1024 + 16 * lane;
    f32x4 h[4]; float ss = 0.f;
#pragma unroll
    for (int q = 0; q < 4; ++q) { h[q] = *(const f32x4*)(hp + 4 * q);
#pragma unroll
        for (int i = 0; i < 4; ++i) { h[q][i] += out[4 * q + i]; ss += h[q][i] * h[q][i]; } }
    ss = wave_sum(ss);
    const float rf = 1.f / sqrtf(ss * (1.f / 1024.f) + EPS);
    const float* gq = gfin + 16 * lane;
    if (STORE) {
#pragma unroll
        for (int q = 0; q < 4; ++q) *(f32x4*)(hp + 4 * q) = h[q] * rf * *(const f32x4*)(gq + 4 * q); }
    else { asm volatile("" :: "v"(h[0] * rf), "v"(h[1] * rf), "v"(h[2] * rf), "v"(h[3] * rf)); }
}
__device__ __forceinline__ void peer_tables(const float* __restrict__ pu, const float* __restrict__ pv, unsigned char* __restrict__ T8, float* __restrict__ sinv, int lane, int gw, int NGW) {
    for (int row = gw; row < 32768; row += NGW) {
        const float* src = (row < 16384 ? pu + (size_t)row * 1024 : pv + (size_t)(row - 16384) * 1024) + 16 * lane;
        f32x4 v[4]; float am = 0.f;
#pragma unroll
        for (int q = 0; q < 4; ++q) { v[q] = *(const f32x4*)(src + 4 * q); am = fmaxf(am, fmaxf(fmaxf(fabsf(v[q][0]), fabsf(v[q][1])), fmaxf(fabsf(v[q][2]), fabsf(v[q][3])))); }
#pragma unroll
        for (int o = 1; o < 64; o <<= 1) am = fmaxf(am, __shfl_xor(am, o));
        const float sc = am > 0.f ? 224.f / am : 1.f;
        u32x4 w;
#pragma unroll
        for (int q = 0; q < 4; ++q) { unsigned t = __builtin_amdgcn_cvt_pk_fp8_f32(v[q][0] * sc, v[q][1] * sc, 0, false); t = __builtin_amdgcn_cvt_pk_fp8_f32(v[q][2] * sc, v[q][3] * sc, t, true); w[q] = t; }
        *(u32x4*)(T8 + (size_t)row * 1024 + 16 * lane) = w;
        if (lane == 0) sinv[row] = am > 0.f ? am / 224.f : 1.f;
    }
}

constexpr int NPHASE = 9;
struct Args { const float* in[17]; float* out; unsigned char* ws; int ph_lo, ph_hi; };
__global__ void __launch_bounds__(512, 2) fwd_kernel(Args a) {
    extern __shared__ __attribute__((aligned(16))) unsigned char lds_raw[];
    LAS unsigned char* lds = (LAS unsigned char*)lds_raw;
    cg::grid_group grid = cg::this_grid();
    const int tid = threadIdx.x, lane = tid & 63, wave = __builtin_amdgcn_readfirstlane(tid >> 6);
    const int lo = a.ph_lo, hi = a.ph_hi, G = gridDim.x;
    unsigned char* ws = a.ws;
    const float *x = a.in[0], *meta = a.in[1], *gmix = a.in[2], *w_in = a.in[3], *bgate = a.in[4], *lblog = a.in[5], *hgn = a.in[6], *sinks = a.in[7], *w_bh = a.in[8], *w_ba = a.in[9],
                *w_out = a.in[10], *gffn = a.in[11], *w_q = a.in[12], *subk = a.in[13], *pu = a.in[14], *pv = a.in[15], *gfin = a.in[16];
    bf16_t *Zh = (bf16_t*)(ws + WS_ZH), *Za = (bf16_t*)(ws + WS_ZA), *Zg = (bf16_t*)(ws + WS_ZG), *A1 = (bf16_t*)(ws + WS_A1), *OM = (bf16_t*)(ws + WS_OM), *A2 = (bf16_t*)(ws + WS_A2);
    bf16_t *Mb = (bf16_t*)(ws + WS_MB), *Qb = (bf16_t*)(ws + WS_QB), *Vt = (bf16_t*)(ws + WS_VT);
    bf16_t *WinT = (bf16_t*)(ws + WS_WIN), *WbhT = (bf16_t*)(ws + WS_WBH), *WbaT = (bf16_t*)(ws + WS_WBA), *WoutT = (bf16_t*)(ws + WS_WOUT), *WqT = (bf16_t*)(ws + WS_WQ), *SK = (bf16_t*)(ws + WS_SK);
    unsigned char *U8 = ws + WS_U8, *V8 = ws + WS_V8; float *suv = (float*)(ws + WS_SUV);
    float *Ub = (float*)(ws + WS_UB), *Dv = (float*)(ws + WS_DV), *rowssp = (float*)(ws + WS_RS);
#ifdef ONLY_PHASE
#define IN(k) ((k) == ONLY_PHASE && lo <= (k) && (k) < hi)
#else
#define IN(k) (lo <= (k) && (k) < hi)
#endif
#define SEAM(k) do { if (lo <= (k) && (k) + 1 < hi) grid.sync(); } while (0)

    if (IN(0)) { P0Args p{x, meta, gmix, w_in, w_bh, w_ba, w_out, w_q, subk, A1, WinT, WbhT, WbaT, WoutT, WqT, SK}; p0_prologue(lds, p); SEAM(0); }
    if (IN(1)) {
        pg8::Gemm g{A1, WinT, MA, 4864, 1024, 1024, 1024}; pg8::StaticOrder S; S.init(MA, 4864, G, (int)blockIdx.x);
        pg8::EpiZ E{Zh, Za, Zg, Vt};
        pg8::gemm_phase<pg8::EpiZ, pg8::StaticOrder, true, true>(lds, g, S, E);
        SEAM(1);
    }
    if (IN(2)) {
        for (int it = blockIdx.x; it < 1024 + 512; it += G) {
            if (it < 1024) {
#ifndef NO_HGA
 hgrn_A(lds, Zh, lblog, Ub, Dv, it);
#endif
 }
            else { const int ai = it - 1024, b = ai >> 6, n = ((ai & 63) >> 1) + 1, kvh = ai & 1;
#pragma unroll 1
                for (int si = wave; si < 16; si += 8) {
#ifndef NO_ATTN
 attn_sub(Za, Vt, sinks, OM, b, n, kvh * 4 + (si >> 2), si & 3, lane);
#endif
 } }
        }
        SEAM(2);
    }
    if (IN(3)) { hgrn_scan(Ub, Dv); SEAM(3); }
    if (IN(4)) { for (int it = blockIdx.x; it < 1024; it += G) hgrn_C(lds, Zh, lblog, Ub, hgn, OM, it); SEAM(4); }
    if (IN(5)) {
        peer_tables(pu, pv, U8, suv, lane, blockIdx.x * 8 + wave, G * 8);
        __syncthreads();
        pg8::StaticOrder S; S.init(MC, 1024, G, (int)blockIdx.x);
        { pg8::Gemm g{OM, WbhT, MC, 1024, 512, 1024, 512}; pg8::EpiGate<0> E{Mb, Zg, bgate}; pg8::gemm_phase<pg8::EpiGate<0>, pg8::StaticOrder, true, true>(lds, g, S, E); }
        { pg8::Gemm g{OM + 512, WbaT, MC, 1024, 512, 1024, 512}; pg8::EpiGate<1> E{Mb, Zg, bgate}; pg8::gemm_phase<pg8::EpiGate<1>, pg8::StaticOrder, true, true>(lds, g, S, E); }
        SEAM(5);
    }
    if (IN(6)) {
        pg8::Gemm g{Mb, WoutT, MC, 1024, 1024, 1024, 1024}; pg8::StaticOrder S; S.init(MC, 1024, G, (int)blockIdx.x);
        pg8::EpiH1 E{x, a.out, A2, gffn, rowssp};
        pg8::gemm_phase<pg8::EpiH1, pg8::StaticOrder, true, true>(lds, g, S, E);
        SEAM(6);
    }
    if (IN(7)) {
        pg8::Gemm g{A2, WqT, MC, 2048, 1024, 1024, 1024}; pg8::StaticOrder S; S.init(MC, 2048, G, (int)blockIdx.x);
        pg8::EpiQ E{Qb, rowssp};
        pg8::gemm_phase<pg8::EpiQ, pg8::StaticOrder, true, true>(lds, g, S, E);
        SEAM(7);
    }
    if (IN(8)) {
        for (int grp = blockIdx.x; grp < MC / 128; grp += G) {
            const int rc0 = grp * 128;
#ifndef NO_TOPK
            peer_topk(lds, Qb, SK, rc0 + 32 * (wave >> 1), 32 * (wave >> 1), 4 * (wave & 1), lane);
#endif
#ifdef PROBE_TOPK2
            __syncthreads(); peer_topk(lds, Qb, SK, rc0 + 32 * (wave >> 1), 32 * (wave >> 1), 4 * (wave & 1), lane);
#endif
            __syncthreads();
#pragma unroll 1
            for (int i = 0; i < 16; ++i) {
#ifdef PROBE_TOKEN2
 peer_token<false>(lds, 16 * wave + i, (size_t)rc0 + 16 * wave + i, A2, rowssp, U8, V8, suv, suv + 16384, a.out, gfin, lane);
#endif
#ifndef NO_TOKEN
 peer_token<true>(lds, 16 * wave + i, (size_t)rc0 + 16 * wave + i, A2, rowssp, U8, V8, suv, suv + 16384, a.out, gfin, lane);
#endif
 }
            __syncthreads();
        }
    }
#undef IN
#undef SEAM
}

extern "C" void kernel_launch(void* const* d_in, const int* in_sizes, int n_in, void* d_out, int out_size, void* d_ws, size_t ws_size, hipStream_t stream) {
    static int grid = 0;
    if (grid == 0) {
        if (n_in != 17 || out_size != MC * DM || ws_size < WS_END) { fprintf(stderr, "kernel_launch: unexpected shapes: n_in %d out %d ws %zu (need %zu)\n", n_in, out_size, ws_size, (size_t)WS_END); grid = -1; return; }
        int dev = 0, cus = 0, per_cu = 0;
        if (hipGetDevice(&dev) != hipSuccess || hipDeviceGetAttribute(&cus, hipDeviceAttributeMultiprocessorCount, dev) != hipSuccess) { fprintf(stderr, "kernel_launch: device query failed\n"); grid = -1; return; }
        if (hipFuncSetAttribute((const void*)fwd_kernel, hipFuncAttributeMaxDynamicSharedMemorySize, LDS_BYTES) != hipSuccess) { fprintf(stderr, "kernel_launch: hipFuncSetAttribute failed\n"); grid = -1; return; }
        if (hipOccupancyMaxActiveBlocksPerMultiprocessor(&per_cu, (const void*)fwd_kernel, 512, LDS_BYTES) != hipSuccess || per_cu < 1) { fprintf(stderr, "kernel_launch: occupancy query says %d blocks per CU\n", per_cu); per_cu = 1; }
        (void)hipGetLastError();
        grid = cus;
        fprintf(stderr, "kernel_launch: grid %d (occupancy %d per CU)\n", grid, per_cu);
    }
    if (grid < 0) return;
    Args a{};
    for (int i = 0; i < 17; ++i) a.in[i] = (const float*)d_in[i];
    a.out = (float*)d_out; a.ws = (unsigned char*)d_ws;
#if MK_ONE_LAUNCH
    a.ph_lo = 0; a.ph_hi = NPHASE;
    void* args[] = {&a};
    hipError_t e = hipLaunchCooperativeKernel((const void*)fwd_kernel, dim3(grid), dim3(512), args, LDS_BYTES, stream);
    if (e != hipSuccess) fprintf(stderr, "kernel_launch: cooperative launch failed: %s (grid %d)\n", hipGetErrorString(e), grid);
#else
#ifdef PROBE_SEQ
    const int seq[] = PROBE_SEQ;
    for (int p : seq) { a.ph_lo = p; a.ph_hi = p + 1; hipLaunchKernelGGL(fwd_kernel, dim3(grid), dim3(512), LDS_BYTES, stream, a); }
#else
    for (int p = 0; p < NPHASE; ++p) { a.ph_lo = p; a.ph_hi = p + 1; hipLaunchKernelGGL(fwd_kernel, dim3(grid), dim3(512), LDS_BYTES, stream, a); }
#endif
#endif
}
```

```cpp
#include <hip/hip_runtime.h>
#include <hip/hip_cooperative_groups.h>
#include <cstdio>
#include <cstdint>
namespace cg = cooperative_groups;

#ifndef MK_ONE_LAUNCH
#define MK_ONE_LAUNCH 1
#endif

constexpr int DM = 1024, NB = 8, SEQ = 4096, NMETA = 16, LTOK = SEQ + NMETA;
constexpr int MA_REAL = NB * LTOK;
constexpr int MA = 33024;
constexpr int MC = NB * SEQ;
constexpr int LPAD = 4224;
constexpr float EPS = 1e-6f;

namespace pg8 {
#define PG8_LAS __attribute__((address_space(3)))
typedef unsigned short bf16_t;
typedef short bf16x8 __attribute__((ext_vector_type(8)));
typedef float f32x4 __attribute__((ext_vector_type(4)));
typedef unsigned u32x4 __attribute__((ext_vector_type(4)));
constexpr int BM = 256, BK = 64, HALF = 128, HTB = HALF * BK * 2  , STAGE_BYTES = 8 * HTB, NXCD = 8, WGM = 8;

__host__ __device__ __forceinline__ int lds_byte(int r, int c) { const int st = (r >> 4) * 2 + (c >> 5), rr = r & 15, cc = c & 31, ob = rr * 64 + cc * 2; return st * 1024 + (ob ^ (((ob >> 9) & 1) << 5)); }
__host__ __device__ __forceinline__ void stage_rc(int b, int& R, int& C) { const int st = b / 1024, sb = b % 1024, swz = sb ^ (((sb >> 9) & 1) << 5); R = (st >> 1) * 16 + swz / 64; C = (st & 1) * 32 + (swz % 64) / 2; }
__host__ __device__ __forceinline__ int perm32(int rho) { const int n = rho >> 4, i = rho & 15; return 8 * (i >> 2) + 4 * n + (i & 3); }

struct Unit { int pm, pn; };
struct Gemm { const bf16_t* A; const bf16_t* Bt; int M, N, K, lda, ldb; };

struct StaticOrder {
    int nM, nN, nwg, G, c;
    __host__ __device__ void init(int M, int N, int G_, int c_) { nM = M / BM; nN = N / BM; nwg = nM * nN; G = G_; c = c_; }
    __host__ __device__ bool next(int i, Unit& u) const {
        const long L = (long)i * G + c; if (L >= nwg) return false;
        int wgid = (int)L; { const int q = nwg / NXCD, r = nwg % NXCD, xcd = wgid % NXCD, off = wgid / NXCD; wgid = (xcd < r ? xcd * (q + 1) : r * (q + 1) + (xcd - r) * q) + off; }
        const int nig = WGM * nN, gid = wgid / nig, fm = gid * WGM, gsz = (nM - fm) < WGM ? (nM - fm) : WGM;
        u.pm = fm + ((wgid % nig) % gsz); u.pn = (wgid % nig) / gsz; return true;
    }
    __device__ __forceinline__ void a_ready(const Unit&) const {}
    __device__ __forceinline__ void done(const Unit&) const {}
};

__device__ __forceinline__ unsigned cvt_pk_bf16(float lo, float hi) { unsigned r; asm volatile("v_cvt_pk_bf16_f32 %0, %1, %2" : "=v"(r) : "v"(lo), "v"(hi)); return r; }
typedef float f32x2 __attribute__((ext_vector_type(2)));
typedef float f32x2_t __attribute__((ext_vector_type(2))); typedef __bf16 bf16x2_t __attribute__((ext_vector_type(2)));
typedef unsigned u32x2 __attribute__((ext_vector_type(2)));
__device__ __forceinline__ unsigned cvtpk(float lo, float hi) { f32x2_t v = {lo, hi}; bf16x2_t b = __builtin_convertvector(v, bf16x2_t); return __builtin_bit_cast(unsigned, b); }
__device__ __forceinline__ bf16_t f2bf(float x) { return (bf16_t)(cvtpk(x, 0.f) & 0xffffu); }
__device__ __forceinline__ float bf2f(bf16_t v) { return __uint_as_float((unsigned)v << 16); }
__device__ __forceinline__ float bflo(unsigned w) { return __uint_as_float(w << 16); }
__device__ __forceinline__ float bfhi(unsigned w) { return __uint_as_float(w & 0xffff0000u); }
__device__ __forceinline__ float sigm(float x) { return __builtin_amdgcn_rcpf(1.f + __expf(-x)); }

struct EpiZ {
    static constexpr bool PERM = true, AFTER_DRAIN = false;
    bf16_t *Zh, *Za, *Zg, *Vt;
    __device__ __forceinline__ void operator()(const f32x4 (&acc)[2][2][4][2], const Unit& u, int wr, int wc, int fr, int fq) const {
        const int pn = u.pn; bf16_t* base; int ldc, colt;
        if (pn < 8) { base = Zh; ldc = 2048; colt = pn * 256; } else if (pn < 11) { base = Za; ldc = 768; colt = (pn - 8) * 256; } else { base = Zg; ldc = 2048; colt = (pn - 11) * 256; }
        const int row0 = u.pm * BM + wr * 64 + fr, col0 = colt + wc * 32 + 8 * fq;
#pragma unroll
        for (int ai = 0; ai < 2; ++ai)
#pragma unroll
            for (int m = 0; m < 4; ++m) { const int row = row0 + ai * HALF + m * 16; bf16_t* rowp = base + (size_t)row * ldc + col0;
#pragma unroll
                for (int bj = 0; bj < 2; ++bj) { const f32x4 v0 = acc[ai][bj][m][0], v1 = acc[ai][bj][m][1];
                    if (pn == 10 && bj == 1) {
                        if (row < MA_REAL) { const int b = row / LTOK, pos = row - b * LTOK; bf16_t* vp = Vt + ((size_t)(b * 128 + wc * 32 + 8 * fq) * LPAD + 112 + pos);
                            vp[0] = f2bf(v0[0]); vp[LPAD] = f2bf(v0[1]); vp[2 * LPAD] = f2bf(v0[2]); vp[3 * LPAD] = f2bf(v0[3]);
                            vp[4 * LPAD] = f2bf(v1[0]); vp[5 * LPAD] = f2bf(v1[1]); vp[6 * LPAD] = f2bf(v1[2]); vp[7 * LPAD] = f2bf(v1[3]); }
                    } else { u32x4 w; w.x = cvtpk(v0[0], v0[1]); w.y = cvtpk(v0[2], v0[3]); w.z = cvtpk(v1[0], v1[1]); w.w = cvtpk(v1[2], v1[3]); *(u32x4*)(rowp + bj * HALF) = w; } } }
    }
};
template <int PASS> struct EpiGate {
    static constexpr bool PERM = true, AFTER_DRAIN = false;
    bf16_t* Mb; const bf16_t* Zg; const float* bgate;
    __device__ __forceinline__ void operator()(const f32x4 (&acc)[2][2][4][2], const Unit& u, int wr, int wc, int fr, int fq) const {
        const int row0 = u.pm * BM + wr * 64 + fr, col0 = u.pn * BM + wc * 32 + 8 * fq;
        f32x4 bv[2][2];
#pragma unroll
        for (int bj = 0; bj < 2; ++bj)
#pragma unroll
            for (int n = 0; n < 2; ++n) bv[bj][n] = *(const f32x4*)(bgate + PASS * 1024 + col0 + bj * HALF + 4 * n);
#pragma unroll
        for (int ai = 0; ai < 2; ++ai)
#pragma unroll
            for (int m = 0; m < 4; ++m) { const int rc = row0 + ai * HALF + m * 16, ra = (rc >> 12) * LTOK + NMETA + (rc & 4095);
                const bf16_t* zp = Zg + (size_t)ra * 2048 + PASS * 1024 + col0; bf16_t* mp = Mb + (size_t)rc * 1024 + col0;
#pragma unroll
                for (int bj = 0; bj < 2; ++bj) { const u32x4 z = *(const u32x4*)(zp + bj * HALF); f32x4 v0 = acc[ai][bj][m][0], v1 = acc[ai][bj][m][1];
                    v0[0] *= sigm(bflo(z.x) + bv[bj][0][0]); v0[1] *= sigm(bfhi(z.x) + bv[bj][0][1]); v0[2] *= sigm(bflo(z.y) + bv[bj][0][2]); v0[3] *= sigm(bfhi(z.y) + bv[bj][0][3]);
                    v1[0] *= sigm(bflo(z.z) + bv[bj][1][0]); v1[1] *= sigm(bfhi(z.z) + bv[bj][1][1]); v1[2] *= sigm(bflo(z.w) + bv[bj][1][2]); v1[3] *= sigm(bfhi(z.w) + bv[bj][1][3]);
                    if (PASS == 1) { const u32x4 o = *(const u32x4*)(mp + bj * HALF);
                        v0[0] += bflo(o.x); v0[1] += bfhi(o.x); v0[2] += bflo(o.y); v0[3] += bfhi(o.y); v1[0] += bflo(o.z); v1[1] += bfhi(o.z); v1[2] += bflo(o.w); v1[3] += bfhi(o.w); }
                    u32x4 w; w.x = cvtpk(v0[0], v0[1]); w.y = cvtpk(v0[2], v0[3]); w.z = cvtpk(v1[0], v1[1]); w.w = cvtpk(v1[2], v1[3]); *(u32x4*)(mp + bj * HALF) = w; } }
    }
};
struct EpiH1 {
    static constexpr bool PERM = false, AFTER_DRAIN = false;
    const float* x; float* h1; bf16_t* A2; const float* gffn; float* rowssp;
    __device__ __forceinline__ void operator()(const f32x4 (&acc)[2][2][4][2], const Unit& u, int wr, int wc, int fr, int fq) const {
        const int row0 = u.pm * BM + wr * 64 + fr, col0 = u.pn * BM + wc * 32 + 4 * fq;
        f32x4 gv[2][2];
#pragma unroll
        for (int bj = 0; bj < 2; ++bj)
#pragma unroll
            for (int n = 0; n < 2; ++n) gv[bj][n] = *(const f32x4*)(gffn + col0 + bj * HALF + n * 16);
#pragma unroll
        for (int ai = 0; ai < 2; ++ai)
#pragma unroll
            for (int m = 0; m < 4; ++m) { const int rc = row0 + ai * HALF + m * 16; float ss = 0.f;
#pragma unroll
                for (int bj = 0; bj < 2; ++bj)
#pragma unroll
                    for (int n = 0; n < 2; ++n) { const size_t off = (size_t)rc * 1024 + col0 + bj * HALF + n * 16;
                        const f32x4 h = *(const f32x4*)(x + off) + acc[ai][bj][m][n]; *(f32x4*)(h1 + off) = h;
                        ss += (h[0] * h[0] + h[1] * h[1]) + (h[2] * h[2] + h[3] * h[3]);
                        const f32x4 y = h * gv[bj][n]; u32x2 w; w.x = cvtpk(y[0], y[1]); w.y = cvtpk(y[2], y[3]); *(u32x2*)(A2 + off) = w; }
                ss += __shfl_xor(ss, 16); ss += __shfl_xor(ss, 32);
                if (fq == 0) rowssp[(size_t)rc * 16 + u.pn * 4 + wc] = ss; }
    }
};
struct EpiQ {
    static constexpr bool PERM = true, AFTER_DRAIN = false;
    bf16_t* Q; const float* rowssp;
    __device__ __forceinline__ void operator()(const f32x4 (&acc)[2][2][4][2], const Unit& u, int wr, int wc, int fr, int fq) const {
        const int row0 = u.pm * BM + wr * 64 + fr, col0 = u.pn * BM + wc * 32 + 8 * fq;
#pragma unroll
        for (int ai = 0; ai < 2; ++ai)
#pragma unroll
            for (int m = 0; m < 4; ++m) { const int rc = row0 + ai * HALF + m * 16;
                const f32x4* rp = (const f32x4*)(rowssp + (size_t)rc * 16); const f32x4 s4 = (rp[0] + rp[1]) + (rp[2] + rp[3]);
                const float rstd = __builtin_amdgcn_rsqf(((s4[0] + s4[1]) + (s4[2] + s4[3])) * (1.0f / 1024.0f) + 1e-6f);
#pragma unroll
                for (int bj = 0; bj < 2; ++bj) { const f32x4 v0 = acc[ai][bj][m][0] * rstd, v1 = acc[ai][bj][m][1] * rstd;
                    u32x4 w; w.x = cvtpk(v0[0], v0[1]); w.y = cvtpk(v0[2], v0[3]); w.z = cvtpk(v1[0], v1[1]); w.w = cvtpk(v1[2], v1[3]); *(u32x4*)(Q + (size_t)rc * 2048 + col0 + bj * HALF) = w; } }
    }
};
template <class Epi, class Sched, bool ALIGN_EPI = false, bool SP2 = false>
__device__ __forceinline__ void gemm_phase(PG8_LAS unsigned char* lds, const Gemm g, const Sched& S, const Epi& E) {
    const int tid = threadIdx.x, wid = __builtin_amdgcn_readfirstlane(tid >> 6), lane = tid & 63, wr = wid >> 2, wc = wid & 3, fr = lane & 15, fq = lane >> 4;
    const int K = g.K, nt = K / BK;
    unsigned voffA[2], voffB[2];
#pragma unroll
    for (int i = 0; i < 2; ++i) { int R, C; stage_rc(tid * 16 + i * 8192, R, C); const int Rb = Epi::PERM ? ((R & ~31) + perm32(R & 31)) : R;
        voffA[i] = (unsigned)(R * g.lda + C) * 2u; voffB[i] = (unsigned)(Rb * g.ldb + C) * 2u; }
    const size_t kstep = (size_t)(BK * 2);
    const size_t hstepA = (size_t)HALF * g.lda * 2, hstepB = (size_t)HALF * g.ldb * 2;
    const size_t tstepA = 2 * hstepA, tstepB = 2 * hstepB;
    const unsigned ldsw = (unsigned)wid * 1024u;
    const int aoff = lds_byte(wr * 64 + fr, fq * 8), boff = lds_byte(wc * 32 + fr, fq * 8);
#define PG8_SA(b, h) (((b) * 2 + (h)) * HTB)
#define PG8_SB(b, h) ((4 + (b) * 2 + (h)) * HTB)
#define PG8_STAGE(bufoff, gbase, voff) do { _Pragma("unroll") for (int _i = 0; _i < 2; ++_i) \
        __builtin_amdgcn_global_load_lds((const unsigned*)((const char*)(gbase) + (voff)[_i]), (PG8_LAS unsigned*)(lds + (bufoff) + ldsw + _i * 8192), 16, 0, 0); } while (0)
#define PG8_LDA(dst, b, h) do { _Pragma("unroll") for (int m = 0; m < 4; ++m) _Pragma("unroll") for (int k = 0; k < 2; ++k) dst[m][k] = *(const PG8_LAS bf16x8*)(lds + PG8_SA(b, h) + aoff + m * 2048 + k * 1024); } while (0)
#define PG8_LDB(dst, b, h) do { _Pragma("unroll") for (int n = 0; n < 2; ++n) _Pragma("unroll") for (int k = 0; k < 2; ++k) dst[n][k] = *(const PG8_LAS bf16x8*)(lds + PG8_SB(b, h) + boff + n * 2048 + k * 1024); } while (0)
#define PG8_MMA(ai, bj, At, Bt) do { __builtin_amdgcn_s_setprio(1); _Pragma("unroll") for (int m = 0; m < 4; ++m) _Pragma("unroll") for (int n = 0; n < 2; ++n) _Pragma("unroll") for (int k = 0; k < 2; ++k) \
        acc[ai][bj][m][n] = __builtin_amdgcn_mfma_f32_16x16x32_bf16(Bt[n][k], At[m][k], acc[ai][bj][m][n], 0, 0, 0); __builtin_amdgcn_s_setprio(0); } while (0)
#define PG8_WAIT_V(n) asm volatile("s_waitcnt vmcnt(" #n ")" ::: "memory")
#define PG8_WAIT_L(n) asm volatile("s_waitcnt lgkmcnt(" #n ")" ::: "memory")
#define PG8_BAR __builtin_amdgcn_s_barrier()
#define PG8_SCHED __builtin_amdgcn_sched_barrier(0)
    Unit cur, nxt; int ui = 0;
    if (!S.next(0, cur)) return;
    f32x4 acc[2][2][4][2];
#pragma unroll
    for (int a = 0; a < 2; ++a)
#pragma unroll
        for (int b = 0; b < 2; ++b)
#pragma unroll
            for (int m = 0; m < 4; ++m)
#pragma unroll
                for (int n = 0; n < 2; ++n) acc[a][b][m][n] = (f32x4){0.f, 0.f, 0.f, 0.f};
    bf16x8 At[4][2], B0[2][2], B1[2][2];
    const char* cA = (const char*)g.A + (size_t)cur.pm * tstepA; const char* cB = (const char*)g.Bt + (size_t)cur.pn * tstepB;
    S.a_ready(cur);
    if constexpr (SP2) {
        PG8_STAGE(PG8_SB(0, 0), cB, voffB); PG8_STAGE(PG8_SB(0, 1), cB + hstepB, voffB); PG8_STAGE(PG8_SA(0, 0), cA, voffA); PG8_STAGE(PG8_SA(0, 1), cA + hstepA, voffA);
        if (wr == 1) PG8_BAR;
        PG8_WAIT_V(2); PG8_BAR;
        PG8_STAGE(PG8_SB(1, 0), cB + kstep, voffB); PG8_STAGE(PG8_SA(1, 0), cA + kstep, voffA); PG8_STAGE(PG8_SB(1, 1), cB + hstepB + kstep, voffB);
        PG8_WAIT_V(6); PG8_BAR;
    } else {
        PG8_STAGE(PG8_SB(0, 0), cB, voffB); PG8_STAGE(PG8_SA(0, 0), cA, voffA); PG8_STAGE(PG8_SB(0, 1), cB + hstepB, voffB); PG8_STAGE(PG8_SA(0, 1), cA + hstepA, voffA);
        if (wr == 1) PG8_BAR;
        PG8_WAIT_V(4); PG8_BAR;
        PG8_STAGE(PG8_SB(1, 0), cB + kstep, voffB); PG8_STAGE(PG8_SA(1, 0), cA + kstep, voffA); PG8_STAGE(PG8_SB(1, 1), cB + hstepB + kstep, voffB);
        PG8_WAIT_V(6); PG8_BAR;
    }
    for (;;) {
        const bool has_next = S.next(ui + 1, nxt);
        const char* nA = has_next ? (const char*)g.A + (size_t)nxt.pm * tstepA : cA; const char* nB = has_next ? (const char*)g.Bt + (size_t)nxt.pn * tstepB : cB;
        for (int t = 0; t < nt; t += 2) {
            const bool last = (t == nt - 2);
            const char* a1 = cA + (size_t)(t + 1) * kstep;
            const char* a2 = last ? nA : cA + (size_t)(t + 2) * kstep; const char* b2 = last ? nB : cB + (size_t)(t + 2) * kstep;
            const char* a3 = a2 + kstep; const char* b3 = b2 + kstep;
            if (last && has_next) S.a_ready(nxt);
            if constexpr (SP2) {
            PG8_LDB(B0, 0, 0); PG8_LDB(B1, 0, 1); PG8_SCHED; PG8_LDA(At, 0, 0); PG8_STAGE(PG8_SA(1, 1), a1 + hstepA, voffA);
            PG8_WAIT_V(8); PG8_WAIT_L(0); PG8_BAR; PG8_MMA(0, 0, At, B0); PG8_MMA(0, 1, At, B1); PG8_BAR; PG8_SCHED;
            PG8_LDA(At, 0, 1); PG8_STAGE(PG8_SB(0, 0), b2, voffB); PG8_STAGE(PG8_SB(0, 1), b2 + hstepB, voffB); PG8_STAGE(PG8_SA(0, 0), a2, voffA);
            PG8_WAIT_V(8); PG8_WAIT_L(0); PG8_BAR; PG8_MMA(1, 0, At, B0); PG8_MMA(1, 1, At, B1); PG8_BAR; PG8_SCHED;
            PG8_LDB(B0, 1, 0); PG8_LDB(B1, 1, 1); PG8_SCHED; PG8_LDA(At, 1, 0); PG8_STAGE(PG8_SA(0, 1), a2 + hstepA, voffA);
            PG8_WAIT_V(8); PG8_WAIT_L(0); PG8_BAR; PG8_MMA(0, 0, At, B0); PG8_MMA(0, 1, At, B1); PG8_BAR; PG8_SCHED;
            PG8_LDA(At, 1, 1); PG8_STAGE(PG8_SB(1, 0), b3, voffB); PG8_STAGE(PG8_SB(1, 1), b3 + hstepB, voffB); PG8_STAGE(PG8_SA(1, 0), a3, voffA);
            PG8_WAIT_V(8); PG8_WAIT_L(0); PG8_BAR; PG8_MMA(1, 0, At, B0); PG8_MMA(1, 1, At, B1); PG8_BAR; PG8_SCHED;
            } else {
            PG8_LDB(B0, 0, 0); PG8_SCHED; PG8_LDA(At, 0, 0); PG8_STAGE(PG8_SA(1, 1), a1 + hstepA, voffA);
            PG8_WAIT_L(8); PG8_BAR; PG8_WAIT_L(0); PG8_MMA(0, 0, At, B0); PG8_BAR; PG8_SCHED;
            PG8_LDB(B1, 0, 1); PG8_STAGE(PG8_SB(0, 0), b2, voffB);
            PG8_BAR; PG8_WAIT_L(0); PG8_MMA(0, 1, At, B1); PG8_BAR;
            PG8_LDA(At, 0, 1); PG8_STAGE(PG8_SA(0, 0), a2, voffA);
            PG8_BAR; PG8_WAIT_L(0); PG8_MMA(1, 0, At, B0); PG8_BAR; PG8_SCHED;
            PG8_STAGE(PG8_SB(0, 1), b2 + hstepB, voffB);
            PG8_WAIT_V(6); PG8_BAR; PG8_MMA(1, 1, At, B1); PG8_BAR;
            PG8_LDB(B0, 1, 0); PG8_SCHED; PG8_LDA(At, 1, 0); PG8_STAGE(PG8_SA(0, 1), a2 + hstepA, voffA);
            PG8_WAIT_L(8); PG8_BAR; PG8_WAIT_L(0); PG8_MMA(0, 0, At, B0); PG8_BAR; PG8_SCHED;
            PG8_LDB(B1, 1, 1); PG8_STAGE(PG8_SB(1, 0), b3, voffB);
            PG8_BAR; PG8_WAIT_L(0); PG8_MMA(0, 1, At, B1); PG8_BAR;
            PG8_LDA(At, 1, 1); PG8_STAGE(PG8_SA(1, 0), a3, voffA);
            PG8_BAR; PG8_WAIT_L(0); PG8_MMA(1, 0, At, B0); PG8_BAR; PG8_SCHED;
            PG8_STAGE(PG8_SB(1, 1), b3 + hstepB, voffB);
            PG8_WAIT_V(6); PG8_BAR; PG8_MMA(1, 1, At, B1); PG8_BAR;
            }
        }
        if constexpr (ALIGN_EPI) { if (wr == 0) PG8_BAR; }
        if constexpr (!Epi::AFTER_DRAIN) { E(acc, cur, wr, wc, fr, fq); S.done(cur); }
        if (!has_next) break;
#pragma unroll
        for (int a = 0; a < 2; ++a)
#pragma unroll
            for (int b = 0; b < 2; ++b)
#pragma unroll
                for (int m = 0; m < 4; ++m)
#pragma unroll
                    for (int n = 0; n < 2; ++n) acc[a][b][m][n] = (f32x4){0.f, 0.f, 0.f, 0.f};
        cur = nxt; cA = nA; cB = nB; ++ui;
        if constexpr (ALIGN_EPI) { if (wr == 1) PG8_BAR; }
    }
    PG8_WAIT_V(0);
    if constexpr (!ALIGN_EPI) { if (wr == 0) PG8_BAR; }
    PG8_BAR;
    if constexpr (Epi::AFTER_DRAIN) { E.fused(acc, cur, wr, wc, fr, fq, lds, wid, lane); S.done(cur); }
#undef PG8_SA
#undef PG8_SB
#undef PG8_STAGE
#undef PG8_LDA
#undef PG8_LDB
#undef PG8_MMA
#undef PG8_WAIT_V
#undef PG8_WAIT_L
#undef PG8_BAR
#undef PG8_SCHED
}
}
using pg8::bf16_t; using pg8::bf16x8; using pg8::f32x4; using pg8::u32x4; using pg8::u32x2; using pg8::cvtpk; using pg8::f2bf; using pg8::bf2f; using pg8::bflo; using pg8::bfhi; using pg8::sigm;
#define LAS __attribute__((address_space(3)))
typedef float f32x16 __attribute__((ext_vector_type(16)));
#define MFMA32(a, b, c) __builtin_amdgcn_mfma_f32_32x32x16_bf16((a), (b), (c), 0, 0, 0)

constexpr size_t MiB = 1u << 20;
constexpr size_t WS_ZH = 0;
constexpr size_t WS_MB = WS_ZH, WS_U8 = WS_ZH + 64 * MiB, WS_V8 = WS_ZH + 80 * MiB, WS_SUV = WS_ZH + 96 * MiB;
constexpr size_t WS_ZA = 129 * MiB;
constexpr size_t WS_ZG = 178 * MiB;
constexpr size_t WS_QB = WS_ZG;
constexpr size_t WS_A1 = 307 * MiB;
constexpr size_t WS_OM = WS_A1, WS_A2 = WS_A1;
constexpr size_t WS_UB = 372 * MiB;
constexpr size_t WS_DV = 436 * MiB;
constexpr size_t WS_VT = 437 * MiB;
constexpr size_t WS_WIN = 446 * MiB;
constexpr size_t WS_WBH = 456 * MiB, WS_WBA = 457 * MiB, WS_WOUT = 458 * MiB, WS_WQ = 460 * MiB, WS_SK = 464 * MiB;
constexpr size_t WS_RS = 465 * MiB;
constexpr size_t WS_END = 467 * MiB;
constexpr int LDS_BYTES = 151552;

__device__ __forceinline__ float wave_sum(float v) {
#pragma unroll
    for (int o = 1; o < 64; o <<= 1) v += __shfl_xor(v, o);
    return v;
}
__device__ __forceinline__ void p0_transpose_item(const float* __restrict__ W, int K, int N, bf16_t* __restrict__ WT, LAS float* scr, int item, int lane) {
    const int nblk = N / 32, kb = item / nblk, nb = item % nblk, k0 = 64 * kb, n0 = 32 * nb;
#pragma unroll 8
    for (int i = 0; i < 32; ++i) { const int kk = 2 * i + (lane >> 5); scr[kk * 33 + (lane & 31)] = W[(size_t)(k0 + kk) * N + n0 + (lane & 31)]; }
    asm volatile("s_waitcnt lgkmcnt(0)" ::: "memory");
    const int c = lane & 7;
#pragma unroll
    for (int j = 0; j < 4; ++j) { const int n = (lane >> 3) + 8 * j; const LAS float* s = scr + (8 * c) * 33 + n;
        u32x4 o; o.x = cvtpk(s[0 * 33], s[1 * 33]); o.y = cvtpk(s[2 * 33], s[3 * 33]); o.z = cvtpk(s[4 * 33], s[5 * 33]); o.w = cvtpk(s[6 * 33], s[7 * 33]);
        *(u32x4*)(WT + (size_t)(n0 + n) * K + k0 + 8 * c) = o; }
    asm volatile("s_waitcnt lgkmcnt(0)" ::: "memory");
}
struct P0Args { const float *x, *meta, *gmix, *w_in, *w_bh, *w_ba, *w_out, *w_q, *subk; bf16_t *A1, *WinT, *WbhT, *WbaT, *WoutT, *WqT, *SK; };
__device__ __forceinline__ void p0_prologue(LAS unsigned char* lds, const P0Args& p) {
    const int tid = threadIdx.x, lane = tid & 63, wave = tid >> 6;
    LAS float* scr = (LAS float*)(lds + wave * 16384);
    const int gw = blockIdx.x * 8 + wave, NGW = gridDim.x * 8;
    constexpr int I_IN = 16 * 152, I_B = 8 * 32, I_O = 16 * 32, I_Q = 16 * 64, NITEMS = I_IN + 2 * I_B + I_O + I_Q;
    for (int it = gw; it < NITEMS; it += NGW) {
        int r = it;
        if (r < I_IN) { p0_transpose_item(p.w_in, 1024, 4864, p.WinT, scr, r, lane); continue; } r -= I_IN;
        if (r < I_B) { p0_transpose_item(p.w_bh, 512, 1024, p.WbhT, scr, r, lane); continue; } r -= I_B;
        if (r < I_B) { p0_transpose_item(p.w_ba, 512, 1024, p.WbaT, scr, r, lane); continue; } r -= I_B;
        if (r < I_O) { p0_transpose_item(p.w_out, 1024, 1024, p.WoutT, scr, r, lane); continue; } r -= I_O;
        p0_transpose_item(p.w_q, 1024, 2048, p.WqT, scr, r, lane);
    }
    for (int i = blockIdx.x * 512 + tid; i < 262144 / 8; i += gridDim.x * 512) {
        const f32x4 a = *(const f32x4*)(p.subk + (size_t)i * 8), b = *(const f32x4*)(p.subk + (size_t)i * 8 + 4);
        u32x4 o; o.x = cvtpk(a[0], a[1]); o.y = cvtpk(a[2], a[3]); o.z = cvtpk(b[0], b[1]); o.w = cvtpk(b[2], b[3]); *(u32x4*)(p.SK + (size_t)i * 8) = o; }
    f32x4 g[4];
#pragma unroll
    for (int j = 0; j < 4; ++j) g[j] = *((const f32x4*)p.gmix + lane + 64 * j);
    for (int m = gw; m < MA; m += NGW) {
        unsigned long long* o8 = (unsigned long long*)(p.A1 + (size_t)m * 1024) + lane;
        if (m >= MA_REAL) {
#pragma unroll
            for (int j = 0; j < 4; ++j) o8[64 * j] = 0ull;
            continue; }
        const int b = m / LTOK, pos = m - b * LTOK;
        const float* src = pos < NMETA ? p.meta + (size_t)pos * 1024 : p.x + ((size_t)b * SEQ + (pos - NMETA)) * 1024;
        const f32x4* xr = (const f32x4*)src + lane; f32x4 v[4]; float s = 0.f;
#pragma unroll
        for (int j = 0; j < 4; ++j) { v[j] = xr[64 * j]; s += (v[j][0] * v[j][0] + v[j][1] * v[j][1]) + (v[j][2] * v[j][2] + v[j][3] * v[j][3]); }
        const float rstd = 1.f / sqrtf(wave_sum(s) * (1.f / 1024.f) + EPS);
#pragma unroll
        for (int j = 0; j < 4; ++j) { const f32x4 y = v[j] * rstd * g[j]; o8[64 * j] = (unsigned long long)cvtpk(y[0], y[1]) | ((unsigned long long)cvtpk(y[2], y[3]) << 32); }
    }
}

constexpr int SR = 272;
constexpr int OFF_Q = 0, OFF_K = 34816, OFF_V = 69632, OFF_S = 104448, OFF_VEC = 139264;
__device__ __forceinline__ bf16x8 ldfrag(const LAS unsigned char* base, int row, int kk8, int h2) { return *(const LAS bf16x8*)(base + row * SR + (kk8 * 16 + 8 * h2) * 2); }

constexpr int OFF_SEGP = OFF_VEC, OFF_VEC2 = OFF_VEC + 8192, OFF_SSQ = OFF_VEC2 + 1024;
template <bool WITH_Q>
__device__ __forceinline__ void hgrn_front(LAS unsigned char* lds, const bf16_t* __restrict__ Zh, const float* __restrict__ lblog, int b, int h, int c, float (&g)[8][4], float (&kk)[8][4], float (&qq)[8][4], u32x2 (&vraw)[8]) {
    const int tid = threadIdx.x, c4 = tid & 31, seg = tid >> 5;
    const f32x4 l0 = *(const f32x4*)(lblog + h * 128 + 4 * c4), l1 = *(const f32x4*)(lblog + 512 + h * 128 + 4 * c4);
    float lb[4], run[4];
#pragma unroll
    for (int k = 0; k < 4; ++k) { lb[k] = sigm(l0[k] - l1[k]); run[k] = 1.f; }
    u32x2 hfw[8], hqw[8];
#pragma unroll
    for (int i = 0; i < 8; ++i) { const int pos = 128 * c - 112 + 8 * seg + i; const bool valid = pos >= 0;
        const bf16_t* zr = Zh + (size_t)(b * LTOK + (valid ? pos : 0)) * 2048 + h * 128 + 4 * c4;
        hfw[i] = *(const u32x2*)(zr + 512); if (WITH_Q) hqw[i] = *(const u32x2*)zr; vraw[i] = *(const u32x2*)(zr + 1024);
        if (!valid) { hfw[i] = (u32x2){0x7f007f00u, 0x7f007f00u}; hqw[i] = (u32x2){0u, 0u}; vraw[i] = (u32x2){0u, 0u}; } }
#pragma unroll
    for (int i = 0; i < 8; ++i) {
        const float hf[4] = {bflo(hfw[i].x), bfhi(hfw[i].x), bflo(hfw[i].y), bfhi(hfw[i].y)};
#pragma unroll
        for (int k = 0; k < 4; ++k) { const float sg = sigm(hf[k]); const float f = lb[k] + (1.f - lb[k]) * sg; kk[i][k] = (1.f - lb[k]) * (1.f - sg); run[k] *= f; g[i][k] = run[k]; }
        if (WITH_Q) { qq[i][0] = bflo(hqw[i].x); qq[i][1] = bfhi(hqw[i].x); qq[i][2] = bflo(hqw[i].y); qq[i][3] = bfhi(hqw[i].y); } }
    *(LAS f32x4*)(lds + OFF_SEGP + (seg * 128 + 4 * c4) * 4) = (f32x4){run[0], run[1], run[2], run[3]};
    __syncthreads();
}
__device__ __forceinline__ void hgrn_base(LAS unsigned char* lds, float (&base)[4]) {
    const int tid = threadIdx.x, c4 = tid & 31, seg = tid >> 5;
    const LAS f32x4* sp = (const LAS f32x4*)(lds + OFF_SEGP) + c4;
    f32x4 p = (f32x4){1.f, 1.f, 1.f, 1.f};
    if (seg < 8) { for (int s = seg; s < 8; ++s) p *= sp[s * 32];
        if (seg == 0) *(LAS f32x4*)(lds + OFF_VEC2 + (4 * c4) * 4) = p;
#pragma unroll
        for (int k = 0; k < 4; ++k) base[k] = __builtin_amdgcn_rcpf(p[k]); }
    else { for (int s = 8; s < seg; ++s) p *= sp[s * 32];
        if (seg == 15) *(LAS f32x4*)(lds + OFF_VEC2 + (128 + 4 * c4) * 4) = p * sp[15 * 32];
#pragma unroll
        for (int k = 0; k < 4; ++k) base[k] = p[k]; }
}
__device__ __forceinline__ void hgrn_put_vt(LAS unsigned char* lds, const u32x2 (&vraw)[8], int c4, int seg) {
#pragma unroll
    for (int k = 0; k < 4; ++k) { unsigned e[8];
#pragma unroll
        for (int i = 0; i < 8; ++i) { const unsigned w = (k < 2) ? vraw[i].x : vraw[i].y; e[i] = (k & 1) ? (w >> 16) : (w & 0xffffu); }
        *(LAS u32x4*)(lds + OFF_V + (4 * c4 + k) * SR + seg * 16) = (u32x4){e[0] | (e[1] << 16), e[2] | (e[3] << 16), e[4] | (e[5] << 16), e[6] | (e[7] << 16)}; }
}

__device__ __forceinline__ void hgrn_A(LAS unsigned char* lds, const bf16_t* __restrict__ Zh, const float* __restrict__ lblog, float* __restrict__ Ub, float* __restrict__ Dv, int item) {
    const int tid = threadIdx.x, lane = tid & 63, wid = tid >> 6, r32 = lane & 31, h2 = lane >> 5;
    const int c = item & 31, bh = item >> 5, b = bh >> 2, h = bh & 3;
    const int c4 = tid & 31, seg = tid >> 5;
    float g[8][4], kk[8][4], qq[8][4]; u32x2 vraw[8];
    hgrn_front<false>(lds, Zh, lblog, b, h, c, g, kk, qq, vraw);
    { float base[4]; hgrn_base(lds, base);
#pragma unroll
      for (int k = 0; k < 4; ++k) { float kt[8];
#pragma unroll
          for (int i = 0; i < 8; ++i) kt[i] = kk[i][k] * __builtin_amdgcn_rcpf(base[k] * g[i][k]);
          *(LAS u32x4*)(lds + OFF_K + (4 * c4 + k) * SR + seg * 16) = (u32x4){cvtpk(kt[0], kt[1]), cvtpk(kt[2], kt[3]), cvtpk(kt[4], kt[5]), cvtpk(kt[6], kt[7])}; }
      hgrn_put_vt(lds, vraw, c4, seg); }
    __syncthreads();
    const int e0 = 32 * (wid >> 1), d0 = 64 * (wid & 1);
    f32x16 acc[2]; acc[0] = f32x16{}; acc[1] = f32x16{};
#pragma unroll
    for (int k8 = 0; k8 < 8; ++k8) { const bf16x8 a = ldfrag(lds + OFF_V, e0 + r32, k8, h2);
#pragma unroll
        for (int j = 0; j < 2; ++j) acc[j] = MFMA32(a, ldfrag(lds + OFF_K, d0 + 32 * j + r32, k8, h2), acc[j]); }
    const LAS float* vec2 = (const LAS float*)(lds + OFF_VEC2);
#pragma unroll
    for (int j = 0; j < 2; ++j) { const int dc = d0 + 32 * j + r32; const float sc = vec2[128 + dc];
        float* up = Ub + ((size_t)item * 128 + e0 + 4 * h2) * 128 + dc;
#pragma unroll
        for (int r = 0; r < 16; ++r) up[(size_t)((r & 3) + 8 * (r >> 2)) * 128] = acc[j][r] * sc; }
    if (tid < 128) Dv[(size_t)item * 128 + tid] = vec2[tid] * vec2[128 + tid];
    __syncthreads();
}

__device__ __forceinline__ void hgrn_C(LAS unsigned char* lds, const bf16_t* __restrict__ Zh, const float* __restrict__ lblog, const float* __restrict__ Ub, const float* __restrict__ hgn, bf16_t* __restrict__ OM, int item) {
    const int tid = threadIdx.x, lane = tid & 63, wid = tid >> 6, r32 = lane & 31, h2 = lane >> 5;
    const int c = (item & 31) + 1, bh = item >> 5, b = bh >> 2, h = bh & 3;
    const int c4 = tid & 31, seg = tid >> 5;
    const int tb = wid >> 1, wh = wid & 1;
    f32x4 sreg[8];
    { const float* sp = Ub + (size_t)item * 16384;
#pragma unroll
      for (int q = 0; q < 8; ++q) sreg[q] = *(const f32x4*)(sp + (size_t)(tid + 512 * q) * 4); }
    const size_t rc = (size_t)b * SEQ + 128 * (c - 1) + 32 * tb + r32, ra = (size_t)b * LTOK + 128 * c - 112 + 32 * tb + r32;
    u32x2 gate[2][4];
#pragma unroll
    for (int j = 0; j < 2; ++j)
#pragma unroll
        for (int gq = 0; gq < 4; ++gq) gate[j][gq] = *(const u32x2*)(Zh + ra * 2048 + 1536 + h * 128 + 64 * wh + 32 * j + 8 * gq + 4 * h2);
    float g[8][4], kk[8][4], qq[8][4]; u32x2 vraw[8];
    hgrn_front<true>(lds, Zh, lblog, b, h, c, g, kk, qq, vraw);
    { float base[4]; hgrn_base(lds, base);
#pragma unroll
      for (int i = 0; i < 8; ++i) { float r[4], ri[4];
#pragma unroll
          for (int k = 0; k < 4; ++k) { r[k] = base[k] * g[i][k]; ri[k] = __builtin_amdgcn_rcpf(r[k]); }
          const int t = 8 * seg + i;
          *(LAS u32x2*)(lds + OFF_Q + t * SR + 8 * c4) = (u32x2){cvtpk(qq[i][0] * r[0], qq[i][1] * r[1]), cvtpk(qq[i][2] * r[2], qq[i][3] * r[3])};
          *(LAS u32x2*)(lds + OFF_K + t * SR + 8 * c4) = (u32x2){cvtpk(kk[i][0] * ri[0], kk[i][1] * ri[1]), cvtpk(kk[i][2] * ri[2], kk[i][3] * ri[3])}; }
      hgrn_put_vt(lds, vraw, c4, seg); }
    __syncthreads();
    { const LAS float* vec2 = (const LAS float*)(lds + OFF_VEC2);
#pragma unroll
      for (int q = 0; q < 8; ++q) { const int idx = tid + 512 * q, e = idx >> 5, d4 = (idx & 31) * 4; const f32x4 pr = *(const LAS f32x4*)(vec2 + d4); const f32x4 sv = sreg[q] * pr;
          *(LAS u32x2*)(lds + OFF_S + e * SR + d4 * 2) = (u32x2){cvtpk(sv[0], sv[1]), cvtpk(sv[2], sv[3])}; } }
    f32x16 sc[2]; sc[0] = f32x16{}; sc[1] = f32x16{};
#pragma unroll
    for (int j = 0; j < 2; ++j) { const int sb = 2 * wh + j;
        if (sb <= tb) {
#pragma unroll
            for (int k8 = 0; k8 < 8; ++k8) sc[j] = MFMA32(ldfrag(lds + OFF_K, 32 * sb + r32, k8, h2), ldfrag(lds + OFF_Q, 32 * tb + r32, k8, h2), sc[j]); } }
    __syncthreads();
    { const int t = 32 * tb + r32;
#pragma unroll
      for (int j = 0; j < 2; ++j) { const int sb = 2 * wh + j;
#pragma unroll
          for (int gq = 0; gq < 4; ++gq) { const int s0 = 32 * sb + 8 * gq + 4 * h2;
              const float p0 = (sb <= tb && s0 + 0 <= t) ? sc[j][4 * gq + 0] : 0.f, p1 = (sb <= tb && s0 + 1 <= t) ? sc[j][4 * gq + 1] : 0.f;
              const float p2 = (sb <= tb && s0 + 2 <= t) ? sc[j][4 * gq + 2] : 0.f, p3 = (sb <= tb && s0 + 3 <= t) ? sc[j][4 * gq + 3] : 0.f;
              u32x2 w; w.x = cvtpk(p0, p1); w.y = cvtpk(p2, p3); *(LAS u32x2*)(lds + OFF_K + t * SR + s0 * 2) = w; } } }
    __syncthreads();
    f32x16 oc[2]; oc[0] = f32x16{}; oc[1] = f32x16{};
    for (int k8 = 0; k8 < 2 * (tb + 1); ++k8) { const bf16x8 pb = ldfrag(lds + OFF_K, 32 * tb + r32, k8, h2);
#pragma unroll
        for (int j = 0; j < 2; ++j) oc[j] = MFMA32(ldfrag(lds + OFF_V, 64 * wh + 32 * j + r32, k8, h2), pb, oc[j]); }
#pragma unroll
    for (int k8 = 0; k8 < 8; ++k8) { const bf16x8 qb = ldfrag(lds + OFF_Q, 32 * tb + r32, k8, h2);
#pragma unroll
        for (int j = 0; j < 2; ++j) oc[j] = MFMA32(ldfrag(lds + OFF_S, 64 * wh + 32 * j + r32, k8, h2), qb, oc[j]); }
    LAS float* ssq = (LAS float*)(lds + OFF_SSQ);
    { float ss = 0.f;
#pragma unroll
      for (int j = 0; j < 2; ++j)
#pragma unroll
          for (int r = 0; r < 16; ++r) ss += oc[j][r] * oc[j][r];
      ss += __shfl_xor(ss, 32);
      if (h2 == 0) ssq[wh * 128 + 32 * tb + r32] = ss; }
    __syncthreads();
    { const int t = 32 * tb + r32; const float rstd = __builtin_amdgcn_rsqf((ssq[t] + ssq[128 + t]) * (1.f / 128.f) + EPS);
#pragma unroll
      for (int j = 0; j < 2; ++j)
#pragma unroll
          for (int gq = 0; gq < 4; ++gq) { const int e = 64 * wh + 32 * j + 8 * gq + 4 * h2;
              const u32x2 gt = gate[j][gq]; const f32x4 gn = *(const f32x4*)(hgn + h * 128 + e);
              const float g0 = bflo(gt.x), g1 = bfhi(gt.x), g2 = bflo(gt.y), g3 = bfhi(gt.y);
              const float o0 = oc[j][4 * gq + 0] * rstd * gn[0] * (g0 * sigm(g0)), o1 = oc[j][4 * gq + 1] * rstd * gn[1] * (g1 * sigm(g1));
              const float o2 = oc[j][4 * gq + 2] * rstd * gn[2] * (g2 * sigm(g2)), o3 = oc[j][4 * gq + 3] * rstd * gn[3] * (g3 * sigm(g3));
              u32x2 w; w.x = cvtpk(o0, o1); w.y = cvtpk(o2, o3); *(u32x2*)(OM + rc * 1024 + h * 128 + e) = w; } }
    __syncthreads();
}

__device__ __forceinline__ void hgrn_scan(float* __restrict__ Ub, const float* __restrict__ Dv) {
    for (int v = blockIdx.x * 512 + threadIdx.x; v < 32 * 4096; v += gridDim.x * 512) {
        const int bh = v >> 12, i4 = v & 4095, e = i4 >> 5, d4 = (i4 & 31) * 4;
        f32x4* up = (f32x4*)(Ub + ((size_t)(bh * 32) * 128 + e) * 128 + d4); const f32x4* dp = (const f32x4*)(Dv + (size_t)(bh * 32) * 128 + d4);
        f32x4 S = (f32x4){0.f, 0.f, 0.f, 0.f};
#pragma unroll 1
        for (int c0 = 0; c0 < 32; c0 += 8) { f32x4 u[8], dv[8];
#pragma unroll
            for (int c = 0; c < 8; ++c) { u[c] = up[(size_t)(c0 + c) * 4096]; dv[c] = dp[(c0 + c) * 32]; }
#pragma unroll
            for (int c = 0; c < 8; ++c) { S = dv[c] * S + u[c]; up[(size_t)(c0 + c) * 4096] = S; } }
    }
}

constexpr int AK_STRIDE = 144, AV_STRIDE = 560, AK_OFF = 0, AV_OFF = 288 * AK_STRIDE;
__device__ __forceinline__ void attn_stage(LAS unsigned char* lds, const bf16_t* __restrict__ Za, const bf16_t* __restrict__ Vt, int b, int n, int kvh) {
    const int tid = threadIdx.x;
    for (int i = tid; i < 288 * 8; i += 512) { const int kl = i >> 3, ch = i & 7; u32x4 v = (u32x4){0u, 0u, 0u, 0u};
        int pos = -1; if (kl < 256) pos = 128 * (n - 1) + kl - 112; else if (kl < 272) pos = kl - 256;
        if (pos >= 0) v = *(const u32x4*)(Za + (size_t)(b * LTOK + pos) * 768 + 512 + kvh * 64 + 8 * ch);
        *(LAS u32x4*)(lds + AK_OFF + kl * AK_STRIDE + ch * 16) = v; }
    for (int i = tid; i < 64 * 35; i += 512) { const int d = i / 35, ch = i - d * 35; u32x4 v = (u32x4){0u, 0u, 0u, 0u};
        const bf16_t* vr = Vt + (size_t)(b * 128 + kvh * 64 + d) * LPAD;
        if (ch < 32) { if (n > 1 || ch >= 14) v = *(const u32x4*)(vr + 128 * (n - 1) + 8 * ch); }
        else if (ch < 34) v = *(const u32x4*)(vr + 112 + 8 * (ch - 32));
        *(LAS u32x4*)(lds + AV_OFF + d * AV_STRIDE + ch * 16) = v; }
}
__device__ __forceinline__ f32x16 attn_tile(const LAS unsigned char* kp, const bf16x8 (&qf)[4], int pk0, bool meta, int pq, int h2) {
    f32x16 S = f32x16{};
#pragma unroll
    for (int k = 0; k < 4; ++k) S = MFMA32(*(const LAS bf16x8*)(kp + 32 * k), qf[k], S);
#pragma unroll
    for (int r = 0; r < 16; ++r) { const int kr = (r & 3) + 8 * (r >> 2) + 4 * h2; const int pk = pk0 + kr;
        const bool ok = meta ? (kr < 16) : ((pk >= 128) && (pk <= pq) && (pq - pk < 128));
        S[r] = ok ? S[r] * 0.125f : -INFINITY; }
    return S;
}
__device__ __forceinline__ void attn_sub(const LAS unsigned char* lds, const bf16_t* __restrict__ Za, const float* __restrict__ sinks, bf16_t* __restrict__ OM, int b, int n, int qh, int sb, int lane) {
    const int r32 = lane & 31, h2 = lane >> 5;
    const int pq = 128 * n + 32 * sb + r32;
    const bf16_t* qp = Za + (size_t)(b * LTOK + pq - 112) * 768 + qh * 64 + 8 * h2;
    bf16x8 qf[4];
#pragma unroll
    for (int k = 0; k < 4; ++k) qf[k] = *(const bf16x8*)(qp + 16 * k);
    const LAS unsigned char* kl = lds + AK_OFF + r32 * AK_STRIDE + 16 * h2;
    const float sink = sinks[qh];
    float mx = sink;
#pragma unroll 1
    for (int j = 0; j < 6; ++j) { const int kl0 = j < 5 ? 32 * (sb + j) : 256;
        const f32x16 S = attn_tile(kl + kl0 * AK_STRIDE, qf, 128 * (n - 1) + kl0, j == 5, pq, h2);
#pragma unroll
        for (int r = 0; r < 16; ++r) mx = fmaxf(mx, S[r]); }
    mx = fmaxf(mx, __shfl_xor(mx, 32));
    float l = 0.f;
    f32x16 O[2]; O[0] = f32x16{}; O[1] = f32x16{};
    const LAS unsigned char* vl = lds + AV_OFF + r32 * AV_STRIDE + 8 * h2;
#pragma unroll 1
    for (int j = 0; j < 6; ++j) { const int kl0 = j < 5 ? 32 * (sb + j) : 256;
        f32x16 S = attn_tile(kl + kl0 * AK_STRIDE, qf, 128 * (n - 1) + kl0, j == 5, pq, h2);
#pragma unroll
        for (int r = 0; r < 16; ++r) { S[r] = __expf(S[r] - mx); l += S[r]; }
#pragma unroll
        for (int s2 = 0; s2 < 2; ++s2) {
            if (j == 5 && s2 == 1) continue;
            u32x4 pw; pw.x = cvtpk(S[8 * s2 + 0], S[8 * s2 + 1]); pw.y = cvtpk(S[8 * s2 + 2], S[8 * s2 + 3]); pw.z = cvtpk(S[8 * s2 + 4], S[8 * s2 + 5]); pw.w = cvtpk(S[8 * s2 + 6], S[8 * s2 + 7]);
            const bf16x8 pb = __builtin_bit_cast(bf16x8, pw);
#pragma unroll
            for (int db = 0; db < 2; ++db) { const LAS unsigned char* vp = vl + (32 * db) * AV_STRIDE + (kl0 + 16 * s2) * 2;
                const u32x2 lo = *(const LAS u32x2*)vp, hi = *(const LAS u32x2*)(vp + 16);
                const u32x4 aw = (u32x4){lo.x, lo.y, hi.x, hi.y};
                O[db] = MFMA32(__builtin_bit_cast(bf16x8, aw), pb, O[db]); } } }
    l += __shfl_xor(l, 32); l += __expf(sink - mx);
    const float inv = __builtin_amdgcn_rcpf(l);
    bf16_t* op = OM + ((size_t)b * SEQ + 128 * (n - 1) + 32 * sb + r32) * 1024 + 512 + qh * 64 + 4 * h2;
#pragma unroll
    for (int db = 0; db < 2; ++db)
#pragma unroll
        for (int g = 0; g < 4; ++g) { u32x2 w; w.x = cvtpk(O[db][4 * g] * inv, O[db][4 * g + 1] * inv); w.y = cvtpk(O[db][4 * g + 2] * inv, O[db][4 * g + 3] * inv);
            *(u32x2*)(op + 32 * db + 8 * g) = w; }
}
__device__ __forceinline__ unsigned f2ord(float f) { const unsigned u = __float_as_uint(f); return (u & 0x80000000u) ? ~u : (u | 0x80000000u); }
__device__ __forceinline__ float ord2f(unsigned u) { return __uint_as_float((u & 0x80000000u) ? (u & 0x7fffffffu) : ~u); }
__device__ __forceinline__ unsigned umax_(unsigned a, unsigned b) { return a > b ? a : b; }
__device__ __forceinline__ unsigned umin_(unsigned a, unsigned b) { return a < b ? a : b; }
template <int N> __device__ __forceinline__ void bitonic_desc(unsigned (&a)[N]) {
#pragma unroll
    for (int k = 2; k <= N; k <<= 1)
#pragma unroll
        for (int j = k >> 1; j > 0; j >>= 1)
#pragma unroll
            for (int i = 0; i < N; ++i) { const int l = i ^ j;
                if (l > i) { const unsigned hi = umax_(a[i], a[l]), lo = umin_(a[i], a[l]); if ((i & k) == 0) { a[i] = hi; a[l] = lo; } else { a[i] = lo; a[l] = hi; } } }
}
__device__ __forceinline__ void merge_top16(unsigned (&a)[16], const unsigned (&b)[16]) {
#pragma unroll
    for (int i = 0; i < 16; ++i) a[i] = umax_(a[i], b[15 - i]);
#pragma unroll
    for (int j = 8; j > 0; j >>= 1)
#pragma unroll
        for (int i = 0; i < 16; ++i) { const int l = i ^ j; if (l > i) { const unsigned hi = umax_(a[i], a[l]), lo = umin_(a[i], a[l]); a[i] = hi; a[l] = lo; } }
}
template <bool PAIR> __device__ __forceinline__ void top16_of(unsigned (&g)[4][16]) {
    bitonic_desc<16>(g[0]); bitonic_desc<16>(g[1]); bitonic_desc<16>(g[2]); bitonic_desc<16>(g[3]);
    merge_top16(g[0], g[1]); merge_top16(g[2], g[3]); merge_top16(g[0], g[2]);
    if (PAIR) { unsigned o[16];
#pragma unroll
        for (int i = 0; i < 16; ++i) o[i] = (unsigned)__shfl_xor((int)g[0][i], 32);
        merge_top16(g[0], o); }
}
__device__ __forceinline__ unsigned sel16p(unsigned long long lo, unsigned long long hi, int i) { const unsigned long long w = (i & 8) ? hi : lo; return (unsigned)(w >> ((i & 7) * 8)) & 0x7fu; }
struct CandTab { unsigned char i[50], j[50]; int n; };
constexpr CandTab make_cands() { CandTab t{}; int n = 0; for (int i = 0; i < 16; ++i) for (int j = 0; j < 16; ++j) if ((i + 1) * (j + 1) <= 16) { t.i[n] = (unsigned char)i; t.j[n] = (unsigned char)j; ++n; } t.n = n; return t; }
constexpr CandTab CT = make_cands();
static_assert(CT.n == 50, "candidate count");

constexpr int PL_IDX = 0, PL_GB = 32768, PL_PA = 65536, PL_SSQ = 131072;
__device__ __forceinline__ void peer_list(const bf16_t* __restrict__ Qb, const bf16_t* __restrict__ SK, int rc0, int h, int c, int r32, int h2, unsigned (&top)[16]) {
    const bf16_t* qp = Qb + (size_t)(rc0 + r32) * 2048 + h * 256 + c * 128 + 8 * h2;
    bf16x8 qf[8];
#pragma unroll
    for (int k = 0; k < 8; ++k) qf[k] = *(const bf16x8*)(qp + 16 * k);
    unsigned g[4][16];
#pragma unroll
    for (int nb = 0; nb < 4; ++nb) {
        const bf16_t* kp = SK + (size_t)((h * 2 + c) * 128 + 32 * nb + r32) * 128 + 8 * h2;
        f32x16 acc = f32x16{};
#pragma unroll
        for (int k = 0; k < 8; ++k) acc = MFMA32(*(const bf16x8*)(kp + 16 * k), qf[k], acc);
#pragma unroll
        for (int r = 0; r < 16; ++r) g[nb][r] = (f2ord(acc[r]) & 0xffffff80u) | (unsigned)(32 * nb + (r & 3) + 8 * (r >> 2) + 4 * h2);
        __builtin_amdgcn_sched_barrier(0);
    }
    top16_of<true>(g);
#pragma unroll
    for (int k = 0; k < 16; ++k) top[k] = g[0][k];
}
__device__ __forceinline__ void peer_topk(LAS unsigned char* lds, const bf16_t* __restrict__ Qb, const bf16_t* __restrict__ SK, int rc0, int tl0, int h0, int lane) {
#pragma unroll 1
    for (int hh = 0; hh < 4; ++hh) {
        asm volatile("" : "+v"(lane));
        const int r32 = lane & 31, h2 = lane >> 5;
        const int h = h0 + hh;
        unsigned ta[16], tb[16];
        peer_list(Qb, SK, rc0, h, 0, r32, h2, ta);
        peer_list(Qb, SK, rc0, h, 1, r32, h2, tb);
        float av[16], bv[16]; unsigned long long ail = 0, aih = 0, bil = 0, bih = 0;
#pragma unroll
        for (int k = 0; k < 16; ++k) { av[k] = ord2f(ta[k] & 0xffffff80u); bv[k] = ord2f(tb[k] & 0xffffff80u);
            if (k < 8) { ail |= (unsigned long long)(ta[k] & 0x7fu) << (8 * k); bil |= (unsigned long long)(tb[k] & 0x7fu) << (8 * k); }
            else { aih |= (unsigned long long)(ta[k] & 0x7fu) << (8 * (k - 8)); bih |= (unsigned long long)(tb[k] & 0x7fu) << (8 * (k - 8)); } }
        unsigned k2[4][16];
#pragma unroll
        for (int k = 0; k < 64; ++k) { if (k < 50) k2[k >> 4][k & 15] = (f2ord(av[CT.i[k < 50 ? k : 0]] + bv[CT.j[k < 50 ? k : 0]]) & 0xffffff00u) | (unsigned)(CT.i[k < 50 ? k : 0] * 16 + CT.j[k < 50 ? k : 0]); else k2[k >> 4][k & 15] = 0u; }
        top16_of<false>(k2);
        float ev[16]; float es = 0.f; const float m0 = ord2f(k2[0][0] & 0xffffff00u);
#pragma unroll
        for (int k = 0; k < 16; ++k) { ev[k] = __expf(ord2f(k2[0][k] & 0xffffff00u) - m0); es += ev[k]; }
        const float inv = 1.f / es;
        LAS unsigned short* ip = (LAS unsigned short*)(lds + PL_IDX) + (tl0 + r32) * 128 + h * 16;
        LAS bf16_t* gp = (LAS bf16_t*)(lds + PL_GB) + (tl0 + r32) * 128 + h * 16;
#pragma unroll
        for (int k = 0; k < 16; ++k) { const int code = (int)(k2[0][k] & 0xffu); const unsigned e = sel16p(ail, aih, code >> 4) * 128u + sel16p(bil, bih, code & 15);
            if ((k >> 3) == h2) { ip[k] = (unsigned short)e; gp[k] = f2bf(ev[k] * inv); } }
    }
}
__device__ __forceinline__ pg8::f32x2_t fp8x2(unsigned w, bool hi) { return hi ? __builtin_amdgcn_cvt_pk_f32_fp8(w, true) : __builtin_amdgcn_cvt_pk_f32_fp8(w, false); }
template <int CTRL> __device__ __forceinline__ float dppf(float v) { return __builtin_bit_cast(float, __builtin_amdgcn_update_dpp(0, __builtin_bit_cast(int, v), CTRL, 0xf, 0xf, true)); }
__device__ __forceinline__ void peer_u_step(LAS unsigned char* lds, int tl, size_t rc, int s, const bf16_t* __restrict__ A2, const unsigned char* __restrict__ U8, int lane) {
    asm volatile("" : "+v"(lane));
    const int c = lane & 7, gq = lane >> 3;
    float x[16];
    { const bf16_t* xp = A2 + rc * 1024 + 128 * s + 16 * c; const u32x4 xa = *(const u32x4*)xp, xb = *(const u32x4*)(xp + 8);
      x[0] = bflo(xa.x); x[1] = bfhi(xa.x); x[2] = bflo(xa.y); x[3] = bfhi(xa.y); x[4] = bflo(xa.z); x[5] = bfhi(xa.z); x[6] = bflo(xa.w); x[7] = bfhi(xa.w);
      x[8] = bflo(xb.x); x[9] = bfhi(xb.x); x[10] = bflo(xb.y); x[11] = bfhi(xb.y); x[12] = bflo(xb.z); x[13] = bfhi(xb.z); x[14] = bflo(xb.w); x[15] = bfhi(xb.w); }
    const LAS unsigned short* ip = (const LAS unsigned short*)(lds + PL_IDX) + tl * 128 + gq;
    LAS float* pp = (LAS float*)(lds + PL_PA) + tl * 128 + gq;
    const unsigned char* ub = U8 + 128 * s + 16 * c;
    u32x4 uw[16];
#pragma unroll
    for (int ig = 0; ig < 16; ++ig) uw[ig] = *(const u32x4*)(ub + (size_t)ip[8 * ig] * 1024);
#pragma unroll
    for (int ig = 0; ig < 16; ++ig) { float d = 0.f;
#pragma unroll
        for (int q = 0; q < 4; ++q) { const pg8::f32x2_t lo = fp8x2(uw[ig][q], false), hi = fp8x2(uw[ig][q], true);
            d += x[4 * q] * lo.x; d += x[4 * q + 1] * lo.y; d += x[4 * q + 2] * hi.x; d += x[4 * q + 3] * hi.y; }
        d += dppf<0xB1>(d); d += dppf<0x4E>(d); d += dppf<0x141>(d);
        if (c == 0) { if (s == 0) pp[8 * ig] = d; else pp[8 * ig] += d; }
        __builtin_amdgcn_sched_barrier(0); }
}
__device__ __forceinline__ void peer_a_step(LAS unsigned char* lds, int tl, size_t rc, const float* __restrict__ rowssp, const float* __restrict__ su, const float* __restrict__ sv, int lane) {
    float rs = rowssp[rc * 16 + (lane & 15)];
    rs += __shfl_xor(rs, 1); rs += __shfl_xor(rs, 2); rs += __shfl_xor(rs, 4); rs += __shfl_xor(rs, 8);
    const float rstd = __builtin_amdgcn_rsqf(rs * (1.f / 1024.f) + EPS);
#pragma unroll
    for (int q = 0; q < 2; ++q) { const int k = lane + 64 * q;
        const unsigned e = ((const LAS unsigned short*)(lds + PL_IDX))[tl * 128 + k];
        LAS float* pp = (LAS float*)(lds + PL_PA) + tl * 128 + k;
        const float z = *pp * rstd * su[e]; const float a = 0.5f * z * (1.f + erff(z * 0.70710678118654752f));
        *pp = bf2f(((const LAS bf16_t*)(lds + PL_GB))[tl * 128 + k]) * a * sv[e]; }
    if (lane == 0) ((LAS float*)(lds + PL_SSQ))[tl] = 0.f;
}
__device__ __forceinline__ void peer_v_step(LAS unsigned char* lds, int tl, size_t rc, int s, const unsigned char* __restrict__ V8, float* __restrict__ dout, int lane) {
    asm volatile("" : "+v"(lane));
    const int c = lane & 7, gq = lane >> 3;
    const LAS unsigned short* ip = (const LAS unsigned short*)(lds + PL_IDX) + tl * 128 + gq;
    const LAS float* wp = (const LAS float*)(lds + PL_PA) + tl * 128 + gq;
    const unsigned char* vb = V8 + 128 * s + 16 * c;
    u32x4 vw[16];
#pragma unroll
    for (int ig = 0; ig < 16; ++ig) vw[ig] = *(const u32x4*)(vb + (size_t)ip[8 * ig] * 1024);
    const bool b3 = lane & 8, b4 = lane & 16, b5 = lane & 32;
    float* hp = dout + rc * 1024 + 128 * s + 16 * c + (b3 ? 8 : 0) + (b4 ? 4 : 0) + (b5 ? 2 : 0);
    pg8::f32x2_t h = *(const pg8::f32x2_t*)hp;
    float out[16];
#pragma unroll
    for (int i = 0; i < 16; ++i) out[i] = 0.f;
#pragma unroll
    for (int ig = 0; ig < 16; ++ig) { const float w = wp[8 * ig];
#pragma unroll
        for (int q = 0; q < 4; ++q) { const pg8::f32x2_t lo = fp8x2(vw[ig][q], false), hi = fp8x2(vw[ig][q], true);
            out[4 * q] += w * lo.x; out[4 * q + 1] += w * lo.y; out[4 * q + 2] += w * hi.x; out[4 * q + 3] += w * hi.y; }
        __builtin_amdgcn_sched_barrier(0); }
#pragma unroll
    for (int j = 0; j < 8; ++j) { const float keep = b3 ? out[j + 8] : out[j], send = b3 ? out[j] : out[j + 8]; out[j] = keep + dppf<0x128>(send); }
#pragma unroll
    for (int j = 0; j < 4; ++j) { const float keep = b4 ? out[j + 4] : out[j], send = b4 ? out[j] : out[j + 4]; out[j] = keep + __shfl_xor(send, 16); }
#pragma unroll
    for (int j = 0; j < 2; ++j) { const float keep = b5 ? out[j + 2] : out[j], send = b5 ? out[j] : out[j + 2]; out[j] = keep + __shfl_xor(send, 32); }
    h.x += out[0]; h.y += out[1];
    *(pg8::f32x2_t*)hp = h;
    const float ss = wave_sum(h.x * h.x + h.y * h.y);
    if (lane == 0) ((LAS float*)(lds + PL_SSQ))[tl] += ss;
}
__device__ __forceinline__ void peer_f_step(LAS unsigned char* lds, int tl, size_t rc, float* __restrict__ dout, const float* __restrict__ gfin, int lane) {
    const float rf = __builtin_amdgcn_rsqf(((const LAS float*)(lds + PL_SSQ))[tl] * (1.f / 1024.f) + EPS);
    float* hp = dout + rc * 1024 + 16 * lane; const float* gq = gfin + 16 * lane;
    f32x4 h[4];
#pragma unroll
    for (int q = 0; q < 4; ++q) h[q] = *(const f32x4*)(hp + 4 * q);
#pragma unroll
    for (int q = 0; q < 4; ++q) *(f32x4*)(hp + 4 * q) = h[q] * rf * *(const f32x4*)(gq + 4 * q);
}
__device__ __forceinline__ void peer_tables(const float* __restrict__ pu, const float* __restrict__ pv, unsigned char* __restrict__ T8, float* __restrict__ sinv, int lane, int gw, int NGW) {
    for (int row = gw; row < 32768; row += NGW) {
        const float* src = (row < 16384 ? pu + (size_t)row * 1024 : pv + (size_t)(row - 16384) * 1024) + 16 * lane;
        f32x4 v[4]; float am = 0.f;
#pragma unroll
        for (int q = 0; q < 4; ++q) { v[q] = *(const f32x4*)(src + 4 * q); am = fmaxf(am, fmaxf(fmaxf(fabsf(v[q][0]), fabsf(v[q][1])), fmaxf(fabsf(v[q][2]), fabsf(v[q][3])))); }
#pragma unroll
        for (int o = 1; o < 64; o <<= 1) am = fmaxf(am, __shfl_xor(am, o));
        const float sc = am > 0.f ? 224.f / am : 1.f;
        u32x4 w;
#pragma unroll
        for (int q = 0; q < 4; ++q) { unsigned t = __builtin_amdgcn_cvt_pk_fp8_f32(v[q][0] * sc, v[q][1] * sc, 0, false); t = __builtin_amdgcn_cvt_pk_fp8_f32(v[q][2] * sc, v[q][3] * sc, t, true); w[q] = t; }
        *(u32x4*)(T8 + (size_t)row * 1024 + 16 * lane) = w;
        if (lane == 0) sinv[row] = am > 0.f ? am / 224.f : 1.f;
    }
}

constexpr int NPHASE = 9;
struct Args { const float* in[17]; float* out; unsigned char* ws; int ph_lo, ph_hi; };
__global__ void __launch_bounds__(512, 2) fwd_kernel(Args a) {
    extern __shared__ __attribute__((aligned(16))) unsigned char lds_raw[];
    LAS unsigned char* lds = (LAS unsigned char*)lds_raw;
    cg::grid_group grid = cg::this_grid();
    const int tid = threadIdx.x, lane = tid & 63, wave = __builtin_amdgcn_readfirstlane(tid >> 6);
    const int lo = a.ph_lo, hi = a.ph_hi, G = gridDim.x;
    unsigned char* ws = a.ws;
    const float *x = a.in[0], *meta = a.in[1], *gmix = a.in[2], *w_in = a.in[3], *bgate = a.in[4], *lblog = a.in[5], *hgn = a.in[6], *sinks = a.in[7], *w_bh = a.in[8], *w_ba = a.in[9],
                *w_out = a.in[10], *gffn = a.in[11], *w_q = a.in[12], *subk = a.in[13], *pu = a.in[14], *pv = a.in[15], *gfin = a.in[16];
    bf16_t *Zh = (bf16_t*)(ws + WS_ZH), *Za = (bf16_t*)(ws + WS_ZA), *Zg = (bf16_t*)(ws + WS_ZG), *A1 = (bf16_t*)(ws + WS_A1), *OM = (bf16_t*)(ws + WS_OM), *A2 = (bf16_t*)(ws + WS_A2);
    bf16_t *Mb = (bf16_t*)(ws + WS_MB), *Qb = (bf16_t*)(ws + WS_QB), *Vt = (bf16_t*)(ws + WS_VT);
    bf16_t *WinT = (bf16_t*)(ws + WS_WIN), *WbhT = (bf16_t*)(ws + WS_WBH), *WbaT = (bf16_t*)(ws + WS_WBA), *WoutT = (bf16_t*)(ws + WS_WOUT), *WqT = (bf16_t*)(ws + WS_WQ), *SK = (bf16_t*)(ws + WS_SK);
    unsigned char *U8 = ws + WS_U8, *V8 = ws + WS_V8; float *suv = (float*)(ws + WS_SUV);
    float *Ub = (float*)(ws + WS_UB), *Dv = (float*)(ws + WS_DV), *rowssp = (float*)(ws + WS_RS);
#ifdef ONLY_PHASE
#define IN(k) ((k) == ONLY_PHASE && lo <= (k) && (k) < hi)
#else
#define IN(k) (lo <= (k) && (k) < hi)
#endif
#define SEAM(k) do { if (lo <= (k) && (k) + 1 < hi) grid.sync(); } while (0)

    if (IN(0)) { P0Args p{x, meta, gmix, w_in, w_bh, w_ba, w_out, w_q, subk, A1, WinT, WbhT, WbaT, WoutT, WqT, SK}; p0_prologue(lds, p); SEAM(0); }
    if (IN(1)) {
        pg8::Gemm g{A1, WinT, MA, 4864, 1024, 1024, 1024}; pg8::StaticOrder S; S.init(MA, 4864, G, (int)blockIdx.x);
        pg8::EpiZ E{Zh, Za, Zg, Vt};
        pg8::gemm_phase<pg8::EpiZ, pg8::StaticOrder, true, true>(lds, g, S, E);
        SEAM(1);
    }
    if (IN(2)) {
        for (int it = blockIdx.x; it < 1024 + 512; it += G) {
            if (it < 1024) {
#ifndef NO_HGA
 hgrn_A(lds, Zh, lblog, Ub, Dv, it);
#endif
 }
            else { const int ai = it - 1024, b = ai >> 6, n = ((ai & 63) >> 1) + 1, kvh = ai & 1;
                attn_stage(lds, Za, Vt, b, n, kvh);
                __syncthreads();
#pragma unroll 1
                for (int si = wave; si < 16; si += 8) attn_sub(lds, Za, sinks, OM, b, n, kvh * 4 + (si >> 2), si & 3, lane);
                __syncthreads(); }
        }
        SEAM(2);
    }
    if (IN(3)) { hgrn_scan(Ub, Dv); SEAM(3); }
    if (IN(4)) { for (int it = blockIdx.x; it < 1024; it += G) hgrn_C(lds, Zh, lblog, Ub, hgn, OM, it); SEAM(4); }
    if (IN(5)) {
        peer_tables(pu, pv, U8, suv, lane, blockIdx.x * 8 + wave, G * 8);
        __syncthreads();
        pg8::StaticOrder S; S.init(MC, 1024, G, (int)blockIdx.x);
        { pg8::Gemm g{OM, WbhT, MC, 1024, 512, 1024, 512}; pg8::EpiGate<0> E{Mb, Zg, bgate}; pg8::gemm_phase<pg8::EpiGate<0>, pg8::StaticOrder, true, true>(lds, g, S, E); }
        { pg8::Gemm g{OM + 512, WbaT, MC, 1024, 512, 1024, 512}; pg8::EpiGate<1> E{Mb, Zg, bgate}; pg8::gemm_phase<pg8::EpiGate<1>, pg8::StaticOrder, true, true>(lds, g, S, E); }
        SEAM(5);
    }
    if (IN(6)) {
        pg8::Gemm g{Mb, WoutT, MC, 1024, 1024, 1024, 1024}; pg8::StaticOrder S; S.init(MC, 1024, G, (int)blockIdx.x);
        pg8::EpiH1 E{x, a.out, A2, gffn, rowssp};
        pg8::gemm_phase<pg8::EpiH1, pg8::StaticOrder, true, true>(lds, g, S, E);
        SEAM(6);
    }
    if (IN(7)) {
        pg8::Gemm g{A2, WqT, MC, 2048, 1024, 1024, 1024}; pg8::StaticOrder S; S.init(MC, 2048, G, (int)blockIdx.x);
        pg8::EpiQ E{Qb, rowssp};
        pg8::gemm_phase<pg8::EpiQ, pg8::StaticOrder, true, true>(lds, g, S, E);
        SEAM(7);
    }
    if (IN(8)) {
        for (int grp = blockIdx.x; grp < MC / 128; grp += G) {
            const int rc0 = grp * 128;
#ifndef NO_TOPK
            peer_topk(lds, Qb, SK, rc0 + 32 * (wave >> 1), 32 * (wave >> 1), 4 * (wave & 1), lane);
#endif
#ifdef PROBE_TOPK2
            __syncthreads(); peer_topk(lds, Qb, SK, rc0 + 32 * (wave >> 1), 32 * (wave >> 1), 4 * (wave & 1), lane);
#endif
            __syncthreads();
            { const int tl0 = 16 * wave; const size_t rcw = (size_t)rc0 + tl0;
#pragma unroll 1
              for (int sl = 0; sl < 8; ++sl)
#pragma unroll 1
                  for (int i = 0; i < 16; ++i) peer_u_step(lds, tl0 + i, rcw + i, sl, A2, U8, lane);
#pragma unroll 1
              for (int i = 0; i < 16; ++i) peer_a_step(lds, tl0 + i, rcw + i, rowssp, suv, suv + 16384, lane);
#pragma unroll 1
              for (int sl = 0; sl < 8; ++sl)
#pragma unroll 1
                  for (int i = 0; i < 16; ++i) peer_v_step(lds, tl0 + i, rcw + i, sl, V8, a.out, lane);
              asm volatile("s_waitcnt vmcnt(0)" ::: "memory");
              __builtin_amdgcn_fence(__ATOMIC_ACQUIRE, "agent");
#pragma unroll 1
              for (int i = 0; i < 16; ++i) peer_f_step(lds, tl0 + i, rcw + i, a.out, gfin, lane); }
            __syncthreads();
        }
    }
#undef IN
#undef SEAM
}

extern "C" void kernel_launch(void* const* d_in, const int* in_sizes, int n_in, void* d_out, int out_size, void* d_ws, size_t ws_size, hipStream_t stream) {
    static int grid = 0;
    if (grid == 0) {
        if (n_in != 17 || out_size != MC * DM || ws_size < WS_END) { fprintf(stderr, "kernel_launch: unexpected shapes: n_in %d out %d ws %zu (need %zu)\n", n_in, out_size, ws_size, (size_t)WS_END); grid = -1; return; }
        int dev = 0, cus = 0, per_cu = 0;
        if (hipGetDevice(&dev) != hipSuccess || hipDeviceGetAttribute(&cus, hipDeviceAttributeMultiprocessorCount, dev) != hipSuccess) { fprintf(stderr, "kernel_launch: device query failed\n"); grid = -1; return; }
        if (hipFuncSetAttribute((const void*)fwd_kernel, hipFuncAttributeMaxDynamicSharedMemorySize, LDS_BYTES) != hipSuccess) { fprintf(stderr, "kernel_launch: hipFuncSetAttribute failed\n"); grid = -1; return; }
        if (hipOccupancyMaxActiveBlocksPerMultiprocessor(&per_cu, (const void*)fwd_kernel, 512, LDS_BYTES) != hipSuccess || per_cu < 1) { fprintf(stderr, "kernel_launch: occupancy query says %d blocks per CU\n", per_cu); per_cu = 1; }
        (void)hipGetLastError();
        grid = cus;
        fprintf(stderr, "kernel_launch: grid %d (occupancy %d per CU)\n", grid, per_cu);
    }
    if (grid < 0) return;
    Args a{};
    for (int i = 0; i < 17; ++i) a.in[i] = (const float*)d_in[i];
    a.out = (float*)d_out; a.ws = (unsigned char*)d_ws;
#if MK_ONE_LAUNCH
    a.ph_lo = 0; a.ph_hi = NPHASE;
    void* args[] = {&a};
    hipError_t e = hipLaunchCooperativeKernel((const void*)fwd_kernel, dim3(grid), dim3(512), args, LDS_BYTES, stream);
    if (e != hipSuccess) fprintf(stderr, "kernel_launch: cooperative launch failed: %s (grid %d)\n", hipGetErrorString(e), grid);
#else
#ifdef PROBE_SEQ
    const int seq[] = PROBE_SEQ;
    for (int p : seq) { a.ph_lo = p; a.ph_hi = p + 1; hipLaunchKernelGGL(fwd_kernel, dim3(grid), dim3(512), LDS_BYTES, stream, a); }
#else
    for (int p = 0; p < NPHASE; ++p) { a.ph_lo = p; a.ph_hi = p + 1; hipLaunchKernelGGL(fwd_kernel, dim3(grid), dim3(512), LDS_BYTES, stream, a); }
#endif
#endif
}
```

```cpp
#include <hip/hip_runtime.h>
#include <hip/hip_cooperative_groups.h>
#include <cstdio>
#include <cstdint>
namespace cg = cooperative_groups;

#ifndef MK_ONE_LAUNCH
#define MK_ONE_LAUNCH 1
#endif

constexpr int DM = 1024, NB = 8, SEQ = 4096, NMETA = 16, LTOK = SEQ + NMETA;
constexpr int MA_REAL = NB * LTOK;
constexpr int MA = 33024;
constexpr int MC = NB * SEQ;
constexpr int LPAD = 4224;
constexpr float EPS = 1e-6f;

namespace pg8 {
#define PG8_LAS __attribute__((address_space(3)))
typedef unsigned short bf16_t;
typedef short bf16x8 __attribute__((ext_vector_type(8)));
typedef float f32x4 __attribute__((ext_vector_type(4)));
typedef unsigned u32x4 __attribute__((ext_vector_type(4)));
constexpr int BM = 256, BK = 64, HALF = 128, HTB = HALF * BK * 2  , STAGE_BYTES = 8 * HTB, NXCD = 8, WGM = 8;

__host__ __device__ __forceinline__ int lds_byte(int r, int c) { const int st = (r >> 4) * 2 + (c >> 5), rr = r & 15, cc = c & 31, ob = rr * 64 + cc * 2; return st * 1024 + (ob ^ (((ob >> 9) & 1) << 5)); }
__host__ __device__ __forceinline__ void stage_rc(int b, int& R, int& C) { const int st = b / 1024, sb = b % 1024, swz = sb ^ (((sb >> 9) & 1) << 5); R = (st >> 1) * 16 + swz / 64; C = (st & 1) * 32 + (swz % 64) / 2; }
__host__ __device__ __forceinline__ int perm32(int rho) { const int n = rho >> 4, i = rho & 15; return 8 * (i >> 2) + 4 * n + (i & 3); }

struct Unit { int pm, pn; };
struct Gemm { const bf16_t* A; const bf16_t* Bt; int M, N, K, lda, ldb; };

struct StaticOrder {
    int nM, nN, nwg, G, c;
    __host__ __device__ void init(int M, int N, int G_, int c_) { nM = M / BM; nN = N / BM; nwg = nM * nN; G = G_; c = c_; }
    __host__ __device__ bool next(int i, Unit& u) const {
        const long L = (long)i * G + c; if (L >= nwg) return false;
        int wgid = (int)L; { const int q = nwg / NXCD, r = nwg % NXCD, xcd = wgid % NXCD, off = wgid / NXCD; wgid = (xcd < r ? xcd * (q + 1) : r * (q + 1) + (xcd - r) * q) + off; }
        const int nig = WGM * nN, gid = wgid / nig, fm = gid * WGM, gsz = (nM - fm) < WGM ? (nM - fm) : WGM;
        u.pm = fm + ((wgid % nig) % gsz); u.pn = (wgid % nig) / gsz; return true;
    }
    __device__ __forceinline__ void a_ready(const Unit&) const {}
    __device__ __forceinline__ void done(const Unit&) const {}
};

__device__ __forceinline__ unsigned cvt_pk_bf16(float lo, float hi) { unsigned r; asm volatile("v_cvt_pk_bf16_f32 %0, %1, %2" : "=v"(r) : "v"(lo), "v"(hi)); return r; }
typedef float f32x2 __attribute__((ext_vector_type(2)));
typedef float f32x2_t __attribute__((ext_vector_type(2))); typedef __bf16 bf16x2_t __attribute__((ext_vector_type(2)));
typedef unsigned u32x2 __attribute__((ext_vector_type(2)));
__device__ __forceinline__ unsigned cvtpk(float lo, float hi) { f32x2_t v = {lo, hi}; bf16x2_t b = __builtin_convertvector(v, bf16x2_t); return __builtin_bit_cast(unsigned, b); }
__device__ __forceinline__ bf16_t f2bf(float x) { return (bf16_t)(cvtpk(x, 0.f) & 0xffffu); }
__device__ __forceinline__ float bf2f(bf16_t v) { return __uint_as_float((unsigned)v << 16); }
__device__ __forceinline__ float bflo(unsigned w) { return __uint_as_float(w << 16); }
__device__ __forceinline__ float bfhi(unsigned w) { return __uint_as_float(w & 0xffff0000u); }
__device__ __forceinline__ float sigm(float x) { return __builtin_amdgcn_rcpf(1.f + __expf(-x)); }

struct EpiZ {
    static constexpr bool PERM = true, AFTER_DRAIN = false;
    bf16_t *Zh, *Za, *Zg, *Vt;
    __device__ __forceinline__ void operator()(const f32x4 (&acc)[2][2][4][2], const Unit& u, int wr, int wc, int fr, int fq) const {
        const int pn = u.pn; bf16_t* base; int ldc, colt;
        if (pn < 8) { base = Zh; ldc = 2048; colt = pn * 256; } else if (pn < 11) { base = Za; ldc = 768; colt = (pn - 8) * 256; } else { base = Zg; ldc = 2048; colt = (pn - 11) * 256; }
        const int row0 = u.pm * BM + wr * 64 + fr, col0 = colt + wc * 32 + 8 * fq;
#pragma unroll
        for (int ai = 0; ai < 2; ++ai)
#pragma unroll
            for (int m = 0; m < 4; ++m) { const int row = row0 + ai * HALF + m * 16; bf16_t* rowp = base + (size_t)row * ldc + col0;
#pragma unroll
                for (int bj = 0; bj < 2; ++bj) { const f32x4 v0 = acc[ai][bj][m][0], v1 = acc[ai][bj][m][1];
                    if (pn == 10 && bj == 1) {
                        if (row < MA_REAL) { const int b = row / LTOK, pos = row - b * LTOK; bf16_t* vp = Vt + ((size_t)(b * 128 + wc * 32 + 8 * fq) * LPAD + 112 + pos);
                            vp[0] = f2bf(v0[0]); vp[LPAD] = f2bf(v0[1]); vp[2 * LPAD] = f2bf(v0[2]); vp[3 * LPAD] = f2bf(v0[3]);
                            vp[4 * LPAD] = f2bf(v1[0]); vp[5 * LPAD] = f2bf(v1[1]); vp[6 * LPAD] = f2bf(v1[2]); vp[7 * LPAD] = f2bf(v1[3]); }
                    } else { u32x4 w; w.x = cvtpk(v0[0], v0[1]); w.y = cvtpk(v0[2], v0[3]); w.z = cvtpk(v1[0], v1[1]); w.w = cvtpk(v1[2], v1[3]); *(u32x4*)(rowp + bj * HALF) = w; } } }
    }
};
template <int PASS> struct EpiGate {
    static constexpr bool PERM = true, AFTER_DRAIN = false;
    bf16_t* Mb; const bf16_t* Zg; const float* bgate;
    __device__ __forceinline__ void operator()(const f32x4 (&acc)[2][2][4][2], const Unit& u, int wr, int wc, int fr, int fq) const {
        const int row0 = u.pm * BM + wr * 64 + fr, col0 = u.pn * BM + wc * 32 + 8 * fq;
        f32x4 bv[2][2];
#pragma unroll
        for (int bj = 0; bj < 2; ++bj)
#pragma unroll
            for (int n = 0; n < 2; ++n) bv[bj][n] = *(const f32x4*)(bgate + PASS * 1024 + col0 + bj * HALF + 4 * n);
#pragma unroll
        for (int ai = 0; ai < 2; ++ai)
#pragma unroll
            for (int m = 0; m < 4; ++m) { const int rc = row0 + ai * HALF + m * 16, ra = (rc >> 12) * LTOK + NMETA + (rc & 4095);
                const bf16_t* zp = Zg + (size_t)ra * 2048 + PASS * 1024 + col0; bf16_t* mp = Mb + (size_t)rc * 1024 + col0;
#pragma unroll
                for (int bj = 0; bj < 2; ++bj) { const u32x4 z = *(const u32x4*)(zp + bj * HALF); f32x4 v0 = acc[ai][bj][m][0], v1 = acc[ai][bj][m][1];
                    v0[0] *= sigm(bflo(z.x) + bv[bj][0][0]); v0[1] *= sigm(bfhi(z.x) + bv[bj][0][1]); v0[2] *= sigm(bflo(z.y) + bv[bj][0][2]); v0[3] *= sigm(bfhi(z.y) + bv[bj][0][3]);
                    v1[0] *= sigm(bflo(z.z) + bv[bj][1][0]); v1[1] *= sigm(bfhi(z.z) + bv[bj][1][1]); v1[2] *= sigm(bflo(z.w) + bv[bj][1][2]); v1[3] *= sigm(bfhi(z.w) + bv[bj][1][3]);
                    if (PASS == 1) { const u32x4 o = *(const u32x4*)(mp + bj * HALF);
                        v0[0] += bflo(o.x); v0[1] += bfhi(o.x); v0[2] += bflo(o.y); v0[3] += bfhi(o.y); v1[0] += bflo(o.z); v1[1] += bfhi(o.z); v1[2] += bflo(o.w); v1[3] += bfhi(o.w); }
                    u32x4 w; w.x = cvtpk(v0[0], v0[1]); w.y = cvtpk(v0[2], v0[3]); w.z = cvtpk(v1[0], v1[1]); w.w = cvtpk(v1[2], v1[3]); *(u32x4*)(mp + bj * HALF) = w; } }
    }
};
struct EpiH1 {
    static constexpr bool PERM = false, AFTER_DRAIN = false;
    const float* x; float* h1; bf16_t* A2; const float* gffn; float* rowssp;
    __device__ __forceinline__ void operator()(const f32x4 (&acc)[2][2][4][2], const Unit& u, int wr, int wc, int fr, int fq) const {
        const int row0 = u.pm * BM + wr * 64 + fr, col0 = u.pn * BM + wc * 32 + 4 * fq;
        f32x4 gv[2][2];
#pragma unroll
        for (int bj = 0; bj < 2; ++bj)
#pragma unroll
            for (int n = 0; n < 2; ++n) gv[bj][n] = *(const f32x4*)(gffn + col0 + bj * HALF + n * 16);
#pragma unroll
        for (int ai = 0; ai < 2; ++ai)
#pragma unroll
            for (int m = 0; m < 4; ++m) { const int rc = row0 + ai * HALF + m * 16; float ss = 0.f;
#pragma unroll
                for (int bj = 0; bj < 2; ++bj)
#pragma unroll
                    for (int n = 0; n < 2; ++n) { const size_t off = (size_t)rc * 1024 + col0 + bj * HALF + n * 16;
                        const f32x4 h = *(const f32x4*)(x + off) + acc[ai][bj][m][n]; *(f32x4*)(h1 + off) = h;
                        ss += (h[0] * h[0] + h[1] * h[1]) + (h[2] * h[2] + h[3] * h[3]);
                        const f32x4 y = h * gv[bj][n]; u32x2 w; w.x = cvtpk(y[0], y[1]); w.y = cvtpk(y[2], y[3]); *(u32x2*)(A2 + off) = w; }
                ss += __shfl_xor(ss, 16); ss += __shfl_xor(ss, 32);
                if (fq == 0) rowssp[(size_t)rc * 16 + u.pn * 4 + wc] = ss; }
    }
};
struct EpiQ {
    static constexpr bool PERM = true, AFTER_DRAIN = false;
    bf16_t* Q; const float* rowssp;
    __device__ __forceinline__ void operator()(const f32x4 (&acc)[2][2][4][2], const Unit& u, int wr, int wc, int fr, int fq) const {
        const int row0 = u.pm * BM + wr * 64 + fr, col0 = u.pn * BM + wc * 32 + 8 * fq;
#pragma unroll
        for (int ai = 0; ai < 2; ++ai)
#pragma unroll
            for (int m = 0; m < 4; ++m) { const int rc = row0 + ai * HALF + m * 16;
                const f32x4* rp = (const f32x4*)(rowssp + (size_t)rc * 16); const f32x4 s4 = (rp[0] + rp[1]) + (rp[2] + rp[3]);
                const float rstd = __builtin_amdgcn_rsqf(((s4[0] + s4[1]) + (s4[2] + s4[3])) * (1.0f / 1024.0f) + 1e-6f);
#pragma unroll
                for (int bj = 0; bj < 2; ++bj) { const f32x4 v0 = acc[ai][bj][m][0] * rstd, v1 = acc[ai][bj][m][1] * rstd;
                    u32x4 w; w.x = cvtpk(v0[0], v0[1]); w.y = cvtpk(v0[2], v0[3]); w.z = cvtpk(v1[0], v1[1]); w.w = cvtpk(v1[2], v1[3]); *(u32x4*)(Q + (size_t)rc * 2048 + col0 + bj * HALF) = w; } }
    }
};
template <class Epi, class Sched, bool ALIGN_EPI = false, bool SP2 = false>
__device__ __forceinline__ void gemm_phase(PG8_LAS unsigned char* lds, const Gemm g, const Sched& S, const Epi& E) {
    const int tid = threadIdx.x, wid = __builtin_amdgcn_readfirstlane(tid >> 6), lane = tid & 63, wr = wid >> 2, wc = wid & 3, fr = lane & 15, fq = lane >> 4;
    const int K = g.K, nt = K / BK;
    unsigned voffA[2], voffB[2];
#pragma unroll
    for (int i = 0; i < 2; ++i) { int R, C; stage_rc(tid * 16 + i * 8192, R, C); const int Rb = Epi::PERM ? ((R & ~31) + perm32(R & 31)) : R;
        voffA[i] = (unsigned)(R * g.lda + C) * 2u; voffB[i] = (unsigned)(Rb * g.ldb + C) * 2u; }
    const size_t kstep = (size_t)(BK * 2);
    const size_t hstepA = (size_t)HALF * g.lda * 2, hstepB = (size_t)HALF * g.ldb * 2;
    const size_t tstepA = 2 * hstepA, tstepB = 2 * hstepB;
    const unsigned ldsw = (unsigned)wid * 1024u;
    const int aoff = lds_byte(wr * 64 + fr, fq * 8), boff = lds_byte(wc * 32 + fr, fq * 8);
#define PG8_SA(b, h) (((b) * 2 + (h)) * HTB)
#define PG8_SB(b, h) ((4 + (b) * 2 + (h)) * HTB)
#define PG8_STAGE(bufoff, gbase, voff) do { _Pragma("unroll") for (int _i = 0; _i < 2; ++_i) \
        __builtin_amdgcn_global_load_lds((const unsigned*)((const char*)(gbase) + (voff)[_i]), (PG8_LAS unsigned*)(lds + (bufoff) + ldsw + _i * 8192), 16, 0, 0); } while (0)
#define PG8_LDA(dst, b, h) do { _Pragma("unroll") for (int m = 0; m < 4; ++m) _Pragma("unroll") for (int k = 0; k < 2; ++k) dst[m][k] = *(const PG8_LAS bf16x8*)(lds + PG8_SA(b, h) + aoff + m * 2048 + k * 1024); } while (0)
#define PG8_LDB(dst, b, h) do { _Pragma("unroll") for (int n = 0; n < 2; ++n) _Pragma("unroll") for (int k = 0; k < 2; ++k) dst[n][k] = *(const PG8_LAS bf16x8*)(lds + PG8_SB(b, h) + boff + n * 2048 + k * 1024); } while (0)
#define PG8_MMA(ai, bj, At, Bt) do { __builtin_amdgcn_s_setprio(1); _Pragma("unroll") for (int m = 0; m < 4; ++m) _Pragma("unroll") for (int n = 0; n < 2; ++n) _Pragma("unroll") for (int k = 0; k < 2; ++k) \
        acc[ai][bj][m][n] = __builtin_amdgcn_mfma_f32_16x16x32_bf16(Bt[n][k], At[m][k], acc[ai][bj][m][n], 0, 0, 0); __builtin_amdgcn_s_setprio(0); } while (0)
#define PG8_WAIT_V(n) asm volatile("s_waitcnt vmcnt(" #n ")" ::: "memory")
#define PG8_WAIT_L(n) asm volatile("s_waitcnt lgkmcnt(" #n ")" ::: "memory")
#define PG8_BAR __builtin_amdgcn_s_barrier()
#define PG8_SCHED __builtin_amdgcn_sched_barrier(0)
    Unit cur, nxt; int ui = 0;
    if (!S.next(0, cur)) return;
    f32x4 acc[2][2][4][2];
#pragma unroll
    for (int a = 0; a < 2; ++a)
#pragma unroll
        for (int b = 0; b < 2; ++b)
#pragma unroll
            for (int m = 0; m < 4; ++m)
#pragma unroll
                for (int n = 0; n < 2; ++n) acc[a][b][m][n] = (f32x4){0.f, 0.f, 0.f, 0.f};
    bf16x8 At[4][2], B0[2][2], B1[2][2];
    const char* cA = (const char*)g.A + (size_t)cur.pm * tstepA; const char* cB = (const char*)g.Bt + (size_t)cur.pn * tstepB;
    S.a_ready(cur);
    if constexpr (SP2) {
        PG8_STAGE(PG8_SB(0, 0), cB, voffB); PG8_STAGE(PG8_SB(0, 1), cB + hstepB, voffB); PG8_STAGE(PG8_SA(0, 0), cA, voffA); PG8_STAGE(PG8_SA(0, 1), cA + hstepA, voffA);
        if (wr == 1) PG8_BAR;
        PG8_WAIT_V(2); PG8_BAR;
        PG8_STAGE(PG8_SB(1, 0), cB + kstep, voffB); PG8_STAGE(PG8_SA(1, 0), cA + kstep, voffA); PG8_STAGE(PG8_SB(1, 1), cB + hstepB + kstep, voffB);
        PG8_WAIT_V(6); PG8_BAR;
    } else {
        PG8_STAGE(PG8_SB(0, 0), cB, voffB); PG8_STAGE(PG8_SA(0, 0), cA, voffA); PG8_STAGE(PG8_SB(0, 1), cB + hstepB, voffB); PG8_STAGE(PG8_SA(0, 1), cA + hstepA, voffA);
        if (wr == 1) PG8_BAR;
        PG8_WAIT_V(4); PG8_BAR;
        PG8_STAGE(PG8_SB(1, 0), cB + kstep, voffB); PG8_STAGE(PG8_SA(1, 0), cA + kstep, voffA); PG8_STAGE(PG8_SB(1, 1), cB + hstepB + kstep, voffB);
        PG8_WAIT_V(6); PG8_BAR;
    }
    for (;;) {
        const bool has_next = S.next(ui + 1, nxt);
        const char* nA = has_next ? (const char*)g.A + (size_t)nxt.pm * tstepA : cA; const char* nB = has_next ? (const char*)g.Bt + (size_t)nxt.pn * tstepB : cB;
        for (int t = 0; t < nt; t += 2) {
            const bool last = (t == nt - 2);
            const char* a1 = cA + (size_t)(t + 1) * kstep;
            const char* a2 = last ? nA : cA + (size_t)(t + 2) * kstep; const char* b2 = last ? nB : cB + (size_t)(t + 2) * kstep;
            const char* a3 = a2 + kstep; const char* b3 = b2 + kstep;
            if (last && has_next) S.a_ready(nxt);
            if constexpr (SP2) {
            PG8_LDB(B0, 0, 0); PG8_LDB(B1, 0, 1); PG8_SCHED; PG8_LDA(At, 0, 0); PG8_STAGE(PG8_SA(1, 1), a1 + hstepA, voffA);
            PG8_WAIT_V(8); PG8_WAIT_L(0); PG8_BAR; PG8_MMA(0, 0, At, B0); PG8_MMA(0, 1, At, B1); PG8_BAR; PG8_SCHED;
            PG8_LDA(At, 0, 1); PG8_STAGE(PG8_SB(0, 0), b2, voffB); PG8_STAGE(PG8_SB(0, 1), b2 + hstepB, voffB); PG8_STAGE(PG8_SA(0, 0), a2, voffA);
            PG8_WAIT_V(8); PG8_WAIT_L(0); PG8_BAR; PG8_MMA(1, 0, At, B0); PG8_MMA(1, 1, At, B1); PG8_BAR; PG8_SCHED;
            PG8_LDB(B0, 1, 0); PG8_LDB(B1, 1, 1); PG8_SCHED; PG8_LDA(At, 1, 0); PG8_STAGE(PG8_SA(0, 1), a2 + hstepA, voffA);
            PG8_WAIT_V(8); PG8_WAIT_L(0); PG8_BAR; PG8_MMA(0, 0, At, B0); PG8_MMA(0, 1, At, B1); PG8_BAR; PG8_SCHED;
            PG8_LDA(At, 1, 1); PG8_STAGE(PG8_SB(1, 0), b3, voffB); PG8_STAGE(PG8_SB(1, 1), b3 + hstepB, voffB); PG8_STAGE(PG8_SA(1, 0), a3, voffA);
            PG8_WAIT_V(8); PG8_WAIT_L(0); PG8_BAR; PG8_MMA(1, 0, At, B0); PG8_MMA(1, 1, At, B1); PG8_BAR; PG8_SCHED;
            } else {
            PG8_LDB(B0, 0, 0); PG8_SCHED; PG8_LDA(At, 0, 0); PG8_STAGE(PG8_SA(1, 1), a1 + hstepA, voffA);
            PG8_WAIT_L(8); PG8_BAR; PG8_WAIT_L(0); PG8_MMA(0, 0, At, B0); PG8_BAR; PG8_SCHED;
            PG8_LDB(B1, 0, 1); PG8_STAGE(PG8_SB(0, 0), b2, voffB);
            PG8_BAR; PG8_WAIT_L(0); PG8_MMA(0, 1, At, B1); PG8_BAR;
            PG8_LDA(At, 0, 1); PG8_STAGE(PG8_SA(0, 0), a2, voffA);
            PG8_BAR; PG8_WAIT_L(0); PG8_MMA(1, 0, At, B0); PG8_BAR; PG8_SCHED;
            PG8_STAGE(PG8_SB(0, 1), b2 + hstepB, voffB);
            PG8_WAIT_V(6); PG8_BAR; PG8_MMA(1, 1, At, B1); PG8_BAR;
            PG8_LDB(B0, 1, 0); PG8_SCHED; PG8_LDA(At, 1, 0); PG8_STAGE(PG8_SA(0, 1), a2 + hstepA, voffA);
            PG8_WAIT_L(8); PG8_BAR; PG8_WAIT_L(0); PG8_MMA(0, 0, At, B0); PG8_BAR; PG8_SCHED;
            PG8_LDB(B1, 1, 1); PG8_STAGE(PG8_SB(1, 0), b3, voffB);
            PG8_BAR; PG8_WAIT_L(0); PG8_MMA(0, 1, At, B1); PG8_BAR;
            PG8_LDA(At, 1, 1); PG8_STAGE(PG8_SA(1, 0), a3, voffA);
            PG8_BAR; PG8_WAIT_L(0); PG8_MMA(1, 0, At, B0); PG8_BAR; PG8_SCHED;
            PG8_STAGE(PG8_SB(1, 1), b3 + hstepB, voffB);
            PG8_WAIT_V(6); PG8_BAR; PG8_MMA(1, 1, At, B1); PG8_BAR;
            }
        }
        if constexpr (ALIGN_EPI) { if (wr == 0) PG8_BAR; }
        if constexpr (!Epi::AFTER_DRAIN) { E(acc, cur, wr, wc, fr, fq); S.done(cur); }
        if (!has_next) break;
#pragma unroll
        for (int a = 0; a < 2; ++a)
#pragma unroll
            for (int b = 0; b < 2; ++b)
#pragma unroll
                for (int m = 0; m < 4; ++m)
#pragma unroll
                    for (int n = 0; n < 2; ++n) acc[a][b][m][n] = (f32x4){0.f, 0.f, 0.f, 0.f};
        cur = nxt; cA = nA; cB = nB; ++ui;
        if constexpr (ALIGN_EPI) { if (wr == 1) PG8_BAR; }
    }
    PG8_WAIT_V(0);
    if constexpr (!ALIGN_EPI) { if (wr == 0) PG8_BAR; }
    PG8_BAR;
    if constexpr (Epi::AFTER_DRAIN) { E.fused(acc, cur, wr, wc, fr, fq, lds, wid, lane); S.done(cur); }
#undef PG8_SA
#undef PG8_SB
#undef PG8_STAGE
#undef PG8_LDA
#undef PG8_LDB
#undef PG8_MMA
#undef PG8_WAIT_V
#undef PG8_WAIT_L
#undef PG8_BAR
#undef PG8_SCHED
}
}
using pg8::bf16_t; using pg8::bf16x8; using pg8::f32x4; using pg8::u32x4; using pg8::u32x2; using pg8::cvtpk; using pg8::f2bf; using pg8::bf2f; using pg8::bflo; using pg8::bfhi; using pg8::sigm;
#define LAS __attribute__((address_space(3)))
typedef float f32x16 __attribute__((ext_vector_type(16)));
#define MFMA32(a, b, c) __builtin_amdgcn_mfma_f32_32x32x16_bf16((a), (b), (c), 0, 0, 0)

constexpr size_t MiB = 1u << 20;
constexpr size_t WS_ZH = 0;
constexpr size_t WS_MB = WS_ZH, WS_U8 = WS_ZH + 64 * MiB, WS_V8 = WS_ZH + 80 * MiB, WS_SUV = WS_ZH + 96 * MiB;
constexpr size_t WS_ZA = 129 * MiB;
constexpr size_t WS_ZG = 178 * MiB;
constexpr size_t WS_QB = WS_ZG;
constexpr size_t WS_A1 = 307 * MiB;
constexpr size_t WS_OM = WS_A1, WS_A2 = WS_A1;
constexpr size_t WS_UB = 372 * MiB;
constexpr size_t WS_DV = 436 * MiB;
constexpr size_t WS_VT = 437 * MiB;
constexpr size_t WS_WIN = 446 * MiB;
constexpr size_t WS_WBH = 456 * MiB, WS_WBA = 457 * MiB, WS_WOUT = 458 * MiB, WS_WQ = 460 * MiB, WS_SK = 464 * MiB;
constexpr size_t WS_RS = 465 * MiB;
constexpr size_t WS_CTL = 467 * MiB, CTL_BYTES = 16384;
constexpr size_t WS_END = 468 * MiB;
constexpr int LDS_BYTES = 151552;

__device__ __forceinline__ float wave_sum(float v) {
#pragma unroll
    for (int o = 1; o < 64; o <<= 1) v += __shfl_xor(v, o);
    return v;
}
__device__ __forceinline__ void p0_transpose_item(const float* __restrict__ W, int K, int N, bf16_t* __restrict__ WT, LAS float* scr, int item, int lane) {
    const int nblk = N / 32, kb = item / nblk, nb = item % nblk, k0 = 64 * kb, n0 = 32 * nb;
#pragma unroll 8
    for (int i = 0; i < 32; ++i) { const int kk = 2 * i + (lane >> 5); scr[kk * 33 + (lane & 31)] = W[(size_t)(k0 + kk) * N + n0 + (lane & 31)]; }
    asm volatile("s_waitcnt lgkmcnt(0)" ::: "memory");
    const int c = lane & 7;
#pragma unroll
    for (int j = 0; j < 4; ++j) { const int n = (lane >> 3) + 8 * j; const LAS float* s = scr + (8 * c) * 33 + n;
        u32x4 o; o.x = cvtpk(s[0 * 33], s[1 * 33]); o.y = cvtpk(s[2 * 33], s[3 * 33]); o.z = cvtpk(s[4 * 33], s[5 * 33]); o.w = cvtpk(s[6 * 33], s[7 * 33]);
        *(u32x4*)(WT + (size_t)(n0 + n) * K + k0 + 8 * c) = o; }
    asm volatile("s_waitcnt lgkmcnt(0)" ::: "memory");
}
struct P0Args { const float *x, *meta, *gmix, *w_in, *w_bh, *w_ba, *w_out, *w_q, *subk; bf16_t *A1, *WinT, *WbhT, *WbaT, *WoutT, *WqT, *SK; };
__device__ __forceinline__ void p0_prologue(LAS unsigned char* lds, const P0Args& p) {
    const int tid = threadIdx.x, lane = tid & 63, wave = tid >> 6;
    LAS float* scr = (LAS float*)(lds + wave * 16384);
    const int gw = blockIdx.x * 8 + wave, NGW = gridDim.x * 8;
    constexpr int I_IN = 16 * 152, I_B = 8 * 32, I_O = 16 * 32, I_Q = 16 * 64, NITEMS = I_IN + 2 * I_B + I_O + I_Q;
    for (int it = gw; it < NITEMS; it += NGW) {
        int r = it;
        if (r < I_IN) { p0_transpose_item(p.w_in, 1024, 4864, p.WinT, scr, r, lane); continue; } r -= I_IN;
        if (r < I_B) { p0_transpose_item(p.w_bh, 512, 1024, p.WbhT, scr, r, lane); continue; } r -= I_B;
        if (r < I_B) { p0_transpose_item(p.w_ba, 512, 1024, p.WbaT, scr, r, lane); continue; } r -= I_B;
        if (r < I_O) { p0_transpose_item(p.w_out, 1024, 1024, p.WoutT, scr, r, lane); continue; } r -= I_O;
        p0_transpose_item(p.w_q, 1024, 2048, p.WqT, scr, r, lane);
    }
    for (int i = blockIdx.x * 512 + tid; i < 262144 / 8; i += gridDim.x * 512) {
        const f32x4 a = *(const f32x4*)(p.subk + (size_t)i * 8), b = *(const f32x4*)(p.subk + (size_t)i * 8 + 4);
        u32x4 o; o.x = cvtpk(a[0], a[1]); o.y = cvtpk(a[2], a[3]); o.z = cvtpk(b[0], b[1]); o.w = cvtpk(b[2], b[3]); *(u32x4*)(p.SK + (size_t)i * 8) = o; }
    f32x4 g[4];
#pragma unroll
    for (int j = 0; j < 4; ++j) g[j] = *((const f32x4*)p.gmix + lane + 64 * j);
    for (int m = gw; m < MA; m += NGW) {
        unsigned long long* o8 = (unsigned long long*)(p.A1 + (size_t)m * 1024) + lane;
        if (m >= MA_REAL) {
#pragma unroll
            for (int j = 0; j < 4; ++j) o8[64 * j] = 0ull;
            continue; }
        const int b = m / LTOK, pos = m - b * LTOK;
        const float* src = pos < NMETA ? p.meta + (size_t)pos * 1024 : p.x + ((size_t)b * SEQ + (pos - NMETA)) * 1024;
        const f32x4* xr = (const f32x4*)src + lane; f32x4 v[4]; float s = 0.f;
#pragma unroll
        for (int j = 0; j < 4; ++j) { v[j] = xr[64 * j]; s += (v[j][0] * v[j][0] + v[j][1] * v[j][1]) + (v[j][2] * v[j][2] + v[j][3] * v[j][3]); }
        const float rstd = 1.f / sqrtf(wave_sum(s) * (1.f / 1024.f) + EPS);
#pragma unroll
        for (int j = 0; j < 4; ++j) { const f32x4 y = v[j] * rstd * g[j]; o8[64 * j] = (unsigned long long)cvtpk(y[0], y[1]) | ((unsigned long long)cvtpk(y[2], y[3]) << 32); }
    }
}

constexpr int SR = 272;
constexpr int OFF_Q = 0, OFF_K = 34816, OFF_V = 69632, OFF_S = 104448, OFF_VEC = 139264;
__device__ __forceinline__ bf16x8 ldfrag(const LAS unsigned char* base, int row, int kk8, int h2) { return *(const LAS bf16x8*)(base + row * SR + (kk8 * 16 + 8 * h2) * 2); }

constexpr int OFF_SEGP = OFF_VEC, OFF_VEC2 = OFF_VEC + 8192, OFF_SSQ = OFF_VEC2 + 1024;
template <bool WITH_Q>
__device__ __forceinline__ void hgrn_front(LAS unsigned char* lds, const bf16_t* __restrict__ Zh, const float* __restrict__ lblog, int b, int h, int c, float (&g)[8][4], float (&kk)[8][4], float (&qq)[8][4], u32x2 (&vraw)[8]) {
    const int tid = threadIdx.x, c4 = tid & 31, seg = tid >> 5;
    const f32x4 l0 = *(const f32x4*)(lblog + h * 128 + 4 * c4), l1 = *(const f32x4*)(lblog + 512 + h * 128 + 4 * c4);
    float lb[4], run[4];
#pragma unroll
    for (int k = 0; k < 4; ++k) { lb[k] = sigm(l0[k] - l1[k]); run[k] = 1.f; }
    u32x2 hfw[8], hqw[8];
#pragma unroll
    for (int i = 0; i < 8; ++i) { const int pos = 128 * c - 112 + 8 * seg + i; const bool valid = pos >= 0;
        const bf16_t* zr = Zh + (size_t)(b * LTOK + (valid ? pos : 0)) * 2048 + h * 128 + 4 * c4;
        hfw[i] = *(const u32x2*)(zr + 512); if (WITH_Q) hqw[i] = *(const u32x2*)zr; vraw[i] = *(const u32x2*)(zr + 1024);
        if (!valid) { hfw[i] = (u32x2){0x7f007f00u, 0x7f007f00u}; hqw[i] = (u32x2){0u, 0u}; vraw[i] = (u32x2){0u, 0u}; } }
#pragma unroll
    for (int i = 0; i < 8; ++i) {
        const float hf[4] = {bflo(hfw[i].x), bfhi(hfw[i].x), bflo(hfw[i].y), bfhi(hfw[i].y)};
#pragma unroll
        for (int k = 0; k < 4; ++k) { const float sg = sigm(hf[k]); const float f = lb[k] + (1.f - lb[k]) * sg; kk[i][k] = (1.f - lb[k]) * (1.f - sg); run[k] *= f; g[i][k] = run[k]; }
        if (WITH_Q) { qq[i][0] = bflo(hqw[i].x); qq[i][1] = bfhi(hqw[i].x); qq[i][2] = bflo(hqw[i].y); qq[i][3] = bfhi(hqw[i].y); } }
    *(LAS f32x4*)(lds + OFF_SEGP + (seg * 128 + 4 * c4) * 4) = (f32x4){run[0], run[1], run[2], run[3]};
    __syncthreads();
}
__device__ __forceinline__ void hgrn_base(LAS unsigned char* lds, float (&base)[4]) {
    const int tid = threadIdx.x, c4 = tid & 31, seg = tid >> 5;
    const LAS f32x4* sp = (const LAS f32x4*)(lds + OFF_SEGP) + c4;
    f32x4 p = (f32x4){1.f, 1.f, 1.f, 1.f};
    if (seg < 8) { for (int s = seg; s < 8; ++s) p *= sp[s * 32];
        if (seg == 0) *(LAS f32x4*)(lds + OFF_VEC2 + (4 * c4) * 4) = p;
#pragma unroll
        for (int k = 0; k < 4; ++k) base[k] = __builtin_amdgcn_rcpf(p[k]); }
    else { for (int s = 8; s < seg; ++s) p *= sp[s * 32];
        if (seg == 15) *(LAS f32x4*)(lds + OFF_VEC2 + (128 + 4 * c4) * 4) = p * sp[15 * 32];
#pragma unroll
        for (int k = 0; k < 4; ++k) base[k] = p[k]; }
}
__device__ __forceinline__ void hgrn_put_vt(LAS unsigned char* lds, const u32x2 (&vraw)[8], int c4, int seg) {
#pragma unroll
    for (int k = 0; k < 4; ++k) { unsigned e[8];
#pragma unroll
        for (int i = 0; i < 8; ++i) { const unsigned w = (k < 2) ? vraw[i].x : vraw[i].y; e[i] = (k & 1) ? (w >> 16) : (w & 0xffffu); }
        *(LAS u32x4*)(lds + OFF_V + (4 * c4 + k) * SR + seg * 16) = (u32x4){e[0] | (e[1] << 16), e[2] | (e[3] << 16), e[4] | (e[5] << 16), e[6] | (e[7] << 16)}; }
}

__device__ __forceinline__ void hgrn_A(LAS unsigned char* lds, const bf16_t* __restrict__ Zh, const float* __restrict__ lblog, float* __restrict__ Ub, float* __restrict__ Dv, int item) {
    const int tid = threadIdx.x, lane = tid & 63, wid = tid >> 6, r32 = lane & 31, h2 = lane >> 5;
    const int c = item & 31, bh = item >> 5, b = bh >> 2, h = bh & 3;
    const int c4 = tid & 31, seg = tid >> 5;
    float g[8][4], kk[8][4], qq[8][4]; u32x2 vraw[8];
    hgrn_front<false>(lds, Zh, lblog, b, h, c, g, kk, qq, vraw);
    { float base[4]; hgrn_base(lds, base);
#pragma unroll
      for (int k = 0; k < 4; ++k) { float kt[8];
#pragma unroll
          for (int i = 0; i < 8; ++i) kt[i] = kk[i][k] * __builtin_amdgcn_rcpf(base[k] * g[i][k]);
          *(LAS u32x4*)(lds + OFF_K + (4 * c4 + k) * SR + seg * 16) = (u32x4){cvtpk(kt[0], kt[1]), cvtpk(kt[2], kt[3]), cvtpk(kt[4], kt[5]), cvtpk(kt[6], kt[7])}; }
      hgrn_put_vt(lds, vraw, c4, seg); }
    __syncthreads();
    const int e0 = 32 * (wid >> 1), d0 = 64 * (wid & 1);
    f32x16 acc[2]; acc[0] = f32x16{}; acc[1] = f32x16{};
#pragma unroll
    for (int k8 = 0; k8 < 8; ++k8) { const bf16x8 a = ldfrag(lds + OFF_V, e0 + r32, k8, h2);
#pragma unroll
        for (int j = 0; j < 2; ++j) acc[j] = MFMA32(a, ldfrag(lds + OFF_K, d0 + 32 * j + r32, k8, h2), acc[j]); }
    const LAS float* vec2 = (const LAS float*)(lds + OFF_VEC2);
#pragma unroll
    for (int j = 0; j < 2; ++j) { const int dc = d0 + 32 * j + r32; const float sc = vec2[128 + dc];
        float* up = Ub + ((size_t)item * 128 + e0 + 4 * h2) * 128 + dc;
#pragma unroll
        for (int r = 0; r < 16; ++r) up[(size_t)((r & 3) + 8 * (r >> 2)) * 128] = acc[j][r] * sc; }
    if (tid < 128) Dv[(size_t)item * 128 + tid] = vec2[tid] * vec2[128 + tid];
    __syncthreads();
}

__device__ __forceinline__ void hgrn_C(LAS unsigned char* lds, const bf16_t* __restrict__ Zh, const float* __restrict__ lblog, const float* __restrict__ Ub, const float* __restrict__ hgn, bf16_t* __restrict__ OM, int item) {
    const int tid = threadIdx.x, lane = tid & 63, wid = tid >> 6, r32 = lane & 31, h2 = lane >> 5;
    const int c = (item & 31) + 1, bh = item >> 5, b = bh >> 2, h = bh & 3;
    const int c4 = tid & 31, seg = tid >> 5;
    const int tb = wid >> 1, wh = wid & 1;
    f32x4 sreg[8];
    { const float* sp = Ub + (size_t)item * 16384;
#pragma unroll
      for (int q = 0; q < 8; ++q) sreg[q] = *(const f32x4*)(sp + (size_t)(tid + 512 * q) * 4); }
    const size_t rc = (size_t)b * SEQ + 128 * (c - 1) + 32 * tb + r32, ra = (size_t)b * LTOK + 128 * c - 112 + 32 * tb + r32;
    u32x2 gate[2][4];
#pragma unroll
    for (int j = 0; j < 2; ++j)
#pragma unroll
        for (int gq = 0; gq < 4; ++gq) gate[j][gq] = *(const u32x2*)(Zh + ra * 2048 + 1536 + h * 128 + 64 * wh + 32 * j + 8 * gq + 4 * h2);
    float g[8][4], kk[8][4], qq[8][4]; u32x2 vraw[8];
    hgrn_front<true>(lds, Zh, lblog, b, h, c, g, kk, qq, vraw);
    { float base[4]; hgrn_base(lds, base);
#pragma unroll
      for (int i = 0; i < 8; ++i) { float r[4], ri[4];
#pragma unroll
          for (int k = 0; k < 4; ++k) { r[k] = base[k] * g[i][k]; ri[k] = __builtin_amdgcn_rcpf(r[k]); }
          const int t = 8 * seg + i;
          *(LAS u32x2*)(lds + OFF_Q + t * SR + 8 * c4) = (u32x2){cvtpk(qq[i][0] * r[0], qq[i][1] * r[1]), cvtpk(qq[i][2] * r[2], qq[i][3] * r[3])};
          *(LAS u32x2*)(lds + OFF_K + t * SR + 8 * c4) = (u32x2){cvtpk(kk[i][0] * ri[0], kk[i][1] * ri[1]), cvtpk(kk[i][2] * ri[2], kk[i][3] * ri[3])}; }
      hgrn_put_vt(lds, vraw, c4, seg); }
    __syncthreads();
    { const LAS float* vec2 = (const LAS float*)(lds + OFF_VEC2);
#pragma unroll
      for (int q = 0; q < 8; ++q) { const int idx = tid + 512 * q, e = idx >> 5, d4 = (idx & 31) * 4; const f32x4 pr = *(const LAS f32x4*)(vec2 + d4); const f32x4 sv = sreg[q] * pr;
          *(LAS u32x2*)(lds + OFF_S + e * SR + d4 * 2) = (u32x2){cvtpk(sv[0], sv[1]), cvtpk(sv[2], sv[3])}; } }
    f32x16 sc[2]; sc[0] = f32x16{}; sc[1] = f32x16{};
#pragma unroll
    for (int j = 0; j < 2; ++j) { const int sb = 2 * wh + j;
        if (sb <= tb) {
#pragma unroll
            for (int k8 = 0; k8 < 8; ++k8) sc[j] = MFMA32(ldfrag(lds + OFF_K, 32 * sb + r32, k8, h2), ldfrag(lds + OFF_Q, 32 * tb + r32, k8, h2), sc[j]); } }
    __syncthreads();
    { const int t = 32 * tb + r32;
#pragma unroll
      for (int j = 0; j < 2; ++j) { const int sb = 2 * wh + j;
#pragma unroll
          for (int gq = 0; gq < 4; ++gq) { const int s0 = 32 * sb + 8 * gq + 4 * h2;
              const float p0 = (sb <= tb && s0 + 0 <= t) ? sc[j][4 * gq + 0] : 0.f, p1 = (sb <= tb && s0 + 1 <= t) ? sc[j][4 * gq + 1] : 0.f;
              const float p2 = (sb <= tb && s0 + 2 <= t) ? sc[j][4 * gq + 2] : 0.f, p3 = (sb <= tb && s0 + 3 <= t) ? sc[j][4 * gq + 3] : 0.f;
              u32x2 w; w.x = cvtpk(p0, p1); w.y = cvtpk(p2, p3); *(LAS u32x2*)(lds + OFF_K + t * SR + s0 * 2) = w; } } }
    __syncthreads();
    f32x16 oc[2]; oc[0] = f32x16{}; oc[1] = f32x16{};
    for (int k8 = 0; k8 < 2 * (tb + 1); ++k8) { const bf16x8 pb = ldfrag(lds + OFF_K, 32 * tb + r32, k8, h2);
#pragma unroll
        for (int j = 0; j < 2; ++j) oc[j] = MFMA32(ldfrag(lds + OFF_V, 64 * wh + 32 * j + r32, k8, h2), pb, oc[j]); }
#pragma unroll
    for (int k8 = 0; k8 < 8; ++k8) { const bf16x8 qb = ldfrag(lds + OFF_Q, 32 * tb + r32, k8, h2);
#pragma unroll
        for (int j = 0; j < 2; ++j) oc[j] = MFMA32(ldfrag(lds + OFF_S, 64 * wh + 32 * j + r32, k8, h2), qb, oc[j]); }
    LAS float* ssq = (LAS float*)(lds + OFF_SSQ);
    { float ss = 0.f;
#pragma unroll
      for (int j = 0; j < 2; ++j)
#pragma unroll
          for (int r = 0; r < 16; ++r) ss += oc[j][r] * oc[j][r];
      ss += __shfl_xor(ss, 32);
      if (h2 == 0) ssq[wh * 128 + 32 * tb + r32] = ss; }
    __syncthreads();
    { const int t = 32 * tb + r32; const float rstd = __builtin_amdgcn_rsqf((ssq[t] + ssq[128 + t]) * (1.f / 128.f) + EPS);
#pragma unroll
      for (int j = 0; j < 2; ++j)
#pragma unroll
          for (int gq = 0; gq < 4; ++gq) { const int e = 64 * wh + 32 * j + 8 * gq + 4 * h2;
              const u32x2 gt = gate[j][gq]; const f32x4 gn = *(const f32x4*)(hgn + h * 128 + e);
              const float g0 = bflo(gt.x), g1 = bfhi(gt.x), g2 = bflo(gt.y), g3 = bfhi(gt.y);
              const float o0 = oc[j][4 * gq + 0] * rstd * gn[0] * (g0 * sigm(g0)), o1 = oc[j][4 * gq + 1] * rstd * gn[1] * (g1 * sigm(g1));
              const float o2 = oc[j][4 * gq + 2] * rstd * gn[2] * (g2 * sigm(g2)), o3 = oc[j][4 * gq + 3] * rstd * gn[3] * (g3 * sigm(g3));
              u32x2 w; w.x = cvtpk(o0, o1); w.y = cvtpk(o2, o3); *(u32x2*)(OM + rc * 1024 + h * 128 + e) = w; } }
    __syncthreads();
}

__device__ __forceinline__ void hgrn_scan(float* __restrict__ Ub, const float* __restrict__ Dv) {
    for (int v = blockIdx.x * 512 + threadIdx.x; v < 32 * 4096; v += gridDim.x * 512) {
        const int bh = v >> 12, i4 = v & 4095, e = i4 >> 5, d4 = (i4 & 31) * 4;
        f32x4* up = (f32x4*)(Ub + ((size_t)(bh * 32) * 128 + e) * 128 + d4); const f32x4* dp = (const f32x4*)(Dv + (size_t)(bh * 32) * 128 + d4);
        f32x4 S = (f32x4){0.f, 0.f, 0.f, 0.f};
#pragma unroll 1
        for (int c0 = 0; c0 < 32; c0 += 8) { f32x4 u[8], dv[8];
#pragma unroll
            for (int c = 0; c < 8; ++c) { u[c] = up[(size_t)(c0 + c) * 4096]; dv[c] = dp[(c0 + c) * 32]; }
#pragma unroll
            for (int c = 0; c < 8; ++c) { S = dv[c] * S + u[c]; up[(size_t)(c0 + c) * 4096] = S; } }
    }
}

constexpr int AK_STRIDE = 144, AV_STRIDE = 560, AK_OFF = 0, AV_OFF = 288 * AK_STRIDE;
__device__ __forceinline__ void attn_stage(LAS unsigned char* lds, const bf16_t* __restrict__ Za, const bf16_t* __restrict__ Vt, int b, int n, int kvh) {
    const int tid = threadIdx.x;
    for (int i = tid; i < 288 * 8; i += 512) { const int kl = i >> 3, ch = i & 7; u32x4 v = (u32x4){0u, 0u, 0u, 0u};
        int pos = -1; if (kl < 256) pos = 128 * (n - 1) + kl - 112; else if (kl < 272) pos = kl - 256;
        if (pos >= 0) v = *(const u32x4*)(Za + (size_t)(b * LTOK + pos) * 768 + 512 + kvh * 64 + 8 * ch);
        *(LAS u32x4*)(lds + AK_OFF + kl * AK_STRIDE + ch * 16) = v; }
    for (int i = tid; i < 64 * 35; i += 512) { const int d = i / 35, ch = i - d * 35; u32x4 v = (u32x4){0u, 0u, 0u, 0u};
        const bf16_t* vr = Vt + (size_t)(b * 128 + kvh * 64 + d) * LPAD;
        if (ch < 32) { if (n > 1 || ch >= 14) v = *(const u32x4*)(vr + 128 * (n - 1) + 8 * ch); }
        else if (ch < 34) v = *(const u32x4*)(vr + 112 + 8 * (ch - 32));
        *(LAS u32x4*)(lds + AV_OFF + d * AV_STRIDE + ch * 16) = v; }
}
__device__ __forceinline__ f32x16 attn_tile(const LAS unsigned char* kp, const bf16x8 (&qf)[4], int pk0, bool meta, int pq, int h2) {
    f32x16 S = f32x16{};
#pragma unroll
    for (int k = 0; k < 4; ++k) S = MFMA32(*(const LAS bf16x8*)(kp + 32 * k), qf[k], S);
#pragma unroll
    for (int r = 0; r < 16; ++r) { const int kr = (r & 3) + 8 * (r >> 2) + 4 * h2; const int pk = pk0 + kr;
        const bool ok = meta ? (kr < 16) : ((pk >= 128) && (pk <= pq) && (pq - pk < 128));
        S[r] = ok ? S[r] * 0.125f : -INFINITY; }
    return S;
}
__device__ __forceinline__ void attn_sub(const LAS unsigned char* lds, const bf16_t* __restrict__ Za, const float* __restrict__ sinks, bf16_t* __restrict__ OM, int b, int n, int qh, int sb, int lane) {
    const int r32 = lane & 31, h2 = lane >> 5;
    const int pq = 128 * n + 32 * sb + r32;
    const bf16_t* qp = Za + (size_t)(b * LTOK + pq - 112) * 768 + qh * 64 + 8 * h2;
    bf16x8 qf[4];
#pragma unroll
    for (int k = 0; k < 4; ++k) qf[k] = *(const bf16x8*)(qp + 16 * k);
    const LAS unsigned char* kl = lds + AK_OFF + r32 * AK_STRIDE + 16 * h2;
    const float sink = sinks[qh];
    float mx = sink;
#pragma unroll 1
    for (int j = 0; j < 6; ++j) { const int kl0 = j < 5 ? 32 * (sb + j) : 256;
        const f32x16 S = attn_tile(kl + kl0 * AK_STRIDE, qf, 128 * (n - 1) + kl0, j == 5, pq, h2);
#pragma unroll
        for (int r = 0; r < 16; ++r) mx = fmaxf(mx, S[r]); }
    mx = fmaxf(mx, __shfl_xor(mx, 32));
    float l = 0.f;
    f32x16 O[2]; O[0] = f32x16{}; O[1] = f32x16{};
    const LAS unsigned char* vl = lds + AV_OFF + r32 * AV_STRIDE + 8 * h2;
#pragma unroll 1
    for (int j = 0; j < 6; ++j) { const int kl0 = j < 5 ? 32 * (sb + j) : 256;
        f32x16 S = attn_tile(kl + kl0 * AK_STRIDE, qf, 128 * (n - 1) + kl0, j == 5, pq, h2);
#pragma unroll
        for (int r = 0; r < 16; ++r) { S[r] = __expf(S[r] - mx); l += S[r]; }
#pragma unroll
        for (int s2 = 0; s2 < 2; ++s2) {
            if (j == 5 && s2 == 1) continue;
            u32x4 pw; pw.x = cvtpk(S[8 * s2 + 0], S[8 * s2 + 1]); pw.y = cvtpk(S[8 * s2 + 2], S[8 * s2 + 3]); pw.z = cvtpk(S[8 * s2 + 4], S[8 * s2 + 5]); pw.w = cvtpk(S[8 * s2 + 6], S[8 * s2 + 7]);
            const bf16x8 pb = __builtin_bit_cast(bf16x8, pw);
#pragma unroll
            for (int db = 0; db < 2; ++db) { const LAS unsigned char* vp = vl + (32 * db) * AV_STRIDE + (kl0 + 16 * s2) * 2;
                const u32x2 lo = *(const LAS u32x2*)vp, hi = *(const LAS u32x2*)(vp + 16);
                const u32x4 aw = (u32x4){lo.x, lo.y, hi.x, hi.y};
                O[db] = MFMA32(__builtin_bit_cast(bf16x8, aw), pb, O[db]); } } }
    l += __shfl_xor(l, 32); l += __expf(sink - mx);
    const float inv = __builtin_amdgcn_rcpf(l);
    bf16_t* op = OM + ((size_t)b * SEQ + 128 * (n - 1) + 32 * sb + r32) * 1024 + 512 + qh * 64 + 4 * h2;
#pragma unroll
    for (int db = 0; db < 2; ++db)
#pragma unroll
        for (int g = 0; g < 4; ++g) { u32x2 w; w.x = cvtpk(O[db][4 * g] * inv, O[db][4 * g + 1] * inv); w.y = cvtpk(O[db][4 * g + 2] * inv, O[db][4 * g + 3] * inv);
            *(u32x2*)(op + 32 * db + 8 * g) = w; }
}
__device__ __forceinline__ unsigned f2ord(float f) { const unsigned u = __float_as_uint(f); return (u & 0x80000000u) ? ~u : (u | 0x80000000u); }
__device__ __forceinline__ float ord2f(unsigned u) { return __uint_as_float((u & 0x80000000u) ? (u & 0x7fffffffu) : ~u); }
__device__ __forceinline__ unsigned umax_(unsigned a, unsigned b) { return a > b ? a : b; }
__device__ __forceinline__ unsigned umin_(unsigned a, unsigned b) { return a < b ? a : b; }
template <int N> __device__ __forceinline__ void bitonic_desc(unsigned (&a)[N]) {
#pragma unroll
    for (int k = 2; k <= N; k <<= 1)
#pragma unroll
        for (int j = k >> 1; j > 0; j >>= 1)
#pragma unroll
            for (int i = 0; i < N; ++i) { const int l = i ^ j;
                if (l > i) { const unsigned hi = umax_(a[i], a[l]), lo = umin_(a[i], a[l]); if ((i & k) == 0) { a[i] = hi; a[l] = lo; } else { a[i] = lo; a[l] = hi; } } }
}
__device__ __forceinline__ void merge_top16(unsigned (&a)[16], const unsigned (&b)[16]) {
#pragma unroll
    for (int i = 0; i < 16; ++i) a[i] = umax_(a[i], b[15 - i]);
#pragma unroll
    for (int j = 8; j > 0; j >>= 1)
#pragma unroll
        for (int i = 0; i < 16; ++i) { const int l = i ^ j; if (l > i) { const unsigned hi = umax_(a[i], a[l]), lo = umin_(a[i], a[l]); a[i] = hi; a[l] = lo; } }
}
template <bool PAIR> __device__ __forceinline__ void top16_of(unsigned (&g)[4][16]) {
    bitonic_desc<16>(g[0]); bitonic_desc<16>(g[1]); bitonic_desc<16>(g[2]); bitonic_desc<16>(g[3]);
    merge_top16(g[0], g[1]); merge_top16(g[2], g[3]); merge_top16(g[0], g[2]);
    if (PAIR) { unsigned o[16];
#pragma unroll
        for (int i = 0; i < 16; ++i) o[i] = (unsigned)__shfl_xor((int)g[0][i], 32);
        merge_top16(g[0], o); }
}
__device__ __forceinline__ unsigned sel16p(unsigned long long lo, unsigned long long hi, int i) { const unsigned long long w = (i & 8) ? hi : lo; return (unsigned)(w >> ((i & 7) * 8)) & 0x7fu; }
struct CandTab { unsigned char i[50], j[50]; int n; };
constexpr CandTab make_cands() { CandTab t{}; int n = 0; for (int i = 0; i < 16; ++i) for (int j = 0; j < 16; ++j) if ((i + 1) * (j + 1) <= 16) { t.i[n] = (unsigned char)i; t.j[n] = (unsigned char)j; ++n; } t.n = n; return t; }
constexpr CandTab CT = make_cands();
static_assert(CT.n == 50, "candidate count");

constexpr int PL_IDX = 0, PL_GB = 32768, PL_PA = 65536, PL_SSQ = 131072;
__device__ __forceinline__ void peer_list(const bf16_t* __restrict__ Qb, const bf16_t* __restrict__ SK, int rc0, int h, int c, int r32, int h2, unsigned (&top)[16]) {
    const bf16_t* qp = Qb + (size_t)(rc0 + r32) * 2048 + h * 256 + c * 128 + 8 * h2;
    bf16x8 qf[8];
#pragma unroll
    for (int k = 0; k < 8; ++k) qf[k] = *(const bf16x8*)(qp + 16 * k);
    unsigned g[4][16];
#pragma unroll
    for (int nb = 0; nb < 4; ++nb) {
        const bf16_t* kp = SK + (size_t)((h * 2 + c) * 128 + 32 * nb + r32) * 128 + 8 * h2;
        f32x16 acc = f32x16{};
#pragma unroll
        for (int k = 0; k < 8; ++k) acc = MFMA32(*(const bf16x8*)(kp + 16 * k), qf[k], acc);
#pragma unroll
        for (int r = 0; r < 16; ++r) g[nb][r] = (f2ord(acc[r]) & 0xffffff80u) | (unsigned)(32 * nb + (r & 3) + 8 * (r >> 2) + 4 * h2);
        __builtin_amdgcn_sched_barrier(0);
    }
    top16_of<true>(g);
#pragma unroll
    for (int k = 0; k < 16; ++k) top[k] = g[0][k];
}
__device__ __forceinline__ void peer_topk(LAS unsigned char* lds, const bf16_t* __restrict__ Qb, const bf16_t* __restrict__ SK, int rc0, int tl0, int h0, int lane) {
#pragma unroll 1
    for (int hh = 0; hh < 4; ++hh) {
        asm volatile("" : "+v"(lane));
        const int r32 = lane & 31, h2 = lane >> 5;
        const int h = h0 + hh;
        unsigned ta[16], tb[16];
        peer_list(Qb, SK, rc0, h, 0, r32, h2, ta);
        peer_list(Qb, SK, rc0, h, 1, r32, h2, tb);
        float av[16], bv[16]; unsigned long long ail = 0, aih = 0, bil = 0, bih = 0;
#pragma unroll
        for (int k = 0; k < 16; ++k) { av[k] = ord2f(ta[k] & 0xffffff80u); bv[k] = ord2f(tb[k] & 0xffffff80u);
            if (k < 8) { ail |= (unsigned long long)(ta[k] & 0x7fu) << (8 * k); bil |= (unsigned long long)(tb[k] & 0x7fu) << (8 * k); }
            else { aih |= (unsigned long long)(ta[k] & 0x7fu) << (8 * (k - 8)); bih |= (unsigned long long)(tb[k] & 0x7fu) << (8 * (k - 8)); } }
        unsigned k2[4][16];
#pragma unroll
        for (int k = 0; k < 64; ++k) { if (k < 50) k2[k >> 4][k & 15] = (f2ord(av[CT.i[k < 50 ? k : 0]] + bv[CT.j[k < 50 ? k : 0]]) & 0xffffff00u) | (unsigned)(CT.i[k < 50 ? k : 0] * 16 + CT.j[k < 50 ? k : 0]); else k2[k >> 4][k & 15] = 0u; }
        top16_of<false>(k2);
        float ev[16]; float es = 0.f; const float m0 = ord2f(k2[0][0] & 0xffffff00u);
#pragma unroll
        for (int k = 0; k < 16; ++k) { ev[k] = __expf(ord2f(k2[0][k] & 0xffffff00u) - m0); es += ev[k]; }
        const float inv = 1.f / es;
        LAS unsigned short* ip = (LAS unsigned short*)(lds + PL_IDX) + (tl0 + r32) * 128 + h * 16;
        LAS bf16_t* gp = (LAS bf16_t*)(lds + PL_GB) + (tl0 + r32) * 128 + h * 16;
#pragma unroll
        for (int k = 0; k < 16; ++k) { const int code = (int)(k2[0][k] & 0xffu); const unsigned e = sel16p(ail, aih, code >> 4) * 128u + sel16p(bil, bih, code & 15);
            if ((k >> 3) == h2) { ip[k] = (unsigned short)e; gp[k] = f2bf(ev[k] * inv); } }
    }
}
__device__ __forceinline__ pg8::f32x2_t fp8x2(unsigned w, bool hi) { return hi ? __builtin_amdgcn_cvt_pk_f32_fp8(w, true) : __builtin_amdgcn_cvt_pk_f32_fp8(w, false); }
template <int CTRL> __device__ __forceinline__ float dppf(float v) { return __builtin_bit_cast(float, __builtin_amdgcn_update_dpp(0, __builtin_bit_cast(int, v), CTRL, 0xf, 0xf, true)); }
template <bool WITH_X>
__device__ __forceinline__ void peer_rows_load(u32x4 (&rw)[16], u32x4 (&xw)[2], const LAS unsigned char* lds, int tl, size_t rc, int s, const unsigned char* __restrict__ T8, const bf16_t* __restrict__ A2, int lane) {
    const int c = lane & 7, gq = lane >> 3;
    if (WITH_X) { xw[0] = *(const u32x4*)((const unsigned char*)A2 + rc * 1024 + 128 * s + 16 * c); xw[1].x = __float_as_uint(*(const float*)((const unsigned char*)A2 + (size_t)MC * 1024 + rc * 4)); }
    const LAS unsigned short* ip = (const LAS unsigned short*)(lds + PL_IDX) + tl * 128 + gq;
    const unsigned char* tb = T8 + 128 * s + 16 * c;
#pragma unroll
    for (int ig = 0; ig < 16; ++ig) rw[ig] = *(const u32x4*)(tb + (size_t)ip[8 * ig] * 1024);
}
__device__ __forceinline__ void peer_u_math(const u32x4 (&uw)[16], const u32x4 (&xw)[2], LAS unsigned char* lds, int tl, int lane) {
    const int c = lane & 7, gq = lane >> 3;
    const int x0 = (int)xw[0].x, x1 = (int)xw[0].y, x2 = (int)xw[0].z, x3 = (int)xw[0].w;
    int acc0 = 0, acc1 = 0;
#pragma unroll
    for (int ig = 0; ig < 16; ++ig) {
        int d = __builtin_amdgcn_sdot4((int)uw[ig].x, x0, 0, false); d = __builtin_amdgcn_sdot4((int)uw[ig].y, x1, d, false); d = __builtin_amdgcn_sdot4((int)uw[ig].z, x2, d, false); d = __builtin_amdgcn_sdot4((int)uw[ig].w, x3, d, false);
        d += __builtin_amdgcn_update_dpp(0, d, 0xB1, 0xf, 0xf, true); d += __builtin_amdgcn_update_dpp(0, d, 0x4E, 0xf, 0xf, true); d += __builtin_amdgcn_update_dpp(0, d, 0x141, 0xf, 0xf, true);
        if (ig < 8) acc0 = (c == ig) ? d : acc0; else acc1 = (c == ig - 8) ? d : acc1; }
    const float sx = __uint_as_float(xw[1].x);
    LAS float* pp = (LAS float*)(lds + PL_PA) + tl * 128 + 8 * c + gq;
    __hip_atomic_fetch_add(pp, (float)acc0 * sx, __ATOMIC_RELAXED, __HIP_MEMORY_SCOPE_WORKGROUP);
    __hip_atomic_fetch_add(pp + 64, (float)acc1 * sx, __ATOMIC_RELAXED, __HIP_MEMORY_SCOPE_WORKGROUP);
}
__device__ __forceinline__ void peer_a_step(LAS unsigned char* lds, int tl, size_t rc, const float* __restrict__ rowssp, const float* __restrict__ su, const float* __restrict__ sv, int lane) {
    float rs = rowssp[rc * 16 + (lane & 15)];
    rs += __shfl_xor(rs, 1); rs += __shfl_xor(rs, 2); rs += __shfl_xor(rs, 4); rs += __shfl_xor(rs, 8);
    const float rstd = __builtin_amdgcn_rsqf(rs * (1.f / 1024.f) + EPS);
#pragma unroll
    for (int q = 0; q < 2; ++q) { const int k = lane + 64 * q;
        const unsigned e = ((const LAS unsigned short*)(lds + PL_IDX))[tl * 128 + k];
        LAS float* pp = (LAS float*)(lds + PL_PA) + tl * 128 + k;
        const float z = *pp * rstd * su[e]; const float a = 0.5f * z * (1.f + erff(z * 0.70710678118654752f));
        *pp = bf2f(((const LAS bf16_t*)(lds + PL_GB))[tl * 128 + k]) * a * sv[e]; }
    if (lane == 0) ((LAS float*)(lds + PL_SSQ))[tl] = 0.f;
}
__device__ __forceinline__ void peer_v_math(const u32x4 (&vw)[16], LAS unsigned char* lds, int tl, size_t rc, int s, float* __restrict__ dout, int lane) {
    const int c = lane & 7, gq = lane >> 3;
    const LAS float* wp = (const LAS float*)(lds + PL_PA) + tl * 128 + gq;
    const bool b3 = lane & 8, b4 = lane & 16, b5 = lane & 32;
    float* hp = dout + rc * 1024 + 128 * s + 16 * c + (b3 ? 8 : 0) + (b4 ? 4 : 0) + (b5 ? 2 : 0);
    pg8::f32x2_t h = *(const pg8::f32x2_t*)hp;
    pg8::f32x2_t o2[8];
#pragma unroll
    for (int i = 0; i < 8; ++i) o2[i] = (pg8::f32x2_t){0.f, 0.f};
#pragma unroll
    for (int ig = 0; ig < 16; ++ig) { const float w = wp[8 * ig]; const pg8::f32x2_t w2 = (pg8::f32x2_t){w, w};
#pragma unroll
        for (int q = 0; q < 4; ++q) { o2[2 * q] += w2 * fp8x2(vw[ig][q], false); o2[2 * q + 1] += w2 * fp8x2(vw[ig][q], true); } }
    float out[16];
#pragma unroll
    for (int i = 0; i < 8; ++i) { out[2 * i] = o2[i].x; out[2 * i + 1] = o2[i].y; }
#pragma unroll
    for (int j = 0; j < 8; ++j) { const float keep = b3 ? out[j + 8] : out[j], send = b3 ? out[j] : out[j + 8]; out[j] = keep + dppf<0x128>(send); }
#pragma unroll
    for (int j = 0; j < 4; ++j) { const float keep = b4 ? out[j + 4] : out[j], send = b4 ? out[j] : out[j + 4]; out[j] = keep + __shfl_xor(send, 16); }
#pragma unroll
    for (int j = 0; j < 2; ++j) { const float keep = b5 ? out[j + 2] : out[j], send = b5 ? out[j] : out[j + 2]; out[j] = keep + __shfl_xor(send, 32); }
    h.x += out[0]; h.y += out[1];
    *(pg8::f32x2_t*)hp = h;
    const float ss = wave_sum(h.x * h.x + h.y * h.y);
    if (lane == 0) ((LAS float*)(lds + PL_SSQ))[tl] += ss;
}
__device__ __forceinline__ void peer_f_step(LAS unsigned char* lds, int tl, size_t rc, float* __restrict__ dout, const float* __restrict__ gfin, int lane) {
    const float rf = __builtin_amdgcn_rsqf(((const LAS float*)(lds + PL_SSQ))[tl] * (1.f / 1024.f) + EPS);
    float* hp = dout + rc * 1024 + 16 * lane; const float* gq = gfin + 16 * lane;
    f32x4 h[4];
#pragma unroll
    for (int q = 0; q < 4; ++q) h[q] = *(const f32x4*)(hp + 4 * q);
#pragma unroll
    for (int q = 0; q < 4; ++q) *(f32x4*)(hp + 4 * q) = h[q] * rf * *(const f32x4*)(gq + 4 * q);
}
__device__ __forceinline__ unsigned pack_i8x4(float a, float b, float c, float d) {
    const int ia = __float2int_rn(a), ib = __float2int_rn(b), ic = __float2int_rn(c), id = __float2int_rn(d);
    return (unsigned)(ia & 0xff) | ((unsigned)(ib & 0xff) << 8) | ((unsigned)(ic & 0xff) << 16) | ((unsigned)id << 24);
}
__device__ __forceinline__ void peer_tables(const float* __restrict__ pu, const float* __restrict__ pv, unsigned char* __restrict__ T8, float* __restrict__ sinv, int lane, int gw, int NGW) {
    for (int row = gw; row < 32768; row += NGW) {
        const bool isu = row < 16384;
        const float* src = (isu ? pu + (size_t)row * 1024 : pv + (size_t)(row - 16384) * 1024) + 16 * lane;
        f32x4 v[4]; float am = 0.f;
#pragma unroll
        for (int q = 0; q < 4; ++q) { v[q] = *(const f32x4*)(src + 4 * q); am = fmaxf(am, fmaxf(fmaxf(fabsf(v[q][0]), fabsf(v[q][1])), fmaxf(fabsf(v[q][2]), fabsf(v[q][3])))); }
#pragma unroll
        for (int o = 1; o < 64; o <<= 1) am = fmaxf(am, __shfl_xor(am, o));
        const float top = isu ? 127.f : 224.f;
        const float sc = am > 0.f ? top / am : 1.f;
        u32x4 w;
        if (isu) {
#pragma unroll
            for (int q = 0; q < 4; ++q) w[q] = pack_i8x4(v[q][0] * sc, v[q][1] * sc, v[q][2] * sc, v[q][3] * sc);
        } else {
#pragma unroll
            for (int q = 0; q < 4; ++q) { unsigned t = __builtin_amdgcn_cvt_pk_fp8_f32(v[q][0] * sc, v[q][1] * sc, 0, false); t = __builtin_amdgcn_cvt_pk_fp8_f32(v[q][2] * sc, v[q][3] * sc, t, true); w[q] = t; } }
        *(u32x4*)(T8 + (size_t)row * 1024 + 16 * lane) = w;
        if (lane == 0) sinv[row] = am > 0.f ? am / top : 1.f;
    }
}
__device__ __forceinline__ void peer_xq_token(const bf16_t* __restrict__ A2, unsigned char* __restrict__ XQ, float* __restrict__ SX, size_t rc, int lane) {
    const u32x4 xa = *(const u32x4*)(A2 + rc * 1024 + 16 * lane), xb = *(const u32x4*)(A2 + rc * 1024 + 16 * lane + 8);
    const unsigned w[8] = {xa.x, xa.y, xa.z, xa.w, xb.x, xb.y, xb.z, xb.w};
    float am = 0.f;
#pragma unroll
    for (int q = 0; q < 8; ++q) am = fmaxf(am, fmaxf(fabsf(bflo(w[q])), fabsf(bfhi(w[q]))));
#pragma unroll
    for (int o = 1; o < 64; o <<= 1) am = fmaxf(am, __shfl_xor(am, o));
    const float sc = am > 0.f ? 127.f / am : 1.f;
    u32x4 o;
#pragma unroll
    for (int q = 0; q < 4; ++q) o[q] = pack_i8x4(bflo(w[2 * q]) * sc, bfhi(w[2 * q]) * sc, bflo(w[2 * q + 1]) * sc, bfhi(w[2 * q + 1]) * sc);
    *(u32x4*)(XQ + rc * 1024 + 16 * lane) = o;
    if (lane == 0) SX[rc] = am > 0.f ? am / 127.f : 1.f;
}

#define XB_TMO      128
#define XB_XCNT(j)  (256  + 64 * (j))
#define XB_XSUB(j)  (1280 + 64 * (j))
#define XB_XGEN(j)  (2304 + 64 * (j))
#define XB_TOP      3328
#define XB_TOPGEN   3392
#define XCD_BAR_WORDS 3456
#define XB_SPIN_CAP (1u << 18)

__device__ __forceinline__ unsigned xb_ld(unsigned* p)              { return __hip_atomic_load(p, __ATOMIC_RELAXED, __HIP_MEMORY_SCOPE_AGENT); }
__device__ __forceinline__ unsigned xb_add(unsigned* p, unsigned v) { return __hip_atomic_fetch_add(p, v, __ATOMIC_RELAXED, __HIP_MEMORY_SCOPE_AGENT); }
__device__ __forceinline__ unsigned xb_xcc_id() { return (unsigned)__builtin_amdgcn_s_getreg((3 << 11) | 20) & 0xFu; }
#define XB_SPIN(cond, bar) do { unsigned _sp = 0; while (cond) { __builtin_amdgcn_s_sleep(1); \
    if ((++_sp & 255u) == 0u) { if (xb_ld(&(bar)[XB_TMO])) break; if (_sp > XB_SPIN_CAP) { atomicAdd(&(bar)[XB_TMO], 1u); break; } } } } while (0)

struct XcdBarrier {
    unsigned* bar; unsigned x;
    volatile LAS unsigned* st;
};

__device__ __forceinline__ XcdBarrier xcd_barrier_post(unsigned* bar, volatile LAS unsigned* st) {
    XcdBarrier b; b.bar = bar; b.x = xb_xcc_id(); b.st = st;
    if (threadIdx.x == 0) (void)xb_add(&bar[XB_XCNT(b.x)], 1u);
    return b;
}
__device__ __forceinline__ void xcd_barrier_complete(unsigned* bar, unsigned x, unsigned& nloc, unsigned& nx) {
    const unsigned G = gridDim.x * gridDim.y * gridDim.z;
    unsigned sum, cnt, mine, sp = 0u;
    for (;;) {
        sum = 0u; cnt = 0u; mine = 0u;
#pragma unroll
        for (unsigned j = 0; j < 16; ++j) { const unsigned c = xb_ld(&bar[XB_XCNT(j)]); sum += c; cnt += (c > 0u) ? 1u : 0u; mine = (j == x) ? c : mine; }
        if (sum == G) break;
        __builtin_amdgcn_s_sleep(1);
        if ((++sp & 255u) == 0u) { if (xb_ld(&bar[XB_TMO])) break; if (sp > XB_SPIN_CAP) { atomicAdd(&bar[XB_TMO], 1u); break; } }
    }
    nloc = mine > 0u ? mine : 1u; nx = cnt > 0u ? cnt : 1u;
}

__device__ __forceinline__ void xcd_barrier(const XcdBarrier& b) {
    asm volatile("s_waitcnt vmcnt(0)" ::: "memory");
    __syncthreads();
    if (threadIdx.x == 0) {
        unsigned* bar = b.bar;
        __builtin_amdgcn_s_waitcnt(0);
        unsigned nloc = b.st[0], nx = b.st[1];
        if (nloc == 0u) { xcd_barrier_complete(bar, b.x, nloc, nx); b.st[0] = nloc; b.st[1] = nx; }
        const unsigned old = xb_add(&bar[XB_XSUB(b.x)], 1u);
        const unsigned gen = old / nloc;
        if (old + 1u == (gen + 1u) * nloc) {
            __builtin_amdgcn_fence(__ATOMIC_RELEASE, "agent");
            asm volatile("s_waitcnt vmcnt(0)" ::: "memory");
            const unsigned og = xb_add(&bar[XB_TOP], 1u);
            const unsigned tg = og / nx;
            if (og + 1u == (tg + 1u) * nx) xb_add(&bar[XB_TOPGEN], 1u);
            else XB_SPIN(xb_ld(&bar[XB_TOPGEN]) == tg, bar);
            __builtin_amdgcn_fence(__ATOMIC_ACQUIRE, "agent");
            xb_add(&bar[XB_XGEN(b.x)], 1u);
            asm volatile("s_waitcnt vmcnt(0)" ::: "memory");
        } else {
            XB_SPIN(xb_ld(&bar[XB_XGEN(b.x)]) == gen, bar);
            __builtin_amdgcn_fence(__ATOMIC_ACQUIRE, "agent");
            asm volatile("s_waitcnt vmcnt(0)" ::: "memory");
        }
    }
    __syncthreads();
}

constexpr int NPHASE = 9;
struct Args { const float* in[17]; float* out; unsigned char* ws; int ph_lo, ph_hi; };
__global__ void __launch_bounds__(512, 2) fwd_kernel(Args a) {
    extern __shared__ __attribute__((aligned(16))) unsigned char lds_raw[];
    LAS unsigned char* lds = (LAS unsigned char*)lds_raw;
    cg::grid_group grid = cg::this_grid();
    const int tid = threadIdx.x, lane = tid & 63, wave = __builtin_amdgcn_readfirstlane(tid >> 6);
    const int lo = a.ph_lo, hi = a.ph_hi, G = gridDim.x;
    unsigned char* ws = a.ws;
    const float *x = a.in[0], *meta = a.in[1], *gmix = a.in[2], *w_in = a.in[3], *bgate = a.in[4], *lblog = a.in[5], *hgn = a.in[6], *sinks = a.in[7], *w_bh = a.in[8], *w_ba = a.in[9],
                *w_out = a.in[10], *gffn = a.in[11], *w_q = a.in[12], *subk = a.in[13], *pu = a.in[14], *pv = a.in[15], *gfin = a.in[16];
    bf16_t *Zh = (bf16_t*)(ws + WS_ZH), *Za = (bf16_t*)(ws + WS_ZA), *Zg = (bf16_t*)(ws + WS_ZG), *A1 = (bf16_t*)(ws + WS_A1), *OM = (bf16_t*)(ws + WS_OM), *A2 = (bf16_t*)(ws + WS_A2);
    bf16_t *Mb = (bf16_t*)(ws + WS_MB), *Qb = (bf16_t*)(ws + WS_QB), *Vt = (bf16_t*)(ws + WS_VT);
    bf16_t *WinT = (bf16_t*)(ws + WS_WIN), *WbhT = (bf16_t*)(ws + WS_WBH), *WbaT = (bf16_t*)(ws + WS_WBA), *WoutT = (bf16_t*)(ws + WS_WOUT), *WqT = (bf16_t*)(ws + WS_WQ), *SK = (bf16_t*)(ws + WS_SK);
    unsigned char *U8 = ws + WS_U8, *V8 = ws + WS_V8, *XQ = ws + WS_MB; float *suv = (float*)(ws + WS_SUV);
    float *Ub = (float*)(ws + WS_UB), *Dv = (float*)(ws + WS_DV), *rowssp = (float*)(ws + WS_RS);
#ifdef ONLY_PHASE
#define IN(k) ((k) == ONLY_PHASE && lo <= (k) && (k) < hi)
#else
#define IN(k) (lo <= (k) && (k) < hi)
#endif
    volatile LAS unsigned* bar_st = (volatile LAS unsigned*)(lds + LDS_BYTES - 64);
    XcdBarrier xbar; xbar.bar = (unsigned*)(ws + WS_CTL); xbar.x = 0; xbar.st = bar_st;
    if (hi - lo > 1) { if (tid < 2) bar_st[tid] = 0u; __syncthreads(); xbar = xcd_barrier_post((unsigned*)(ws + WS_CTL), bar_st); }
#define SEAM(k) do { if (lo <= (k) && (k) + 1 < hi) { if ((k) == 0) grid.sync(); else xcd_barrier(xbar); } } while (0)

    if (IN(0)) { P0Args p{x, meta, gmix, w_in, w_bh, w_ba, w_out, w_q, subk, A1, WinT, WbhT, WbaT, WoutT, WqT, SK}; p0_prologue(lds, p); SEAM(0); }
    if (IN(1)) {
        pg8::Gemm g{A1, WinT, MA, 4864, 1024, 1024, 1024}; pg8::StaticOrder S; S.init(MA, 4864, G, (int)blockIdx.x);
        pg8::EpiZ E{Zh, Za, Zg, Vt};
        pg8::gemm_phase<pg8::EpiZ, pg8::StaticOrder, true, true>(lds, g, S, E);
        SEAM(1);
    }
    if (IN(2)) {
        for (int it = blockIdx.x; it < 1024 + 512; it += G) {
            if (it < 1024) {
#ifndef NO_HGA
 hgrn_A(lds, Zh, lblog, Ub, Dv, it);
#endif
 }
            else { const int ai = it - 1024, b = ai >> 6, n = ((ai & 63) >> 1) + 1, kvh = ai & 1;
                attn_stage(lds, Za, Vt, b, n, kvh);
                __syncthreads();
#pragma unroll 1
                for (int si = wave; si < 16; si += 8) attn_sub(lds, Za, sinks, OM, b, n, kvh * 4 + (si >> 2), si & 3, lane);
                __syncthreads(); }
        }
        SEAM(2);
    }
    if (IN(3)) { hgrn_scan(Ub, Dv); SEAM(3); }
    if (IN(4)) { for (int it = blockIdx.x; it < 1024; it += G) hgrn_C(lds, Zh, lblog, Ub, hgn, OM, it); SEAM(4); }
    if (IN(5)) {
        peer_tables(pu, pv, U8, suv, lane, blockIdx.x * 8 + wave, G * 8);
        __syncthreads();
        pg8::StaticOrder S; S.init(MC, 1024, G, (int)blockIdx.x);
        { pg8::Gemm g{OM, WbhT, MC, 1024, 512, 1024, 512}; pg8::EpiGate<0> E{Mb, Zg, bgate}; pg8::gemm_phase<pg8::EpiGate<0>, pg8::StaticOrder, true, true>(lds, g, S, E); }
        { pg8::Gemm g{OM + 512, WbaT, MC, 1024, 512, 1024, 512}; pg8::EpiGate<1> E{Mb, Zg, bgate}; pg8::gemm_phase<pg8::EpiGate<1>, pg8::StaticOrder, true, true>(lds, g, S, E); }
        SEAM(5);
    }
    if (IN(6)) {
        pg8::Gemm g{Mb, WoutT, MC, 1024, 1024, 1024, 1024}; pg8::StaticOrder S; S.init(MC, 1024, G, (int)blockIdx.x);
        pg8::EpiH1 E{x, a.out, A2, gffn, rowssp};
        pg8::gemm_phase<pg8::EpiH1, pg8::StaticOrder, true, true>(lds, g, S, E);
        SEAM(6);
    }
    if (IN(7)) {
        pg8::Gemm g{A2, WqT, MC, 2048, 1024, 1024, 1024}; pg8::StaticOrder S; S.init(MC, 2048, G, (int)blockIdx.x);
        pg8::EpiQ E{Qb, rowssp};
        pg8::gemm_phase<pg8::EpiQ, pg8::StaticOrder, true, true>(lds, g, S, E);
        SEAM(7);
    }
    if (IN(8)) {
        for (int grp = blockIdx.x; grp < MC / 128; grp += G) {
            const int rc0 = grp * 128;
#ifndef NO_TOPK
            peer_topk(lds, Qb, SK, rc0 + 32 * (wave >> 1), 32 * (wave >> 1), 4 * (wave & 1), lane);
#endif
#ifdef PROBE_TOPK2
            __syncthreads(); peer_topk(lds, Qb, SK, rc0 + 32 * (wave >> 1), 32 * (wave >> 1), 4 * (wave & 1), lane);
#endif
            __syncthreads();
            { const int tl0 = 16 * wave; const size_t rcw = (size_t)rc0 + tl0;
              { LAS f32x4* pz = (LAS f32x4*)(lds + PL_PA + tl0 * 512);
#pragma unroll
                for (int q = 0; q < 8; ++q) pz[lane + 64 * q] = (f32x4){0.f, 0.f, 0.f, 0.f}; }
#pragma unroll 1
              for (int i = 0; i < 16; ++i) peer_xq_token(A2, XQ, (float*)(XQ + (size_t)MC * 1024), rcw + i, lane);
              asm volatile("s_waitcnt vmcnt(0)" ::: "memory");
              { u32x4 ra[16], rb[16], xa[2], xb[2];
                peer_rows_load<true>(ra, xa, lds, tl0, rcw, 0, U8, (const bf16_t*)XQ, lane);
#pragma unroll 1
                for (int st = 0; st < 128; st += 2) {
                    peer_rows_load<true>(rb, xb, lds, tl0 + ((st + 1) & 15), rcw + ((st + 1) & 15), (st + 1) >> 4, U8, (const bf16_t*)XQ, lane);
                    __builtin_amdgcn_sched_barrier(0);
                    peer_u_math(ra, xa, lds, tl0 + (st & 15), lane);
                    { const int sn = st + 2 < 128 ? st + 2 : 127; peer_rows_load<true>(ra, xa, lds, tl0 + (sn & 15), rcw + (sn & 15), sn >> 4, U8, (const bf16_t*)XQ, lane); }
                    __builtin_amdgcn_sched_barrier(0);
                    peer_u_math(rb, xb, lds, tl0 + ((st + 1) & 15), lane); } }
#pragma unroll 1
              for (int i = 0; i < 16; ++i) peer_a_step(lds, tl0 + i, rcw + i, rowssp, suv, suv + 16384, lane);
              { u32x4 ra[16], rb[16], xd[2];
                peer_rows_load<false>(ra, xd, lds, tl0, rcw, 0, V8, A2, lane);
#pragma unroll 1
                for (int st = 0; st < 128; st += 2) {
                    peer_rows_load<false>(rb, xd, lds, tl0 + ((st + 1) & 15), rcw, (st + 1) >> 4, V8, A2, lane);
                    __builtin_amdgcn_sched_barrier(0);
                    peer_v_math(ra, lds, tl0 + (st & 15), rcw + (st & 15), st >> 4, a.out, lane);
                    { const int sn = st + 2 < 128 ? st + 2 : 127; peer_rows_load<false>(ra, xd, lds, tl0 + (sn & 15), rcw, sn >> 4, V8, A2, lane); }
                    __builtin_amdgcn_sched_barrier(0);
                    peer_v_math(rb, lds, tl0 + ((st + 1) & 15), rcw + ((st + 1) & 15), (st + 1) >> 4, a.out, lane); } }
              asm volatile("s_waitcnt vmcnt(0)" ::: "memory");
              __builtin_amdgcn_fence(__ATOMIC_ACQUIRE, "agent");
#pragma unroll 1
              for (int i = 0; i < 16; ++i) peer_f_step(lds, tl0 + i, rcw + i, a.out, gfin, lane); }
            __syncthreads();
        }
    }
#undef IN
#undef SEAM
}

extern "C" void kernel_launch(void* const* d_in, const int* in_sizes, int n_in, void* d_out, int out_size, void* d_ws, size_t ws_size, hipStream_t stream) {
    static int grid = 0;
    if (grid == 0) {
        if (n_in != 17 || out_size != MC * DM || ws_size < WS_END) { fprintf(stderr, "kernel_launch: unexpected shapes: n_in %d out %d ws %zu (need %zu)\n", n_in, out_size, ws_size, (size_t)WS_END); grid = -1; return; }
        int dev = 0, cus = 0, per_cu = 0;
        if (hipGetDevice(&dev) != hipSuccess || hipDeviceGetAttribute(&cus, hipDeviceAttributeMultiprocessorCount, dev) != hipSuccess) { fprintf(stderr, "kernel_launch: device query failed\n"); grid = -1; return; }
        if (hipFuncSetAttribute((const void*)fwd_kernel, hipFuncAttributeMaxDynamicSharedMemorySize, LDS_BYTES) != hipSuccess) { fprintf(stderr, "kernel_launch: hipFuncSetAttribute failed\n"); grid = -1; return; }
        if (hipOccupancyMaxActiveBlocksPerMultiprocessor(&per_cu, (const void*)fwd_kernel, 512, LDS_BYTES) != hipSuccess || per_cu < 1) { fprintf(stderr, "kernel_launch: occupancy query says %d blocks per CU\n", per_cu); per_cu = 1; }
        (void)hipGetLastError();
        grid = cus;
        fprintf(stderr, "kernel_launch: grid %d (occupancy %d per CU)\n", grid, per_cu);
    }
    if (grid < 0) return;
    if (hipMemsetAsync((char*)d_ws + WS_CTL, 0, CTL_BYTES, stream) != hipSuccess) { fprintf(stderr, "kernel_launch: memset of the barrier words failed\n"); return; }
    Args a{};
    for (int i = 0; i < 17; ++i) a.in[i] = (const float*)d_in[i];
    a.out = (float*)d_out; a.ws = (unsigned char*)d_ws;
#if MK_ONE_LAUNCH
    a.ph_lo = 0; a.ph_hi = NPHASE;
    void* args[] = {&a};
    hipError_t e = hipLaunchCooperativeKernel((const void*)fwd_kernel, dim3(grid), dim3(512), args, LDS_BYTES, stream);
    if (e != hipSuccess) fprintf(stderr, "kernel_launch: cooperative launch failed: %s (grid %d)\n", hipGetErrorString(e), grid);
#else
#ifdef PROBE_SEQ
    const int seq[] = PROBE_SEQ;
    for (int p : seq) { a.ph_lo = p; a.ph_hi = p + 1; hipLaunchKernelGGL(fwd_kernel, dim3(grid), dim3(512), LDS_BYTES, stream, a); }
#else
    for (int p = 0; p < NPHASE; ++p) { a.ph_lo = p; a.ph_hi = p + 1; hipLaunchKernelGGL(fwd_kernel, dim3(grid), dim3(512), LDS_BYTES, stream, a); }
#endif
#endif
}
```

```cpp
#include <hip/hip_runtime.h>
#include <hip/hip_cooperative_groups.h>
#include <cstdio>
#include <cstdint>
namespace cg = cooperative_groups;

#ifndef MK_ONE_LAUNCH
#define MK_ONE_LAUNCH 1
#endif

constexpr int DM = 1024, NB = 8, SEQ = 4096, NMETA = 16, LTOK = SEQ + NMETA;
constexpr int MA_REAL = NB * LTOK;
constexpr int MA = 33024;
constexpr int MC = NB * SEQ;
constexpr int LPAD = 4224;
constexpr float EPS = 1e-6f;

namespace pg8 {
#define PG8_LAS __attribute__((address_space(3)))
typedef unsigned short bf16_t;
typedef short bf16x8 __attribute__((ext_vector_type(8)));
typedef float f32x4 __attribute__((ext_vector_type(4)));
typedef unsigned u32x4 __attribute__((ext_vector_type(4)));
constexpr int BM = 256, BK = 64, HALF = 128, HTB = HALF * BK * 2  , STAGE_BYTES = 8 * HTB, NXCD = 8, WGM = 8;

__host__ __device__ __forceinline__ int lds_byte(int r, int c) { const int st = (r >> 4) * 2 + (c >> 5), rr = r & 15, cc = c & 31, ob = rr * 64 + cc * 2; return st * 1024 + (ob ^ (((ob >> 9) & 1) << 5)); }
__host__ __device__ __forceinline__ void stage_rc(int b, int& R, int& C) { const int st = b / 1024, sb = b % 1024, swz = sb ^ (((sb >> 9) & 1) << 5); R = (st >> 1) * 16 + swz / 64; C = (st & 1) * 32 + (swz % 64) / 2; }
__host__ __device__ __forceinline__ int perm32(int rho) { const int n = rho >> 4, i = rho & 15; return 8 * (i >> 2) + 4 * n + (i & 3); }

struct Unit { int pm, pn; };
struct Gemm { const bf16_t* A; const bf16_t* Bt; int M, N, K, lda, ldb; };

struct StaticOrder {
    int nM, nN, nwg, G, c;
    __host__ __device__ void init(int M, int N, int G_, int c_) { nM = M / BM; nN = N / BM; nwg = nM * nN; G = G_; c = c_; }
    __host__ __device__ bool next(int i, Unit& u) const {
        const long L = (long)i * G + c; if (L >= nwg) return false;
        int wgid = (int)L; { const int q = nwg / NXCD, r = nwg % NXCD, xcd = wgid % NXCD, off = wgid / NXCD; wgid = (xcd < r ? xcd * (q + 1) : r * (q + 1) + (xcd - r) * q) + off; }
        const int nig = WGM * nN, gid = wgid / nig, fm = gid * WGM, gsz = (nM - fm) < WGM ? (nM - fm) : WGM;
        u.pm = fm + ((wgid % nig) % gsz); u.pn = (wgid % nig) / gsz; return true;
    }
    __device__ __forceinline__ void a_ready(const Unit&) const {}
    __device__ __forceinline__ void done(const Unit&) const {}
};

__device__ __forceinline__ unsigned cvt_pk_bf16(float lo, float hi) { unsigned r; asm volatile("v_cvt_pk_bf16_f32 %0, %1, %2" : "=v"(r) : "v"(lo), "v"(hi)); return r; }
typedef float f32x2 __attribute__((ext_vector_type(2)));
typedef float f32x2_t __attribute__((ext_vector_type(2))); typedef __bf16 bf16x2_t __attribute__((ext_vector_type(2)));
typedef unsigned u32x2 __attribute__((ext_vector_type(2)));
__device__ __forceinline__ unsigned cvtpk(float lo, float hi) { f32x2_t v = {lo, hi}; bf16x2_t b = __builtin_convertvector(v, bf16x2_t); return __builtin_bit_cast(unsigned, b); }
__device__ __forceinline__ bf16_t f2bf(float x) { return (bf16_t)(cvtpk(x, 0.f) & 0xffffu); }
__device__ __forceinline__ float bf2f(bf16_t v) { return __uint_as_float((unsigned)v << 16); }
__device__ __forceinline__ float bflo(unsigned w) { return __uint_as_float(w << 16); }
__device__ __forceinline__ float bfhi(unsigned w) { return __uint_as_float(w & 0xffff0000u); }
__device__ __forceinline__ float sigm(float x) { return __builtin_amdgcn_rcpf(1.f + __expf(-x)); }

struct EpiZ {
    static constexpr bool PERM = true, AFTER_DRAIN = false, MIDK = false;
    bf16_t *Zh, *Za, *Zg, *Vt; const float* bgate;
    __device__ __forceinline__ void operator()(const f32x4 (&acc)[2][2][4][2], const Unit& u, int wr, int wc, int fr, int fq) const {
        const int pn = u.pn; bf16_t* base; int ldc, colt;
        if (pn < 8) { base = Zh; ldc = 2048; colt = pn * 256; } else if (pn < 11) { base = Za; ldc = 768; colt = (pn - 8) * 256; } else { base = Zg; ldc = 2048; colt = (pn - 11) * 256; }
        const int row0 = u.pm * BM + wr * 64 + fr, col0 = colt + wc * 32 + 8 * fq;
#pragma unroll
        for (int ai = 0; ai < 2; ++ai)
#pragma unroll
            for (int m = 0; m < 4; ++m) { const int row = row0 + ai * HALF + m * 16; bf16_t* rowp = base + (size_t)row * ldc + col0;
#pragma unroll
                for (int bj = 0; bj < 2; ++bj) { f32x4 v0 = acc[ai][bj][m][0], v1 = acc[ai][bj][m][1];
                    if (pn >= 11) { const f32x4 b0 = *(const f32x4*)(bgate + col0 + bj * HALF), b1 = *(const f32x4*)(bgate + col0 + bj * HALF + 4);
#pragma unroll
                        for (int i = 0; i < 4; ++i) { v0[i] = sigm(v0[i] + b0[i]); v1[i] = sigm(v1[i] + b1[i]); } }
                    if (pn == 10 && bj == 1) {
                        if (row < MA_REAL) { const int b = row / LTOK, pos = row - b * LTOK; bf16_t* vp = Vt + ((size_t)(b * 128 + wc * 32 + 8 * fq) * LPAD + 112 + pos);
                            vp[0] = f2bf(v0[0]); vp[LPAD] = f2bf(v0[1]); vp[2 * LPAD] = f2bf(v0[2]); vp[3 * LPAD] = f2bf(v0[3]);
                            vp[4 * LPAD] = f2bf(v1[0]); vp[5 * LPAD] = f2bf(v1[1]); vp[6 * LPAD] = f2bf(v1[2]); vp[7 * LPAD] = f2bf(v1[3]); }
                    } else { u32x4 w; w.x = cvtpk(v0[0], v0[1]); w.y = cvtpk(v0[2], v0[3]); w.z = cvtpk(v1[0], v1[1]); w.w = cvtpk(v1[2], v1[3]); *(u32x4*)(rowp + bj * HALF) = w; } } }
    }
};
struct EpiGate {
    static constexpr bool PERM = true, AFTER_DRAIN = false, MIDK = true;
    bf16_t* Mb; const bf16_t* Zg; const float* bgate;
    __device__ __forceinline__ void mid(f32x4 (&acc)[2][2][4][2], const Unit& u, int wr, int wc, int fr, int fq) const {
        const int row0 = u.pm * BM + wr * 64 + fr, col0 = u.pn * BM + wc * 32 + 8 * fq;
#pragma unroll
        for (int bj = 0; bj < 2; ++bj)
#pragma unroll
            for (int ai = 0; ai < 2; ++ai)
#pragma unroll
                for (int m = 0; m < 4; ++m) { const int rc = row0 + ai * HALF + m * 16, ra = (rc >> 12) * LTOK + NMETA + (rc & 4095);
                    const bf16_t* zp = Zg + (size_t)ra * 2048 + col0 + bj * HALF; const u32x4 za = *(const u32x4*)zp, zb = *(const u32x4*)(zp + 1024);
                    f32x4& v0 = acc[ai][bj][m][0]; f32x4& v1 = acc[ai][bj][m][1];
                    v0[0] *= bflo(za.x) * __builtin_amdgcn_rcpf(bflo(zb.x)); v0[1] *= bfhi(za.x) * __builtin_amdgcn_rcpf(bfhi(zb.x)); v0[2] *= bflo(za.y) * __builtin_amdgcn_rcpf(bflo(zb.y)); v0[3] *= bfhi(za.y) * __builtin_amdgcn_rcpf(bfhi(zb.y));
                    v1[0] *= bflo(za.z) * __builtin_amdgcn_rcpf(bflo(zb.z)); v1[1] *= bfhi(za.z) * __builtin_amdgcn_rcpf(bfhi(zb.z)); v1[2] *= bflo(za.w) * __builtin_amdgcn_rcpf(bflo(zb.w)); v1[3] *= bfhi(za.w) * __builtin_amdgcn_rcpf(bfhi(zb.w));
                    asm volatile("" ::: "memory"); }
    }
    __device__ __forceinline__ void operator()(const f32x4 (&acc)[2][2][4][2], const Unit& u, int wr, int wc, int fr, int fq) const {
        const int row0 = u.pm * BM + wr * 64 + fr, col0 = u.pn * BM + wc * 32 + 8 * fq;
#pragma unroll
        for (int ai = 0; ai < 2; ++ai)
#pragma unroll
            for (int m = 0; m < 4; ++m) { const int rc = row0 + ai * HALF + m * 16, ra = (rc >> 12) * LTOK + NMETA + (rc & 4095);
                const bf16_t* zp = Zg + (size_t)ra * 2048 + 1024 + col0; bf16_t* mp = Mb + (size_t)rc * 1024 + col0;
#pragma unroll
                for (int bj = 0; bj < 2; ++bj) { const u32x4 z = *(const u32x4*)(zp + bj * HALF); f32x4 v0 = acc[ai][bj][m][0], v1 = acc[ai][bj][m][1];
                    v0[0] *= bflo(z.x); v0[1] *= bfhi(z.x); v0[2] *= bflo(z.y); v0[3] *= bfhi(z.y); v1[0] *= bflo(z.z); v1[1] *= bfhi(z.z); v1[2] *= bflo(z.w); v1[3] *= bfhi(z.w);
                    u32x4 w; w.x = cvtpk(v0[0], v0[1]); w.y = cvtpk(v0[2], v0[3]); w.z = cvtpk(v1[0], v1[1]); w.w = cvtpk(v1[2], v1[3]); *(u32x4*)(mp + bj * HALF) = w; } }
    }
};
struct EpiH1 {
    static constexpr bool PERM = false, AFTER_DRAIN = false, MIDK = false;
    const float* x; bf16_t* h1; bf16_t* A2; const float* gffn; float* rowssp;
    __device__ __forceinline__ void operator()(const f32x4 (&acc)[2][2][4][2], const Unit& u, int wr, int wc, int fr, int fq) const {
        const int row0 = u.pm * BM + wr * 64 + fr, col0 = u.pn * BM + wc * 32 + 4 * fq;
        f32x4 gv[2][2];
#pragma unroll
        for (int bj = 0; bj < 2; ++bj)
#pragma unroll
            for (int n = 0; n < 2; ++n) gv[bj][n] = *(const f32x4*)(gffn + col0 + bj * HALF + n * 16);
#pragma unroll
        for (int ai = 0; ai < 2; ++ai)
#pragma unroll
            for (int m = 0; m < 4; ++m) { const int rc = row0 + ai * HALF + m * 16; float ss = 0.f;
#pragma unroll
                for (int bj = 0; bj < 2; ++bj)
#pragma unroll
                    for (int n = 0; n < 2; ++n) { const size_t off = (size_t)rc * 1024 + col0 + bj * HALF + n * 16;
                        const f32x4 h = *(const f32x4*)(x + off) + acc[ai][bj][m][n]; { u32x2 hw; hw.x = cvtpk(h[0], h[1]); hw.y = cvtpk(h[2], h[3]); *(u32x2*)(h1 + off) = hw; }
                        ss += (h[0] * h[0] + h[1] * h[1]) + (h[2] * h[2] + h[3] * h[3]);
                        const f32x4 y = h * gv[bj][n]; u32x2 w; w.x = cvtpk(y[0], y[1]); w.y = cvtpk(y[2], y[3]); *(u32x2*)(A2 + off) = w; }
                ss += __shfl_xor(ss, 16); ss += __shfl_xor(ss, 32);
                if (fq == 0) rowssp[(size_t)rc * 16 + u.pn * 4 + wc] = ss; }
    }
};
struct EpiQ {
    static constexpr bool PERM = true, AFTER_DRAIN = false, MIDK = false;
    bf16_t* Q; const float* rowssp;
    __device__ __forceinline__ void operator()(const f32x4 (&acc)[2][2][4][2], const Unit& u, int wr, int wc, int fr, int fq) const {
        const int row0 = u.pm * BM + wr * 64 + fr, col0 = u.pn * BM + wc * 32 + 8 * fq;
#pragma unroll
        for (int ai = 0; ai < 2; ++ai)
#pragma unroll
            for (int m = 0; m < 4; ++m) { const int rc = row0 + ai * HALF + m * 16;
                const f32x4* rp = (const f32x4*)(rowssp + (size_t)rc * 16); const f32x4 s4 = (rp[0] + rp[1]) + (rp[2] + rp[3]);
                const float rstd = __builtin_amdgcn_rsqf(((s4[0] + s4[1]) + (s4[2] + s4[3])) * (1.0f / 1024.0f) + 1e-6f);
#pragma unroll
                for (int bj = 0; bj < 2; ++bj) { const f32x4 v0 = acc[ai][bj][m][0] * rstd, v1 = acc[ai][bj][m][1] * rstd;
                    u32x4 w; w.x = cvtpk(v0[0], v0[1]); w.y = cvtpk(v0[2], v0[3]); w.z = cvtpk(v1[0], v1[1]); w.w = cvtpk(v1[2], v1[3]); const int col = col0 + bj * HALF;
                    *(u32x4*)(Q + ((size_t)((((rc >> 5) * 8 + (col >> 8)) * 2 + ((col >> 7) & 1)) * 8 + ((col & 127) >> 4)) * 64 + ((col >> 3) & 1) * 32 + (rc & 31)) * 8) = w; } }
    }
};
template <class Epi, class Sched, bool ALIGN_EPI = false, bool SP2 = false>
__device__ __forceinline__ void gemm_phase(PG8_LAS unsigned char* lds, const Gemm g, const Sched& S, const Epi& E) {
    const int tid = threadIdx.x, wid = __builtin_amdgcn_readfirstlane(tid >> 6), lane = tid & 63, wr = wid >> 2, wc = wid & 3, fr = lane & 15, fq = lane >> 4;
    const int K = g.K, nt = K / BK;
    unsigned voffA[2], voffB[2];
#pragma unroll
    for (int i = 0; i < 2; ++i) { int R, C; stage_rc(tid * 16 + i * 8192, R, C); const int Rb = Epi::PERM ? ((R & ~31) + perm32(R & 31)) : R;
        voffA[i] = (unsigned)(R * g.lda + C) * 2u; voffB[i] = (unsigned)(Rb * g.ldb + C) * 2u; }
    const size_t kstep = (size_t)(BK * 2);
    const size_t hstepA = (size_t)HALF * g.lda * 2, hstepB = (size_t)HALF * g.ldb * 2;
    const size_t tstepA = 2 * hstepA, tstepB = 2 * hstepB;
    const unsigned ldsw = (unsigned)wid * 1024u;
    const int aoff = lds_byte(wr * 64 + fr, fq * 8), boff = lds_byte(wc * 32 + fr, fq * 8);
#define PG8_SA(b, h) (((b) * 2 + (h)) * HTB)
#define PG8_SB(b, h) ((4 + (b) * 2 + (h)) * HTB)
#define PG8_STAGE(bufoff, gbase, voff) do { _Pragma("unroll") for (int _i = 0; _i < 2; ++_i) \
        __builtin_amdgcn_global_load_lds((const unsigned*)((const char*)(gbase) + (voff)[_i]), (PG8_LAS unsigned*)(lds + (bufoff) + ldsw + _i * 8192), 16, 0, 0); } while (0)
#define PG8_LDA(dst, b, h) do { _Pragma("unroll") for (int m = 0; m < 4; ++m) _Pragma("unroll") for (int k = 0; k < 2; ++k) dst[m][k] = *(const PG8_LAS bf16x8*)(lds + PG8_SA(b, h) + aoff + m * 2048 + k * 1024); } while (0)
#define PG8_LDB(dst, b, h) do { _Pragma("unroll") for (int n = 0; n < 2; ++n) _Pragma("unroll") for (int k = 0; k < 2; ++k) dst[n][k] = *(const PG8_LAS bf16x8*)(lds + PG8_SB(b, h) + boff + n * 2048 + k * 1024); } while (0)
#define PG8_MMA(ai, bj, At, Bt) do { __builtin_amdgcn_s_setprio(1); _Pragma("unroll") for (int m = 0; m < 4; ++m) _Pragma("unroll") for (int n = 0; n < 2; ++n) _Pragma("unroll") for (int k = 0; k < 2; ++k) \
        acc[ai][bj][m][n] = __builtin_amdgcn_mfma_f32_16x16x32_bf16(Bt[n][k], At[m][k], acc[ai][bj][m][n], 0, 0, 0); __builtin_amdgcn_s_setprio(0); } while (0)
#define PG8_WAIT_V(n) asm volatile("s_waitcnt vmcnt(" #n ")" ::: "memory")
#define PG8_WAIT_L(n) asm volatile("s_waitcnt lgkmcnt(" #n ")" ::: "memory")
#define PG8_BAR __builtin_amdgcn_s_barrier()
#define PG8_SCHED __builtin_amdgcn_sched_barrier(0)
    Unit cur, nxt; int ui = 0;
    if (!S.next(0, cur)) return;
    f32x4 acc[2][2][4][2];
#pragma unroll
    for (int a = 0; a < 2; ++a)
#pragma unroll
        for (int b = 0; b < 2; ++b)
#pragma unroll
            for (int m = 0; m < 4; ++m)
#pragma unroll
                for (int n = 0; n < 2; ++n) acc[a][b][m][n] = (f32x4){0.f, 0.f, 0.f, 0.f};
    bf16x8 At[4][2], B0[2][2], B1[2][2];
    const char* cA = (const char*)g.A + (size_t)cur.pm * tstepA; const char* cB = (const char*)g.Bt + (size_t)cur.pn * tstepB;
    S.a_ready(cur);
    if constexpr (SP2) {
        PG8_STAGE(PG8_SB(0, 0), cB, voffB); PG8_STAGE(PG8_SB(0, 1), cB + hstepB, voffB); PG8_STAGE(PG8_SA(0, 0), cA, voffA); PG8_STAGE(PG8_SA(0, 1), cA + hstepA, voffA);
        if (wr == 1) PG8_BAR;
        PG8_WAIT_V(2); PG8_BAR;
        PG8_STAGE(PG8_SB(1, 0), cB + kstep, voffB); PG8_STAGE(PG8_SA(1, 0), cA + kstep, voffA); PG8_STAGE(PG8_SB(1, 1), cB + hstepB + kstep, voffB);
        PG8_WAIT_V(6); PG8_BAR;
    } else {
        PG8_STAGE(PG8_SB(0, 0), cB, voffB); PG8_STAGE(PG8_SA(0, 0), cA, voffA); PG8_STAGE(PG8_SB(0, 1), cB + hstepB, voffB); PG8_STAGE(PG8_SA(0, 1), cA + hstepA, voffA);
        if (wr == 1) PG8_BAR;
        PG8_WAIT_V(4); PG8_BAR;
        PG8_STAGE(PG8_SB(1, 0), cB + kstep, voffB); PG8_STAGE(PG8_SA(1, 0), cA + kstep, voffA); PG8_STAGE(PG8_SB(1, 1), cB + hstepB + kstep, voffB);
        PG8_WAIT_V(6); PG8_BAR;
    }
    for (;;) {
        const bool has_next = S.next(ui + 1, nxt);
        const char* nA = has_next ? (const char*)g.A + (size_t)nxt.pm * tstepA : cA; const char* nB = has_next ? (const char*)g.Bt + (size_t)nxt.pn * tstepB : cB;
        for (int t = 0; t < nt; t += 2) {
            if constexpr (Epi::MIDK) { if (t == (nt >> 1)) { PG8_SCHED; E.mid(acc, cur, wr, wc, fr, fq); PG8_SCHED; } }
            const bool last = (t == nt - 2);
            const char* a1 = cA + (size_t)(t + 1) * kstep;
            const char* a2 = last ? nA : cA + (size_t)(t + 2) * kstep; const char* b2 = last ? nB : cB + (size_t)(t + 2) * kstep;
            const char* a3 = a2 + kstep; const char* b3 = b2 + kstep;
            if (last && has_next) S.a_ready(nxt);
            if constexpr (SP2) {
            PG8_LDB(B0, 0, 0); PG8_LDB(B1, 0, 1); PG8_SCHED; PG8_LDA(At, 0, 0); PG8_STAGE(PG8_SA(1, 1), a1 + hstepA, voffA);
            PG8_WAIT_V(8); PG8_WAIT_L(0); PG8_BAR; PG8_MMA(0, 0, At, B0); PG8_MMA(0, 1, At, B1); PG8_BAR; PG8_SCHED;
            PG8_LDA(At, 0, 1); PG8_STAGE(PG8_SB(0, 0), b2, voffB); PG8_STAGE(PG8_SB(0, 1), b2 + hstepB, voffB); PG8_STAGE(PG8_SA(0, 0), a2, voffA);
            PG8_WAIT_V(8); PG8_WAIT_L(0); PG8_BAR; PG8_MMA(1, 0, At, B0); PG8_MMA(1, 1, At, B1); PG8_BAR; PG8_SCHED;
            PG8_LDB(B0, 1, 0); PG8_LDB(B1, 1, 1); PG8_SCHED; PG8_LDA(At, 1, 0); PG8_STAGE(PG8_SA(0, 1), a2 + hstepA, voffA);
            PG8_WAIT_V(8); PG8_WAIT_L(0); PG8_BAR; PG8_MMA(0, 0, At, B0); PG8_MMA(0, 1, At, B1); PG8_BAR; PG8_SCHED;
            PG8_LDA(At, 1, 1); PG8_STAGE(PG8_SB(1, 0), b3, voffB); PG8_STAGE(PG8_SB(1, 1), b3 + hstepB, voffB); PG8_STAGE(PG8_SA(1, 0), a3, voffA);
            PG8_WAIT_V(8); PG8_WAIT_L(0); PG8_BAR; PG8_MMA(1, 0, At, B0); PG8_MMA(1, 1, At, B1); PG8_BAR; PG8_SCHED;
            } else {
            PG8_LDB(B0, 0, 0); PG8_SCHED; PG8_LDA(At, 0, 0); PG8_STAGE(PG8_SA(1, 1), a1 + hstepA, voffA);
            PG8_WAIT_L(8); PG8_BAR; PG8_WAIT_L(0); PG8_MMA(0, 0, At, B0); PG8_BAR; PG8_SCHED;
            PG8_LDB(B1, 0, 1); PG8_STAGE(PG8_SB(0, 0), b2, voffB);
            PG8_BAR; PG8_WAIT_L(0); PG8_MMA(0, 1, At, B1); PG8_BAR;
            PG8_LDA(At, 0, 1); PG8_STAGE(PG8_SA(0, 0), a2, voffA);
            PG8_BAR; PG8_WAIT_L(0); PG8_MMA(1, 0, At, B0); PG8_BAR; PG8_SCHED;
            PG8_STAGE(PG8_SB(0, 1), b2 + hstepB, voffB);
            PG8_WAIT_V(6); PG8_BAR; PG8_MMA(1, 1, At, B1); PG8_BAR;
            PG8_LDB(B0, 1, 0); PG8_SCHED; PG8_LDA(At, 1, 0); PG8_STAGE(PG8_SA(0, 1), a2 + hstepA, voffA);
            PG8_WAIT_L(8); PG8_BAR; PG8_WAIT_L(0); PG8_MMA(0, 0, At, B0); PG8_BAR; PG8_SCHED;
            PG8_LDB(B1, 1, 1); PG8_STAGE(PG8_SB(1, 0), b3, voffB);
            PG8_BAR; PG8_WAIT_L(0); PG8_MMA(0, 1, At, B1); PG8_BAR;
            PG8_LDA(At, 1, 1); PG8_STAGE(PG8_SA(1, 0), a3, voffA);
            PG8_BAR; PG8_WAIT_L(0); PG8_MMA(1, 0, At, B0); PG8_BAR; PG8_SCHED;
            PG8_STAGE(PG8_SB(1, 1), b3 + hstepB, voffB);
            PG8_WAIT_V(6); PG8_BAR; PG8_MMA(1, 1, At, B1); PG8_BAR;
            }
        }
        if constexpr (ALIGN_EPI) { if (wr == 0) PG8_BAR; }
        if constexpr (!Epi::AFTER_DRAIN) { E(acc, cur, wr, wc, fr, fq); S.done(cur); }
        if (!has_next) break;
#pragma unroll
        for (int a = 0; a < 2; ++a)
#pragma unroll
            for (int b = 0; b < 2; ++b)
#pragma unroll
                for (int m = 0; m < 4; ++m)
#pragma unroll
                    for (int n = 0; n < 2; ++n) acc[a][b][m][n] = (f32x4){0.f, 0.f, 0.f, 0.f};
        cur = nxt; cA = nA; cB = nB; ++ui;
        if constexpr (ALIGN_EPI) { if (wr == 1) PG8_BAR; }
    }
    PG8_WAIT_V(0);
    if constexpr (!ALIGN_EPI) { if (wr == 0) PG8_BAR; }
    PG8_BAR;
    if constexpr (Epi::AFTER_DRAIN) { E.fused(acc, cur, wr, wc, fr, fq, lds, wid, lane); S.done(cur); }
#undef PG8_SA
#undef PG8_SB
#undef PG8_STAGE
#undef PG8_LDA
#undef PG8_LDB
#undef PG8_MMA
#undef PG8_WAIT_V
#undef PG8_WAIT_L
#undef PG8_BAR
#undef PG8_SCHED
}
}
using pg8::bf16_t; using pg8::bf16x8; using pg8::f32x4; using pg8::u32x4; using pg8::u32x2; using pg8::cvtpk; using pg8::f2bf; using pg8::bf2f; using pg8::bflo; using pg8::bfhi; using pg8::sigm;
#define LAS __attribute__((address_space(3)))
typedef float f32x16 __attribute__((ext_vector_type(16)));
#define MFMA32(a, b, c) __builtin_amdgcn_mfma_f32_32x32x16_bf16((a), (b), (c), 0, 0, 0)

constexpr size_t MiB = 1u << 20;
constexpr size_t WS_ZH = 0;
constexpr size_t WS_H1B = 372 * MiB;
constexpr size_t WS_MB = WS_ZH, WS_U8 = WS_ZH + 64 * MiB, WS_V8 = WS_ZH + 80 * MiB, WS_SUV = WS_ZH + 96 * MiB;
constexpr size_t WS_ZA = 129 * MiB;
constexpr size_t WS_ZG = 178 * MiB;
constexpr size_t WS_QB = WS_ZG;
constexpr size_t WS_A1 = 307 * MiB;
constexpr size_t WS_OM = WS_A1, WS_A2 = WS_A1;
constexpr size_t WS_UB = 372 * MiB;
constexpr size_t WS_DV = 436 * MiB;
constexpr size_t WS_VT = 437 * MiB;
constexpr size_t WS_WIN = 446 * MiB;
constexpr size_t WS_WBH = 456 * MiB, WS_WBA = 457 * MiB, WS_WOUT = 458 * MiB, WS_WQ = 460 * MiB, WS_SK = 464 * MiB;
constexpr size_t WS_RS = 465 * MiB;
constexpr size_t WS_CTL = 467 * MiB, CTL_BYTES = 16384;
constexpr size_t WS_END = 468 * MiB;
constexpr int LDS_BYTES = 151552;

__device__ __forceinline__ float wave_sum(float v) {
#pragma unroll
    for (int o = 1; o < 64; o <<= 1) v += __shfl_xor(v, o);
    return v;
}
__device__ __forceinline__ void p0_transpose_item(const float* __restrict__ W, int K, int N, bf16_t* __restrict__ WT, LAS float* scr, int item, int lane, int ldw = 0) {
    if (ldw == 0) ldw = K;
    const int nblk = N / 32, kb = item / nblk, nb = item % nblk, k0 = 64 * kb, n0 = 32 * nb;
#pragma unroll 8
    for (int i = 0; i < 32; ++i) { const int kk = 2 * i + (lane >> 5); scr[kk * 33 + (lane & 31)] = W[(size_t)(k0 + kk) * N + n0 + (lane & 31)]; }
    asm volatile("s_waitcnt lgkmcnt(0)" ::: "memory");
    const int c = lane & 7;
#pragma unroll
    for (int j = 0; j < 4; ++j) { const int n = (lane >> 3) + 8 * j; const LAS float* s = scr + (8 * c) * 33 + n;
        u32x4 o; o.x = cvtpk(s[0 * 33], s[1 * 33]); o.y = cvtpk(s[2 * 33], s[3 * 33]); o.z = cvtpk(s[4 * 33], s[5 * 33]); o.w = cvtpk(s[6 * 33], s[7 * 33]);
        *(u32x4*)(WT + (size_t)(n0 + n) * ldw + k0 + 8 * c) = o; }
    asm volatile("s_waitcnt lgkmcnt(0)" ::: "memory");
}
struct P0Args { const float *x, *meta, *gmix, *w_in, *w_bh, *w_ba, *w_out, *w_q, *subk; bf16_t *A1, *WinT, *WbhT, *WbaT, *WoutT, *WqT, *SK; };
__device__ __forceinline__ void p0_prologue(LAS unsigned char* lds, const P0Args& p) {
    const int tid = threadIdx.x, lane = tid & 63, wave = tid >> 6;
    LAS float* scr = (LAS float*)(lds + wave * 16384);
    const int gw = blockIdx.x * 8 + wave, NGW = gridDim.x * 8;
    constexpr int I_IN = 16 * 152, I_B = 8 * 32, I_O = 16 * 32, I_Q = 16 * 64, NITEMS = I_IN + 2 * I_B + I_O + I_Q;
    for (int it = gw; it < NITEMS; it += NGW) {
        int r = it;
        if (r < I_IN) { p0_transpose_item(p.w_in, 1024, 4864, p.WinT, scr, r, lane); continue; } r -= I_IN;
        if (r < I_B) { p0_transpose_item(p.w_bh, 512, 1024, p.WbhT, scr, r, lane, 1024); continue; } r -= I_B;
        if (r < I_B) { p0_transpose_item(p.w_ba, 512, 1024, p.WbhT + 512, scr, r, lane, 1024); continue; } r -= I_B;
        if (r < I_O) { p0_transpose_item(p.w_out, 1024, 1024, p.WoutT, scr, r, lane); continue; } r -= I_O;
        p0_transpose_item(p.w_q, 1024, 2048, p.WqT, scr, r, lane);
    }
    for (int p_ = blockIdx.x * 512 + tid; p_ < 262144 / 8; p_ += gridDim.x * 512) {
        const int ln = p_ & 63, kk = (p_ >> 6) & 7, nb = (p_ >> 9) & 3, hc = p_ >> 11;
        const float* src = p.subk + (size_t)(hc * 128 + 32 * nb + (ln & 31)) * 128 + 16 * kk + 8 * (ln >> 5);
        const f32x4 a = *(const f32x4*)src, b = *(const f32x4*)(src + 4);
        u32x4 o; o.x = cvtpk(a[0], a[1]); o.y = cvtpk(a[2], a[3]); o.z = cvtpk(b[0], b[1]); o.w = cvtpk(b[2], b[3]); *(u32x4*)(p.SK + (size_t)p_ * 8) = o; }
    f32x4 g[4];
#pragma unroll
    for (int j = 0; j < 4; ++j) g[j] = *((const f32x4*)p.gmix + lane + 64 * j);
    for (int m = gw; m < MA; m += NGW) {
        unsigned long long* o8 = (unsigned long long*)(p.A1 + (size_t)m * 1024) + lane;
        if (m >= MA_REAL) {
#pragma unroll
            for (int j = 0; j < 4; ++j) o8[64 * j] = 0ull;
            continue; }
        const int b = m / LTOK, pos = m - b * LTOK;
        const float* src = pos < NMETA ? p.meta + (size_t)pos * 1024 : p.x + ((size_t)b * SEQ + (pos - NMETA)) * 1024;
        const f32x4* xr = (const f32x4*)src + lane; f32x4 v[4]; float s = 0.f;
#pragma unroll
        for (int j = 0; j < 4; ++j) { v[j] = xr[64 * j]; s += (v[j][0] * v[j][0] + v[j][1] * v[j][1]) + (v[j][2] * v[j][2] + v[j][3] * v[j][3]); }
        const float rstd = 1.f / sqrtf(wave_sum(s) * (1.f / 1024.f) + EPS);
#pragma unroll
        for (int j = 0; j < 4; ++j) { const f32x4 y = v[j] * rstd * g[j]; o8[64 * j] = (unsigned long long)cvtpk(y[0], y[1]) | ((unsigned long long)cvtpk(y[2], y[3]) << 32); }
    }
}

constexpr int SR = 272;
constexpr int OFF_Q = 0, OFF_K = 34816, OFF_V = 69632, OFF_S = 104448, OFF_VEC = 139264;
__device__ __forceinline__ bf16x8 ldfrag(const LAS unsigned char* base, int row, int kk8, int h2) { return *(const LAS bf16x8*)(base + row * SR + (kk8 * 16 + 8 * h2) * 2); }

constexpr int OFF_SEGP = OFF_VEC, OFF_VEC2 = OFF_VEC + 8192, OFF_SSQ = OFF_VEC2 + 1024;
template <bool WITH_Q>
__device__ __forceinline__ void hgrn_front(LAS unsigned char* lds, const bf16_t* __restrict__ Zh, const float* __restrict__ lblog, int b, int h, int c, float (&g)[8][4], float (&kk)[8][4], float (&qq)[8][4], u32x2 (&vraw)[8]) {
    const int tid = threadIdx.x, c4 = tid & 31, seg = tid >> 5;
    const f32x4 l0 = *(const f32x4*)(lblog + h * 128 + 4 * c4), l1 = *(const f32x4*)(lblog + 512 + h * 128 + 4 * c4);
    float lb[4], run[4];
#pragma unroll
    for (int k = 0; k < 4; ++k) { lb[k] = sigm(l0[k] - l1[k]); run[k] = 1.f; }
    u32x2 hfw[8], hqw[8];
#pragma unroll
    for (int i = 0; i < 8; ++i) { const int pos = 128 * c - 112 + 8 * seg + i; const bool valid = pos >= 0;
        const bf16_t* zr = Zh + (size_t)(b * LTOK + (valid ? pos : 0)) * 2048 + h * 128 + 4 * c4;
        hfw[i] = *(const u32x2*)(zr + 512); if (WITH_Q) hqw[i] = *(const u32x2*)zr; vraw[i] = *(const u32x2*)(zr + 1024);
        if (!valid) { hfw[i] = (u32x2){0x7f007f00u, 0x7f007f00u}; hqw[i] = (u32x2){0u, 0u}; vraw[i] = (u32x2){0u, 0u}; } }
#pragma unroll
    for (int i = 0; i < 8; ++i) {
        const float hf[4] = {bflo(hfw[i].x), bfhi(hfw[i].x), bflo(hfw[i].y), bfhi(hfw[i].y)};
#pragma unroll
        for (int k = 0; k < 4; ++k) { const float sg = sigm(hf[k]); const float f = lb[k] + (1.f - lb[k]) * sg; kk[i][k] = (1.f - lb[k]) * (1.f - sg); run[k] *= f; g[i][k] = run[k]; }
        if (WITH_Q) { qq[i][0] = bflo(hqw[i].x); qq[i][1] = bfhi(hqw[i].x); qq[i][2] = bflo(hqw[i].y); qq[i][3] = bfhi(hqw[i].y); } }
    *(LAS f32x4*)(lds + OFF_SEGP + (seg * 128 + 4 * c4) * 4) = (f32x4){run[0], run[1], run[2], run[3]};
    __syncthreads();
}
__device__ __forceinline__ void hgrn_base(LAS unsigned char* lds, float (&base)[4]) {
    const int tid = threadIdx.x, c4 = tid & 31, seg = tid >> 5;
    const LAS f32x4* sp = (const LAS f32x4*)(lds + OFF_SEGP) + c4;
    f32x4 p = (f32x4){1.f, 1.f, 1.f, 1.f};
    if (seg < 8) { for (int s = seg; s < 8; ++s) p *= sp[s * 32];
        if (seg == 0) *(LAS f32x4*)(lds + OFF_VEC2 + (4 * c4) * 4) = p;
#pragma unroll
        for (int k = 0; k < 4; ++k) base[k] = __builtin_amdgcn_rcpf(p[k]); }
    else { for (int s = 8; s < seg; ++s) p *= sp[s * 32];
        if (seg == 15) *(LAS f32x4*)(lds + OFF_VEC2 + (128 + 4 * c4) * 4) = p * sp[15 * 32];
#pragma unroll
        for (int k = 0; k < 4; ++k) base[k] = p[k]; }
}
__device__ __forceinline__ void hgrn_put_vt(LAS unsigned char* lds, const u32x2 (&vraw)[8], int c4, int seg) {
#pragma unroll
    for (int k = 0; k < 4; ++k) { unsigned e[8];
#pragma unroll
        for (int i = 0; i < 8; ++i) { const unsigned w = (k < 2) ? vraw[i].x : vraw[i].y; e[i] = (k & 1) ? (w >> 16) : (w & 0xffffu); }
        *(LAS u32x4*)(lds + OFF_V + (4 * c4 + k) * SR + seg * 16) = (u32x4){e[0] | (e[1] << 16), e[2] | (e[3] << 16), e[4] | (e[5] << 16), e[6] | (e[7] << 16)}; }
}

__device__ __forceinline__ void hgrn_A(LAS unsigned char* lds, const bf16_t* __restrict__ Zh, const float* __restrict__ lblog, float* __restrict__ Ub, float* __restrict__ Dv, int item) {
    const int tid = threadIdx.x, lane = tid & 63, wid = tid >> 6, r32 = lane & 31, h2 = lane >> 5;
    const int c = item & 31, bh = item >> 5, b = bh >> 2, h = bh & 3;
    const int c4 = tid & 31, seg = tid >> 5;
    float g[8][4], kk[8][4], qq[8][4]; u32x2 vraw[8];
    hgrn_front<false>(lds, Zh, lblog, b, h, c, g, kk, qq, vraw);
    { float base[4]; hgrn_base(lds, base);
#pragma unroll
      for (int k = 0; k < 4; ++k) { float kt[8];
#pragma unroll
          for (int i = 0; i < 8; ++i) kt[i] = kk[i][k] * __builtin_amdgcn_rcpf(base[k] * g[i][k]);
          *(LAS u32x4*)(lds + OFF_K + (4 * c4 + k) * SR + seg * 16) = (u32x4){cvtpk(kt[0], kt[1]), cvtpk(kt[2], kt[3]), cvtpk(kt[4], kt[5]), cvtpk(kt[6], kt[7])}; }
      hgrn_put_vt(lds, vraw, c4, seg); }
    __syncthreads();
    const int e0 = 32 * (wid >> 1), d0 = 64 * (wid & 1);
    f32x16 acc[2]; acc[0] = f32x16{}; acc[1] = f32x16{};
#pragma unroll
    for (int k8 = 0; k8 < 8; ++k8) { const bf16x8 a = ldfrag(lds + OFF_V, e0 + r32, k8, h2);
#pragma unroll
        for (int j = 0; j < 2; ++j) acc[j] = MFMA32(a, ldfrag(lds + OFF_K, d0 + 32 * j + r32, k8, h2), acc[j]); }
    const LAS float* vec2 = (const LAS float*)(lds + OFF_VEC2);
#pragma unroll
    for (int j = 0; j < 2; ++j) { const int dc = d0 + 32 * j + r32; const float sc = vec2[128 + dc];
        float* up = Ub + ((size_t)item * 128 + e0 + 4 * h2) * 128 + dc;
#pragma unroll
        for (int r = 0; r < 16; ++r) up[(size_t)((r & 3) + 8 * (r >> 2)) * 128] = acc[j][r] * sc; }
    if (tid < 128) Dv[(size_t)item * 128 + tid] = vec2[tid] * vec2[128 + tid];
    __syncthreads();
}

__device__ __forceinline__ void hgrn_C(LAS unsigned char* lds, const bf16_t* __restrict__ Zh, const float* __restrict__ lblog, const float* __restrict__ Ub, const float* __restrict__ hgn, bf16_t* __restrict__ OM, int item) {
    const int tid = threadIdx.x, lane = tid & 63, wid = tid >> 6, r32 = lane & 31, h2 = lane >> 5;
    const int c = (item & 31) + 1, bh = item >> 5, b = bh >> 2, h = bh & 3;
    const int c4 = tid & 31, seg = tid >> 5;
    const int tb = wid >> 1, wh = wid & 1;
    f32x4 sreg[8];
    { const float* sp = Ub + (size_t)item * 16384;
#pragma unroll
      for (int q = 0; q < 8; ++q) sreg[q] = *(const f32x4*)(sp + (size_t)(tid + 512 * q) * 4); }
    const size_t rc = (size_t)b * SEQ + 128 * (c - 1) + 32 * tb + r32, ra = (size_t)b * LTOK + 128 * c - 112 + 32 * tb + r32;
    u32x2 gate[2][4];
#pragma unroll
    for (int j = 0; j < 2; ++j)
#pragma unroll
        for (int gq = 0; gq < 4; ++gq) gate[j][gq] = *(const u32x2*)(Zh + ra * 2048 + 1536 + h * 128 + 64 * wh + 32 * j + 8 * gq + 4 * h2);
    float g[8][4], kk[8][4], qq[8][4]; u32x2 vraw[8];
    hgrn_front<true>(lds, Zh, lblog, b, h, c, g, kk, qq, vraw);
    { float base[4]; hgrn_base(lds, base);
#pragma unroll
      for (int i = 0; i < 8; ++i) { float r[4], ri[4];
#pragma unroll
          for (int k = 0; k < 4; ++k) { r[k] = base[k] * g[i][k]; ri[k] = __builtin_amdgcn_rcpf(r[k]); }
          const int t = 8 * seg + i;
          *(LAS u32x2*)(lds + OFF_Q + t * SR + 8 * c4) = (u32x2){cvtpk(qq[i][0] * r[0], qq[i][1] * r[1]), cvtpk(qq[i][2] * r[2], qq[i][3] * r[3])};
          *(LAS u32x2*)(lds + OFF_K + t * SR + 8 * c4) = (u32x2){cvtpk(kk[i][0] * ri[0], kk[i][1] * ri[1]), cvtpk(kk[i][2] * ri[2], kk[i][3] * ri[3])}; }
      hgrn_put_vt(lds, vraw, c4, seg); }
    __syncthreads();
    { const LAS float* vec2 = (const LAS float*)(lds + OFF_VEC2);
#pragma unroll
      for (int q = 0; q < 8; ++q) { const int idx = tid + 512 * q, e = idx >> 5, d4 = (idx & 31) * 4; const f32x4 pr = *(const LAS f32x4*)(vec2 + d4); const f32x4 sv = sreg[q] * pr;
          *(LAS u32x2*)(lds + OFF_S + e * SR + d4 * 2) = (u32x2){cvtpk(sv[0], sv[1]), cvtpk(sv[2], sv[3])}; } }
    f32x16 sc[2]; sc[0] = f32x16{}; sc[1] = f32x16{};
#pragma unroll
    for (int j = 0; j < 2; ++j) { const int sb = 2 * wh + j;
        if (sb <= tb) {
#pragma unroll
            for (int k8 = 0; k8 < 8; ++k8) sc[j] = MFMA32(ldfrag(lds + OFF_K, 32 * sb + r32, k8, h2), ldfrag(lds + OFF_Q, 32 * tb + r32, k8, h2), sc[j]); } }
    __syncthreads();
    { const int t = 32 * tb + r32;
#pragma unroll
      for (int j = 0; j < 2; ++j) { const int sb = 2 * wh + j;
#pragma unroll
          for (int gq = 0; gq < 4; ++gq) { const int s0 = 32 * sb + 8 * gq + 4 * h2;
              const float p0 = (sb <= tb && s0 + 0 <= t) ? sc[j][4 * gq + 0] : 0.f, p1 = (sb <= tb && s0 + 1 <= t) ? sc[j][4 * gq + 1] : 0.f;
              const float p2 = (sb <= tb && s0 + 2 <= t) ? sc[j][4 * gq + 2] : 0.f, p3 = (sb <= tb && s0 + 3 <= t) ? sc[j][4 * gq + 3] : 0.f;
              u32x2 w; w.x = cvtpk(p0, p1); w.y = cvtpk(p2, p3); *(LAS u32x2*)(lds + OFF_K + t * SR + s0 * 2) = w; } } }
    __syncthreads();
    f32x16 oc[2]; oc[0] = f32x16{}; oc[1] = f32x16{};
    for (int k8 = 0; k8 < 2 * (tb + 1); ++k8) { const bf16x8 pb = ldfrag(lds + OFF_K, 32 * tb + r32, k8, h2);
#pragma unroll
        for (int j = 0; j < 2; ++j) oc[j] = MFMA32(ldfrag(lds + OFF_V, 64 * wh + 32 * j + r32, k8, h2), pb, oc[j]); }
#pragma unroll
    for (int k8 = 0; k8 < 8; ++k8) { const bf16x8 qb = ldfrag(lds + OFF_Q, 32 * tb + r32, k8, h2);
#pragma unroll
        for (int j = 0; j < 2; ++j) oc[j] = MFMA32(ldfrag(lds + OFF_S, 64 * wh + 32 * j + r32, k8, h2), qb, oc[j]); }
    LAS float* ssq = (LAS float*)(lds + OFF_SSQ);
    { float ss = 0.f;
#pragma unroll
      for (int j = 0; j < 2; ++j)
#pragma unroll
          for (int r = 0; r < 16; ++r) ss += oc[j][r] * oc[j][r];
      ss += __shfl_xor(ss, 32);
      if (h2 == 0) ssq[wh * 128 + 32 * tb + r32] = ss; }
    __syncthreads();
    { const int t = 32 * tb + r32; const float rstd = __builtin_amdgcn_rsqf((ssq[t] + ssq[128 + t]) * (1.f / 128.f) + EPS);
#pragma unroll
      for (int j = 0; j < 2; ++j)
#pragma unroll
          for (int gq = 0; gq < 4; ++gq) { const int e = 64 * wh + 32 * j + 8 * gq + 4 * h2;
              const u32x2 gt = gate[j][gq]; const f32x4 gn = *(const f32x4*)(hgn + h * 128 + e);
              const float g0 = bflo(gt.x), g1 = bfhi(gt.x), g2 = bflo(gt.y), g3 = bfhi(gt.y);
              const float o0 = oc[j][4 * gq + 0] * rstd * gn[0] * (g0 * sigm(g0)), o1 = oc[j][4 * gq + 1] * rstd * gn[1] * (g1 * sigm(g1));
              const float o2 = oc[j][4 * gq + 2] * rstd * gn[2] * (g2 * sigm(g2)), o3 = oc[j][4 * gq + 3] * rstd * gn[3] * (g3 * sigm(g3));
              u32x2 w; w.x = cvtpk(o0, o1); w.y = cvtpk(o2, o3); *(u32x2*)(OM + rc * 1024 + h * 128 + e) = w; } }
    __syncthreads();
}

__device__ __forceinline__ void hgrn_scan(float* __restrict__ Ub, const float* __restrict__ Dv) {
    for (int v = blockIdx.x * 512 + threadIdx.x; v < 32 * 4096; v += gridDim.x * 512) {
        const int bh = v >> 12, i4 = v & 4095, e = i4 >> 5, d4 = (i4 & 31) * 4;
        f32x4* up = (f32x4*)(Ub + ((size_t)(bh * 32) * 128 + e) * 128 + d4); const f32x4* dp = (const f32x4*)(Dv + (size_t)(bh * 32) * 128 + d4);
        f32x4 S = (f32x4){0.f, 0.f, 0.f, 0.f};
#pragma unroll 1
        for (int c0 = 0; c0 < 32; c0 += 8) { f32x4 u[8], dv[8];
#pragma unroll
            for (int c = 0; c < 8; ++c) { u[c] = up[(size_t)(c0 + c) * 4096]; dv[c] = dp[(c0 + c) * 32]; }
#pragma unroll
            for (int c = 0; c < 8; ++c) { S = dv[c] * S + u[c]; up[(size_t)(c0 + c) * 4096] = S; } }
    }
}

constexpr int AK_STRIDE = 144, AV_STRIDE = 560, AK_OFF = 0, AV_OFF = 288 * AK_STRIDE;
__device__ __forceinline__ void attn_stage(LAS unsigned char* lds, const bf16_t* __restrict__ Za, const bf16_t* __restrict__ Vt, int b, int n, int kvh) {
    const int tid = threadIdx.x;
    for (int i = tid; i < 288 * 8; i += 512) { const int kl = i >> 3, ch = i & 7; u32x4 v = (u32x4){0u, 0u, 0u, 0u};
        int pos = -1; if (kl < 256) pos = 128 * (n - 1) + kl - 112; else if (kl < 272) pos = kl - 256;
        if (pos >= 0) v = *(const u32x4*)(Za + (size_t)(b * LTOK + pos) * 768 + 512 + kvh * 64 + 8 * ch);
        *(LAS u32x4*)(lds + AK_OFF + kl * AK_STRIDE + ch * 16) = v; }
    for (int i = tid; i < 64 * 35; i += 512) { const int d = i / 35, ch = i - d * 35; u32x4 v = (u32x4){0u, 0u, 0u, 0u};
        const bf16_t* vr = Vt + (size_t)(b * 128 + kvh * 64 + d) * LPAD;
        if (ch < 32) { if (n > 1 || ch >= 14) v = *(const u32x4*)(vr + 128 * (n - 1) + 8 * ch); }
        else if (ch < 34) v = *(const u32x4*)(vr + 112 + 8 * (ch - 32));
        *(LAS u32x4*)(lds + AV_OFF + d * AV_STRIDE + ch * 16) = v; }
}
__device__ __forceinline__ f32x16 attn_tile(const LAS unsigned char* kp, const bf16x8 (&qf)[4], int pk0, bool meta, int pq, int h2) {
    f32x16 S = f32x16{};
#pragma unroll
    for (int k = 0; k < 4; ++k) S = MFMA32(*(const LAS bf16x8*)(kp + 32 * k), qf[k], S);
#pragma unroll
    for (int r = 0; r < 16; ++r) { const int kr = (r & 3) + 8 * (r >> 2) + 4 * h2; const int pk = pk0 + kr;
        const bool ok = meta ? (kr < 16) : ((pk >= 128) && (pk <= pq) && (pq - pk < 128));
        S[r] = ok ? S[r] * 0.125f : -INFINITY; }
    return S;
}
__device__ __forceinline__ void attn_sub(const LAS unsigned char* lds, const bf16_t* __restrict__ Za, const float* __restrict__ sinks, bf16_t* __restrict__ OM, int b, int n, int qh, int sb, int lane) {
    const int r32 = lane & 31, h2 = lane >> 5;
    const int pq = 128 * n + 32 * sb + r32;
    const bf16_t* qp = Za + (size_t)(b * LTOK + pq - 112) * 768 + qh * 64 + 8 * h2;
    bf16x8 qf[4];
#pragma unroll
    for (int k = 0; k < 4; ++k) qf[k] = *(const bf16x8*)(qp + 16 * k);
    const LAS unsigned char* kl = lds + AK_OFF + r32 * AK_STRIDE + 16 * h2;
    const float sink = sinks[qh];
    float mx = sink;
#pragma unroll 1
    for (int j = 0; j < 6; ++j) { const int kl0 = j < 5 ? 32 * (sb + j) : 256;
        const f32x16 S = attn_tile(kl + kl0 * AK_STRIDE, qf, 128 * (n - 1) + kl0, j == 5, pq, h2);
#pragma unroll
        for (int r = 0; r < 16; ++r) mx = fmaxf(mx, S[r]); }
    mx = fmaxf(mx, __shfl_xor(mx, 32));
    float l = 0.f;
    f32x16 O[2]; O[0] = f32x16{}; O[1] = f32x16{};
    const LAS unsigned char* vl = lds + AV_OFF + r32 * AV_STRIDE + 8 * h2;
#pragma unroll 1
    for (int j = 0; j < 6; ++j) { const int kl0 = j < 5 ? 32 * (sb + j) : 256;
        f32x16 S = attn_tile(kl + kl0 * AK_STRIDE, qf, 128 * (n - 1) + kl0, j == 5, pq, h2);
#pragma unroll
        for (int r = 0; r < 16; ++r) { S[r] = __expf(S[r] - mx); l += S[r]; }
#pragma unroll
        for (int s2 = 0; s2 < 2; ++s2) {
            if (j == 5 && s2 == 1) continue;
            u32x4 pw; pw.x = cvtpk(S[8 * s2 + 0], S[8 * s2 + 1]); pw.y = cvtpk(S[8 * s2 + 2], S[8 * s2 + 3]); pw.z = cvtpk(S[8 * s2 + 4], S[8 * s2 + 5]); pw.w = cvtpk(S[8 * s2 + 6], S[8 * s2 + 7]);
            const bf16x8 pb = __builtin_bit_cast(bf16x8, pw);
#pragma unroll
            for (int db = 0; db < 2; ++db) { const LAS unsigned char* vp = vl + (32 * db) * AV_STRIDE + (kl0 + 16 * s2) * 2;
                const u32x2 lo = *(const LAS u32x2*)vp, hi = *(const LAS u32x2*)(vp + 16);
                const u32x4 aw = (u32x4){lo.x, lo.y, hi.x, hi.y};
                O[db] = MFMA32(__builtin_bit_cast(bf16x8, aw), pb, O[db]); } } }
    l += __shfl_xor(l, 32); l += __expf(sink - mx);
    const float inv = __builtin_amdgcn_rcpf(l);
    bf16_t* op = OM + ((size_t)b * SEQ + 128 * (n - 1) + 32 * sb + r32) * 1024 + 512 + qh * 64 + 4 * h2;
#pragma unroll
    for (int db = 0; db < 2; ++db)
#pragma unroll
        for (int g = 0; g < 4; ++g) { u32x2 w; w.x = cvtpk(O[db][4 * g] * inv, O[db][4 * g + 1] * inv); w.y = cvtpk(O[db][4 * g + 2] * inv, O[db][4 * g + 3] * inv);
            *(u32x2*)(op + 32 * db + 8 * g) = w; }
}
__device__ __forceinline__ unsigned f2ord(float f) { const unsigned u = __float_as_uint(f); return (u & 0x80000000u) ? ~u : (u | 0x80000000u); }
__device__ __forceinline__ float ord2f(unsigned u) { return __uint_as_float((u & 0x80000000u) ? (u & 0x7fffffffu) : ~u); }
__device__ __forceinline__ unsigned umax_(unsigned a, unsigned b) { return a > b ? a : b; }
__device__ __forceinline__ unsigned umin_(unsigned a, unsigned b) { return a < b ? a : b; }
template <int N> __device__ __forceinline__ void bitonic_desc(unsigned (&a)[N]) {
#pragma unroll
    for (int k = 2; k <= N; k <<= 1)
#pragma unroll
        for (int j = k >> 1; j > 0; j >>= 1)
#pragma unroll
            for (int i = 0; i < N; ++i) { const int l = i ^ j;
                if (l > i) { const unsigned hi = umax_(a[i], a[l]), lo = umin_(a[i], a[l]); if ((i & k) == 0) { a[i] = hi; a[l] = lo; } else { a[i] = lo; a[l] = hi; } } }
}
__device__ __forceinline__ void merge_top16(unsigned (&a)[16], const unsigned (&b)[16]) {
#pragma unroll
    for (int i = 0; i < 16; ++i) a[i] = umax_(a[i], b[15 - i]);
#pragma unroll
    for (int j = 8; j > 0; j >>= 1)
#pragma unroll
        for (int i = 0; i < 16; ++i) { const int l = i ^ j; if (l > i) { const unsigned hi = umax_(a[i], a[l]), lo = umin_(a[i], a[l]); a[i] = hi; a[l] = lo; } }
}
template <bool PAIR> __device__ __forceinline__ void top16_of(unsigned (&g)[4][16]) {
    bitonic_desc<16>(g[0]); bitonic_desc<16>(g[1]); bitonic_desc<16>(g[2]); bitonic_desc<16>(g[3]);
    merge_top16(g[0], g[1]); merge_top16(g[2], g[3]); merge_top16(g[0], g[2]);
    if (PAIR) { unsigned o[16];
#pragma unroll
        for (int i = 0; i < 16; ++i) o[i] = (unsigned)__shfl_xor((int)g[0][i], 32);
        merge_top16(g[0], o); }
}
__device__ __forceinline__ unsigned sel16p(unsigned long long lo, unsigned long long hi, int i) { const unsigned long long w = (i & 8) ? hi : lo; return (unsigned)(w >> ((i & 7) * 8)) & 0x7fu; }
struct CandTab { unsigned char i[50], j[50]; int n; };
constexpr CandTab make_cands() { CandTab t{}; int n = 0; for (int i = 0; i < 16; ++i) for (int j = 0; j < 16; ++j) if ((i + 1) * (j + 1) <= 16) { t.i[n] = (unsigned char)i; t.j[n] = (unsigned char)j; ++n; } t.n = n; return t; }
constexpr CandTab CT = make_cands();
static_assert(CT.n == 50, "candidate count");

constexpr int PL_IDX = 0, PL_GB = 32768, PL_PA = 65536, PL_SSQ = 131072;
__device__ __forceinline__ void peer_list(const bf16_t* __restrict__ Qb, const bf16_t* __restrict__ SK, int rc0, int h, int c, int r32, int h2, unsigned (&top)[16]) {
    const int lane_ = 32 * h2 + r32;
    const bf16_t* qp = Qb + ((size_t)((((rc0 >> 5) * 8 + h) * 2 + c) * 8) * 64 + lane_) * 8;
    bf16x8 qf[8];
#pragma unroll
    for (int k = 0; k < 8; ++k) qf[k] = *(const bf16x8*)(qp + 512 * k);
    unsigned g[4][16];
#pragma unroll
    for (int nb = 0; nb < 4; ++nb) {
        const bf16_t* kp = SK + ((size_t)(((h * 2 + c) * 4 + nb) * 8) * 64 + lane_) * 8;
        f32x16 acc = f32x16{};
#pragma unroll
        for (int k = 0; k < 8; ++k) acc = MFMA32(*(const bf16x8*)(kp + 512 * k), qf[k], acc);
#pragma unroll
        for (int r = 0; r < 16; ++r) g[nb][r] = (f2ord(acc[r]) & 0xffffff80u) | (unsigned)(32 * nb + (r & 3) + 8 * (r >> 2) + 4 * h2);
        __builtin_amdgcn_sched_barrier(0);
    }
    top16_of<true>(g);
#pragma unroll
    for (int k = 0; k < 16; ++k) top[k] = g[0][k];
}
__device__ __forceinline__ void peer_topk(LAS unsigned char* lds, const bf16_t* __restrict__ Qb, const bf16_t* __restrict__ SK, int rc0, int tl0, int h0, int lane) {
#pragma unroll 1
    for (int hh = 0; hh < 4; ++hh) {
        asm volatile("" : "+v"(lane));
        const int r32 = lane & 31, h2 = lane >> 5;
        const int h = h0 + hh;
        unsigned ta[16], tb[16];
        peer_list(Qb, SK, rc0, h, 0, r32, h2, ta);
        peer_list(Qb, SK, rc0, h, 1, r32, h2, tb);
        float av[16], bv[16]; unsigned long long ail = 0, aih = 0, bil = 0, bih = 0;
#pragma unroll
        for (int k = 0; k < 16; ++k) { av[k] = ord2f(ta[k] & 0xffffff80u); bv[k] = ord2f(tb[k] & 0xffffff80u);
            if (k < 8) { ail |= (unsigned long long)(ta[k] & 0x7fu) << (8 * k); bil |= (unsigned long long)(tb[k] & 0x7fu) << (8 * k); }
            else { aih |= (unsigned long long)(ta[k] & 0x7fu) << (8 * (k - 8)); bih |= (unsigned long long)(tb[k] & 0x7fu) << (8 * (k - 8)); } }
        unsigned k2[4][16];
#pragma unroll
        for (int k = 0; k < 64; ++k) { if (k < 50) k2[k >> 4][k & 15] = (f2ord(av[CT.i[k < 50 ? k : 0]] + bv[CT.j[k < 50 ? k : 0]]) & 0xffffff00u) | (unsigned)(CT.i[k < 50 ? k : 0] * 16 + CT.j[k < 50 ? k : 0]); else k2[k >> 4][k & 15] = 0u; }
        top16_of<false>(k2);
        float ev[16]; float es = 0.f; const float m0 = ord2f(k2[0][0] & 0xffffff00u);
#pragma unroll
        for (int k = 0; k < 16; ++k) { ev[k] = __expf(ord2f(k2[0][k] & 0xffffff00u) - m0); es += ev[k]; }
        const float inv = 1.f / es;
        LAS unsigned short* ip = (LAS unsigned short*)(lds + PL_IDX) + (tl0 + r32) * 128 + h * 16;
        LAS bf16_t* gp = (LAS bf16_t*)(lds + PL_GB) + (tl0 + r32) * 128 + h * 16;
#pragma unroll
        for (int k = 0; k < 16; ++k) { const int code = (int)(k2[0][k] & 0xffu); const unsigned e = sel16p(ail, aih, code >> 4) * 128u + sel16p(bil, bih, code & 15);
            if ((k >> 3) == h2) { ip[k] = (unsigned short)e; gp[k] = f2bf(ev[k] * inv); } }
    }
}
__device__ __forceinline__ pg8::f32x2_t fp8x2(unsigned w, bool hi) { return hi ? __builtin_amdgcn_cvt_pk_f32_fp8(w, true) : __builtin_amdgcn_cvt_pk_f32_fp8(w, false); }
template <int CTRL> __device__ __forceinline__ float dppf(float v) { return __builtin_bit_cast(float, __builtin_amdgcn_update_dpp(0, __builtin_bit_cast(int, v), CTRL, 0xf, 0xf, true)); }
template <bool WITH_X>
__device__ __forceinline__ void peer_rows_load(u32x4 (&rw)[16], u32x4 (&xw)[2], const LAS unsigned char* lds, int tl, size_t rc, int s, const unsigned char* __restrict__ T8, const bf16_t* __restrict__ A2, int lane) {
    const int c = lane & 7, gq = lane >> 3;
    if (WITH_X) { xw[0] = *(const u32x4*)((const unsigned char*)A2 + rc * 1024 + 128 * s + 16 * c); xw[1].x = __float_as_uint(*(const float*)((const unsigned char*)A2 + (size_t)MC * 1024 + rc * 4)); }
    const LAS unsigned short* ip = (const LAS unsigned short*)(lds + PL_IDX) + tl * 128 + gq;
    const unsigned char* tb = T8 + 128 * s + 16 * c;
#pragma unroll
    for (int ig = 0; ig < 16; ++ig) rw[ig] = *(const u32x4*)(tb + (size_t)ip[8 * ig] * 1024);
}
__device__ __forceinline__ void peer_u_math(const u32x4 (&uw)[16], const u32x4 (&xw)[2], LAS unsigned char* lds, int tl, int lane) {
    const int c = lane & 7, gq = lane >> 3;
    const int x0 = (int)xw[0].x, x1 = (int)xw[0].y, x2 = (int)xw[0].z, x3 = (int)xw[0].w;
    int acc0 = 0, acc1 = 0;
#pragma unroll
    for (int ig = 0; ig < 16; ++ig) {
        int d = __builtin_amdgcn_sdot4((int)uw[ig].x, x0, 0, false); d = __builtin_amdgcn_sdot4((int)uw[ig].y, x1, d, false); d = __builtin_amdgcn_sdot4((int)uw[ig].z, x2, d, false); d = __builtin_amdgcn_sdot4((int)uw[ig].w, x3, d, false);
        d += __builtin_amdgcn_update_dpp(0, d, 0xB1, 0xf, 0xf, true); d += __builtin_amdgcn_update_dpp(0, d, 0x4E, 0xf, 0xf, true); d += __builtin_amdgcn_update_dpp(0, d, 0x141, 0xf, 0xf, true);
        if (ig < 8) acc0 = (c == ig) ? d : acc0; else acc1 = (c == ig - 8) ? d : acc1; }
    const float sx = __uint_as_float(xw[1].x);
    LAS float* pp = (LAS float*)(lds + PL_PA) + tl * 128 + 8 * c + gq;
    __hip_atomic_fetch_add(pp, (float)acc0 * sx, __ATOMIC_RELAXED, __HIP_MEMORY_SCOPE_WORKGROUP);
    __hip_atomic_fetch_add(pp + 64, (float)acc1 * sx, __ATOMIC_RELAXED, __HIP_MEMORY_SCOPE_WORKGROUP);
}
__device__ __forceinline__ void peer_a_step(LAS unsigned char* lds, int tl, size_t rc, const float* __restrict__ rowssp, const float* __restrict__ su, const float* __restrict__ sv, int lane) {
    float rs = rowssp[rc * 16 + (lane & 15)];
    rs += __shfl_xor(rs, 1); rs += __shfl_xor(rs, 2); rs += __shfl_xor(rs, 4); rs += __shfl_xor(rs, 8);
    const float rstd = __builtin_amdgcn_rsqf(rs * (1.f / 1024.f) + EPS);
#pragma unroll
    for (int q = 0; q < 2; ++q) { const int k = lane + 64 * q;
        const unsigned e = ((const LAS unsigned short*)(lds + PL_IDX))[tl * 128 + k];
        LAS float* pp = (LAS float*)(lds + PL_PA) + tl * 128 + k;
        const float z = *pp * rstd * su[e]; const float a = 0.5f * z * (1.f + erff(z * 0.70710678118654752f));
        *pp = bf2f(((const LAS bf16_t*)(lds + PL_GB))[tl * 128 + k]) * a * sv[e]; }
    if (lane == 0) ((LAS float*)(lds + PL_SSQ))[tl] = 0.f;
}
__device__ __forceinline__ void peer_v_math(const u32x4 (&vw)[16], LAS unsigned char* lds, int tl, size_t rc, int s, bf16_t* __restrict__ dout, int lane) {
    const int c = lane & 7, gq = lane >> 3;
    const LAS float* wp = (const LAS float*)(lds + PL_PA) + tl * 128 + gq;
    const bool b3 = lane & 8, b4 = lane & 16, b5 = lane & 32;
    unsigned* hp = (unsigned*)(dout + rc * 1024 + 128 * s + 16 * c + (b3 ? 8 : 0) + (b4 ? 4 : 0) + (b5 ? 2 : 0));
    const unsigned hw = *hp; pg8::f32x2_t h = (pg8::f32x2_t){bflo(hw), bfhi(hw)};
    pg8::f32x2_t o2[8];
#pragma unroll
    for (int i = 0; i < 8; ++i) o2[i] = (pg8::f32x2_t){0.f, 0.f};
#pragma unroll
    for (int ig = 0; ig < 16; ++ig) { const float w = wp[8 * ig]; const pg8::f32x2_t w2 = (pg8::f32x2_t){w, w};
#pragma unroll
        for (int q = 0; q < 4; ++q) { o2[2 * q] += w2 * fp8x2(vw[ig][q], false); o2[2 * q + 1] += w2 * fp8x2(vw[ig][q], true); } }
    float out[16];
#pragma unroll
    for (int i = 0; i < 8; ++i) { out[2 * i] = o2[i].x; out[2 * i + 1] = o2[i].y; }
#pragma unroll
    for (int j = 0; j < 8; ++j) { const float keep = b3 ? out[j + 8] : out[j], send = b3 ? out[j] : out[j + 8]; out[j] = keep + dppf<0x128>(send); }
#pragma unroll
    for (int j = 0; j < 4; ++j) { const float keep = b4 ? out[j + 4] : out[j], send = b4 ? out[j] : out[j + 4]; out[j] = keep + __shfl_xor(send, 16); }
#pragma unroll
    for (int j = 0; j < 2; ++j) { const float keep = b5 ? out[j + 2] : out[j], send = b5 ? out[j] : out[j + 2]; out[j] = keep + __shfl_xor(send, 32); }
    h.x += out[0]; h.y += out[1];
    *hp = cvtpk(h.x, h.y);
    const float ss = wave_sum(h.x * h.x + h.y * h.y);
    if (lane == 0) ((LAS float*)(lds + PL_SSQ))[tl] += ss;
}
__device__ __forceinline__ void peer_f_step(LAS unsigned char* lds, int tl, size_t rc, const bf16_t* __restrict__ h2b, float* __restrict__ dout, const float* __restrict__ gfin, int lane) {
    const float rf = __builtin_amdgcn_rsqf(((const LAS float*)(lds + PL_SSQ))[tl] * (1.f / 1024.f) + EPS);
    const u32x4 ha = *(const u32x4*)(h2b + rc * 1024 + 16 * lane), hb = *(const u32x4*)(h2b + rc * 1024 + 16 * lane + 8);
    float* op = dout + rc * 1024 + 16 * lane; const float* gq = gfin + 16 * lane;
    *(f32x4*)(op) = (f32x4){bflo(ha.x), bfhi(ha.x), bflo(ha.y), bfhi(ha.y)} * rf * *(const f32x4*)(gq);
    *(f32x4*)(op + 4) = (f32x4){bflo(ha.z), bfhi(ha.z), bflo(ha.w), bfhi(ha.w)} * rf * *(const f32x4*)(gq + 4);
    *(f32x4*)(op + 8) = (f32x4){bflo(hb.x), bfhi(hb.x), bflo(hb.y), bfhi(hb.y)} * rf * *(const f32x4*)(gq + 8);
    *(f32x4*)(op + 12) = (f32x4){bflo(hb.z), bfhi(hb.z), bflo(hb.w), bfhi(hb.w)} * rf * *(const f32x4*)(gq + 12);
}
__device__ __forceinline__ unsigned pack_i8x4(float a, float b, float c, float d) {
    const int ia = __float2int_rn(a), ib = __float2int_rn(b), ic = __float2int_rn(c), id = __float2int_rn(d);
    return (unsigned)(ia & 0xff) | ((unsigned)(ib & 0xff) << 8) | ((unsigned)(ic & 0xff) << 16) | ((unsigned)id << 24);
}
__device__ __forceinline__ void peer_tables(const float* __restrict__ pu, const float* __restrict__ pv, unsigned char* __restrict__ T8, float* __restrict__ sinv, int lane, int gw, int NGW) {
    for (int row = gw; row < 32768; row += NGW) {
        const bool isu = row < 16384;
        const float* src = (isu ? pu + (size_t)row * 1024 : pv + (size_t)(row - 16384) * 1024) + 16 * lane;
        f32x4 v[4]; float am = 0.f;
#pragma unroll
        for (int q = 0; q < 4; ++q) { v[q] = *(const f32x4*)(src + 4 * q); am = fmaxf(am, fmaxf(fmaxf(fabsf(v[q][0]), fabsf(v[q][1])), fmaxf(fabsf(v[q][2]), fabsf(v[q][3])))); }
#pragma unroll
        for (int o = 1; o < 64; o <<= 1) am = fmaxf(am, __shfl_xor(am, o));
        const float top = isu ? 127.f : 224.f;
        const float sc = am > 0.f ? top / am : 1.f;
        u32x4 w;
        if (isu) {
#pragma unroll
            for (int q = 0; q < 4; ++q) w[q] = pack_i8x4(v[q][0] * sc, v[q][1] * sc, v[q][2] * sc, v[q][3] * sc);
        } else {
#pragma unroll
            for (int q = 0; q < 4; ++q) { unsigned t = __builtin_amdgcn_cvt_pk_fp8_f32(v[q][0] * sc, v[q][1] * sc, 0, false); t = __builtin_amdgcn_cvt_pk_fp8_f32(v[q][2] * sc, v[q][3] * sc, t, true); w[q] = t; } }
        *(u32x4*)(T8 + (size_t)row * 1024 + 16 * lane) = w;
        if (lane == 0) sinv[row] = am > 0.f ? am / top : 1.f;
    }
}
__device__ __forceinline__ void peer_xq_token(const bf16_t* __restrict__ A2, unsigned char* __restrict__ XQ, float* __restrict__ SX, size_t rc, int lane) {
    const u32x4 xa = *(const u32x4*)(A2 + rc * 1024 + 16 * lane), xb = *(const u32x4*)(A2 + rc * 1024 + 16 * lane + 8);
    const unsigned w[8] = {xa.x, xa.y, xa.z, xa.w, xb.x, xb.y, xb.z, xb.w};
    float am = 0.f;
#pragma unroll
    for (int q = 0; q < 8; ++q) am = fmaxf(am, fmaxf(fabsf(bflo(w[q])), fabsf(bfhi(w[q]))));
#pragma unroll
    for (int o = 1; o < 64; o <<= 1) am = fmaxf(am, __shfl_xor(am, o));
    const float sc = am > 0.f ? 127.f / am : 1.f;
    u32x4 o;
#pragma unroll
    for (int q = 0; q < 4; ++q) o[q] = pack_i8x4(bflo(w[2 * q]) * sc, bfhi(w[2 * q]) * sc, bflo(w[2 * q + 1]) * sc, bfhi(w[2 * q + 1]) * sc);
    *(u32x4*)(XQ + rc * 1024 + 16 * lane) = o;
    if (lane == 0) SX[rc] = am > 0.f ? am / 127.f : 1.f;
}

#define XB_TMO      128
#define XB_XCNT(j)  (256  + 64 * (j))
#define XB_XSUB(j)  (1280 + 64 * (j))
#define XB_XGEN(j)  (2304 + 64 * (j))
#define XB_TOP      3328
#define XB_TOPGEN   3392
#define XCD_BAR_WORDS 3456
#define XB_SPIN_CAP (1u << 18)

__device__ __forceinline__ unsigned xb_ld(unsigned* p)              { return __hip_atomic_load(p, __ATOMIC_RELAXED, __HIP_MEMORY_SCOPE_AGENT); }
__device__ __forceinline__ unsigned xb_add(unsigned* p, unsigned v) { return __hip_atomic_fetch_add(p, v, __ATOMIC_RELAXED, __HIP_MEMORY_SCOPE_AGENT); }
__device__ __forceinline__ unsigned xb_xcc_id() { return (unsigned)__builtin_amdgcn_s_getreg((3 << 11) | 20) & 0xFu; }
#define XB_SPIN(cond, bar) do { unsigned _sp = 0; while (cond) { __builtin_amdgcn_s_sleep(1); \
    if ((++_sp & 255u) == 0u) { if (xb_ld(&(bar)[XB_TMO])) break; if (_sp > XB_SPIN_CAP) { atomicAdd(&(bar)[XB_TMO], 1u); break; } } } } while (0)

struct XcdBarrier {
    unsigned* bar; unsigned x;
    volatile LAS unsigned* st;
};

__device__ __forceinline__ XcdBarrier xcd_barrier_post(unsigned* bar, volatile LAS unsigned* st) {
    XcdBarrier b; b.bar = bar; b.x = xb_xcc_id(); b.st = st;
    if (threadIdx.x == 0) (void)xb_add(&bar[XB_XCNT(b.x)], 1u);
    return b;
}
__device__ __forceinline__ void xcd_barrier_complete(unsigned* bar, unsigned x, unsigned& nloc, unsigned& nx) {
    const unsigned G = gridDim.x * gridDim.y * gridDim.z;
    unsigned sum, cnt, mine, sp = 0u;
    for (;;) {
        sum = 0u; cnt = 0u; mine = 0u;
#pragma unroll
        for (unsigned j = 0; j < 16; ++j) { const unsigned c = xb_ld(&bar[XB_XCNT(j)]); sum += c; cnt += (c > 0u) ? 1u : 0u; mine = (j == x) ? c : mine; }
        if (sum == G) break;
        __builtin_amdgcn_s_sleep(1);
        if ((++sp & 255u) == 0u) { if (xb_ld(&bar[XB_TMO])) break; if (sp > XB_SPIN_CAP) { atomicAdd(&bar[XB_TMO], 1u); break; } }
    }
    nloc = mine > 0u ? mine : 1u; nx = cnt > 0u ? cnt : 1u;
}

__device__ __forceinline__ void xcd_barrier(const XcdBarrier& b) {
    asm volatile("s_waitcnt vmcnt(0)" ::: "memory");
    __syncthreads();
    if (threadIdx.x == 0) {
        unsigned* bar = b.bar;
        __builtin_amdgcn_s_waitcnt(0);
        unsigned nloc = b.st[0], nx = b.st[1];
        if (nloc == 0u) { xcd_barrier_complete(bar, b.x, nloc, nx); b.st[0] = nloc; b.st[1] = nx; }
        const unsigned old = xb_add(&bar[XB_XSUB(b.x)], 1u);
        const unsigned gen = old / nloc;
        if (old + 1u == (gen + 1u) * nloc) {
            __builtin_amdgcn_fence(__ATOMIC_RELEASE, "agent");
            asm volatile("s_waitcnt vmcnt(0)" ::: "memory");
            const unsigned og = xb_add(&bar[XB_TOP], 1u);
            const unsigned tg = og / nx;
            if (og + 1u == (tg + 1u) * nx) xb_add(&bar[XB_TOPGEN], 1u);
            else XB_SPIN(xb_ld(&bar[XB_TOPGEN]) == tg, bar);
            __builtin_amdgcn_fence(__ATOMIC_ACQUIRE, "agent");
            xb_add(&bar[XB_XGEN(b.x)], 1u);
            asm volatile("s_waitcnt vmcnt(0)" ::: "memory");
        } else {
            XB_SPIN(xb_ld(&bar[XB_XGEN(b.x)]) == gen, bar);
            __builtin_amdgcn_fence(__ATOMIC_ACQUIRE, "agent");
            asm volatile("s_waitcnt vmcnt(0)" ::: "memory");
        }
    }
    __syncthreads();
}

constexpr int NPHASE = 9;
struct Args { const float* in[17]; float* out; unsigned char* ws; int ph_lo, ph_hi; };
__global__ void __launch_bounds__(512, 2) fwd_kernel(Args a) {
    extern __shared__ __attribute__((aligned(16))) unsigned char lds_raw[];
    LAS unsigned char* lds = (LAS unsigned char*)lds_raw;
    cg::grid_group grid = cg::this_grid();
    const int tid = threadIdx.x, lane = tid & 63, wave = __builtin_amdgcn_readfirstlane(tid >> 6);
    const int lo = a.ph_lo, hi = a.ph_hi, G = gridDim.x;
    typedef const __attribute__((address_space(4))) Args* kargp_t;
#define KARGS kargp_t kp_ = (kargp_t)__builtin_amdgcn_kernarg_segment_ptr(); asm volatile("" : "+s"(kp_)); unsigned char* const ws = kp_->ws
#define INP(k) ((const float*)kp_->in[k])
#define WSP(T, off) ((T*)(ws + (off)))
#ifdef ONLY_PHASE
#define IN(k) ((k) == ONLY_PHASE && lo <= (k) && (k) < hi)
#else
#define IN(k) (lo <= (k) && (k) < hi)
#endif
    volatile LAS unsigned* bar_st = (volatile LAS unsigned*)(lds + LDS_BYTES - 64);
    XcdBarrier xbar; xbar.bar = (unsigned*)(a.ws + WS_CTL); xbar.x = 0; xbar.st = bar_st;
    if (hi - lo > 1) { if (tid < 2) bar_st[tid] = 0u; __syncthreads(); xbar = xcd_barrier_post((unsigned*)(a.ws + WS_CTL), bar_st); }
    if (lo < 0) grid.sync();
#define SEAM(k) do { if (lo <= (k) && (k) + 1 < hi) xcd_barrier(xbar); } while (0)

    if (IN(0)) { KARGS; P0Args p{INP(0), INP(1), INP(2), INP(3), INP(8), INP(9), INP(10), INP(12), INP(13), WSP(bf16_t, WS_A1), WSP(bf16_t, WS_WIN), WSP(bf16_t, WS_WBH), WSP(bf16_t, WS_WBA), WSP(bf16_t, WS_WOUT), WSP(bf16_t, WS_WQ), WSP(bf16_t, WS_SK)}; p0_prologue(lds, p); SEAM(0); }
    if (IN(1)) {
        KARGS; bf16_t *A1 = WSP(bf16_t, WS_A1), *WinT = WSP(bf16_t, WS_WIN), *Zh = WSP(bf16_t, WS_ZH), *Za = WSP(bf16_t, WS_ZA), *Zg = WSP(bf16_t, WS_ZG), *Vt = WSP(bf16_t, WS_VT);
        pg8::Gemm g{A1, WinT, MA, 4864, 1024, 1024, 1024}; pg8::StaticOrder S; S.init(MA, 4864, G, (int)blockIdx.x);
        pg8::EpiZ E{Zh, Za, Zg, Vt, INP(4)};
        pg8::gemm_phase<pg8::EpiZ, pg8::StaticOrder, true, true>(lds, g, S, E);
        SEAM(1);
    }
    if (IN(2)) {
        KARGS; bf16_t *Zh = WSP(bf16_t, WS_ZH), *Za = WSP(bf16_t, WS_ZA), *Vt = WSP(bf16_t, WS_VT), *OM = WSP(bf16_t, WS_OM); float *Ub = WSP(float, WS_UB), *Dv = WSP(float, WS_DV); const float *lblog = INP(5), *sinks = INP(7);
        for (int it = blockIdx.x; it < 1024 + 512; it += G) {
            if (it < 1024) {
#ifndef NO_HGA
 hgrn_A(lds, Zh, lblog, Ub, Dv, it);
#endif
 }
            else { const int ai = it - 1024, b = ai >> 6, n = ((ai & 63) >> 1) + 1, kvh = ai & 1;
                attn_stage(lds, Za, Vt, b, n, kvh);
                __syncthreads();
#pragma unroll 1
                for (int si = wave; si < 16; si += 8) attn_sub(lds, Za, sinks, OM, b, n, kvh * 4 + (si >> 2), si & 3, lane);
                __syncthreads(); }
        }
        SEAM(2);
    }
    if (IN(3)) { KARGS; hgrn_scan(WSP(float, WS_UB), WSP(float, WS_DV)); SEAM(3); }
    if (IN(4)) { KARGS; for (int it = blockIdx.x; it < 1024; it += G) hgrn_C(lds, WSP(bf16_t, WS_ZH), INP(5), WSP(float, WS_UB), INP(6), WSP(bf16_t, WS_OM), it); SEAM(4); }
    if (IN(5)) {
        KARGS; bf16_t *OM = WSP(bf16_t, WS_OM), *WbhT = WSP(bf16_t, WS_WBH), *Mb = WSP(bf16_t, WS_MB), *Zg = WSP(bf16_t, WS_ZG); const float* bgate = INP(4);
        peer_tables(INP(14), INP(15), ws + WS_U8, WSP(float, WS_SUV), lane, blockIdx.x * 8 + wave, G * 8);
        __syncthreads();
        pg8::StaticOrder S; S.init(MC, 1024, G, (int)blockIdx.x);
        { pg8::Gemm g{OM, WbhT, MC, 1024, 1024, 1024, 1024}; pg8::EpiGate E{Mb, Zg, bgate}; pg8::gemm_phase<pg8::EpiGate, pg8::StaticOrder, true, true>(lds, g, S, E); }
        SEAM(5);
    }
    if (IN(6)) {
        KARGS; bf16_t *Mb = WSP(bf16_t, WS_MB), *WoutT = WSP(bf16_t, WS_WOUT), *A2 = WSP(bf16_t, WS_A2); float* rowssp = WSP(float, WS_RS); const float *x = INP(0), *gffn = INP(11);
        pg8::Gemm g{Mb, WoutT, MC, 1024, 1024, 1024, 1024}; pg8::StaticOrder S; S.init(MC, 1024, G, (int)blockIdx.x);
        pg8::EpiH1 E{x, WSP(bf16_t, WS_H1B), A2, gffn, rowssp};
        pg8::gemm_phase<pg8::EpiH1, pg8::StaticOrder, true, true>(lds, g, S, E);
        SEAM(6);
    }
    if (IN(7)) {
        KARGS; bf16_t *A2 = WSP(bf16_t, WS_A2), *WqT = WSP(bf16_t, WS_WQ), *Qb = WSP(bf16_t, WS_QB); float* rowssp = WSP(float, WS_RS);
        pg8::Gemm g{A2, WqT, MC, 2048, 1024, 1024, 1024}; pg8::StaticOrder S; S.init(MC, 2048, G, (int)blockIdx.x);
        pg8::EpiQ E{Qb, rowssp};
        pg8::gemm_phase<pg8::EpiQ, pg8::StaticOrder, true, true>(lds, g, S, E);
        SEAM(7);
    }
    if (IN(8)) {
        KARGS; bf16_t *Qb = WSP(bf16_t, WS_QB), *SK = WSP(bf16_t, WS_SK), *A2 = WSP(bf16_t, WS_A2); unsigned char *U8 = ws + WS_U8, *V8 = ws + WS_V8, *XQ = ws + WS_MB; float *suv = WSP(float, WS_SUV), *rowssp = WSP(float, WS_RS), *outp = kp_->out; bf16_t* H1B = WSP(bf16_t, WS_H1B); const float* gfin = INP(16);
        for (int grp = blockIdx.x; grp < MC / 128; grp += G) {
            const int rc0 = grp * 128;
#ifndef NO_TOPK
            peer_topk(lds, Qb, SK, rc0 + 32 * (wave >> 1), 32 * (wave >> 1), 4 * (wave & 1), lane);
#endif
#ifdef PROBE_TOPK2
            __syncthreads(); peer_topk(lds, Qb, SK, rc0 + 32 * (wave >> 1), 32 * (wave >> 1), 4 * (wave & 1), lane);
#endif
            __syncthreads();
            { const int tl0 = 16 * wave; const size_t rcw = (size_t)rc0 + tl0;
              { LAS f32x4* pz = (LAS f32x4*)(lds + PL_PA + tl0 * 512);
#pragma unroll
                for (int q = 0; q < 8; ++q) pz[lane + 64 * q] = (f32x4){0.f, 0.f, 0.f, 0.f}; }
#pragma unroll 1
              for (int i = 0; i < 16; ++i) peer_xq_token(A2, XQ, (float*)(XQ + (size_t)MC * 1024), rcw + i, lane);
              asm volatile("s_waitcnt vmcnt(0)" ::: "memory");
              { u32x4 ra[16], rb[16], xa[2], xb[2];
                peer_rows_load<true>(ra, xa, lds, tl0, rcw, 0, U8, (const bf16_t*)XQ, lane);
#pragma unroll 1
                for (int st = 0; st < 128; st += 2) {
                    peer_rows_load<true>(rb, xb, lds, tl0 + ((st + 1) & 15), rcw + ((st + 1) & 15), (st + 1) >> 4, U8, (const bf16_t*)XQ, lane);
                    __builtin_amdgcn_sched_barrier(0);
                    peer_u_math(ra, xa, lds, tl0 + (st & 15), lane);
                    { const int sn = st + 2 < 128 ? st + 2 : 127; peer_rows_load<true>(ra, xa, lds, tl0 + (sn & 15), rcw + (sn & 15), sn >> 4, U8, (const bf16_t*)XQ, lane); }
                    __builtin_amdgcn_sched_barrier(0);
                    peer_u_math(rb, xb, lds, tl0 + ((st + 1) & 15), lane); } }
#pragma unroll 1
              for (int i = 0; i < 16; ++i) peer_a_step(lds, tl0 + i, rcw + i, rowssp, suv, suv + 16384, lane);
              { u32x4 ra[16], rb[16], xd[2];
                peer_rows_load<false>(ra, xd, lds, tl0, rcw, 0, V8, A2, lane);
#pragma unroll 1
                for (int st = 0; st < 128; st += 2) {
                    peer_rows_load<false>(rb, xd, lds, tl0 + ((st + 1) & 15), rcw, (st + 1) >> 4, V8, A2, lane);
                    __builtin_amdgcn_sched_barrier(0);
                    peer_v_math(ra, lds, tl0 + (st & 15), rcw + (st & 15), st >> 4, H1B, lane);
                    { const int sn = st + 2 < 128 ? st + 2 : 127; peer_rows_load<false>(ra, xd, lds, tl0 + (sn & 15), rcw, sn >> 4, V8, A2, lane); }
                    __builtin_amdgcn_sched_barrier(0);
                    peer_v_math(rb, lds, tl0 + ((st + 1) & 15), rcw + ((st + 1) & 15), (st + 1) >> 4, H1B, lane); } }
              asm volatile("s_waitcnt vmcnt(0)" ::: "memory");
              __builtin_amdgcn_fence(__ATOMIC_ACQUIRE, "agent");
#pragma unroll 1
              for (int i = 0; i < 16; ++i) peer_f_step(lds, tl0 + i, rcw + i, H1B, outp, gfin, lane); }
            __syncthreads();
        }
    }
#undef IN
#undef SEAM
}

extern "C" void kernel_launch(void* const* d_in, const int* in_sizes, int n_in, void* d_out, int out_size, void* d_ws, size_t ws_size, hipStream_t stream) {
    static int grid = 0;
    if (grid == 0) {
        if (n_in != 17 || out_size != MC * DM || ws_size < WS_END) { fprintf(stderr, "kernel_launch: unexpected shapes: n_in %d out %d ws %zu (need %zu)\n", n_in, out_size, ws_size, (size_t)WS_END); grid = -1; return; }
        int dev = 0, cus = 0, per_cu = 0;
        if (hipGetDevice(&dev) != hipSuccess || hipDeviceGetAttribute(&cus, hipDeviceAttributeMultiprocessorCount, dev) != hipSuccess) { fprintf(stderr, "kernel_launch: device query failed\n"); grid = -1; return; }
        if (hipFuncSetAttribute((const void*)fwd_kernel, hipFuncAttributeMaxDynamicSharedMemorySize, LDS_BYTES) != hipSuccess) { fprintf(stderr, "kernel_launch: hipFuncSetAttribute failed\n"); grid = -1; return; }
        if (hipOccupancyMaxActiveBlocksPerMultiprocessor(&per_cu, (const void*)fwd_kernel, 512, LDS_BYTES) != hipSuccess || per_cu < 1) { fprintf(stderr, "kernel_launch: occupancy query says %d blocks per CU\n", per_cu); per_cu = 1; }
        (void)hipGetLastError();
        grid = cus;
        fprintf(stderr, "kernel_launch: grid %d (occupancy %d per CU)\n", grid, per_cu);
    }
    if (grid < 0) return;
    if (hipMemsetAsync((char*)d_ws + WS_CTL, 0, CTL_BYTES, stream) != hipSuccess) { fprintf(stderr, "kernel_launch: memset of the barrier words failed\n"); return; }
    Args a{};
    for (int i = 0; i < 17; ++i) a.in[i] = (const float*)d_in[i];
    a.out = (float*)d_out; a.ws = (unsigned char*)d_ws;
#if MK_ONE_LAUNCH
    a.ph_lo = 0; a.ph_hi = NPHASE;
    void* args[] = {&a};
    hipError_t e = hipLaunchCooperativeKernel((const void*)fwd_kernel, dim3(grid), dim3(512), args, LDS_BYTES, stream);
    if (e != hipSuccess) fprintf(stderr, "kernel_launch: cooperative launch failed: %s (grid %d)\n", hipGetErrorString(e), grid);
#else
#ifdef PROBE_SEQ
    const int seq[] = PROBE_SEQ;
    for (int p : seq) { a.ph_lo = p; a.ph_hi = p + 1; hipLaunchKernelGGL(fwd_kernel, dim3(grid), dim3(512), LDS_BYTES, stream, a); }
#else
    for (int p = 0; p < NPHASE; ++p) { a.ph_lo = p; a.ph_hi = p + 1; hipLaunchKernelGGL(fwd_kernel, dim3(grid), dim3(512), LDS_BYTES, stream, a); }
#endif
#endif
}
```

```cpp
#include <hip/hip_runtime.h>
#include <hip/hip_cooperative_groups.h>
#include <cstdio>
#include <cstdint>
namespace cg = cooperative_groups;

#ifndef MK_ONE_LAUNCH
#define MK_ONE_LAUNCH 1
#endif

constexpr int DM = 1024, NB = 8, SEQ = 4096, NMETA = 16, LTOK = SEQ + NMETA;
constexpr int MA_REAL = NB * LTOK;
constexpr int MA = 33024;
constexpr int MC = NB * SEQ;
constexpr int LPAD = 4224;
constexpr float EPS = 1e-6f;

namespace pg8 {
#define PG8_LAS __attribute__((address_space(3)))
typedef unsigned short bf16_t;
typedef short bf16x8 __attribute__((ext_vector_type(8)));
typedef float f32x4 __attribute__((ext_vector_type(4)));
typedef unsigned u32x4 __attribute__((ext_vector_type(4)));
constexpr int BM = 256, BK = 64, HALF = 128, HTB = HALF * BK * 2  , STAGE_BYTES = 8 * HTB, NXCD = 8, WGM = 8;

__host__ __device__ __forceinline__ int lds_byte(int r, int c) { const int st = (r >> 4) * 2 + (c >> 5), rr = r & 15, cc = c & 31, ob = rr * 64 + cc * 2; return st * 1024 + (ob ^ (((ob >> 9) & 1) << 5)); }
__host__ __device__ __forceinline__ void stage_rc(int b, int& R, int& C) { const int st = b / 1024, sb = b % 1024, swz = sb ^ (((sb >> 9) & 1) << 5); R = (st >> 1) * 16 + swz / 64; C = (st & 1) * 32 + (swz % 64) / 2; }
__host__ __device__ __forceinline__ int perm32(int rho) { const int n = rho >> 4, i = rho & 15; return 8 * (i >> 2) + 4 * n + (i & 3); }

struct Unit { int pm, pn; };
struct Gemm { const bf16_t* A; const bf16_t* Bt; int M, N, K, lda, ldb; };

struct StaticOrder {
    int nM, nN, nwg, G, c;
    __host__ __device__ void init(int M, int N, int G_, int c_) { nM = M / BM; nN = N / BM; nwg = nM * nN; G = G_; c = c_; }
    __host__ __device__ bool next(int i, Unit& u) const {
        const long L = (long)i * G + c; if (L >= nwg) return false;
        int wgid = (int)L; { const int q = nwg / NXCD, r = nwg % NXCD, xcd = wgid % NXCD, off = wgid / NXCD; wgid = (xcd < r ? xcd * (q + 1) : r * (q + 1) + (xcd - r) * q) + off; }
        const int nig = WGM * nN, gid = wgid / nig, fm = gid * WGM, gsz = (nM - fm) < WGM ? (nM - fm) : WGM;
        u.pm = fm + ((wgid % nig) % gsz); u.pn = (wgid % nig) / gsz; return true;
    }
    __device__ __forceinline__ void a_ready(const Unit&) const {}
    __device__ __forceinline__ void done(const Unit&) const {}
};

__device__ __forceinline__ unsigned cvt_pk_bf16(float lo, float hi) { unsigned r; asm volatile("v_cvt_pk_bf16_f32 %0, %1, %2" : "=v"(r) : "v"(lo), "v"(hi)); return r; }
typedef float f32x2 __attribute__((ext_vector_type(2)));
typedef float f32x2_t __attribute__((ext_vector_type(2))); typedef __bf16 bf16x2_t __attribute__((ext_vector_type(2)));
typedef unsigned u32x2 __attribute__((ext_vector_type(2)));
__device__ __forceinline__ unsigned cvtpk(float lo, float hi) { f32x2_t v = {lo, hi}; bf16x2_t b = __builtin_convertvector(v, bf16x2_t); return __builtin_bit_cast(unsigned, b); }
__device__ __forceinline__ bf16_t f2bf(float x) { return (bf16_t)(cvtpk(x, 0.f) & 0xffffu); }
__device__ __forceinline__ float bf2f(bf16_t v) { return __uint_as_float((unsigned)v << 16); }
__device__ __forceinline__ float bflo(unsigned w) { return __uint_as_float(w << 16); }
__device__ __forceinline__ float bfhi(unsigned w) { return __uint_as_float(w & 0xffff0000u); }
__device__ __forceinline__ float sigm(float x) { return __builtin_amdgcn_rcpf(1.f + __expf(-x)); }

struct EpiZ {
    static constexpr bool PERM = true, AFTER_DRAIN = false, MIDK = false;
    bf16_t *Zh, *Za, *Zg, *Vt; const float* bgate;
    __device__ __forceinline__ void operator()(const f32x4 (&acc)[2][2][4][2], const Unit& u, int wr, int wc, int fr, int fq) const {
        const int pn = u.pn; bf16_t* base; int ldc, colt;
        if (pn < 8) { base = Zh; ldc = 2048; colt = pn * 256; } else if (pn < 11) { base = Za; ldc = 768; colt = (pn - 8) * 256; } else { base = Zg; ldc = 2048; colt = (pn - 11) * 256; }
        const int row0 = u.pm * BM + wr * 64 + fr, col0 = colt + wc * 32 + 8 * fq;
#pragma unroll
        for (int ai = 0; ai < 2; ++ai)
#pragma unroll
            for (int m = 0; m < 4; ++m) { const int row = row0 + ai * HALF + m * 16; bf16_t* rowp = base + (size_t)row * ldc + col0;
#pragma unroll
                for (int bj = 0; bj < 2; ++bj) { f32x4 v0 = acc[ai][bj][m][0], v1 = acc[ai][bj][m][1];
                    if (pn >= 11) { const f32x4 b0 = *(const f32x4*)(bgate + col0 + bj * HALF), b1 = *(const f32x4*)(bgate + col0 + bj * HALF + 4);
#pragma unroll
                        for (int i = 0; i < 4; ++i) { v0[i] = sigm(v0[i] + b0[i]); v1[i] = sigm(v1[i] + b1[i]); } }
                    if (pn == 10 && bj == 1) {
                        if (row < MA_REAL) { const int b = row / LTOK, pos = row - b * LTOK; bf16_t* vp = Vt + ((size_t)(b * 128 + wc * 32 + 8 * fq) * LPAD + 112 + pos);
                            vp[0] = f2bf(v0[0]); vp[LPAD] = f2bf(v0[1]); vp[2 * LPAD] = f2bf(v0[2]); vp[3 * LPAD] = f2bf(v0[3]);
                            vp[4 * LPAD] = f2bf(v1[0]); vp[5 * LPAD] = f2bf(v1[1]); vp[6 * LPAD] = f2bf(v1[2]); vp[7 * LPAD] = f2bf(v1[3]); }
                    } else { u32x4 w; w.x = cvtpk(v0[0], v0[1]); w.y = cvtpk(v0[2], v0[3]); w.z = cvtpk(v1[0], v1[1]); w.w = cvtpk(v1[2], v1[3]); *(u32x4*)(rowp + bj * HALF) = w; } } }
    }
};
struct EpiGate {
    static constexpr bool PERM = true, AFTER_DRAIN = false, MIDK = true;
    bf16_t* Mb; const bf16_t* Zg; const float* bgate;
    __device__ __forceinline__ void mid(f32x4 (&acc)[2][2][4][2], const Unit& u, int wr, int wc, int fr, int fq) const {
        const int row0 = u.pm * BM + wr * 64 + fr, col0 = u.pn * BM + wc * 32 + 8 * fq;
#pragma unroll
        for (int bj = 0; bj < 2; ++bj)
#pragma unroll
            for (int ai = 0; ai < 2; ++ai)
#pragma unroll
                for (int m = 0; m < 4; ++m) { const int rc = row0 + ai * HALF + m * 16, ra = (rc >> 12) * LTOK + NMETA + (rc & 4095);
                    const bf16_t* zp = Zg + (size_t)ra * 2048 + col0 + bj * HALF; const u32x4 za = *(const u32x4*)zp, zb = *(const u32x4*)(zp + 1024);
                    f32x4& v0 = acc[ai][bj][m][0]; f32x4& v1 = acc[ai][bj][m][1];
                    v0[0] *= bflo(za.x) * __builtin_amdgcn_rcpf(bflo(zb.x)); v0[1] *= bfhi(za.x) * __builtin_amdgcn_rcpf(bfhi(zb.x)); v0[2] *= bflo(za.y) * __builtin_amdgcn_rcpf(bflo(zb.y)); v0[3] *= bfhi(za.y) * __builtin_amdgcn_rcpf(bfhi(zb.y));
                    v1[0] *= bflo(za.z) * __builtin_amdgcn_rcpf(bflo(zb.z)); v1[1] *= bfhi(za.z) * __builtin_amdgcn_rcpf(bfhi(zb.z)); v1[2] *= bflo(za.w) * __builtin_amdgcn_rcpf(bflo(zb.w)); v1[3] *= bfhi(za.w) * __builtin_amdgcn_rcpf(bfhi(zb.w));
                    asm volatile("" ::: "memory"); }
    }
    __device__ __forceinline__ void operator()(const f32x4 (&acc)[2][2][4][2], const Unit& u, int wr, int wc, int fr, int fq) const {
        const int row0 = u.pm * BM + wr * 64 + fr, col0 = u.pn * BM + wc * 32 + 8 * fq;
#pragma unroll
        for (int ai = 0; ai < 2; ++ai)
#pragma unroll
            for (int m = 0; m < 4; ++m) { const int rc = row0 + ai * HALF + m * 16, ra = (rc >> 12) * LTOK + NMETA + (rc & 4095);
                const bf16_t* zp = Zg + (size_t)ra * 2048 + 1024 + col0; bf16_t* mp = Mb + (size_t)rc * 1024 + col0;
#pragma unroll
                for (int bj = 0; bj < 2; ++bj) { const u32x4 z = *(const u32x4*)(zp + bj * HALF); f32x4 v0 = acc[ai][bj][m][0], v1 = acc[ai][bj][m][1];
                    v0[0] *= bflo(z.x); v0[1] *= bfhi(z.x); v0[2] *= bflo(z.y); v0[3] *= bfhi(z.y); v1[0] *= bflo(z.z); v1[1] *= bfhi(z.z); v1[2] *= bflo(z.w); v1[3] *= bfhi(z.w);
                    u32x4 w; w.x = cvtpk(v0[0], v0[1]); w.y = cvtpk(v0[2], v0[3]); w.z = cvtpk(v1[0], v1[1]); w.w = cvtpk(v1[2], v1[3]); *(u32x4*)(mp + bj * HALF) = w; } }
    }
};
struct EpiH1 {
    static constexpr bool PERM = false, AFTER_DRAIN = false, MIDK = false;
    const float* x; bf16_t* h1; bf16_t* A2; const float* gffn; float* rowssp;
    __device__ __forceinline__ void operator()(const f32x4 (&acc)[2][2][4][2], const Unit& u, int wr, int wc, int fr, int fq) const {
        const int row0 = u.pm * BM + wr * 64 + fr, col0 = u.pn * BM + wc * 32 + 4 * fq;
        f32x4 gv[2][2];
#pragma unroll
        for (int bj = 0; bj < 2; ++bj)
#pragma unroll
            for (int n = 0; n < 2; ++n) gv[bj][n] = *(const f32x4*)(gffn + col0 + bj * HALF + n * 16);
#pragma unroll
        for (int ai = 0; ai < 2; ++ai)
#pragma unroll
            for (int m = 0; m < 4; ++m) { const int rc = row0 + ai * HALF + m * 16; float ss = 0.f;
#pragma unroll
                for (int bj = 0; bj < 2; ++bj)
#pragma unroll
                    for (int n = 0; n < 2; ++n) { const size_t off = (size_t)rc * 1024 + col0 + bj * HALF + n * 16;
                        const f32x4 h = *(const f32x4*)(x + off) + acc[ai][bj][m][n]; { u32x2 hw; hw.x = cvtpk(h[0], h[1]); hw.y = cvtpk(h[2], h[3]); *(u32x2*)(h1 + off) = hw; }
                        ss += (h[0] * h[0] + h[1] * h[1]) + (h[2] * h[2] + h[3] * h[3]);
                        const f32x4 y = h * gv[bj][n]; u32x2 w; w.x = cvtpk(y[0], y[1]); w.y = cvtpk(y[2], y[3]); *(u32x2*)(A2 + off) = w; }
                ss += __shfl_xor(ss, 16); ss += __shfl_xor(ss, 32);
                if (fq == 0) rowssp[(size_t)rc * 16 + u.pn * 4 + wc] = ss; }
    }
};
struct EpiQ {
    static constexpr bool PERM = true, AFTER_DRAIN = false, MIDK = false;
    bf16_t* Q; const float* rowssp;
    __device__ __forceinline__ void operator()(const f32x4 (&acc)[2][2][4][2], const Unit& u, int wr, int wc, int fr, int fq) const {
        const int row0 = u.pm * BM + wr * 64 + fr, col0 = u.pn * BM + wc * 32 + 8 * fq;
#pragma unroll
        for (int ai = 0; ai < 2; ++ai)
#pragma unroll
            for (int m = 0; m < 4; ++m) { const int rc = row0 + ai * HALF + m * 16;
                const f32x4* rp = (const f32x4*)(rowssp + (size_t)rc * 16); const f32x4 s4 = (rp[0] + rp[1]) + (rp[2] + rp[3]);
                const float rstd = __builtin_amdgcn_rsqf(((s4[0] + s4[1]) + (s4[2] + s4[3])) * (1.0f / 1024.0f) + 1e-6f);
#pragma unroll
                for (int bj = 0; bj < 2; ++bj) { const f32x4 v0 = acc[ai][bj][m][0] * rstd, v1 = acc[ai][bj][m][1] * rstd;
                    u32x4 w; w.x = cvtpk(v0[0], v0[1]); w.y = cvtpk(v0[2], v0[3]); w.z = cvtpk(v1[0], v1[1]); w.w = cvtpk(v1[2], v1[3]); const int col = col0 + bj * HALF;
                    *(u32x4*)(Q + ((size_t)((((rc >> 5) * 8 + (col >> 8)) * 2 + ((col >> 7) & 1)) * 8 + ((col & 127) >> 4)) * 64 + ((col >> 3) & 1) * 32 + (rc & 31)) * 8) = w; } }
    }
};
template <class Epi, class Sched, bool ALIGN_EPI = false, bool SP2 = false>
__device__ __forceinline__ void gemm_phase(PG8_LAS unsigned char* lds, const Gemm g, const Sched& S, const Epi& E) {
    const int tid = threadIdx.x, wid = __builtin_amdgcn_readfirstlane(tid >> 6), lane = tid & 63, wr = wid >> 2, wc = wid & 3, fr = lane & 15, fq = lane >> 4;
    const int K = g.K, nt = K / BK;
    unsigned voffA[2], voffB[2];
#pragma unroll
    for (int i = 0; i < 2; ++i) { int R, C; stage_rc(tid * 16 + i * 8192, R, C); const int Rb = Epi::PERM ? ((R & ~31) + perm32(R & 31)) : R;
        voffA[i] = (unsigned)(R * g.lda + C) * 2u; voffB[i] = (unsigned)(Rb * g.ldb + C) * 2u; }
    const size_t kstep = (size_t)(BK * 2);
    const size_t hstepA = (size_t)HALF * g.lda * 2, hstepB = (size_t)HALF * g.ldb * 2;
    const size_t tstepA = 2 * hstepA, tstepB = 2 * hstepB;
    const unsigned ldsw = (unsigned)wid * 1024u;
    const int aoff = lds_byte(wr * 64 + fr, fq * 8), boff = lds_byte(wc * 32 + fr, fq * 8);
#define PG8_SA(b, h) (((b) * 2 + (h)) * HTB)
#define PG8_SB(b, h) ((4 + (b) * 2 + (h)) * HTB)
#define PG8_STAGE(bufoff, gbase, voff) do { _Pragma("unroll") for (int _i = 0; _i < 2; ++_i) \
        __builtin_amdgcn_global_load_lds((const unsigned*)((const char*)(gbase) + (voff)[_i]), (PG8_LAS unsigned*)(lds + (bufoff) + ldsw + _i * 8192), 16, 0, 0); } while (0)
#define PG8_LDA(dst, b, h) do { _Pragma("unroll") for (int m = 0; m < 4; ++m) _Pragma("unroll") for (int k = 0; k < 2; ++k) dst[m][k] = *(const PG8_LAS bf16x8*)(lds + PG8_SA(b, h) + aoff + m * 2048 + k * 1024); } while (0)
#define PG8_LDB(dst, b, h) do { _Pragma("unroll") for (int n = 0; n < 2; ++n) _Pragma("unroll") for (int k = 0; k < 2; ++k) dst[n][k] = *(const PG8_LAS bf16x8*)(lds + PG8_SB(b, h) + boff + n * 2048 + k * 1024); } while (0)
#define PG8_MMA(ai, bj, At, Bt) do { __builtin_amdgcn_s_setprio(1); _Pragma("unroll") for (int m = 0; m < 4; ++m) _Pragma("unroll") for (int n = 0; n < 2; ++n) _Pragma("unroll") for (int k = 0; k < 2; ++k) \
        acc[ai][bj][m][n] = __builtin_amdgcn_mfma_f32_16x16x32_bf16(Bt[n][k], At[m][k], acc[ai][bj][m][n], 0, 0, 0); __builtin_amdgcn_s_setprio(0); } while (0)
#define PG8_WAIT_V(n) asm volatile("s_waitcnt vmcnt(" #n ")" ::: "memory")
#define PG8_WAIT_L(n) asm volatile("s_waitcnt lgkmcnt(" #n ")" ::: "memory")
#define PG8_BAR __builtin_amdgcn_s_barrier()
#define PG8_SCHED __builtin_amdgcn_sched_barrier(0)
    Unit cur, nxt; int ui = 0;
    if (!S.next(0, cur)) return;
    f32x4 acc[2][2][4][2];
#pragma unroll
    for (int a = 0; a < 2; ++a)
#pragma unroll
        for (int b = 0; b < 2; ++b)
#pragma unroll
            for (int m = 0; m < 4; ++m)
#pragma unroll
                for (int n = 0; n < 2; ++n) acc[a][b][m][n] = (f32x4){0.f, 0.f, 0.f, 0.f};
    bf16x8 At[4][2], B0[2][2], B1[2][2];
    const char* cA = (const char*)g.A + (size_t)cur.pm * tstepA; const char* cB = (const char*)g.Bt + (size_t)cur.pn * tstepB;
    S.a_ready(cur);
    if constexpr (SP2) {
        PG8_STAGE(PG8_SB(0, 0), cB, voffB); PG8_STAGE(PG8_SB(0, 1), cB + hstepB, voffB); PG8_STAGE(PG8_SA(0, 0), cA, voffA); PG8_STAGE(PG8_SA(0, 1), cA + hstepA, voffA);
        if (wr == 1) PG8_BAR;
        PG8_WAIT_V(2); PG8_BAR;
        PG8_STAGE(PG8_SB(1, 0), cB + kstep, voffB); PG8_STAGE(PG8_SA(1, 0), cA + kstep, voffA); PG8_STAGE(PG8_SB(1, 1), cB + hstepB + kstep, voffB);
        PG8_WAIT_V(6); PG8_BAR;
    } else {
        PG8_STAGE(PG8_SB(0, 0), cB, voffB); PG8_STAGE(PG8_SA(0, 0), cA, voffA); PG8_STAGE(PG8_SB(0, 1), cB + hstepB, voffB); PG8_STAGE(PG8_SA(0, 1), cA + hstepA, voffA);
        if (wr == 1) PG8_BAR;
        PG8_WAIT_V(4); PG8_BAR;
        PG8_STAGE(PG8_SB(1, 0), cB + kstep, voffB); PG8_STAGE(PG8_SA(1, 0), cA + kstep, voffA); PG8_STAGE(PG8_SB(1, 1), cB + hstepB + kstep, voffB);
        PG8_WAIT_V(6); PG8_BAR;
    }
    for (;;) {
        const bool has_next = S.next(ui + 1, nxt);
        const char* nA = has_next ? (const char*)g.A + (size_t)nxt.pm * tstepA : cA; const char* nB = has_next ? (const char*)g.Bt + (size_t)nxt.pn * tstepB : cB;
        for (int t = 0; t < nt; t += 2) {
            if constexpr (Epi::MIDK) { if (t == (nt >> 1)) { PG8_SCHED; E.mid(acc, cur, wr, wc, fr, fq); PG8_SCHED; } }
            const bool last = (t == nt - 2);
            const char* a1 = cA + (size_t)(t + 1) * kstep;
            const char* a2 = last ? nA : cA + (size_t)(t + 2) * kstep; const char* b2 = last ? nB : cB + (size_t)(t + 2) * kstep;
            const char* a3 = a2 + kstep; const char* b3 = b2 + kstep;
            if (last && has_next) S.a_ready(nxt);
            if constexpr (SP2) {
            PG8_LDB(B0, 0, 0); PG8_LDB(B1, 0, 1); PG8_SCHED; PG8_LDA(At, 0, 0); PG8_STAGE(PG8_SA(1, 1), a1 + hstepA, voffA);
            PG8_WAIT_V(8); PG8_WAIT_L(0); PG8_BAR; PG8_MMA(0, 0, At, B0); PG8_MMA(0, 1, At, B1); PG8_BAR; PG8_SCHED;
            PG8_LDA(At, 0, 1); PG8_STAGE(PG8_SB(0, 0), b2, voffB); PG8_STAGE(PG8_SB(0, 1), b2 + hstepB, voffB); PG8_STAGE(PG8_SA(0, 0), a2, voffA);
            PG8_WAIT_V(8); PG8_WAIT_L(0); PG8_BAR; PG8_MMA(1, 0, At, B0); PG8_MMA(1, 1, At, B1); PG8_BAR; PG8_SCHED;
            PG8_LDB(B0, 1, 0); PG8_LDB(B1, 1, 1); PG8_SCHED; PG8_LDA(At, 1, 0); PG8_STAGE(PG8_SA(0, 1), a2 + hstepA, voffA);
            PG8_WAIT_V(8); PG8_WAIT_L(0); PG8_BAR; PG8_MMA(0, 0, At, B0); PG8_MMA(0, 1, At, B1); PG8_BAR; PG8_SCHED;
            PG8_LDA(At, 1, 1); PG8_STAGE(PG8_SB(1, 0), b3, voffB); PG8_STAGE(PG8_SB(1, 1), b3 + hstepB, voffB); PG8_STAGE(PG8_SA(1, 0), a3, voffA);
            PG8_WAIT_V(8); PG8_WAIT_L(0); PG8_BAR; PG8_MMA(1, 0, At, B0); PG8_MMA(1, 1, At, B1); PG8_BAR; PG8_SCHED;
            } else {
            PG8_LDB(B0, 0, 0); PG8_SCHED; PG8_LDA(At, 0, 0); PG8_STAGE(PG8_SA(1, 1), a1 + hstepA, voffA);
            PG8_WAIT_L(8); PG8_BAR; PG8_WAIT_L(0); PG8_MMA(0, 0, At, B0); PG8_BAR; PG8_SCHED;
            PG8_LDB(B1, 0, 1); PG8_STAGE(PG8_SB(0, 0), b2, voffB);
            PG8_BAR; PG8_WAIT_L(0); PG8_MMA(0, 1, At, B1); PG8_BAR;
            PG8_LDA(At, 0, 1); PG8_STAGE(PG8_SA(0, 0), a2, voffA);
            PG8_BAR; PG8_WAIT_L(0); PG8_MMA(1, 0, At, B0); PG8_BAR; PG8_SCHED;
            PG8_STAGE(PG8_SB(0, 1), b2 + hstepB, voffB);
            PG8_WAIT_V(6); PG8_BAR; PG8_MMA(1, 1, At, B1); PG8_BAR;
            PG8_LDB(B0, 1, 0); PG8_SCHED; PG8_LDA(At, 1, 0); PG8_STAGE(PG8_SA(0, 1), a2 + hstepA, voffA);
            PG8_WAIT_L(8); PG8_BAR; PG8_WAIT_L(0); PG8_MMA(0, 0, At, B0); PG8_BAR; PG8_SCHED;
            PG8_LDB(B1, 1, 1); PG8_STAGE(PG8_SB(1, 0), b3, voffB);
            PG8_BAR; PG8_WAIT_L(0); PG8_MMA(0, 1, At, B1); PG8_BAR;
            PG8_LDA(At, 1, 1); PG8_STAGE(PG8_SA(1, 0), a3, voffA);
            PG8_BAR; PG8_WAIT_L(0); PG8_MMA(1, 0, At, B0); PG8_BAR; PG8_SCHED;
            PG8_STAGE(PG8_SB(1, 1), b3 + hstepB, voffB);
            PG8_WAIT_V(6); PG8_BAR; PG8_MMA(1, 1, At, B1); PG8_BAR;
            }
        }
        if constexpr (ALIGN_EPI) { if (wr == 0) PG8_BAR; }
        if constexpr (!Epi::AFTER_DRAIN) { E(acc, cur, wr, wc, fr, fq); S.done(cur); }
        if (!has_next) break;
#pragma unroll
        for (int a = 0; a < 2; ++a)
#pragma unroll
            for (int b = 0; b < 2; ++b)
#pragma unroll
                for (int m = 0; m < 4; ++m)
#pragma unroll
                    for (int n = 0; n < 2; ++n) acc[a][b][m][n] = (f32x4){0.f, 0.f, 0.f, 0.f};
        cur = nxt; cA = nA; cB = nB; ++ui;
        if constexpr (ALIGN_EPI) { if (wr == 1) PG8_BAR; }
    }
    PG8_WAIT_V(0);
    if constexpr (!ALIGN_EPI) { if (wr == 0) PG8_BAR; }
    PG8_BAR;
    if constexpr (Epi::AFTER_DRAIN) { E.fused(acc, cur, wr, wc, fr, fq, lds, wid, lane); S.done(cur); }
#undef PG8_SA
#undef PG8_SB
#undef PG8_STAGE
#undef PG8_LDA
#undef PG8_LDB
#undef PG8_MMA
#undef PG8_WAIT_V
#undef PG8_WAIT_L
#undef PG8_BAR
#undef PG8_SCHED
}
}
using pg8::bf16_t; using pg8::bf16x8; using pg8::f32x4; using pg8::u32x4; using pg8::u32x2; using pg8::cvtpk; using pg8::f2bf; using pg8::bf2f; using pg8::bflo; using pg8::bfhi; using pg8::sigm;
#define LAS __attribute__((address_space(3)))
typedef float f32x16 __attribute__((ext_vector_type(16)));
#define MFMA32(a, b, c) __builtin_amdgcn_mfma_f32_32x32x16_bf16((a), (b), (c), 0, 0, 0)

constexpr size_t MiB = 1u << 20;
constexpr size_t WS_ZH = 0;
constexpr size_t WS_H1B = 372 * MiB;
constexpr size_t WS_MB = WS_ZH, WS_U8 = WS_ZH + 64 * MiB, WS_V8 = WS_ZH + 80 * MiB, WS_SUV = WS_ZH + 96 * MiB;
constexpr size_t WS_ZA = 129 * MiB;
constexpr size_t WS_ZG = 178 * MiB;
constexpr size_t WS_QB = WS_ZG;
constexpr size_t WS_A1 = 307 * MiB;
constexpr size_t WS_OM = WS_A1, WS_A2 = WS_A1;
constexpr size_t WS_UB = 372 * MiB;
constexpr size_t WS_DV = 436 * MiB;
constexpr size_t WS_VT = 437 * MiB;
constexpr size_t WS_WIN = 446 * MiB;
constexpr size_t WS_WBH = 456 * MiB, WS_WBA = 457 * MiB, WS_WOUT = 458 * MiB, WS_WQ = 460 * MiB, WS_SK = 464 * MiB;
constexpr size_t WS_RS = 465 * MiB;
constexpr size_t WS_CTL = 467 * MiB, CTL_BYTES = 16384;
constexpr size_t WS_END = 468 * MiB;
constexpr int LDS_BYTES = 151552;

__device__ __forceinline__ float wave_sum(float v) {
#pragma unroll
    for (int o = 1; o < 64; o <<= 1) v += __shfl_xor(v, o);
    return v;
}
__device__ __forceinline__ void p0_transpose_item(const float* __restrict__ W, int K, int N, bf16_t* __restrict__ WT, LAS float* scr, int item, int lane, int ldw = 0) {
    if (ldw == 0) ldw = K;
    const int nblk = N / 32, kb = item / nblk, nb = item % nblk, k0 = 64 * kb, n0 = 32 * nb;
#pragma unroll 8
    for (int i = 0; i < 32; ++i) { const int kk = 2 * i + (lane >> 5); scr[kk * 33 + (lane & 31)] = W[(size_t)(k0 + kk) * N + n0 + (lane & 31)]; }
    asm volatile("s_waitcnt lgkmcnt(0)" ::: "memory");
    const int c = lane & 7;
#pragma unroll
    for (int j = 0; j < 4; ++j) { const int n = (lane >> 3) + 8 * j; const LAS float* s = scr + (8 * c) * 33 + n;
        u32x4 o; o.x = cvtpk(s[0 * 33], s[1 * 33]); o.y = cvtpk(s[2 * 33], s[3 * 33]); o.z = cvtpk(s[4 * 33], s[5 * 33]); o.w = cvtpk(s[6 * 33], s[7 * 33]);
        *(u32x4*)(WT + (size_t)(n0 + n) * ldw + k0 + 8 * c) = o; }
    asm volatile("s_waitcnt lgkmcnt(0)" ::: "memory");
}
struct P0Args { const float *x, *meta, *gmix, *w_in, *w_bh, *w_ba, *w_out, *w_q, *subk; bf16_t *A1, *WinT, *WbhT, *WbaT, *WoutT, *WqT, *SK; };
__device__ __forceinline__ void p0_prologue(LAS unsigned char* lds, const P0Args& p) {
    const int tid = threadIdx.x, lane = tid & 63, wave = tid >> 6;
    LAS float* scr = (LAS float*)(lds + wave * 16384);
    const int gw = blockIdx.x * 8 + wave, NGW = gridDim.x * 8;
    constexpr int I_IN = 16 * 152, I_B = 8 * 32, I_O = 16 * 32, I_Q = 16 * 64, NITEMS = I_IN + 2 * I_B + I_O + I_Q;
    for (int it = gw; it < NITEMS; it += NGW) {
        int r = it;
        if (r < I_IN) { p0_transpose_item(p.w_in, 1024, 4864, p.WinT, scr, r, lane); continue; } r -= I_IN;
        if (r < I_B) { p0_transpose_item(p.w_bh, 512, 1024, p.WbhT, scr, r, lane, 1024); continue; } r -= I_B;
        if (r < I_B) { p0_transpose_item(p.w_ba, 512, 1024, p.WbhT + 512, scr, r, lane, 1024); continue; } r -= I_B;
        if (r < I_O) { p0_transpose_item(p.w_out, 1024, 1024, p.WoutT, scr, r, lane); continue; } r -= I_O;
        p0_transpose_item(p.w_q, 1024, 2048, p.WqT, scr, r, lane);
    }
    for (int p_ = blockIdx.x * 512 + tid; p_ < 262144 / 8; p_ += gridDim.x * 512) {
        const int ln = p_ & 63, kk = (p_ >> 6) & 7, nb = (p_ >> 9) & 3, hc = p_ >> 11;
        const float* src = p.subk + (size_t)(hc * 128 + 32 * nb + (ln & 31)) * 128 + 16 * kk + 8 * (ln >> 5);
        const f32x4 a = *(const f32x4*)src, b = *(const f32x4*)(src + 4);
        u32x4 o; o.x = cvtpk(a[0], a[1]); o.y = cvtpk(a[2], a[3]); o.z = cvtpk(b[0], b[1]); o.w = cvtpk(b[2], b[3]); *(u32x4*)(p.SK + (size_t)p_ * 8) = o; }
    f32x4 g[4];
#pragma unroll
    for (int j = 0; j < 4; ++j) g[j] = *((const f32x4*)p.gmix + lane + 64 * j);
    for (int m = gw; m < MA; m += NGW) {
        unsigned long long* o8 = (unsigned long long*)(p.A1 + (size_t)m * 1024) + lane;
        if (m >= MA_REAL) {
#pragma unroll
            for (int j = 0; j < 4; ++j) o8[64 * j] = 0ull;
            continue; }
        const int b = m / LTOK, pos = m - b * LTOK;
        const float* src = pos < NMETA ? p.meta + (size_t)pos * 1024 : p.x + ((size_t)b * SEQ + (pos - NMETA)) * 1024;
        const f32x4* xr = (const f32x4*)src + lane; f32x4 v[4]; float s = 0.f;
#pragma unroll
        for (int j = 0; j < 4; ++j) { v[j] = xr[64 * j]; s += (v[j][0] * v[j][0] + v[j][1] * v[j][1]) + (v[j][2] * v[j][2] + v[j][3] * v[j][3]); }
        const float rstd = 1.f / sqrtf(wave_sum(s) * (1.f / 1024.f) + EPS);
#pragma unroll
        for (int j = 0; j < 4; ++j) { const f32x4 y = v[j] * rstd * g[j]; o8[64 * j] = (unsigned long long)cvtpk(y[0], y[1]) | ((unsigned long long)cvtpk(y[2], y[3]) << 32); }
    }
}

constexpr int SR = 272;
constexpr int OFF_Q = 0, OFF_K = 34816, OFF_V = 69632, OFF_S = 104448, OFF_VEC = 139264;
__device__ __forceinline__ bf16x8 ldfrag(const LAS unsigned char* base, int row, int kk8, int h2) { return *(const LAS bf16x8*)(base + row * SR + (kk8 * 16 + 8 * h2) * 2); }

constexpr int OFF_SEGP = OFF_VEC, OFF_VEC2 = OFF_VEC + 8192, OFF_SSQ = OFF_VEC2 + 1024;
template <bool WITH_Q>
__device__ __forceinline__ void hgrn_front(LAS unsigned char* lds, const bf16_t* __restrict__ Zh, const float* __restrict__ lblog, int b, int h, int c, float (&g)[8][4], float (&kk)[8][4], float (&qq)[8][4], u32x2 (&vraw)[8]) {
    const int tid = threadIdx.x, c4 = tid & 31, seg = tid >> 5;
    const f32x4 l0 = *(const f32x4*)(lblog + h * 128 + 4 * c4), l1 = *(const f32x4*)(lblog + 512 + h * 128 + 4 * c4);
    float lb[4], run[4];
#pragma unroll
    for (int k = 0; k < 4; ++k) { lb[k] = sigm(l0[k] - l1[k]); run[k] = 1.f; }
    u32x2 hfw[8], hqw[8];
#pragma unroll
    for (int i = 0; i < 8; ++i) { const int pos = 128 * c - 112 + 8 * seg + i; const bool valid = pos >= 0;
        const bf16_t* zr = Zh + (size_t)(b * LTOK + (valid ? pos : 0)) * 2048 + h * 128 + 4 * c4;
        hfw[i] = *(const u32x2*)(zr + 512); if (WITH_Q) hqw[i] = *(const u32x2*)zr; vraw[i] = *(const u32x2*)(zr + 1024);
        if (!valid) { hfw[i] = (u32x2){0x7f007f00u, 0x7f007f00u}; hqw[i] = (u32x2){0u, 0u}; vraw[i] = (u32x2){0u, 0u}; } }
#pragma unroll
    for (int i = 0; i < 8; ++i) {
        const float hf[4] = {bflo(hfw[i].x), bfhi(hfw[i].x), bflo(hfw[i].y), bfhi(hfw[i].y)};
#pragma unroll
        for (int k = 0; k < 4; ++k) { const float sg = sigm(hf[k]); const float f = lb[k] + (1.f - lb[k]) * sg; kk[i][k] = (1.f - lb[k]) * (1.f - sg); run[k] *= f; g[i][k] = run[k]; }
        if (WITH_Q) { qq[i][0] = bflo(hqw[i].x); qq[i][1] = bfhi(hqw[i].x); qq[i][2] = bflo(hqw[i].y); qq[i][3] = bfhi(hqw[i].y); } }
    *(LAS f32x4*)(lds + OFF_SEGP + (seg * 128 + 4 * c4) * 4) = (f32x4){run[0], run[1], run[2], run[3]};
    __syncthreads();
}
__device__ __forceinline__ void hgrn_base(LAS unsigned char* lds, float (&base)[4]) {
    const int tid = threadIdx.x, c4 = tid & 31, seg = tid >> 5;
    const LAS f32x4* sp = (const LAS f32x4*)(lds + OFF_SEGP) + c4;
    f32x4 p = (f32x4){1.f, 1.f, 1.f, 1.f};
    if (seg < 8) { for (int s = seg; s < 8; ++s) p *= sp[s * 32];
        if (seg == 0) *(LAS f32x4*)(lds + OFF_VEC2 + (4 * c4) * 4) = p;
#pragma unroll
        for (int k = 0; k < 4; ++k) base[k] = __builtin_amdgcn_rcpf(p[k]); }
    else { for (int s = 8; s < seg; ++s) p *= sp[s * 32];
        if (seg == 15) *(LAS f32x4*)(lds + OFF_VEC2 + (128 + 4 * c4) * 4) = p * sp[15 * 32];
#pragma unroll
        for (int k = 0; k < 4; ++k) base[k] = p[k]; }
}
__device__ __forceinline__ void hgrn_put_vt(LAS unsigned char* lds, const u32x2 (&vraw)[8], int c4, int seg) {
#pragma unroll
    for (int k = 0; k < 4; ++k) { unsigned e[8];
#pragma unroll
        for (int i = 0; i < 8; ++i) { const unsigned w = (k < 2) ? vraw[i].x : vraw[i].y; e[i] = (k & 1) ? (w >> 16) : (w & 0xffffu); }
        *(LAS u32x4*)(lds + OFF_V + (4 * c4 + k) * SR + seg * 16) = (u32x4){e[0] | (e[1] << 16), e[2] | (e[3] << 16), e[4] | (e[5] << 16), e[6] | (e[7] << 16)}; }
}

__device__ __forceinline__ void hgrn_A(LAS unsigned char* lds, const bf16_t* __restrict__ Zh, const float* __restrict__ lblog, float* __restrict__ Ub, float* __restrict__ Dv, int item) {
    const int tid = threadIdx.x, lane = tid & 63, wid = tid >> 6, r32 = lane & 31, h2 = lane >> 5;
    const int c = item & 31, bh = item >> 5, b = bh >> 2, h = bh & 3;
    const int c4 = tid & 31, seg = tid >> 5;
    float g[8][4], kk[8][4], qq[8][4]; u32x2 vraw[8];
    hgrn_front<false>(lds, Zh, lblog, b, h, c, g, kk, qq, vraw);
    { float base[4]; hgrn_base(lds, base);
#pragma unroll
      for (int k = 0; k < 4; ++k) { float kt[8];
#pragma unroll
          for (int i = 0; i < 8; ++i) kt[i] = kk[i][k] * __builtin_amdgcn_rcpf(base[k] * g[i][k]);
          *(LAS u32x4*)(lds + OFF_K + (4 * c4 + k) * SR + seg * 16) = (u32x4){cvtpk(kt[0], kt[1]), cvtpk(kt[2], kt[3]), cvtpk(kt[4], kt[5]), cvtpk(kt[6], kt[7])}; }
      hgrn_put_vt(lds, vraw, c4, seg); }
    __syncthreads();
    const int e0 = 32 * (wid >> 1), d0 = 64 * (wid & 1);
    f32x16 acc[2]; acc[0] = f32x16{}; acc[1] = f32x16{};
#pragma unroll
    for (int k8 = 0; k8 < 8; ++k8) { const bf16x8 a = ldfrag(lds + OFF_V, e0 + r32, k8, h2);
#pragma unroll
        for (int j = 0; j < 2; ++j) acc[j] = MFMA32(a, ldfrag(lds + OFF_K, d0 + 32 * j + r32, k8, h2), acc[j]); }
    const LAS float* vec2 = (const LAS float*)(lds + OFF_VEC2);
#pragma unroll
    for (int j = 0; j < 2; ++j) { const int dc = d0 + 32 * j + r32; const float sc = vec2[128 + dc];
        float* up = Ub + ((size_t)item * 128 + e0 + 4 * h2) * 128 + dc;
#pragma unroll
        for (int r = 0; r < 16; ++r) up[(size_t)((r & 3) + 8 * (r >> 2)) * 128] = acc[j][r] * sc; }
    if (tid < 128) Dv[(size_t)item * 128 + tid] = vec2[tid] * vec2[128 + tid];
    __syncthreads();
}

__device__ __forceinline__ void hgrn_C(LAS unsigned char* lds, const bf16_t* __restrict__ Zh, const float* __restrict__ lblog, const float* __restrict__ Ub, const float* __restrict__ hgn, bf16_t* __restrict__ OM, int item) {
    const int tid = threadIdx.x, lane = tid & 63, wid = tid >> 6, r32 = lane & 31, h2 = lane >> 5;
    const int c = (item & 31) + 1, bh = item >> 5, b = bh >> 2, h = bh & 3;
    const int c4 = tid & 31, seg = tid >> 5;
    const int tb = wid >> 1, wh = wid & 1;
    f32x4 sreg[8];
    { const float* sp = Ub + (size_t)item * 16384;
#pragma unroll
      for (int q = 0; q < 8; ++q) sreg[q] = *(const f32x4*)(sp + (size_t)(tid + 512 * q) * 4); }
    const size_t rc = (size_t)b * SEQ + 128 * (c - 1) + 32 * tb + r32, ra = (size_t)b * LTOK + 128 * c - 112 + 32 * tb + r32;
    u32x2 gate[2][4];
#pragma unroll
    for (int j = 0; j < 2; ++j)
#pragma unroll
        for (int gq = 0; gq < 4; ++gq) gate[j][gq] = *(const u32x2*)(Zh + ra * 2048 + 1536 + h * 128 + 64 * wh + 32 * j + 8 * gq + 4 * h2);
    float g[8][4], kk[8][4], qq[8][4]; u32x2 vraw[8];
    hgrn_front<true>(lds, Zh, lblog, b, h, c, g, kk, qq, vraw);
    { float base[4]; hgrn_base(lds, base);
#pragma unroll
      for (int i = 0; i < 8; ++i) { float r[4], ri[4];
#pragma unroll
          for (int k = 0; k < 4; ++k) { r[k] = base[k] * g[i][k]; ri[k] = __builtin_amdgcn_rcpf(r[k]); }
          const int t = 8 * seg + i;
          *(LAS u32x2*)(lds + OFF_Q + t * SR + 8 * c4) = (u32x2){cvtpk(qq[i][0] * r[0], qq[i][1] * r[1]), cvtpk(qq[i][2] * r[2], qq[i][3] * r[3])};
          *(LAS u32x2*)(lds + OFF_K + t * SR + 8 * c4) = (u32x2){cvtpk(kk[i][0] * ri[0], kk[i][1] * ri[1]), cvtpk(kk[i][2] * ri[2], kk[i][3] * ri[3])}; }
      hgrn_put_vt(lds, vraw, c4, seg); }
    __syncthreads();
    { const LAS float* vec2 = (const LAS float*)(lds + OFF_VEC2);
#pragma unroll
      for (int q = 0; q < 8; ++q) { const int idx = tid + 512 * q, e = idx >> 5, d4 = (idx & 31) * 4; const f32x4 pr = *(const LAS f32x4*)(vec2 + d4); const f32x4 sv = sreg[q] * pr;
          *(LAS u32x2*)(lds + OFF_S + e * SR + d4 * 2) = (u32x2){cvtpk(sv[0], sv[1]), cvtpk(sv[2], sv[3])}; } }
    f32x16 sc[2]; sc[0] = f32x16{}; sc[1] = f32x16{};
#pragma unroll
    for (int j = 0; j < 2; ++j) { const int sb = 2 * wh + j;
        if (sb <= tb) {
#pragma unroll
            for (int k8 = 0; k8 < 8; ++k8) sc[j] = MFMA32(ldfrag(lds + OFF_K, 32 * sb + r32, k8, h2), ldfrag(lds + OFF_Q, 32 * tb + r32, k8, h2), sc[j]); } }
    __syncthreads();
    { const int t = 32 * tb + r32;
#pragma unroll
      for (int j = 0; j < 2; ++j) { const int sb = 2 * wh + j;
#pragma unroll
          for (int gq = 0; gq < 4; ++gq) { const int s0 = 32 * sb + 8 * gq + 4 * h2;
              const float p0 = (sb <= tb && s0 + 0 <= t) ? sc[j][4 * gq + 0] : 0.f, p1 = (sb <= tb && s0 + 1 <= t) ? sc[j][4 * gq + 1] : 0.f;
              const float p2 = (sb <= tb && s0 + 2 <= t) ? sc[j][4 * gq + 2] : 0.f, p3 = (sb <= tb && s0 + 3 <= t) ? sc[j][4 * gq + 3] : 0.f;
              u32x2 w; w.x = cvtpk(p0, p1); w.y = cvtpk(p2, p3); *(LAS u32x2*)(lds + OFF_K + t * SR + s0 * 2) = w; } } }
    __syncthreads();
    f32x16 oc[2]; oc[0] = f32x16{}; oc[1] = f32x16{};
    for (int k8 = 0; k8 < 2 * (tb + 1); ++k8) { const bf16x8 pb = ldfrag(lds + OFF_K, 32 * tb + r32, k8, h2);
#pragma unroll
        for (int j = 0; j < 2; ++j) oc[j] = MFMA32(ldfrag(lds + OFF_V, 64 * wh + 32 * j + r32, k8, h2), pb, oc[j]); }
#pragma unroll
    for (int k8 = 0; k8 < 8; ++k8) { const bf16x8 qb = ldfrag(lds + OFF_Q, 32 * tb + r32, k8, h2);
#pragma unroll
        for (int j = 0; j < 2; ++j) oc[j] = MFMA32(ldfrag(lds + OFF_S, 64 * wh + 32 * j + r32, k8, h2), qb, oc[j]); }
    LAS float* ssq = (LAS float*)(lds + OFF_SSQ);
    { float ss = 0.f;
#pragma unroll
      for (int j = 0; j < 2; ++j)
#pragma unroll
          for (int r = 0; r < 16; ++r) ss += oc[j][r] * oc[j][r];
      ss += __shfl_xor(ss, 32);
      if (h2 == 0) ssq[wh * 128 + 32 * tb + r32] = ss; }
    __syncthreads();
    { const int t = 32 * tb + r32; const float rstd = __builtin_amdgcn_rsqf((ssq[t] + ssq[128 + t]) * (1.f / 128.f) + EPS);
#pragma unroll
      for (int j = 0; j < 2; ++j)
#pragma unroll
          for (int gq = 0; gq < 4; ++gq) { const int e = 64 * wh + 32 * j + 8 * gq + 4 * h2;
              const u32x2 gt = gate[j][gq]; const f32x4 gn = *(const f32x4*)(hgn + h * 128 + e);
              const float g0 = bflo(gt.x), g1 = bfhi(gt.x), g2 = bflo(gt.y), g3 = bfhi(gt.y);
              const float o0 = oc[j][4 * gq + 0] * rstd * gn[0] * (g0 * sigm(g0)), o1 = oc[j][4 * gq + 1] * rstd * gn[1] * (g1 * sigm(g1));
              const float o2 = oc[j][4 * gq + 2] * rstd * gn[2] * (g2 * sigm(g2)), o3 = oc[j][4 * gq + 3] * rstd * gn[3] * (g3 * sigm(g3));
              u32x2 w; w.x = cvtpk(o0, o1); w.y = cvtpk(o2, o3); *(u32x2*)(OM + rc * 1024 + h * 128 + e) = w; } }
    __syncthreads();
}

__device__ __forceinline__ void hgrn_scan(float* __restrict__ Ub, const float* __restrict__ Dv) {
    for (int v = blockIdx.x * 512 + threadIdx.x; v < 32 * 4096; v += gridDim.x * 512) {
        const int bh = v >> 12, i4 = v & 4095, e = i4 >> 5, d4 = (i4 & 31) * 4;
        f32x4* up = (f32x4*)(Ub + ((size_t)(bh * 32) * 128 + e) * 128 + d4); const f32x4* dp = (const f32x4*)(Dv + (size_t)(bh * 32) * 128 + d4);
        f32x4 S = (f32x4){0.f, 0.f, 0.f, 0.f};
#pragma unroll 1
        for (int c0 = 0; c0 < 32; c0 += 8) { f32x4 u[8], dv[8];
#pragma unroll
            for (int c = 0; c < 8; ++c) { u[c] = up[(size_t)(c0 + c) * 4096]; dv[c] = dp[(c0 + c) * 32]; }
#pragma unroll
            for (int c = 0; c < 8; ++c) { S = dv[c] * S + u[c]; up[(size_t)(c0 + c) * 4096] = S; } }
    }
}

constexpr int AK_STRIDE = 144, AV_STRIDE = 560, AK_OFF = 0, AV_OFF = 288 * AK_STRIDE;
__device__ __forceinline__ void attn_stage(LAS unsigned char* lds, const bf16_t* __restrict__ Za, const bf16_t* __restrict__ Vt, int b, int n, int kvh) {
    const int tid = threadIdx.x;
    for (int i = tid; i < 288 * 8; i += 512) { const int kl = i >> 3, ch = i & 7; u32x4 v = (u32x4){0u, 0u, 0u, 0u};
        int pos = -1; if (kl < 256) pos = 128 * (n - 1) + kl - 112; else if (kl < 272) pos = kl - 256;
        if (pos >= 0) v = *(const u32x4*)(Za + (size_t)(b * LTOK + pos) * 768 + 512 + kvh * 64 + 8 * ch);
        *(LAS u32x4*)(lds + AK_OFF + kl * AK_STRIDE + ch * 16) = v; }
    for (int i = tid; i < 64 * 35; i += 512) { const int d = i / 35, ch = i - d * 35; u32x4 v = (u32x4){0u, 0u, 0u, 0u};
        const bf16_t* vr = Vt + (size_t)(b * 128 + kvh * 64 + d) * LPAD;
        if (ch < 32) { if (n > 1 || ch >= 14) v = *(const u32x4*)(vr + 128 * (n - 1) + 8 * ch); }
        else if (ch < 34) v = *(const u32x4*)(vr + 112 + 8 * (ch - 32));
        *(LAS u32x4*)(lds + AV_OFF + d * AV_STRIDE + ch * 16) = v; }
}
__device__ __forceinline__ f32x16 attn_qk(const LAS unsigned char* kp, const bf16x8 (&qf)[4]) {
    f32x16 S = f32x16{};
#pragma unroll
    for (int k = 0; k < 4; ++k) S = MFMA32(*(const LAS bf16x8*)(kp + 32 * k), qf[k], S);
    return S;
}
template <int MODE> __device__ __forceinline__ bool attn_vis(int kr, int r32) { return MODE == 0 ? true : MODE == 1 ? (kr > r32) : MODE == 2 ? (kr <= r32) : (kr < 16); }
template <int MODE> __device__ __forceinline__ float attn_tile_max(const f32x16& S, int r32, int h2) {
    float m = -INFINITY;
#pragma unroll
    for (int r = 0; r < 16; ++r) { const int kr = (r & 3) + 8 * (r >> 2) + 4 * h2; m = fmaxf(m, attn_vis<MODE>(kr, r32) ? S[r] : -INFINITY); }
    return m;
}
template <int MODE> __device__ __forceinline__ void attn_tile_pv(f32x16 S, float c2, float mneg, int r32, int h2, float& l, f32x16 (&O)[2], const LAS unsigned char* vl, int kl0) {
#pragma unroll
    for (int r = 0; r < 16; ++r) { const int kr = (r & 3) + 8 * (r >> 2) + 4 * h2; const float p = __builtin_amdgcn_exp2f(__builtin_fmaf(S[r], c2, mneg)); S[r] = attn_vis<MODE>(kr, r32) ? p : 0.f; l += S[r]; }
#pragma unroll
    for (int s2 = 0; s2 < 2; ++s2) {
        if (MODE == 3 && s2 == 1) continue;
        u32x4 pw; pw.x = cvtpk(S[8 * s2 + 0], S[8 * s2 + 1]); pw.y = cvtpk(S[8 * s2 + 2], S[8 * s2 + 3]); pw.z = cvtpk(S[8 * s2 + 4], S[8 * s2 + 5]); pw.w = cvtpk(S[8 * s2 + 6], S[8 * s2 + 7]);
        const bf16x8 pb = __builtin_bit_cast(bf16x8, pw);
#pragma unroll
        for (int db = 0; db < 2; ++db) { const LAS unsigned char* vp = vl + (32 * db) * AV_STRIDE + (kl0 + 16 * s2) * 2;
            const u32x2 lo = *(const LAS u32x2*)vp, hi = *(const LAS u32x2*)(vp + 16);
            const u32x4 aw = (u32x4){lo.x, lo.y, hi.x, hi.y};
            O[db] = MFMA32(__builtin_bit_cast(bf16x8, aw), pb, O[db]); } }
}
__device__ __forceinline__ void attn_sub(const LAS unsigned char* lds, const bf16_t* __restrict__ Za, const float* __restrict__ sinks, bf16_t* __restrict__ OM, int b, int n, int qh, int sb, int lane) {
    const int r32 = lane & 31, h2 = lane >> 5;
    const int pq = 128 * n + 32 * sb + r32;
    const bf16_t* qp = Za + (size_t)(b * LTOK + pq - 112) * 768 + qh * 64 + 8 * h2;
    bf16x8 qf[4];
#pragma unroll
    for (int k = 0; k < 4; ++k) qf[k] = *(const bf16x8*)(qp + 16 * k);
    const LAS unsigned char* kl = lds + AK_OFF + r32 * AK_STRIDE + 16 * h2;
    const LAS unsigned char* vl = lds + AV_OFF + r32 * AV_STRIDE + 8 * h2;
    const float c2 = 0.125f * 1.4426950408889634f;
    const float sinkl = sinks[qh] * 1.4426950408889634f;
    const int jskip = n == 1 ? 4 - sb : 0;
    float mraw = -INFINITY;
#pragma unroll
    for (int j = 0; j < 5; ++j) { if (j < jskip) continue;
        const f32x16 S = attn_qk(kl + (32 * (sb + j)) * AK_STRIDE, qf);
        mraw = fmaxf(mraw, j == 0 ? attn_tile_max<1>(S, r32, h2) : j == 4 ? attn_tile_max<2>(S, r32, h2) : attn_tile_max<0>(S, r32, h2)); }
    { const f32x16 S = attn_qk(kl + 256 * AK_STRIDE, qf); mraw = fmaxf(mraw, attn_tile_max<3>(S, r32, h2)); }
    float mx = fmaxf(mraw * c2, sinkl);
    mx = fmaxf(mx, __shfl_xor(mx, 32));
    float l = 0.f; const float mneg = -mx;
    f32x16 O[2]; O[0] = f32x16{}; O[1] = f32x16{};
#pragma unroll
    for (int j = 0; j < 5; ++j) { if (j < jskip) continue;
        const int kl0 = 32 * (sb + j); const f32x16 S = attn_qk(kl + kl0 * AK_STRIDE, qf);
        if (j == 0) attn_tile_pv<1>(S, c2, mneg, r32, h2, l, O, vl, kl0); else if (j == 4) attn_tile_pv<2>(S, c2, mneg, r32, h2, l, O, vl, kl0); else attn_tile_pv<0>(S, c2, mneg, r32, h2, l, O, vl, kl0); }
    { const f32x16 S = attn_qk(kl + 256 * AK_STRIDE, qf); attn_tile_pv<3>(S, c2, mneg, r32, h2, l, O, vl, 256); }
    l += __shfl_xor(l, 32); l += __builtin_amdgcn_exp2f(sinkl - mx);
    const float inv = __builtin_amdgcn_rcpf(l);
    bf16_t* op = OM + ((size_t)b * SEQ + 128 * (n - 1) + 32 * sb + r32) * 1024 + 512 + qh * 64 + 4 * h2;
#pragma unroll
    for (int db = 0; db < 2; ++db)
#pragma unroll
        for (int g = 0; g < 4; ++g) { u32x2 w; w.x = cvtpk(O[db][4 * g] * inv, O[db][4 * g + 1] * inv); w.y = cvtpk(O[db][4 * g + 2] * inv, O[db][4 * g + 3] * inv);
            *(u32x2*)(op + 32 * db + 8 * g) = w; }
}
__device__ __forceinline__ unsigned f2ord(float f) { const unsigned u = __float_as_uint(f); return (u & 0x80000000u) ? ~u : (u | 0x80000000u); }
__device__ __forceinline__ float ord2f(unsigned u) { return __uint_as_float((u & 0x80000000u) ? (u & 0x7fffffffu) : ~u); }
__device__ __forceinline__ unsigned umax_(unsigned a, unsigned b) { return a > b ? a : b; }
__device__ __forceinline__ unsigned umin_(unsigned a, unsigned b) { return a < b ? a : b; }
template <int N> __device__ __forceinline__ void bitonic_desc(unsigned (&a)[N]) {
#pragma unroll
    for (int k = 2; k <= N; k <<= 1)
#pragma unroll
        for (int j = k >> 1; j > 0; j >>= 1)
#pragma unroll
            for (int i = 0; i < N; ++i) { const int l = i ^ j;
                if (l > i) { const unsigned hi = umax_(a[i], a[l]), lo = umin_(a[i], a[l]); if ((i & k) == 0) { a[i] = hi; a[l] = lo; } else { a[i] = lo; a[l] = hi; } } }
}
__device__ __forceinline__ void merge_top16(unsigned (&a)[16], const unsigned (&b)[16]) {
#pragma unroll
    for (int i = 0; i < 16; ++i) a[i] = umax_(a[i], b[15 - i]);
#pragma unroll
    for (int j = 8; j > 0; j >>= 1)
#pragma unroll
        for (int i = 0; i < 16; ++i) { const int l = i ^ j; if (l > i) { const unsigned hi = umax_(a[i], a[l]), lo = umin_(a[i], a[l]); a[i] = hi; a[l] = lo; } }
}
template <bool PAIR> __device__ __forceinline__ void top16_of(unsigned (&g)[4][16]) {
    bitonic_desc<16>(g[0]); bitonic_desc<16>(g[1]); bitonic_desc<16>(g[2]); bitonic_desc<16>(g[3]);
    merge_top16(g[0], g[1]); merge_top16(g[2], g[3]); merge_top16(g[0], g[2]);
    if (PAIR) { unsigned o[16]; const bool up = (threadIdx.x & 32) != 0;
#pragma unroll
        for (int i = 0; i < 16; ++i) { const auto r = __builtin_amdgcn_permlane32_swap(g[0][i], g[0][i], false, false); o[i] = up ? r[0] : r[1]; }
        merge_top16(g[0], o); }
}
__device__ __forceinline__ unsigned sel16p(unsigned long long lo, unsigned long long hi, int i) { const unsigned long long w = (i & 8) ? hi : lo; return (unsigned)(w >> ((i & 7) * 8)) & 0x7fu; }
struct CandTab { unsigned char i[50], j[50]; int n; };
constexpr CandTab make_cands() { CandTab t{}; int n = 0; for (int i = 0; i < 16; ++i) for (int j = 0; j < 16; ++j) if ((i + 1) * (j + 1) <= 16) { t.i[n] = (unsigned char)i; t.j[n] = (unsigned char)j; ++n; } t.n = n; return t; }
constexpr CandTab CT = make_cands();
static_assert(CT.n == 50, "candidate count");

constexpr int PL_IDX = 0, PL_GB = 32768, PL_PA = 65536, PL_SSQ = 131072;
__device__ __forceinline__ void peer_list(const bf16_t* __restrict__ Qb, const bf16_t* __restrict__ SK, int rc0, int h, int c, int r32, int h2, unsigned (&top)[16]) {
    const int lane_ = 32 * h2 + r32;
    const bf16_t* qp = Qb + ((size_t)((((rc0 >> 5) * 8 + h) * 2 + c) * 8) * 64 + lane_) * 8;
    bf16x8 qf[8];
#pragma unroll
    for (int k = 0; k < 8; ++k) qf[k] = *(const bf16x8*)(qp + 512 * k);
    unsigned g[4][16];
#pragma unroll
    for (int nb = 0; nb < 4; ++nb) {
        const bf16_t* kp = SK + ((size_t)(((h * 2 + c) * 4 + nb) * 8) * 64 + lane_) * 8;
        f32x16 acc = f32x16{};
#pragma unroll
        for (int k = 0; k < 8; ++k) acc = MFMA32(*(const bf16x8*)(kp + 512 * k), qf[k], acc);
#pragma unroll
        for (int r = 0; r < 16; ++r) g[nb][r] = (f2ord(acc[r]) & 0xffffff80u) | (unsigned)(32 * nb + (r & 3) + 8 * (r >> 2) + 4 * h2);
        __builtin_amdgcn_sched_barrier(0);
    }
    top16_of<true>(g);
#pragma unroll
    for (int k = 0; k < 16; ++k) top[k] = g[0][k];
}
__device__ __forceinline__ void peer_topk(LAS unsigned char* lds, const bf16_t* __restrict__ Qb, const bf16_t* __restrict__ SK, int rc0, int tl0, int h0, int lane) {
#pragma unroll 1
    for (int hh = 0; hh < 4; ++hh) {
        asm volatile("" : "+v"(lane));
        const int r32 = lane & 31, h2 = lane >> 5;
        const int h = h0 + hh;
        unsigned ta[16], tb[16];
        peer_list(Qb, SK, rc0, h, 0, r32, h2, ta);
        peer_list(Qb, SK, rc0, h, 1, r32, h2, tb);
        float av[16], bv[16]; unsigned long long ail = 0, aih = 0, bil = 0, bih = 0;
#pragma unroll
        for (int k = 0; k < 16; ++k) { av[k] = ord2f(ta[k] & 0xffffff80u); bv[k] = ord2f(tb[k] & 0xffffff80u);
            if (k < 8) { ail |= (unsigned long long)(ta[k] & 0x7fu) << (8 * k); bil |= (unsigned long long)(tb[k] & 0x7fu) << (8 * k); }
            else { aih |= (unsigned long long)(ta[k] & 0x7fu) << (8 * (k - 8)); bih |= (unsigned long long)(tb[k] & 0x7fu) << (8 * (k - 8)); } }
        unsigned k2[4][16];
#pragma unroll
        for (int k = 0; k < 64; ++k) { if (k < 50) k2[k >> 4][k & 15] = (f2ord(av[CT.i[k < 50 ? k : 0]] + bv[CT.j[k < 50 ? k : 0]]) & 0xffffff00u) | (unsigned)(CT.i[k < 50 ? k : 0] * 16 + CT.j[k < 50 ? k : 0]); else k2[k >> 4][k & 15] = 0u; }
        top16_of<false>(k2);
        float ev[16]; float es = 0.f; const float m0 = ord2f(k2[0][0] & 0xffffff00u);
#pragma unroll
        for (int k = 0; k < 16; ++k) { ev[k] = __expf(ord2f(k2[0][k] & 0xffffff00u) - m0); es += ev[k]; }
        const float inv = 1.f / es;
        LAS unsigned short* ip = (LAS unsigned short*)(lds + PL_IDX) + (tl0 + r32) * 128 + h * 16;
        LAS bf16_t* gp = (LAS bf16_t*)(lds + PL_GB) + (tl0 + r32) * 128 + h * 16;
#pragma unroll
        for (int k = 0; k < 16; ++k) { const int code = (int)(k2[0][k] & 0xffu); const unsigned e = sel16p(ail, aih, code >> 4) * 128u + sel16p(bil, bih, code & 15);
            if ((k >> 3) == h2) { ip[k] = (unsigned short)e; gp[k] = f2bf(ev[k] * inv); } }
    }
}
__device__ __forceinline__ pg8::f32x2_t fp8x2(unsigned w, bool hi) { return hi ? __builtin_amdgcn_cvt_pk_f32_fp8(w, true) : __builtin_amdgcn_cvt_pk_f32_fp8(w, false); }
template <int CTRL> __device__ __forceinline__ float dppf(float v) { return __builtin_bit_cast(float, __builtin_amdgcn_update_dpp(0, __builtin_bit_cast(int, v), CTRL, 0xf, 0xf, true)); }
template <bool WITH_X>
__device__ __forceinline__ void peer_rows_load(u32x4 (&rw)[16], u32x4 (&xw)[2], const LAS unsigned char* lds, int tl, size_t rc, int s, const unsigned char* __restrict__ T8, const bf16_t* __restrict__ A2, int lane) {
    const int c = lane & 7, gq = lane >> 3;
    if (WITH_X) { xw[0] = *(const u32x4*)((const unsigned char*)A2 + rc * 1024 + 128 * s + 16 * c); xw[1].x = __float_as_uint(*(const float*)((const unsigned char*)A2 + (size_t)MC * 1024 + rc * 4)); }
    const LAS unsigned short* ip = (const LAS unsigned short*)(lds + PL_IDX) + tl * 128 + gq;
    const __amdgpu_buffer_rsrc_t rs = __builtin_amdgcn_make_buffer_rsrc((void*)T8, (short)0, 16 << 20, 0x00020000);
    const unsigned c16 = 16u * (unsigned)c; const int soff = 128 * s;
#pragma unroll
    for (int ig = 0; ig < 16; ++ig) rw[ig] = __builtin_bit_cast(u32x4, __builtin_amdgcn_raw_buffer_load_b128(rs, (int)(((unsigned)ip[8 * ig] << 10) | c16), soff, 0));
}
__device__ __forceinline__ void peer_u_math(const u32x4 (&uw)[16], const u32x4 (&xw)[2], LAS unsigned char* lds, int tl, int lane) {
    const int c = lane & 7, gq = lane >> 3;
    const int x0 = (int)xw[0].x, x1 = (int)xw[0].y, x2 = (int)xw[0].z, x3 = (int)xw[0].w;
    int acc0 = 0, acc1 = 0;
#pragma unroll
    for (int ig = 0; ig < 16; ++ig) {
        int d = __builtin_amdgcn_sdot4((int)uw[ig].x, x0, 0, false); d = __builtin_amdgcn_sdot4((int)uw[ig].y, x1, d, false); d = __builtin_amdgcn_sdot4((int)uw[ig].z, x2, d, false); d = __builtin_amdgcn_sdot4((int)uw[ig].w, x3, d, false);
        d += __builtin_amdgcn_update_dpp(0, d, 0xB1, 0xf, 0xf, true); d += __builtin_amdgcn_update_dpp(0, d, 0x4E, 0xf, 0xf, true); d += __builtin_amdgcn_update_dpp(0, d, 0x141, 0xf, 0xf, true);
        if (ig < 8) acc0 = (c == ig) ? d : acc0; else acc1 = (c == ig - 8) ? d : acc1; }
    const float sx = __uint_as_float(xw[1].x);
    LAS float* pp = (LAS float*)(lds + PL_PA) + tl * 128 + 8 * c + gq;
    __hip_atomic_fetch_add(pp, (float)acc0 * sx, __ATOMIC_RELAXED, __HIP_MEMORY_SCOPE_WORKGROUP);
    __hip_atomic_fetch_add(pp + 64, (float)acc1 * sx, __ATOMIC_RELAXED, __HIP_MEMORY_SCOPE_WORKGROUP);
}
__device__ __forceinline__ void peer_a_step(LAS unsigned char* lds, int tl, size_t rc, const float* __restrict__ rowssp, const float* __restrict__ su, const float* __restrict__ sv, int lane) {
    float rs = rowssp[rc * 16 + (lane & 15)];
    rs += __shfl_xor(rs, 1); rs += __shfl_xor(rs, 2); rs += __shfl_xor(rs, 4); rs += __shfl_xor(rs, 8);
    const float rstd = __builtin_amdgcn_rsqf(rs * (1.f / 1024.f) + EPS);
#pragma unroll
    for (int q = 0; q < 2; ++q) { const int k = lane + 64 * q;
        const unsigned e = ((const LAS unsigned short*)(lds + PL_IDX))[tl * 128 + k];
        LAS float* pp = (LAS float*)(lds + PL_PA) + tl * 128 + k;
        const float z = *pp * rstd * su[e]; const float a = 0.5f * z * (1.f + erff(z * 0.70710678118654752f));
        *pp = bf2f(((const LAS bf16_t*)(lds + PL_GB))[tl * 128 + k]) * a * sv[e]; }
    if (lane == 0) ((LAS float*)(lds + PL_SSQ))[tl] = 0.f;
}
__device__ __forceinline__ void peer_v_math(const u32x4 (&vw)[16], LAS unsigned char* lds, int tl, size_t rc, int s, bf16_t* __restrict__ dout, int lane) {
    const int c = lane & 7, gq = lane >> 3;
    const LAS float* wp = (const LAS float*)(lds + PL_PA) + tl * 128 + gq;
    const bool b3 = lane & 8, b4 = lane & 16, b5 = lane & 32;
    unsigned* hp = (unsigned*)(dout + rc * 1024 + 128 * s + 16 * c + (b3 ? 8 : 0) + (b4 ? 4 : 0) + (b5 ? 2 : 0));
    const unsigned hw = *hp; pg8::f32x2_t h = (pg8::f32x2_t){bflo(hw), bfhi(hw)};
    pg8::f32x2_t o2[8];
#pragma unroll
    for (int i = 0; i < 8; ++i) o2[i] = (pg8::f32x2_t){0.f, 0.f};
#pragma unroll
    for (int ig = 0; ig < 16; ++ig) { const float w = wp[8 * ig]; const pg8::f32x2_t w2 = (pg8::f32x2_t){w, w};
#pragma unroll
        for (int q = 0; q < 4; ++q) { o2[2 * q] += w2 * fp8x2(vw[ig][q], false); o2[2 * q + 1] += w2 * fp8x2(vw[ig][q], true); } }
    float out[16];
#pragma unroll
    for (int i = 0; i < 8; ++i) { out[2 * i] = o2[i].x; out[2 * i + 1] = o2[i].y; }
#pragma unroll
    for (int j = 0; j < 8; ++j) { const float keep = b3 ? out[j + 8] : out[j], send = b3 ? out[j] : out[j + 8]; out[j] = keep + dppf<0x128>(send); }
#pragma unroll
    for (int j = 0; j < 4; ++j) { const auto r = __builtin_amdgcn_permlane16_swap(__float_as_uint(out[j]), __float_as_uint(out[j + 4]), false, false); out[j] = __uint_as_float(r[0]) + __uint_as_float(r[1]); }
#pragma unroll
    for (int j = 0; j < 2; ++j) { const auto r = __builtin_amdgcn_permlane32_swap(__float_as_uint(out[j]), __float_as_uint(out[j + 2]), false, false); out[j] = __uint_as_float(r[0]) + __uint_as_float(r[1]); }
    h.x += out[0]; h.y += out[1];
    *hp = cvtpk(h.x, h.y);
}
__device__ __forceinline__ void peer_f_step(LAS unsigned char* lds, int tl, size_t rc, const bf16_t* __restrict__ h2b, float* __restrict__ dout, const float* __restrict__ gfin, int lane) {
    const u32x4 ha = *(const u32x4*)(h2b + rc * 1024 + 16 * lane), hb = *(const u32x4*)(h2b + rc * 1024 + 16 * lane + 8);
    const f32x4 h0 = (f32x4){bflo(ha.x), bfhi(ha.x), bflo(ha.y), bfhi(ha.y)}, h1 = (f32x4){bflo(ha.z), bfhi(ha.z), bflo(ha.w), bfhi(ha.w)};
    const f32x4 h2 = (f32x4){bflo(hb.x), bfhi(hb.x), bflo(hb.y), bfhi(hb.y)}, h3 = (f32x4){bflo(hb.z), bfhi(hb.z), bflo(hb.w), bfhi(hb.w)};
    const f32x4 sq = (h0 * h0 + h1 * h1) + (h2 * h2 + h3 * h3);
    const float rf = __builtin_amdgcn_rsqf(wave_sum((sq[0] + sq[1]) + (sq[2] + sq[3])) * (1.f / 1024.f) + EPS);
    float* op = dout + rc * 1024 + 16 * lane; const float* gq = gfin + 16 * lane;
    *(f32x4*)(op) = h0 * rf * *(const f32x4*)(gq);
    *(f32x4*)(op + 4) = h1 * rf * *(const f32x4*)(gq + 4);
    *(f32x4*)(op + 8) = h2 * rf * *(const f32x4*)(gq + 8);
    *(f32x4*)(op + 12) = h3 * rf * *(const f32x4*)(gq + 12);
}
__device__ __forceinline__ unsigned pack_i8x4(float a, float b, float c, float d) {
    const int ia = __float2int_rn(a), ib = __float2int_rn(b), ic = __float2int_rn(c), id = __float2int_rn(d);
    return (unsigned)(ia & 0xff) | ((unsigned)(ib & 0xff) << 8) | ((unsigned)(ic & 0xff) << 16) | ((unsigned)id << 24);
}
__device__ __forceinline__ void peer_tables(const float* __restrict__ pu, const float* __restrict__ pv, unsigned char* __restrict__ T8, float* __restrict__ sinv, int lane, int gw, int NGW) {
    for (int row = gw; row < 32768; row += NGW) {
        const bool isu = row < 16384;
        const float* src = (isu ? pu + (size_t)row * 1024 : pv + (size_t)(row - 16384) * 1024) + 16 * lane;
        f32x4 v[4]; float am = 0.f;
#pragma unroll
        for (int q = 0; q < 4; ++q) { v[q] = *(const f32x4*)(src + 4 * q); am = fmaxf(am, fmaxf(fmaxf(fabsf(v[q][0]), fabsf(v[q][1])), fmaxf(fabsf(v[q][2]), fabsf(v[q][3])))); }
#pragma unroll
        for (int o = 1; o < 64; o <<= 1) am = fmaxf(am, __shfl_xor(am, o));
        const float top = isu ? 127.f : 224.f;
        const float sc = am > 0.f ? top / am : 1.f;
        u32x4 w;
        if (isu) {
#pragma unroll
            for (int q = 0; q < 4; ++q) w[q] = pack_i8x4(v[q][0] * sc, v[q][1] * sc, v[q][2] * sc, v[q][3] * sc);
        } else {
#pragma unroll
            for (int q = 0; q < 4; ++q) { unsigned t = __builtin_amdgcn_cvt_pk_fp8_f32(v[q][0] * sc, v[q][1] * sc, 0, false); t = __builtin_amdgcn_cvt_pk_fp8_f32(v[q][2] * sc, v[q][3] * sc, t, true); w[q] = t; } }
        *(u32x4*)(T8 + (size_t)row * 1024 + 16 * lane) = w;
        if (lane == 0) sinv[row] = am > 0.f ? am / top : 1.f;
    }
}
__device__ __forceinline__ void peer_xq_token(const bf16_t* __restrict__ A2, unsigned char* __restrict__ XQ, float* __restrict__ SX, size_t rc, int lane) {
    const u32x4 xa = *(const u32x4*)(A2 + rc * 1024 + 16 * lane), xb = *(const u32x4*)(A2 + rc * 1024 + 16 * lane + 8);
    const unsigned w[8] = {xa.x, xa.y, xa.z, xa.w, xb.x, xb.y, xb.z, xb.w};
    float am = 0.f;
#pragma unroll
    for (int q = 0; q < 8; ++q) am = fmaxf(am, fmaxf(fabsf(bflo(w[q])), fabsf(bfhi(w[q]))));
#pragma unroll
    for (int o = 1; o < 64; o <<= 1) am = fmaxf(am, __shfl_xor(am, o));
    const float sc = am > 0.f ? 127.f / am : 1.f;
    u32x4 o;
#pragma unroll
    for (int q = 0; q < 4; ++q) o[q] = pack_i8x4(bflo(w[2 * q]) * sc, bfhi(w[2 * q]) * sc, bflo(w[2 * q + 1]) * sc, bfhi(w[2 * q + 1]) * sc);
    *(u32x4*)(XQ + rc * 1024 + 16 * lane) = o;
    if (lane == 0) SX[rc] = am > 0.f ? am / 127.f : 1.f;
}

#define XB_TMO      128
#define XB_XCNT(j)  (256  + 64 * (j))
#define XB_XSUB(j)  (1280 + 64 * (j))
#define XB_XGEN(j)  (2304 + 64 * (j))
#define XB_TOP      3328
#define XB_TOPGEN   3392
#define XCD_BAR_WORDS 3456
#define XB_SPIN_CAP (1u << 18)

__device__ __forceinline__ unsigned xb_ld(unsigned* p)              { return __hip_atomic_load(p, __ATOMIC_RELAXED, __HIP_MEMORY_SCOPE_AGENT); }
__device__ __forceinline__ unsigned xb_add(unsigned* p, unsigned v) { return __hip_atomic_fetch_add(p, v, __ATOMIC_RELAXED, __HIP_MEMORY_SCOPE_AGENT); }
__device__ __forceinline__ unsigned xb_xcc_id() { return (unsigned)__builtin_amdgcn_s_getreg((3 << 11) | 20) & 0xFu; }
#define XB_SPIN(cond, bar) do { unsigned _sp = 0; while (cond) { __builtin_amdgcn_s_sleep(1); \
    if ((++_sp & 255u) == 0u) { if (xb_ld(&(bar)[XB_TMO])) break; if (_sp > XB_SPIN_CAP) { atomicAdd(&(bar)[XB_TMO], 1u); break; } } } } while (0)

struct XcdBarrier {
    unsigned* bar; unsigned x;
    volatile LAS unsigned* st;
};

__device__ __forceinline__ XcdBarrier xcd_barrier_post(unsigned* bar, volatile LAS unsigned* st) {
    XcdBarrier b; b.bar = bar; b.x = xb_xcc_id(); b.st = st;
    if (threadIdx.x == 0) (void)xb_add(&bar[XB_XCNT(b.x)], 1u);
    return b;
}
__device__ __forceinline__ void xcd_barrier_complete(unsigned* bar, unsigned x, unsigned& nloc, unsigned& nx) {
    const unsigned G = gridDim.x * gridDim.y * gridDim.z;
    unsigned sum, cnt, mine, sp = 0u;
    for (;;) {
        sum = 0u; cnt = 0u; mine = 0u;
#pragma unroll
        for (unsigned j = 0; j < 16; ++j) { const unsigned c = xb_ld(&bar[XB_XCNT(j)]); sum += c; cnt += (c > 0u) ? 1u : 0u; mine = (j == x) ? c : mine; }
        if (sum == G) break;
        __builtin_amdgcn_s_sleep(1);
        if ((++sp & 255u) == 0u) { if (xb_ld(&bar[XB_TMO])) break; if (sp > XB_SPIN_CAP) { atomicAdd(&bar[XB_TMO], 1u); break; } }
    }
    nloc = mine > 0u ? mine : 1u; nx = cnt > 0u ? cnt : 1u;
}

__device__ __forceinline__ void xcd_barrier(const XcdBarrier& b) {
    asm volatile("s_waitcnt vmcnt(0)" ::: "memory");
    __syncthreads();
    if (threadIdx.x == 0) {
        unsigned* bar = b.bar;
        __builtin_amdgcn_s_waitcnt(0);
        unsigned nloc = b.st[0], nx = b.st[1];
        if (nloc == 0u) { xcd_barrier_complete(bar, b.x, nloc, nx); b.st[0] = nloc; b.st[1] = nx; }
        const unsigned old = xb_add(&bar[XB_XSUB(b.x)], 1u);
        const unsigned gen = old / nloc;
        if (old + 1u == (gen + 1u) * nloc) {
            __builtin_amdgcn_fence(__ATOMIC_RELEASE, "agent");
            asm volatile("s_waitcnt vmcnt(0)" ::: "memory");
            const unsigned og = xb_add(&bar[XB_TOP], 1u);
            const unsigned tg = og / nx;
            if (og + 1u == (tg + 1u) * nx) xb_add(&bar[XB_TOPGEN], 1u);
            else XB_SPIN(xb_ld(&bar[XB_TOPGEN]) == tg, bar);
            __builtin_amdgcn_fence(__ATOMIC_ACQUIRE, "agent");
            xb_add(&bar[XB_XGEN(b.x)], 1u);
            asm volatile("s_waitcnt vmcnt(0)" ::: "memory");
        } else {
            XB_SPIN(xb_ld(&bar[XB_XGEN(b.x)]) == gen, bar);
            __builtin_amdgcn_fence(__ATOMIC_ACQUIRE, "agent");
            asm volatile("s_waitcnt vmcnt(0)" ::: "memory");
        }
    }
    __syncthreads();
}

constexpr int NPHASE = 9;
struct Args { const float* in[17]; float* out; unsigned char* ws; int ph_lo, ph_hi; };
__global__ void __launch_bounds__(512, 2) fwd_kernel(Args a) {
    extern __shared__ __attribute__((aligned(16))) unsigned char lds_raw[];
    LAS unsigned char* lds = (LAS unsigned char*)lds_raw;
    cg::grid_group grid = cg::this_grid();
    const int tid = threadIdx.x, lane = tid & 63, wave = __builtin_amdgcn_readfirstlane(tid >> 6);
    const int lo = a.ph_lo, hi = a.ph_hi, G = gridDim.x;
    typedef const __attribute__((address_space(4))) Args* kargp_t;
#define KARGS kargp_t kp_ = (kargp_t)__builtin_amdgcn_kernarg_segment_ptr(); asm volatile("" : "+s"(kp_)); unsigned char* const ws = kp_->ws
#define INP(k) ((const float*)kp_->in[k])
#define WSP(T, off) ((T*)(ws + (off)))
#ifdef ONLY_PHASE
#define IN(k) ((k) == ONLY_PHASE && lo <= (k) && (k) < hi)
#else
#define IN(k) (lo <= (k) && (k) < hi)
#endif
    volatile LAS unsigned* bar_st = (volatile LAS unsigned*)(lds + LDS_BYTES - 64);
    XcdBarrier xbar; xbar.bar = (unsigned*)(a.ws + WS_CTL); xbar.x = 0; xbar.st = bar_st;
    if (hi - lo > 1) { if (tid < 2) bar_st[tid] = 0u; __syncthreads(); xbar = xcd_barrier_post((unsigned*)(a.ws + WS_CTL), bar_st); }
    if (lo < 0) grid.sync();
#define SEAM(k) do { if (lo <= (k) && (k) + 1 < hi) xcd_barrier(xbar); } while (0)

    if (IN(0)) { KARGS; P0Args p{INP(0), INP(1), INP(2), INP(3), INP(8), INP(9), INP(10), INP(12), INP(13), WSP(bf16_t, WS_A1), WSP(bf16_t, WS_WIN), WSP(bf16_t, WS_WBH), WSP(bf16_t, WS_WBA), WSP(bf16_t, WS_WOUT), WSP(bf16_t, WS_WQ), WSP(bf16_t, WS_SK)}; p0_prologue(lds, p); SEAM(0); }
    if (IN(1)) {
        KARGS; bf16_t *A1 = WSP(bf16_t, WS_A1), *WinT = WSP(bf16_t, WS_WIN), *Zh = WSP(bf16_t, WS_ZH), *Za = WSP(bf16_t, WS_ZA), *Zg = WSP(bf16_t, WS_ZG), *Vt = WSP(bf16_t, WS_VT);
        pg8::Gemm g{A1, WinT, MA, 4864, 1024, 1024, 1024}; pg8::StaticOrder S; S.init(MA, 4864, G, (int)blockIdx.x);
        pg8::EpiZ E{Zh, Za, Zg, Vt, INP(4)};
        pg8::gemm_phase<pg8::EpiZ, pg8::StaticOrder, true, true>(lds, g, S, E);
        SEAM(1);
    }
    if (IN(2)) {
        KARGS; bf16_t *Zh = WSP(bf16_t, WS_ZH), *Za = WSP(bf16_t, WS_ZA), *Vt = WSP(bf16_t, WS_VT), *OM = WSP(bf16_t, WS_OM); float *Ub = WSP(float, WS_UB), *Dv = WSP(float, WS_DV); const float *lblog = INP(5), *sinks = INP(7);
        for (int it = blockIdx.x; it < 1024 + 512; it += G) {
            if (it < 1024) {
#ifndef NO_HGA
 hgrn_A(lds, Zh, lblog, Ub, Dv, it);
#endif
 }
            else { const int ai = it - 1024, b = ai >> 6, n = ((ai & 63) >> 1) + 1, kvh = ai & 1;
                attn_stage(lds, Za, Vt, b, n, kvh);
                __syncthreads();
#pragma unroll 1
                for (int si = wave; si < 16; si += 8) attn_sub(lds, Za, sinks, OM, b, n, kvh * 4 + (si >> 2), si & 3, lane);
                __syncthreads(); }
        }
        SEAM(2);
    }
    if (IN(3)) { KARGS; hgrn_scan(WSP(float, WS_UB), WSP(float, WS_DV)); SEAM(3); }
    if (IN(4)) { KARGS; for (int it = blockIdx.x; it < 1024; it += G) hgrn_C(lds, WSP(bf16_t, WS_ZH), INP(5), WSP(float, WS_UB), INP(6), WSP(bf16_t, WS_OM), it); SEAM(4); }
    if (IN(5)) {
        KARGS; bf16_t *OM = WSP(bf16_t, WS_OM), *WbhT = WSP(bf16_t, WS_WBH), *Mb = WSP(bf16_t, WS_MB), *Zg = WSP(bf16_t, WS_ZG); const float* bgate = INP(4);
        peer_tables(INP(14), INP(15), ws + WS_U8, WSP(float, WS_SUV), lane, blockIdx.x * 8 + wave, G * 8);
        __syncthreads();
        pg8::StaticOrder S; S.init(MC, 1024, G, (int)blockIdx.x);
        { pg8::Gemm g{OM, WbhT, MC, 1024, 1024, 1024, 1024}; pg8::EpiGate E{Mb, Zg, bgate}; pg8::gemm_phase<pg8::EpiGate, pg8::StaticOrder, true, true>(lds, g, S, E); }
        SEAM(5);
    }
    if (IN(6)) {
        KARGS; bf16_t *Mb = WSP(bf16_t, WS_MB), *WoutT = WSP(bf16_t, WS_WOUT), *A2 = WSP(bf16_t, WS_A2); float* rowssp = WSP(float, WS_RS); const float *x = INP(0), *gffn = INP(11);
        pg8::Gemm g{Mb, WoutT, MC, 1024, 1024, 1024, 1024}; pg8::StaticOrder S; S.init(MC, 1024, G, (int)blockIdx.x);
        pg8::EpiH1 E{x, WSP(bf16_t, WS_H1B), A2, gffn, rowssp};
        pg8::gemm_phase<pg8::EpiH1, pg8::StaticOrder, true, true>(lds, g, S, E);
        SEAM(6);
    }
    if (IN(7)) {
        KARGS; bf16_t *A2 = WSP(bf16_t, WS_A2), *WqT = WSP(bf16_t, WS_WQ), *Qb = WSP(bf16_t, WS_QB); float* rowssp = WSP(float, WS_RS);
        pg8::Gemm g{A2, WqT, MC, 2048, 1024, 1024, 1024}; pg8::StaticOrder S; S.init(MC, 2048, G, (int)blockIdx.x);
        pg8::EpiQ E{Qb, rowssp};
        pg8::gemm_phase<pg8::EpiQ, pg8::StaticOrder, true, true>(lds, g, S, E);
        SEAM(7);
    }
    if (IN(8)) {
        KARGS; bf16_t *Qb = WSP(bf16_t, WS_QB), *SK = WSP(bf16_t, WS_SK), *A2 = WSP(bf16_t, WS_A2); unsigned char *U8 = ws + WS_U8, *V8 = ws + WS_V8, *XQ = ws + WS_MB; float *suv = WSP(float, WS_SUV), *rowssp = WSP(float, WS_RS), *outp = kp_->out; bf16_t* H1B = WSP(bf16_t, WS_H1B); const float* gfin = INP(16);
        for (int grp = blockIdx.x; grp < MC / 128; grp += G) {
            const int rc0 = grp * 128;
#ifndef NO_TOPK
            peer_topk(lds, Qb, SK, rc0 + 32 * (wave >> 1), 32 * (wave >> 1), 4 * (wave & 1), lane);
#endif
#ifdef PROBE_TOPK2
            __syncthreads(); peer_topk(lds, Qb, SK, rc0 + 32 * (wave >> 1), 32 * (wave >> 1), 4 * (wave & 1), lane);
#endif
            __syncthreads();
            { const int tl0 = 16 * wave; const size_t rcw = (size_t)rc0 + tl0;
              { LAS f32x4* pz = (LAS f32x4*)(lds + PL_PA + tl0 * 512);
#pragma unroll
                for (int q = 0; q < 8; ++q) pz[lane + 64 * q] = (f32x4){0.f, 0.f, 0.f, 0.f}; }
#pragma unroll 1
              for (int i = 0; i < 16; ++i) peer_xq_token(A2, XQ, (float*)(XQ + (size_t)MC * 1024), rcw + i, lane);
              asm volatile("s_waitcnt vmcnt(0)" ::: "memory");
              { u32x4 ra[16], rb[16], xa[2], xb[2];
                peer_rows_load<true>(ra, xa, lds, tl0, rcw, 0, U8, (const bf16_t*)XQ, lane);
#pragma unroll 1
                for (int st = 0; st < 128; st += 2) {
                    peer_rows_load<true>(rb, xb, lds, tl0 + ((st + 1) & 15), rcw + ((st + 1) & 15), (st + 1) >> 4, U8, (const bf16_t*)XQ, lane);
                    __builtin_amdgcn_sched_barrier(0);
                    peer_u_math(ra, xa, lds, tl0 + (st & 15), lane);
                    { const int sn = st + 2 < 128 ? st + 2 : 127; peer_rows_load<true>(ra, xa, lds, tl0 + (sn & 15), rcw + (sn & 15), sn >> 4, U8, (const bf16_t*)XQ, lane); }
                    __builtin_amdgcn_sched_barrier(0);
                    peer_u_math(rb, xb, lds, tl0 + ((st + 1) & 15), lane); } }
#pragma unroll 1
              for (int i = 0; i < 16; ++i) peer_a_step(lds, tl0 + i, rcw + i, rowssp, suv, suv + 16384, lane);
              { u32x4 ra[16], rb[16], xd[2];
                peer_rows_load<false>(ra, xd, lds, tl0, rcw, 0, V8, A2, lane);
#pragma unroll 1
                for (int st = 0; st < 128; st += 2) {
                    peer_rows_load<false>(rb, xd, lds, tl0 + ((st + 1) & 15), rcw, (st + 1) >> 4, V8, A2, lane);
                    __builtin_amdgcn_sched_barrier(0);
                    peer_v_math(ra, lds, tl0 + (st & 15), rcw + (st & 15), st >> 4, H1B, lane);
                    { const int sn = st + 2 < 128 ? st + 2 : 127; peer_rows_load<false>(ra, xd, lds, tl0 + (sn & 15), rcw, sn >> 4, V8, A2, lane); }
                    __builtin_amdgcn_sched_barrier(0);
                    peer_v_math(rb, lds, tl0 + ((st + 1) & 15), rcw + ((st + 1) & 15), (st + 1) >> 4, H1B, lane); } }
              asm volatile("s_waitcnt vmcnt(0)" ::: "memory");
              __builtin_amdgcn_fence(__ATOMIC_ACQUIRE, "agent");
#pragma unroll 1
              for (int i = 0; i < 16; ++i) peer_f_step(lds, tl0 + i, rcw + i, H1B, outp, gfin, lane); }
            __syncthreads();
        }
    }
#undef IN
#undef SEAM
}

extern "C" void kernel_launch(void* const* d_in, const int* in_sizes, int n_in, void* d_out, int out_size, void* d_ws, size_t ws_size, hipStream_t stream) {
    static int grid = 0;
    if (grid == 0) {
        if (n_in != 17 || out_size != MC * DM || ws_size < WS_END) { fprintf(stderr, "kernel_launch: unexpected shapes: n_in %d out %d ws %zu (need %zu)\n", n_in, out_size, ws_size, (size_t)WS_END); grid = -1; return; }
        int dev = 0, cus = 0, per_cu = 0;
        if (hipGetDevice(&dev) != hipSuccess || hipDeviceGetAttribute(&cus, hipDeviceAttributeMultiprocessorCount, dev) != hipSuccess) { fprintf(stderr, "kernel_launch: device query failed\n"); grid = -1; return; }
        if (hipFuncSetAttribute((const void*)fwd_kernel, hipFuncAttributeMaxDynamicSharedMemorySize, LDS_BYTES) != hipSuccess) { fprintf(stderr, "kernel_launch: hipFuncSetAttribute failed\n"); grid = -1; return; }
        if (hipOccupancyMaxActiveBlocksPerMultiprocessor(&per_cu, (const void*)fwd_kernel, 512, LDS_BYTES) != hipSuccess || per_cu < 1) { fprintf(stderr, "kernel_launch: occupancy query says %d blocks per CU\n", per_cu); per_cu = 1; }
        (void)hipGetLastError();
        grid = cus;
        fprintf(stderr, "kernel_launch: grid %d (occupancy %d per CU)\n", grid, per_cu);
    }
    if (grid < 0) return;
    if (hipMemsetAsync((char*)d_ws + WS_CTL, 0, CTL_BYTES, stream) != hipSuccess) { fprintf(stderr, "kernel_launch: memset of the barrier words failed\n"); return; }
    Args a{};
    for (int i = 0; i < 17; ++i) a.in[i] = (const float*)d_in[i];
    a.out = (float*)d_out; a.ws = (unsigned char*)d_ws;
#if MK_ONE_LAUNCH
    a.ph_lo = 0; a.ph_hi = NPHASE;
    void* args[] = {&a};
    hipError_t e = hipLaunchCooperativeKernel((const void*)fwd_kernel, dim3(grid), dim3(512), args, LDS_BYTES, stream);
    if (e != hipSuccess) fprintf(stderr, "kernel_launch: cooperative launch failed: %s (grid %d)\n", hipGetErrorString(e), grid);
#else
#ifdef PROBE_SEQ
    const int seq[] = PROBE_SEQ;
    for (int p : seq) { a.ph_lo = p; a.ph_hi = p + 1; hipLaunchKernelGGL(fwd_kernel, dim3(grid), dim3(512), LDS_BYTES, stream, a); }
#else
    for (int p = 0; p < NPHASE; ++p) { a.ph_lo = p; a.ph_hi = p + 1; hipLaunchKernelGGL(fwd_kernel, dim3(grid), dim3(512), LDS_BYTES, stream, a); }
#endif
#endif
}
```

```cpp
#include <hip/hip_runtime.h>
#include <hip/hip_cooperative_groups.h>
#include <cstdio>
#include <cstdint>
namespace cg = cooperative_groups;

#ifndef MK_ONE_LAUNCH
#define MK_ONE_LAUNCH 1
#endif

constexpr int DM = 1024, NB = 8, SEQ = 4096, NMETA = 16, LTOK = SEQ + NMETA;
constexpr int MA_REAL = NB * LTOK;
constexpr int MA = 33024;
constexpr int MC = NB * SEQ;
constexpr int LPAD = 4224;
constexpr float EPS = 1e-6f;

namespace pg8 {
#define PG8_LAS __attribute__((address_space(3)))
typedef unsigned short bf16_t;
typedef short bf16x8 __attribute__((ext_vector_type(8)));
typedef float f32x4 __attribute__((ext_vector_type(4)));
typedef unsigned u32x4 __attribute__((ext_vector_type(4)));
constexpr int BM = 256, BK = 64, HALF = 128, HTB = HALF * BK * 2  , STAGE_BYTES = 8 * HTB, NXCD = 8, WGM = 8;

__host__ __device__ __forceinline__ int lds_byte(int r, int c) { const int st = (r >> 4) * 2 + (c >> 5), rr = r & 15, cc = c & 31, ob = rr * 64 + cc * 2; return st * 1024 + (ob ^ (((ob >> 9) & 1) << 5)); }
__host__ __device__ __forceinline__ void stage_rc(int b, int& R, int& C) { const int st = b / 1024, sb = b % 1024, swz = sb ^ (((sb >> 9) & 1) << 5); R = (st >> 1) * 16 + swz / 64; C = (st & 1) * 32 + (swz % 64) / 2; }
__host__ __device__ __forceinline__ int perm32(int rho) { const int n = rho >> 4, i = rho & 15; return 8 * (i >> 2) + 4 * n + (i & 3); }

struct Unit { int pm, pn; };
struct Gemm { const bf16_t* A; const bf16_t* Bt; int M, N, K, lda, ldb; };

struct StaticOrder {
    int nM, nN, nwg, G, c;
    __host__ __device__ void init(int M, int N, int G_, int c_) { nM = M / BM; nN = N / BM; nwg = nM * nN; G = G_; c = c_; }
    __host__ __device__ bool next(int i, Unit& u) const {
        const long L = (long)i * G + c; if (L >= nwg) return false;
        int wgid = (int)L; { const int q = nwg / NXCD, r = nwg % NXCD, xcd = wgid % NXCD, off = wgid / NXCD; wgid = (xcd < r ? xcd * (q + 1) : r * (q + 1) + (xcd - r) * q) + off; }
        const int nig = WGM * nN, gid = wgid / nig, fm = gid * WGM, gsz = (nM - fm) < WGM ? (nM - fm) : WGM;
        u.pm = fm + ((wgid % nig) % gsz); u.pn = (wgid % nig) / gsz; return true;
    }
    __device__ __forceinline__ void a_ready(const Unit&) const {}
    __device__ __forceinline__ void done(const Unit&) const {}
};

__device__ __forceinline__ unsigned cvt_pk_bf16(float lo, float hi) { unsigned r; asm volatile("v_cvt_pk_bf16_f32 %0, %1, %2" : "=v"(r) : "v"(lo), "v"(hi)); return r; }
typedef float f32x2 __attribute__((ext_vector_type(2)));
typedef float f32x2_t __attribute__((ext_vector_type(2))); typedef __bf16 bf16x2_t __attribute__((ext_vector_type(2)));
typedef unsigned u32x2 __attribute__((ext_vector_type(2)));
__device__ __forceinline__ unsigned cvtpk(float lo, float hi) { f32x2_t v = {lo, hi}; bf16x2_t b = __builtin_convertvector(v, bf16x2_t); return __builtin_bit_cast(unsigned, b); }
__device__ __forceinline__ bf16_t f2bf(float x) { return (bf16_t)(cvtpk(x, 0.f) & 0xffffu); }
__device__ __forceinline__ float bf2f(bf16_t v) { return __uint_as_float((unsigned)v << 16); }
__device__ __forceinline__ float bflo(unsigned w) { return __uint_as_float(w << 16); }
__device__ __forceinline__ float bfhi(unsigned w) { return __uint_as_float(w & 0xffff0000u); }
__device__ __forceinline__ float sigm(float x) { return __builtin_amdgcn_rcpf(1.f + __expf(-x)); }

struct EpiZ {
    static constexpr bool PERM = true, AFTER_DRAIN = false, MIDK = false;
    bf16_t *Zh, *Za, *Zg, *Vt; const float* bgate;
    __device__ __forceinline__ void operator()(const f32x4 (&acc)[2][2][4][2], const Unit& u, int wr, int wc, int fr, int fq) const {
        const int pn = u.pn; bf16_t* base; int ldc, colt;
        if (pn < 8) { base = Zh; ldc = 2048; colt = pn * 256; } else if (pn < 11) { base = Za; ldc = 768; colt = (pn - 8) * 256; } else { base = Zg; ldc = 2048; colt = (pn - 11) * 256; }
        const int row0 = u.pm * BM + wr * 64 + fr, col0 = colt + wc * 32 + 8 * fq;
#pragma unroll
        for (int ai = 0; ai < 2; ++ai)
#pragma unroll
            for (int m = 0; m < 4; ++m) { const int row = row0 + ai * HALF + m * 16; bf16_t* rowp = base + (size_t)row * ldc + col0;
#pragma unroll
                for (int bj = 0; bj < 2; ++bj) { f32x4 v0 = acc[ai][bj][m][0], v1 = acc[ai][bj][m][1];
                    if (pn >= 11) { const f32x4 b0 = *(const f32x4*)(bgate + col0 + bj * HALF), b1 = *(const f32x4*)(bgate + col0 + bj * HALF + 4);
#pragma unroll
                        for (int i = 0; i < 4; ++i) { v0[i] = sigm(v0[i] + b0[i]); v1[i] = sigm(v1[i] + b1[i]); } }
                    if (pn == 10 && bj == 1) {
                        if (row < MA_REAL) { const int b = row / LTOK, pos = row - b * LTOK; bf16_t* vp = Vt + ((size_t)(b * 128 + wc * 32 + 8 * fq) * LPAD + 112 + pos);
                            vp[0] = f2bf(v0[0]); vp[LPAD] = f2bf(v0[1]); vp[2 * LPAD] = f2bf(v0[2]); vp[3 * LPAD] = f2bf(v0[3]);
                            vp[4 * LPAD] = f2bf(v1[0]); vp[5 * LPAD] = f2bf(v1[1]); vp[6 * LPAD] = f2bf(v1[2]); vp[7 * LPAD] = f2bf(v1[3]); }
                    } else { u32x4 w; w.x = cvtpk(v0[0], v0[1]); w.y = cvtpk(v0[2], v0[3]); w.z = cvtpk(v1[0], v1[1]); w.w = cvtpk(v1[2], v1[3]); *(u32x4*)(rowp + bj * HALF) = w; } } }
    }
};
struct EpiGate {
    static constexpr bool PERM = true, AFTER_DRAIN = false, MIDK = true;
    bf16_t* Mb; const bf16_t* Zg; const float* bgate;
    __device__ __forceinline__ void mid(f32x4 (&acc)[2][2][4][2], const Unit& u, int wr, int wc, int fr, int fq) const {
        const int row0 = u.pm * BM + wr * 64 + fr, col0 = u.pn * BM + wc * 32 + 8 * fq;
#pragma unroll
        for (int bj = 0; bj < 2; ++bj)
#pragma unroll
            for (int ai = 0; ai < 2; ++ai)
#pragma unroll
                for (int m = 0; m < 4; ++m) { const int rc = row0 + ai * HALF + m * 16, ra = (rc >> 12) * LTOK + NMETA + (rc & 4095);
                    const bf16_t* zp = Zg + (size_t)ra * 2048 + col0 + bj * HALF; const u32x4 za = *(const u32x4*)zp, zb = *(const u32x4*)(zp + 1024);
                    f32x4& v0 = acc[ai][bj][m][0]; f32x4& v1 = acc[ai][bj][m][1];
                    v0[0] *= bflo(za.x) * __builtin_amdgcn_rcpf(bflo(zb.x)); v0[1] *= bfhi(za.x) * __builtin_amdgcn_rcpf(bfhi(zb.x)); v0[2] *= bflo(za.y) * __builtin_amdgcn_rcpf(bflo(zb.y)); v0[3] *= bfhi(za.y) * __builtin_amdgcn_rcpf(bfhi(zb.y));
                    v1[0] *= bflo(za.z) * __builtin_amdgcn_rcpf(bflo(zb.z)); v1[1] *= bfhi(za.z) * __builtin_amdgcn_rcpf(bfhi(zb.z)); v1[2] *= bflo(za.w) * __builtin_amdgcn_rcpf(bflo(zb.w)); v1[3] *= bfhi(za.w) * __builtin_amdgcn_rcpf(bfhi(zb.w));
                    asm volatile("" ::: "memory"); }
    }
    __device__ __forceinline__ void operator()(const f32x4 (&acc)[2][2][4][2], const Unit& u, int wr, int wc, int fr, int fq) const {
        const int row0 = u.pm * BM + wr * 64 + fr, col0 = u.pn * BM + wc * 32 + 8 * fq;
#pragma unroll
        for (int ai = 0; ai < 2; ++ai)
#pragma unroll
            for (int m = 0; m < 4; ++m) { const int rc = row0 + ai * HALF + m * 16, ra = (rc >> 12) * LTOK + NMETA + (rc & 4095);
                const bf16_t* zp = Zg + (size_t)ra * 2048 + 1024 + col0; bf16_t* mp = Mb + (size_t)rc * 1024 + col0;
#pragma unroll
                for (int bj = 0; bj < 2; ++bj) { const u32x4 z = *(const u32x4*)(zp + bj * HALF); f32x4 v0 = acc[ai][bj][m][0], v1 = acc[ai][bj][m][1];
                    v0[0] *= bflo(z.x); v0[1] *= bfhi(z.x); v0[2] *= bflo(z.y); v0[3] *= bfhi(z.y); v1[0] *= bflo(z.z); v1[1] *= bfhi(z.z); v1[2] *= bflo(z.w); v1[3] *= bfhi(z.w);
                    u32x4 w; w.x = cvtpk(v0[0], v0[1]); w.y = cvtpk(v0[2], v0[3]); w.z = cvtpk(v1[0], v1[1]); w.w = cvtpk(v1[2], v1[3]); *(u32x4*)(mp + bj * HALF) = w; } }
    }
};
struct EpiH1 {
    static constexpr bool PERM = false, AFTER_DRAIN = false, MIDK = false;
    const float* x; bf16_t* h1; float* rowssp;
    __device__ __forceinline__ void operator()(const f32x4 (&acc)[2][2][4][2], const Unit& u, int wr, int wc, int fr, int fq) const {
        const int row0 = u.pm * BM + wr * 64 + fr, col0 = u.pn * BM + wc * 32 + 4 * fq;
#pragma unroll
        for (int ai = 0; ai < 2; ++ai)
#pragma unroll
            for (int m = 0; m < 4; ++m) { const int rc = row0 + ai * HALF + m * 16; float ss = 0.f;
#pragma unroll
                for (int bj = 0; bj < 2; ++bj)
#pragma unroll
                    for (int n = 0; n < 2; ++n) { const size_t off = (size_t)rc * 1024 + col0 + bj * HALF + n * 16;
                        const f32x4 h = *(const f32x4*)(x + off) + acc[ai][bj][m][n]; { u32x2 hw; hw.x = cvtpk(h[0], h[1]); hw.y = cvtpk(h[2], h[3]); *(u32x2*)(h1 + off) = hw; }
                        ss += (h[0] * h[0] + h[1] * h[1]) + (h[2] * h[2] + h[3] * h[3]);
}
                ss += __shfl_xor(ss, 16); ss += __shfl_xor(ss, 32);
                if (fq == 0) rowssp[(size_t)rc * 16 + u.pn * 4 + wc] = ss; }
    }
};
struct EpiQ {
    static constexpr bool PERM = true, AFTER_DRAIN = false, MIDK = false;
    bf16_t* Q;
    __device__ __forceinline__ void operator()(const f32x4 (&acc)[2][2][4][2], const Unit& u, int wr, int wc, int fr, int fq) const {
        const int row0 = u.pm * BM + wr * 64 + fr, col0 = u.pn * BM + wc * 32 + 8 * fq;
#pragma unroll
        for (int ai = 0; ai < 2; ++ai)
#pragma unroll
            for (int m = 0; m < 4; ++m) { const int rc = row0 + ai * HALF + m * 16;
#pragma unroll
                for (int bj = 0; bj < 2; ++bj) { const f32x4 v0 = acc[ai][bj][m][0], v1 = acc[ai][bj][m][1];
                    u32x4 w; w.x = cvtpk(v0[0], v0[1]); w.y = cvtpk(v0[2], v0[3]); w.z = cvtpk(v1[0], v1[1]); w.w = cvtpk(v1[2], v1[3]);
                    const int col = col0 + bj * HALF;
                    *(u32x4*)(Q + ((size_t)((((rc >> 5) * 8 + (col >> 8)) * 2 + ((col >> 7) & 1)) * 8 + ((col & 127) >> 4)) * 64 + ((col >> 3) & 1) * 32 + (rc & 31)) * 8) = w; } }
    }
};
template <class Epi, class Sched, bool ALIGN_EPI = false, bool SP2 = false>
__device__ __forceinline__ void gemm_phase(PG8_LAS unsigned char* lds, const Gemm g, const Sched& S, const Epi& E) {
    const int tid = threadIdx.x, wid = __builtin_amdgcn_readfirstlane(tid >> 6), lane = tid & 63, wr = wid >> 2, wc = wid & 3, fr = lane & 15, fq = lane >> 4;
    const int K = g.K, nt = K / BK;
    unsigned voffA[2], voffB[2];
#pragma unroll
    for (int i = 0; i < 2; ++i) { int R, C; stage_rc(tid * 16 + i * 8192, R, C); const int Rb = Epi::PERM ? ((R & ~31) + perm32(R & 31)) : R;
        voffA[i] = (unsigned)(R * g.lda + C) * 2u; voffB[i] = (unsigned)(Rb * g.ldb + C) * 2u; }
    const size_t kstep = (size_t)(BK * 2);
    const size_t hstepA = (size_t)HALF * g.lda * 2, hstepB = (size_t)HALF * g.ldb * 2;
    const size_t tstepA = 2 * hstepA, tstepB = 2 * hstepB;
    const unsigned ldsw = (unsigned)wid * 1024u;
    const int aoff = lds_byte(wr * 64 + fr, fq * 8), boff = lds_byte(wc * 32 + fr, fq * 8);
#define PG8_SA(b, h) (((b) * 2 + (h)) * HTB)
#define PG8_SB(b, h) ((4 + (b) * 2 + (h)) * HTB)
#define PG8_STAGE(bufoff, gbase, voff) do { _Pragma("unroll") for (int _i = 0; _i < 2; ++_i) \
        __builtin_amdgcn_global_load_lds((const unsigned*)((const char*)(gbase) + (voff)[_i]), (PG8_LAS unsigned*)(lds + (bufoff) + ldsw + _i * 8192), 16, 0, 0); } while (0)
#define PG8_LDA(dst, b, h) do { _Pragma("unroll") for (int m = 0; m < 4; ++m) _Pragma("unroll") for (int k = 0; k < 2; ++k) dst[m][k] = *(const PG8_LAS bf16x8*)(lds + PG8_SA(b, h) + aoff + m * 2048 + k * 1024); } while (0)
#define PG8_LDB(dst, b, h) do { _Pragma("unroll") for (int n = 0; n < 2; ++n) _Pragma("unroll") for (int k = 0; k < 2; ++k) dst[n][k] = *(const PG8_LAS bf16x8*)(lds + PG8_SB(b, h) + boff + n * 2048 + k * 1024); } while (0)
#define PG8_MMA(ai, bj, At, Bt) do { __builtin_amdgcn_s_setprio(1); _Pragma("unroll") for (int m = 0; m < 4; ++m) _Pragma("unroll") for (int n = 0; n < 2; ++n) _Pragma("unroll") for (int k = 0; k < 2; ++k) \
        acc[ai][bj][m][n] = __builtin_amdgcn_mfma_f32_16x16x32_bf16(Bt[n][k], At[m][k], acc[ai][bj][m][n], 0, 0, 0); __builtin_amdgcn_s_setprio(0); } while (0)
#define PG8_WAIT_V(n) asm volatile("s_waitcnt vmcnt(" #n ")" ::: "memory")
#define PG8_WAIT_L(n) asm volatile("s_waitcnt lgkmcnt(" #n ")" ::: "memory")
#define PG8_BAR __builtin_amdgcn_s_barrier()
#define PG8_SCHED __builtin_amdgcn_sched_barrier(0)
    Unit cur, nxt; int ui = 0;
    if (!S.next(0, cur)) return;
    f32x4 acc[2][2][4][2];
#pragma unroll
    for (int a = 0; a < 2; ++a)
#pragma unroll
        for (int b = 0; b < 2; ++b)
#pragma unroll
            for (int m = 0; m < 4; ++m)
#pragma unroll
                for (int n = 0; n < 2; ++n) acc[a][b][m][n] = (f32x4){0.f, 0.f, 0.f, 0.f};
    bf16x8 At[4][2], B0[2][2], B1[2][2];
    const char* cA = (const char*)g.A + (size_t)cur.pm * tstepA; const char* cB = (const char*)g.Bt + (size_t)cur.pn * tstepB;
    S.a_ready(cur);
    if constexpr (SP2) {
        PG8_STAGE(PG8_SB(0, 0), cB, voffB); PG8_STAGE(PG8_SB(0, 1), cB + hstepB, voffB); PG8_STAGE(PG8_SA(0, 0), cA, voffA); PG8_STAGE(PG8_SA(0, 1), cA + hstepA, voffA);
        if (wr == 1) PG8_BAR;
        PG8_WAIT_V(2); PG8_BAR;
        PG8_STAGE(PG8_SB(1, 0), cB + kstep, voffB); PG8_STAGE(PG8_SA(1, 0), cA + kstep, voffA); PG8_STAGE(PG8_SB(1, 1), cB + hstepB + kstep, voffB);
        PG8_WAIT_V(6); PG8_BAR;
    } else {
        PG8_STAGE(PG8_SB(0, 0), cB, voffB); PG8_STAGE(PG8_SA(0, 0), cA, voffA); PG8_STAGE(PG8_SB(0, 1), cB + hstepB, voffB); PG8_STAGE(PG8_SA(0, 1), cA + hstepA, voffA);
        if (wr == 1) PG8_BAR;
        PG8_WAIT_V(4); PG8_BAR;
        PG8_STAGE(PG8_SB(1, 0), cB + kstep, voffB); PG8_STAGE(PG8_SA(1, 0), cA + kstep, voffA); PG8_STAGE(PG8_SB(1, 1), cB + hstepB + kstep, voffB);
        PG8_WAIT_V(6); PG8_BAR;
    }
    for (;;) {
        const bool has_next = S.next(ui + 1, nxt);
        const char* nA = has_next ? (const char*)g.A + (size_t)nxt.pm * tstepA : cA; const char* nB = has_next ? (const char*)g.Bt + (size_t)nxt.pn * tstepB : cB;
        for (int t = 0; t < nt; t += 2) {
            if constexpr (Epi::MIDK) { if (t == (nt >> 1)) { PG8_SCHED; E.mid(acc, cur, wr, wc, fr, fq); PG8_SCHED; } }
            const bool last = (t == nt - 2);
            const char* a1 = cA + (size_t)(t + 1) * kstep;
            const char* a2 = last ? nA : cA + (size_t)(t + 2) * kstep; const char* b2 = last ? nB : cB + (size_t)(t + 2) * kstep;
            const char* a3 = a2 + kstep; const char* b3 = b2 + kstep;
            if (last && has_next) S.a_ready(nxt);
            if constexpr (SP2) {
            PG8_LDB(B0, 0, 0); PG8_LDB(B1, 0, 1); PG8_SCHED; PG8_LDA(At, 0, 0); PG8_STAGE(PG8_SA(1, 1), a1 + hstepA, voffA);
            PG8_WAIT_V(8); PG8_WAIT_L(0); PG8_BAR; PG8_MMA(0, 0, At, B0); PG8_MMA(0, 1, At, B1); PG8_BAR; PG8_SCHED;
            PG8_LDA(At, 0, 1); PG8_STAGE(PG8_SB(0, 0), b2, voffB); PG8_STAGE(PG8_SB(0, 1), b2 + hstepB, voffB); PG8_STAGE(PG8_SA(0, 0), a2, voffA);
            PG8_WAIT_V(8); PG8_WAIT_L(0); PG8_BAR; PG8_MMA(1, 0, At, B0); PG8_MMA(1, 1, At, B1); PG8_BAR; PG8_SCHED;
            PG8_LDB(B0, 1, 0); PG8_LDB(B1, 1, 1); PG8_SCHED; PG8_LDA(At, 1, 0); PG8_STAGE(PG8_SA(0, 1), a2 + hstepA, voffA);
            PG8_WAIT_V(8); PG8_WAIT_L(0); PG8_BAR; PG8_MMA(0, 0, At, B0); PG8_MMA(0, 1, At, B1); PG8_BAR; PG8_SCHED;
            PG8_LDA(At, 1, 1); PG8_STAGE(PG8_SB(1, 0), b3, voffB); PG8_STAGE(PG8_SB(1, 1), b3 + hstepB, voffB); PG8_STAGE(PG8_SA(1, 0), a3, voffA);
            PG8_WAIT_V(8); PG8_WAIT_L(0); PG8_BAR; PG8_MMA(1, 0, At, B0); PG8_MMA(1, 1, At, B1); PG8_BAR; PG8_SCHED;
            } else {
            PG8_LDB(B0, 0, 0); PG8_SCHED; PG8_LDA(At, 0, 0); PG8_STAGE(PG8_SA(1, 1), a1 + hstepA, voffA);
            PG8_WAIT_L(8); PG8_BAR; PG8_WAIT_L(0); PG8_MMA(0, 0, At, B0); PG8_BAR; PG8_SCHED;
            PG8_LDB(B1, 0, 1); PG8_STAGE(PG8_SB(0, 0), b2, voffB);
            PG8_BAR; PG8_WAIT_L(0); PG8_MMA(0, 1, At, B1); PG8_BAR;
            PG8_LDA(At, 0, 1); PG8_STAGE(PG8_SA(0, 0), a2, voffA);
            PG8_BAR; PG8_WAIT_L(0); PG8_MMA(1, 0, At, B0); PG8_BAR; PG8_SCHED;
            PG8_STAGE(PG8_SB(0, 1), b2 + hstepB, voffB);
            PG8_WAIT_V(6); PG8_BAR; PG8_MMA(1, 1, At, B1); PG8_BAR;
            PG8_LDB(B0, 1, 0); PG8_SCHED; PG8_LDA(At, 1, 0); PG8_STAGE(PG8_SA(0, 1), a2 + hstepA, voffA);
            PG8_WAIT_L(8); PG8_BAR; PG8_WAIT_L(0); PG8_MMA(0, 0, At, B0); PG8_BAR; PG8_SCHED;
            PG8_LDB(B1, 1, 1); PG8_STAGE(PG8_SB(1, 0), b3, voffB);
            PG8_BAR; PG8_WAIT_L(0); PG8_MMA(0, 1, At, B1); PG8_BAR;
            PG8_LDA(At, 1, 1); PG8_STAGE(PG8_SA(1, 0), a3, voffA);
            PG8_BAR; PG8_WAIT_L(0); PG8_MMA(1, 0, At, B0); PG8_BAR; PG8_SCHED;
            PG8_STAGE(PG8_SB(1, 1), b3 + hstepB, voffB);
            PG8_WAIT_V(6); PG8_BAR; PG8_MMA(1, 1, At, B1); PG8_BAR;
            }
        }
        if constexpr (ALIGN_EPI) { if (wr == 0) PG8_BAR; }
        if constexpr (!Epi::AFTER_DRAIN) { E(acc, cur, wr, wc, fr, fq); S.done(cur); }
        if (!has_next) break;
#pragma unroll
        for (int a = 0; a < 2; ++a)
#pragma unroll
            for (int b = 0; b < 2; ++b)
#pragma unroll
                for (int m = 0; m < 4; ++m)
#pragma unroll
                    for (int n = 0; n < 2; ++n) acc[a][b][m][n] = (f32x4){0.f, 0.f, 0.f, 0.f};
        cur = nxt; cA = nA; cB = nB; ++ui;
        if constexpr (ALIGN_EPI) { if (wr == 1) PG8_BAR; }
    }
    PG8_WAIT_V(0);
    if constexpr (!ALIGN_EPI) { if (wr == 0) PG8_BAR; }
    PG8_BAR;
    if constexpr (Epi::AFTER_DRAIN) { E.fused(acc, cur, wr, wc, fr, fq, lds, wid, lane); S.done(cur); }
#undef PG8_SA
#undef PG8_SB
#undef PG8_STAGE
#undef PG8_LDA
#undef PG8_LDB
#undef PG8_MMA
#undef PG8_WAIT_V
#undef PG8_WAIT_L
#undef PG8_BAR
#undef PG8_SCHED
}
}
using pg8::bf16_t; using pg8::bf16x8; using pg8::f32x4; using pg8::u32x4; using pg8::u32x2; using pg8::cvtpk; using pg8::f2bf; using pg8::bf2f; using pg8::bflo; using pg8::bfhi; using pg8::sigm;
#define LAS __attribute__((address_space(3)))
typedef float f32x16 __attribute__((ext_vector_type(16)));
#define MFMA32(a, b, c) __builtin_amdgcn_mfma_f32_32x32x16_bf16((a), (b), (c), 0, 0, 0)

constexpr size_t MiB = 1u << 20;
constexpr size_t WS_ZH = 0;
constexpr size_t WS_H1B = 372 * MiB;
constexpr size_t WS_MB = WS_ZH, WS_U8 = WS_ZH + 64 * MiB, WS_V8 = WS_ZH + 80 * MiB, WS_SUV = WS_ZH + 96 * MiB;
constexpr size_t WS_ZA = 129 * MiB;
constexpr size_t WS_ZG = 178 * MiB;
constexpr size_t WS_QB = WS_ZG;
constexpr size_t WS_A1 = 307 * MiB;
constexpr size_t WS_OM = WS_A1, WS_A2 = WS_A1;
constexpr size_t WS_UB = 372 * MiB;
constexpr size_t WS_DV = 436 * MiB;
constexpr size_t WS_VT = 437 * MiB;
constexpr size_t WS_WIN = 446 * MiB;
constexpr size_t WS_WBH = 456 * MiB, WS_WBA = 457 * MiB, WS_WOUT = 458 * MiB, WS_WQ = 460 * MiB, WS_SK = 464 * MiB;
constexpr size_t WS_RS = 465 * MiB;
constexpr size_t WS_CTL = 467 * MiB, CTL_BYTES = 16384;
constexpr size_t WS_END = 468 * MiB;
constexpr int LDS_BYTES = 151552;

__device__ __forceinline__ float wave_sum(float v) {
#pragma unroll
    for (int o = 1; o < 64; o <<= 1) v += __shfl_xor(v, o);
    return v;
}
__device__ __forceinline__ void p0_transpose_item(const float* __restrict__ W, int K, int N, bf16_t* __restrict__ WT, LAS float* scr, int item, int lane, int ldw = 0, const float* __restrict__ kscale = nullptr) {
    if (ldw == 0) ldw = K;
    const int nblk = N / 32, kb = item / nblk, nb = item % nblk, k0 = 64 * kb, n0 = 32 * nb;
#pragma unroll 8
    for (int i = 0; i < 32; ++i) { const int kk = 2 * i + (lane >> 5); scr[kk * 33 + (lane & 31)] = W[(size_t)(k0 + kk) * N + n0 + (lane & 31)] * (kscale ? kscale[k0 + kk] : 1.f); }
    asm volatile("s_waitcnt lgkmcnt(0)" ::: "memory");
    const int c = lane & 7;
#pragma unroll
    for (int j = 0; j < 4; ++j) { const int n = (lane >> 3) + 8 * j; const LAS float* s = scr + (8 * c) * 33 + n;
        u32x4 o; o.x = cvtpk(s[0 * 33], s[1 * 33]); o.y = cvtpk(s[2 * 33], s[3 * 33]); o.z = cvtpk(s[4 * 33], s[5 * 33]); o.w = cvtpk(s[6 * 33], s[7 * 33]);
        *(u32x4*)(WT + (size_t)(n0 + n) * ldw + k0 + 8 * c) = o; }
    asm volatile("s_waitcnt lgkmcnt(0)" ::: "memory");
}
struct P0Args { const float *x, *meta, *gmix, *w_in, *w_bh, *w_ba, *w_out, *w_q, *subk, *gffn; bf16_t *A1, *WinT, *WbhT, *WbaT, *WoutT, *WqT, *SK; };
__device__ __forceinline__ void p0_prologue(LAS unsigned char* lds, const P0Args& p) {
    const int tid = threadIdx.x, lane = tid & 63, wave = tid >> 6;
    LAS float* scr = (LAS float*)(lds + wave * 16384);
    const int gw = blockIdx.x * 8 + wave, NGW = gridDim.x * 8;
    constexpr int I_IN = 16 * 152, I_B = 8 * 32, I_O = 16 * 32, I_Q = 16 * 64, NITEMS = I_IN + 2 * I_B + I_O + I_Q;
    for (int it = gw; it < NITEMS; it += NGW) {
        int r = it;
        if (r < I_IN) { p0_transpose_item(p.w_in, 1024, 4864, p.WinT, scr, r, lane); continue; } r -= I_IN;
        if (r < I_B) { p0_transpose_item(p.w_bh, 512, 1024, p.WbhT, scr, r, lane, 1024); continue; } r -= I_B;
        if (r < I_B) { p0_transpose_item(p.w_ba, 512, 1024, p.WbhT + 512, scr, r, lane, 1024); continue; } r -= I_B;
        if (r < I_O) { p0_transpose_item(p.w_out, 1024, 1024, p.WoutT, scr, r, lane); continue; } r -= I_O;
        p0_transpose_item(p.w_q, 1024, 2048, p.WqT, scr, r, lane, 0, p.gffn);
    }
    for (int p_ = blockIdx.x * 512 + tid; p_ < 262144 / 8; p_ += gridDim.x * 512) {
        const int ln = p_ & 63, kk = (p_ >> 6) & 7, nb = (p_ >> 9) & 3, hc = p_ >> 11;
        const float* src = p.subk + (size_t)(hc * 128 + 32 * nb + (ln & 31)) * 128 + 16 * kk + 8 * (ln >> 5);
        const f32x4 a = *(const f32x4*)src, b = *(const f32x4*)(src + 4);
        u32x4 o; o.x = cvtpk(a[0], a[1]); o.y = cvtpk(a[2], a[3]); o.z = cvtpk(b[0], b[1]); o.w = cvtpk(b[2], b[3]); *(u32x4*)(p.SK + (size_t)p_ * 8) = o; }
    f32x4 g[4];
#pragma unroll
    for (int j = 0; j < 4; ++j) g[j] = *((const f32x4*)p.gmix + lane + 64 * j);
    for (int m0 = gw; m0 < MA; m0 += 4 * NGW) {
        f32x4 v[4][4];
#pragma unroll
        for (int r = 0; r < 4; ++r) { const int m = m0 + r * NGW;
            if (m < MA_REAL) { const int b = m / LTOK, pos = m - b * LTOK;
                const float* src = pos < NMETA ? p.meta + (size_t)pos * 1024 : p.x + ((size_t)b * SEQ + (pos - NMETA)) * 1024;
                const f32x4* xr = (const f32x4*)src + lane;
#pragma unroll
                for (int j = 0; j < 4; ++j) v[r][j] = xr[64 * j]; }
            else {
#pragma unroll
                for (int j = 0; j < 4; ++j) v[r][j] = (f32x4){0.f, 0.f, 0.f, 0.f}; } }
#pragma unroll
        for (int r = 0; r < 4; ++r) { const int m = m0 + r * NGW;
            if (m < MA) { float s = 0.f;
#pragma unroll
                for (int j = 0; j < 4; ++j) s += (v[r][j][0] * v[r][j][0] + v[r][j][1] * v[r][j][1]) + (v[r][j][2] * v[r][j][2] + v[r][j][3] * v[r][j][3]);
                const float rstd = __builtin_amdgcn_rsqf(wave_sum(s) * (1.f / 1024.f) + EPS);
                unsigned long long* o8 = (unsigned long long*)(p.A1 + (size_t)m * 1024) + lane;
#pragma unroll
                for (int j = 0; j < 4; ++j) { const f32x4 y = v[r][j] * rstd * g[j]; o8[64 * j] = (unsigned long long)cvtpk(y[0], y[1]) | ((unsigned long long)cvtpk(y[2], y[3]) << 32); } } }
    }
}

constexpr int SR = 272;
constexpr int OFF_Q = 0, OFF_K = 34816, OFF_V = 69632, OFF_S = 104448, OFF_VEC = 139264;
__device__ __forceinline__ bf16x8 ldfrag(const LAS unsigned char* base, int row, int kk8, int h2) { return *(const LAS bf16x8*)(base + row * SR + (kk8 * 16 + 8 * h2) * 2); }

constexpr int OFF_SEGP = OFF_VEC, OFF_VEC2 = OFF_VEC + 8192, OFF_SSQ = OFF_VEC2 + 1024;
template <bool WITH_Q>
__device__ __forceinline__ void hgrn_front(LAS unsigned char* lds, const bf16_t* __restrict__ Zh, const float* __restrict__ lblog, int b, int h, int c, float (&g)[8][4], float (&kk)[8][4], float (&qq)[8][4], u32x2 (&vraw)[8]) {
    const int tid = threadIdx.x, c4 = tid & 31, seg = tid >> 5;
    const f32x4 l0 = *(const f32x4*)(lblog + h * 128 + 4 * c4), l1 = *(const f32x4*)(lblog + 512 + h * 128 + 4 * c4);
    float lb[4], run[4];
#pragma unroll
    for (int k = 0; k < 4; ++k) { lb[k] = sigm(l0[k] - l1[k]); run[k] = 1.f; }
    u32x2 hfw[8], hqw[8];
#pragma unroll
    for (int i = 0; i < 8; ++i) { const int pos = 128 * c - 112 + 8 * seg + i; const bool valid = pos >= 0;
        const bf16_t* zr = Zh + (size_t)(b * LTOK + (valid ? pos : 0)) * 2048 + h * 128 + 4 * c4;
        hfw[i] = *(const u32x2*)(zr + 512); if (WITH_Q) hqw[i] = *(const u32x2*)zr; vraw[i] = *(const u32x2*)(zr + 1024);
        if (!valid) { hfw[i] = (u32x2){0x7f007f00u, 0x7f007f00u}; hqw[i] = (u32x2){0u, 0u}; vraw[i] = (u32x2){0u, 0u}; } }
#pragma unroll
    for (int i = 0; i < 8; ++i) {
        const float hf[4] = {bflo(hfw[i].x), bfhi(hfw[i].x), bflo(hfw[i].y), bfhi(hfw[i].y)};
#pragma unroll
        for (int k = 0; k < 4; ++k) { const float sg = sigm(hf[k]); const float f = lb[k] + (1.f - lb[k]) * sg; kk[i][k] = (1.f - lb[k]) * (1.f - sg); run[k] *= f; g[i][k] = run[k]; }
        if (WITH_Q) { qq[i][0] = bflo(hqw[i].x); qq[i][1] = bfhi(hqw[i].x); qq[i][2] = bflo(hqw[i].y); qq[i][3] = bfhi(hqw[i].y); } }
    *(LAS f32x4*)(lds + OFF_SEGP + (seg * 128 + 4 * c4) * 4) = (f32x4){run[0], run[1], run[2], run[3]};
    __syncthreads();
}
__device__ __forceinline__ void hgrn_base(LAS unsigned char* lds, float (&base)[4]) {
    const int tid = threadIdx.x, c4 = tid & 31, seg = tid >> 5;
    const LAS f32x4* sp = (const LAS f32x4*)(lds + OFF_SEGP) + c4;
    f32x4 p = (f32x4){1.f, 1.f, 1.f, 1.f};
    if (seg < 8) { for (int s = seg; s < 8; ++s) p *= sp[s * 32];
        if (seg == 0) *(LAS f32x4*)(lds + OFF_VEC2 + (4 * c4) * 4) = p;
#pragma unroll
        for (int k = 0; k < 4; ++k) base[k] = __builtin_amdgcn_rcpf(p[k]); }
    else { for (int s = 8; s < seg; ++s) p *= sp[s * 32];
        if (seg == 15) *(LAS f32x4*)(lds + OFF_VEC2 + (128 + 4 * c4) * 4) = p * sp[15 * 32];
#pragma unroll
        for (int k = 0; k < 4; ++k) base[k] = p[k]; }
}
__device__ __forceinline__ void hgrn_put_vt(LAS unsigned char* lds, const u32x2 (&vraw)[8], int c4, int seg) {
#pragma unroll
    for (int k = 0; k < 4; ++k) { unsigned e[8];
#pragma unroll
        for (int i = 0; i < 8; ++i) { const unsigned w = (k < 2) ? vraw[i].x : vraw[i].y; e[i] = (k & 1) ? (w >> 16) : (w & 0xffffu); }
        *(LAS u32x4*)(lds + OFF_V + (4 * c4 + k) * SR + seg * 16) = (u32x4){e[0] | (e[1] << 16), e[2] | (e[3] << 16), e[4] | (e[5] << 16), e[6] | (e[7] << 16)}; }
}

__device__ __forceinline__ void hgrn_A(LAS unsigned char* lds, const bf16_t* __restrict__ Zh, const float* __restrict__ lblog, float* __restrict__ Ub, float* __restrict__ Dv, int item) {
    const int tid = threadIdx.x, lane = tid & 63, wid = tid >> 6, r32 = lane & 31, h2 = lane >> 5;
    const int c = item & 31, bh = item >> 5, b = bh >> 2, h = bh & 3;
    const int c4 = tid & 31, seg = tid >> 5;
    float g[8][4], kk[8][4], qq[8][4]; u32x2 vraw[8];
    hgrn_front<false>(lds, Zh, lblog, b, h, c, g, kk, qq, vraw);
    { float base[4]; hgrn_base(lds, base);
#pragma unroll
      for (int k = 0; k < 4; ++k) { float kt[8];
#pragma unroll
          for (int i = 0; i < 8; ++i) kt[i] = kk[i][k] * __builtin_amdgcn_rcpf(base[k] * g[i][k]);
          *(LAS u32x4*)(lds + OFF_K + (4 * c4 + k) * SR + seg * 16) = (u32x4){cvtpk(kt[0], kt[1]), cvtpk(kt[2], kt[3]), cvtpk(kt[4], kt[5]), cvtpk(kt[6], kt[7])}; }
      hgrn_put_vt(lds, vraw, c4, seg); }
    __syncthreads();
    const int e0 = 32 * (wid >> 1), d0 = 64 * (wid & 1);
    f32x16 acc[2]; acc[0] = f32x16{}; acc[1] = f32x16{};
#pragma unroll
    for (int k8 = 0; k8 < 8; ++k8) { const bf16x8 a = ldfrag(lds + OFF_V, e0 + r32, k8, h2);
#pragma unroll
        for (int j = 0; j < 2; ++j) acc[j] = MFMA32(a, ldfrag(lds + OFF_K, d0 + 32 * j + r32, k8, h2), acc[j]); }
    const LAS float* vec2 = (const LAS float*)(lds + OFF_VEC2);
#pragma unroll
    for (int j = 0; j < 2; ++j) { const int dc = d0 + 32 * j + r32; const float sc = vec2[128 + dc];
        float* up = Ub + ((size_t)item * 128 + e0 + 4 * h2) * 128 + dc;
#pragma unroll
        for (int r = 0; r < 16; ++r) up[(size_t)((r & 3) + 8 * (r >> 2)) * 128] = acc[j][r] * sc; }
    if (tid < 128) Dv[(size_t)item * 128 + tid] = vec2[tid] * vec2[128 + tid];
    __syncthreads();
}

__device__ __forceinline__ void hgrn_C(LAS unsigned char* lds, const bf16_t* __restrict__ Zh, const float* __restrict__ lblog, const float* __restrict__ Ub, const float* __restrict__ hgn, bf16_t* __restrict__ OM, int item) {
    const int tid = threadIdx.x, lane = tid & 63, wid = tid >> 6, r32 = lane & 31, h2 = lane >> 5;
    const int c = (item & 31) + 1, bh = item >> 5, b = bh >> 2, h = bh & 3;
    const int c4 = tid & 31, seg = tid >> 5;
    const int tb = wid >> 1, wh = wid & 1;
    f32x4 sreg[8];
    { const float* sp = Ub + (size_t)item * 16384;
#pragma unroll
      for (int q = 0; q < 8; ++q) sreg[q] = *(const f32x4*)(sp + (size_t)(tid + 512 * q) * 4); }
    const size_t rc = (size_t)b * SEQ + 128 * (c - 1) + 32 * tb + r32, ra = (size_t)b * LTOK + 128 * c - 112 + 32 * tb + r32;
    u32x2 gate[2][4];
#pragma unroll
    for (int j = 0; j < 2; ++j)
#pragma unroll
        for (int gq = 0; gq < 4; ++gq) gate[j][gq] = *(const u32x2*)(Zh + ra * 2048 + 1536 + h * 128 + 64 * wh + 32 * j + 8 * gq + 4 * h2);
    float g[8][4], kk[8][4], qq[8][4]; u32x2 vraw[8];
    hgrn_front<true>(lds, Zh, lblog, b, h, c, g, kk, qq, vraw);
    { float base[4]; hgrn_base(lds, base);
#pragma unroll
      for (int i = 0; i < 8; ++i) { float r[4], ri[4];
#pragma unroll
          for (int k = 0; k < 4; ++k) { r[k] = base[k] * g[i][k]; ri[k] = __builtin_amdgcn_rcpf(r[k]); }
          const int t = 8 * seg + i;
          *(LAS u32x2*)(lds + OFF_Q + t * SR + 8 * c4) = (u32x2){cvtpk(qq[i][0] * r[0], qq[i][1] * r[1]), cvtpk(qq[i][2] * r[2], qq[i][3] * r[3])};
          *(LAS u32x2*)(lds + OFF_K + t * SR + 8 * c4) = (u32x2){cvtpk(kk[i][0] * ri[0], kk[i][1] * ri[1]), cvtpk(kk[i][2] * ri[2], kk[i][3] * ri[3])}; }
      hgrn_put_vt(lds, vraw, c4, seg); }
    __syncthreads();
    { const LAS float* vec2 = (const LAS float*)(lds + OFF_VEC2);
#pragma unroll
      for (int q = 0; q < 8; ++q) { const int idx = tid + 512 * q, e = idx >> 5, d4 = (idx & 31) * 4; const f32x4 pr = *(const LAS f32x4*)(vec2 + d4); const f32x4 sv = sreg[q] * pr;
          *(LAS u32x2*)(lds + OFF_S + e * SR + d4 * 2) = (u32x2){cvtpk(sv[0], sv[1]), cvtpk(sv[2], sv[3])}; } }
    f32x16 sc[2]; sc[0] = f32x16{}; sc[1] = f32x16{};
#pragma unroll
    for (int j = 0; j < 2; ++j) { const int sb = 2 * wh + j;
        if (sb <= tb) {
#pragma unroll
            for (int k8 = 0; k8 < 8; ++k8) sc[j] = MFMA32(ldfrag(lds + OFF_K, 32 * sb + r32, k8, h2), ldfrag(lds + OFF_Q, 32 * tb + r32, k8, h2), sc[j]); } }
    __syncthreads();
    { const int t = 32 * tb + r32;
#pragma unroll
      for (int j = 0; j < 2; ++j) { const int sb = 2 * wh + j;
#pragma unroll
          for (int gq = 0; gq < 4; ++gq) { const int s0 = 32 * sb + 8 * gq + 4 * h2;
              const float p0 = (sb <= tb && s0 + 0 <= t) ? sc[j][4 * gq + 0] : 0.f, p1 = (sb <= tb && s0 + 1 <= t) ? sc[j][4 * gq + 1] : 0.f;
              const float p2 = (sb <= tb && s0 + 2 <= t) ? sc[j][4 * gq + 2] : 0.f, p3 = (sb <= tb && s0 + 3 <= t) ? sc[j][4 * gq + 3] : 0.f;
              u32x2 w; w.x = cvtpk(p0, p1); w.y = cvtpk(p2, p3); *(LAS u32x2*)(lds + OFF_K + t * SR + s0 * 2) = w; } } }
    __syncthreads();
    f32x16 oc[2]; oc[0] = f32x16{}; oc[1] = f32x16{};
    for (int k8 = 0; k8 < 2 * (tb + 1); ++k8) { const bf16x8 pb = ldfrag(lds + OFF_K, 32 * tb + r32, k8, h2);
#pragma unroll
        for (int j = 0; j < 2; ++j) oc[j] = MFMA32(ldfrag(lds + OFF_V, 64 * wh + 32 * j + r32, k8, h2), pb, oc[j]); }
#pragma unroll
    for (int k8 = 0; k8 < 8; ++k8) { const bf16x8 qb = ldfrag(lds + OFF_Q, 32 * tb + r32, k8, h2);
#pragma unroll
        for (int j = 0; j < 2; ++j) oc[j] = MFMA32(ldfrag(lds + OFF_S, 64 * wh + 32 * j + r32, k8, h2), qb, oc[j]); }
    LAS float* ssq = (LAS float*)(lds + OFF_SSQ);
    { float ss = 0.f;
#pragma unroll
      for (int j = 0; j < 2; ++j)
#pragma unroll
          for (int r = 0; r < 16; ++r) ss += oc[j][r] * oc[j][r];
      ss += __shfl_xor(ss, 32);
      if (h2 == 0) ssq[wh * 128 + 32 * tb + r32] = ss; }
    __syncthreads();
    { const int t = 32 * tb + r32; const float rstd = __builtin_amdgcn_rsqf((ssq[t] + ssq[128 + t]) * (1.f / 128.f) + EPS);
#pragma unroll
      for (int j = 0; j < 2; ++j)
#pragma unroll
          for (int gq = 0; gq < 4; ++gq) { const int e = 64 * wh + 32 * j + 8 * gq + 4 * h2;
              const u32x2 gt = gate[j][gq]; const f32x4 gn = *(const f32x4*)(hgn + h * 128 + e);
              const float g0 = bflo(gt.x), g1 = bfhi(gt.x), g2 = bflo(gt.y), g3 = bfhi(gt.y);
              const float o0 = oc[j][4 * gq + 0] * rstd * gn[0] * (g0 * sigm(g0)), o1 = oc[j][4 * gq + 1] * rstd * gn[1] * (g1 * sigm(g1));
              const float o2 = oc[j][4 * gq + 2] * rstd * gn[2] * (g2 * sigm(g2)), o3 = oc[j][4 * gq + 3] * rstd * gn[3] * (g3 * sigm(g3));
              u32x2 w; w.x = cvtpk(o0, o1); w.y = cvtpk(o2, o3); *(u32x2*)(OM + rc * 1024 + h * 128 + e) = w; } }
    __syncthreads();
}

__device__ __forceinline__ void hgrn_scan(float* __restrict__ Ub, const float* __restrict__ Dv) {
    for (int v = blockIdx.x * 512 + threadIdx.x; v < 32 * 4096; v += gridDim.x * 512) {
        const int bh = v >> 12, i4 = v & 4095, e = i4 >> 5, d4 = (i4 & 31) * 4;
        f32x4* up = (f32x4*)(Ub + ((size_t)(bh * 32) * 128 + e) * 128 + d4); const f32x4* dp = (const f32x4*)(Dv + (size_t)(bh * 32) * 128 + d4);
        f32x4 S = (f32x4){0.f, 0.f, 0.f, 0.f};
#pragma unroll 1
        for (int c0 = 0; c0 < 32; c0 += 8) { f32x4 u[8], dv[8];
#pragma unroll
            for (int c = 0; c < 8; ++c) { u[c] = up[(size_t)(c0 + c) * 4096]; dv[c] = dp[(c0 + c) * 32]; }
#pragma unroll
            for (int c = 0; c < 8; ++c) { S = dv[c] * S + u[c]; up[(size_t)(c0 + c) * 4096] = S; } }
    }
}

constexpr int AK_STRIDE = 144, AV_STRIDE = 560, AK_OFF = 0, AV_OFF = 288 * AK_STRIDE;
__device__ __forceinline__ void attn_stage(LAS unsigned char* lds, const bf16_t* __restrict__ Za, const bf16_t* __restrict__ Vt, int b, int n, int kvh) {
    const int tid = threadIdx.x;
    for (int i = tid; i < 288 * 8; i += 512) { const int kl = i >> 3, ch = i & 7; u32x4 v = (u32x4){0u, 0u, 0u, 0u};
        int pos = -1; if (kl < 256) pos = 128 * (n - 1) + kl - 112; else if (kl < 272) pos = kl - 256;
        if (pos >= 0) v = *(const u32x4*)(Za + (size_t)(b * LTOK + pos) * 768 + 512 + kvh * 64 + 8 * ch);
        *(LAS u32x4*)(lds + AK_OFF + kl * AK_STRIDE + ch * 16) = v; }
    for (int i = tid; i < 64 * 35; i += 512) { const int d = i / 35, ch = i - d * 35; u32x4 v = (u32x4){0u, 0u, 0u, 0u};
        const bf16_t* vr = Vt + (size_t)(b * 128 + kvh * 64 + d) * LPAD;
        if (ch < 32) { if (n > 1 || ch >= 14) v = *(const u32x4*)(vr + 128 * (n - 1) + 8 * ch); }
        else if (ch < 34) v = *(const u32x4*)(vr + 112 + 8 * (ch - 32));
        *(LAS u32x4*)(lds + AV_OFF + d * AV_STRIDE + ch * 16) = v; }
}
__device__ __forceinline__ f32x16 attn_qk(const LAS unsigned char* kp, const bf16x8 (&qf)[4]) {
    f32x16 S = f32x16{};
#pragma unroll
    for (int k = 0; k < 4; ++k) S = MFMA32(*(const LAS bf16x8*)(kp + 32 * k), qf[k], S);
    return S;
}
template <int MODE> __device__ __forceinline__ bool attn_vis(int kr, int r32) { return MODE == 0 ? true : MODE == 1 ? (kr > r32) : MODE == 2 ? (kr <= r32) : (kr < 16); }
template <int MODE> __device__ __forceinline__ float attn_tile_max(const f32x16& S, int r32, int h2) {
    float m = -INFINITY;
#pragma unroll
    for (int r = 0; r < 16; ++r) { const int kr = (r & 3) + 8 * (r >> 2) + 4 * h2; m = fmaxf(m, attn_vis<MODE>(kr, r32) ? S[r] : -INFINITY); }
    return m;
}
template <int MODE> __device__ __forceinline__ void attn_tile_pv(f32x16 S, float c2, float mneg, int r32, int h2, float& l, f32x16 (&O)[2], const LAS unsigned char* vl, int kl0) {
#pragma unroll
    for (int r = 0; r < 16; ++r) { const int kr = (r & 3) + 8 * (r >> 2) + 4 * h2; const float p = __builtin_amdgcn_exp2f(__builtin_fmaf(S[r], c2, mneg)); S[r] = attn_vis<MODE>(kr, r32) ? p : 0.f; l += S[r]; }
#pragma unroll
    for (int s2 = 0; s2 < 2; ++s2) {
        if (MODE == 3 && s2 == 1) continue;
        u32x4 pw; pw.x = cvtpk(S[8 * s2 + 0], S[8 * s2 + 1]); pw.y = cvtpk(S[8 * s2 + 2], S[8 * s2 + 3]); pw.z = cvtpk(S[8 * s2 + 4], S[8 * s2 + 5]); pw.w = cvtpk(S[8 * s2 + 6], S[8 * s2 + 7]);
        const bf16x8 pb = __builtin_bit_cast(bf16x8, pw);
#pragma unroll
        for (int db = 0; db < 2; ++db) { const LAS unsigned char* vp = vl + (32 * db) * AV_STRIDE + (kl0 + 16 * s2) * 2;
            const u32x2 lo = *(const LAS u32x2*)vp, hi = *(const LAS u32x2*)(vp + 16);
            const u32x4 aw = (u32x4){lo.x, lo.y, hi.x, hi.y};
            O[db] = MFMA32(__builtin_bit_cast(bf16x8, aw), pb, O[db]); } }
}
__device__ __forceinline__ void attn_sub(const LAS unsigned char* lds, const bf16_t* __restrict__ Za, const float* __restrict__ sinks, bf16_t* __restrict__ OM, int b, int n, int qh, int sb, int lane) {
    const int r32 = lane & 31, h2 = lane >> 5;
    const int pq = 128 * n + 32 * sb + r32;
    const bf16_t* qp = Za + (size_t)(b * LTOK + pq - 112) * 768 + qh * 64 + 8 * h2;
    bf16x8 qf[4];
#pragma unroll
    for (int k = 0; k < 4; ++k) qf[k] = *(const bf16x8*)(qp + 16 * k);
    const LAS unsigned char* kl = lds + AK_OFF + r32 * AK_STRIDE + 16 * h2;
    const LAS unsigned char* vl = lds + AV_OFF + r32 * AV_STRIDE + 8 * h2;
    const float c2 = 0.125f * 1.4426950408889634f;
    const float sinkl = sinks[qh] * 1.4426950408889634f;
    const int jskip = n == 1 ? 4 - sb : 0;
    float mraw = -INFINITY;
#pragma unroll
    for (int j = 0; j < 5; ++j) { if (j < jskip) continue;
        const f32x16 S = attn_qk(kl + (32 * (sb + j)) * AK_STRIDE, qf);
        mraw = fmaxf(mraw, j == 0 ? attn_tile_max<1>(S, r32, h2) : j == 4 ? attn_tile_max<2>(S, r32, h2) : attn_tile_max<0>(S, r32, h2)); }
    { const f32x16 S = attn_qk(kl + 256 * AK_STRIDE, qf); mraw = fmaxf(mraw, attn_tile_max<3>(S, r32, h2)); }
    float mx = fmaxf(mraw * c2, sinkl);
    mx = fmaxf(mx, __shfl_xor(mx, 32));
    float l = 0.f; const float mneg = -mx;
    f32x16 O[2]; O[0] = f32x16{}; O[1] = f32x16{};
#pragma unroll
    for (int j = 0; j < 5; ++j) { if (j < jskip) continue;
        const int kl0 = 32 * (sb + j); const f32x16 S = attn_qk(kl + kl0 * AK_STRIDE, qf);
        if (j == 0) attn_tile_pv<1>(S, c2, mneg, r32, h2, l, O, vl, kl0); else if (j == 4) attn_tile_pv<2>(S, c2, mneg, r32, h2, l, O, vl, kl0); else attn_tile_pv<0>(S, c2, mneg, r32, h2, l, O, vl, kl0); }
    { const f32x16 S = attn_qk(kl + 256 * AK_STRIDE, qf); attn_tile_pv<3>(S, c2, mneg, r32, h2, l, O, vl, 256); }
    l += __shfl_xor(l, 32); l += __builtin_amdgcn_exp2f(sinkl - mx);
    const float inv = __builtin_amdgcn_rcpf(l);
    bf16_t* op = OM + ((size_t)b * SEQ + 128 * (n - 1) + 32 * sb + r32) * 1024 + 512 + qh * 64 + 4 * h2;
#pragma unroll
    for (int db = 0; db < 2; ++db)
#pragma unroll
        for (int g = 0; g < 4; ++g) { u32x2 w; w.x = cvtpk(O[db][4 * g] * inv, O[db][4 * g + 1] * inv); w.y = cvtpk(O[db][4 * g + 2] * inv, O[db][4 * g + 3] * inv);
            *(u32x2*)(op + 32 * db + 8 * g) = w; }
}
__device__ __forceinline__ unsigned f2ord(float f) { const unsigned u = __float_as_uint(f); return (u & 0x80000000u) ? ~u : (u | 0x80000000u); }
__device__ __forceinline__ float ord2f(unsigned u) { return __uint_as_float((u & 0x80000000u) ? (u & 0x7fffffffu) : ~u); }
__device__ __forceinline__ unsigned umax_(unsigned a, unsigned b) { return a > b ? a : b; }
__device__ __forceinline__ unsigned umin_(unsigned a, unsigned b) { return a < b ? a : b; }
struct Net16 { unsigned char a[63], b[63]; };
constexpr Net16 make_net16() {
    constexpr int P[63][2] = {{0,1},{2,3},{0,2},{1,3},{1,2},{4,5},{6,7},{4,6},{5,7},{5,6},{0,4},{2,6},{2,4},{1,5},{3,7},{3,5},{1,2},{3,4},{5,6},{8,9},{10,11},{8,10},{9,11},{9,10},{12,13},{14,15},{12,14},{13,15},{13,14},
        {8,12},{10,14},{10,12},{9,13},{11,15},{11,13},{9,10},{11,12},{13,14},{0,8},{4,12},{4,8},{2,10},{6,14},{6,10},{2,4},{6,8},{10,12},{1,9},{5,13},{5,9},{3,11},{7,15},{7,11},{3,5},{7,9},{11,13},{1,2},{3,4},{5,6},{7,8},{9,10},{11,12},{13,14}};
    Net16 n{}; for (int k = 0; k < 63; ++k) { n.a[k] = (unsigned char)P[k][0]; n.b[k] = (unsigned char)P[k][1]; } return n;
}
constexpr Net16 NET16 = make_net16();
template <int N> __device__ __forceinline__ void bitonic_desc(unsigned (&a)[N]) {
    static_assert(N == 16, "16-input network");
#pragma unroll
    for (int k = 0; k < 63; ++k) { const unsigned hi = umax_(a[NET16.a[k]], a[NET16.b[k]]), lo = umin_(a[NET16.a[k]], a[NET16.b[k]]); a[NET16.a[k]] = hi; a[NET16.b[k]] = lo; }
}
__device__ __forceinline__ void merge_top16(unsigned (&a)[16], const unsigned (&b)[16]) {
#pragma unroll
    for (int i = 0; i < 16; ++i) a[i] = umax_(a[i], b[15 - i]);
#pragma unroll
    for (int j = 8; j > 0; j >>= 1)
#pragma unroll
        for (int i = 0; i < 16; ++i) { const int l = i ^ j; if (l > i) { const unsigned hi = umax_(a[i], a[l]), lo = umin_(a[i], a[l]); a[i] = hi; a[l] = lo; } }
}
template <bool PAIR> __device__ __forceinline__ void top16_of(unsigned (&g)[4][16]) {
    bitonic_desc<16>(g[0]); bitonic_desc<16>(g[1]); bitonic_desc<16>(g[2]); bitonic_desc<16>(g[3]);
    merge_top16(g[0], g[1]); merge_top16(g[2], g[3]); merge_top16(g[0], g[2]);
    if (PAIR) { unsigned o[16]; const bool up = (threadIdx.x & 32) != 0;
#pragma unroll
        for (int i = 0; i < 16; ++i) { const auto r = __builtin_amdgcn_permlane32_swap(g[0][i], g[0][i], false, false); o[i] = up ? r[0] : r[1]; }
        merge_top16(g[0], o); }
}
__device__ __forceinline__ unsigned sel16p(unsigned long long lo, unsigned long long hi, int i) { const unsigned long long w = (i & 8) ? hi : lo; return (unsigned)(w >> ((i & 7) * 8)) & 0x7fu; }
struct CandTab { unsigned char i[50], j[50]; int n; };
constexpr CandTab make_cands() { CandTab t{}; int n = 0; for (int i = 0; i < 16; ++i) for (int j = 0; j < 16; ++j) if ((i + 1) * (j + 1) <= 16) { t.i[n] = (unsigned char)i; t.j[n] = (unsigned char)j; ++n; } t.n = n; return t; }
constexpr CandTab CT = make_cands();
static_assert(CT.n == 50, "candidate count");

constexpr int PL_IDX = 0, PL_GB = 32768, PL_PA = 65536, PL_SSQ = 131072;
__device__ __forceinline__ void peer_list(const bf16_t* __restrict__ Qb, const bf16_t* __restrict__ SK, int rc0, int h, int c, int r32, int h2, unsigned (&top)[16]) {
    const int lane_ = 32 * h2 + r32;
    const bf16_t* qp = Qb + ((size_t)((((rc0 >> 5) * 8 + h) * 2 + c) * 8) * 64 + lane_) * 8;
    bf16x8 qf[8];
#pragma unroll
    for (int k = 0; k < 8; ++k) qf[k] = *(const bf16x8*)(qp + 512 * k);
    unsigned g[4][16];
#pragma unroll
    for (int nb = 0; nb < 4; ++nb) {
        const bf16_t* kp = SK + ((size_t)(((h * 2 + c) * 4 + nb) * 8) * 64 + lane_) * 8;
        f32x16 acc = f32x16{};
#pragma unroll
        for (int k = 0; k < 8; ++k) acc = MFMA32(*(const bf16x8*)(kp + 512 * k), qf[k], acc);
#pragma unroll
        for (int r = 0; r < 16; ++r) g[nb][r] = (f2ord(acc[r]) & 0xffffff80u) | (unsigned)(32 * nb + (r & 3) + 8 * (r >> 2) + 4 * h2);
        __builtin_amdgcn_sched_barrier(0);
    }
    top16_of<true>(g);
#pragma unroll
    for (int k = 0; k < 16; ++k) top[k] = g[0][k];
}
__device__ __forceinline__ void peer_topk(LAS unsigned char* lds, const bf16_t* __restrict__ Qb, const bf16_t* __restrict__ SK, const float* __restrict__ rowssp, int rc0, int tl0, int h0, int lane) {
    float rstd_t;
    { const f32x4* rp = (const f32x4*)(rowssp + (size_t)(rc0 + (lane & 31)) * 16); const f32x4 s4 = (rp[0] + rp[1]) + (rp[2] + rp[3]); rstd_t = __builtin_amdgcn_rsqf(((s4[0] + s4[1]) + (s4[2] + s4[3])) * (1.0f / 1024.0f) + EPS); }
#pragma unroll 1
    for (int hh = 0; hh < 4; ++hh) {
        asm volatile("" : "+v"(lane));
        const int r32 = lane & 31, h2 = lane >> 5;
        const int h = h0 + hh;
        unsigned ta[16], tb[16];
        peer_list(Qb, SK, rc0, h, 0, r32, h2, ta);
        peer_list(Qb, SK, rc0, h, 1, r32, h2, tb);
        float av[16], bv[16]; unsigned long long ail = 0, aih = 0, bil = 0, bih = 0;
#pragma unroll
        for (int k = 0; k < 16; ++k) { av[k] = ord2f(ta[k] & 0xffffff80u); bv[k] = ord2f(tb[k] & 0xffffff80u);
            if (k < 8) { ail |= (unsigned long long)(ta[k] & 0x7fu) << (8 * k); bil |= (unsigned long long)(tb[k] & 0x7fu) << (8 * k); }
            else { aih |= (unsigned long long)(ta[k] & 0x7fu) << (8 * (k - 8)); bih |= (unsigned long long)(tb[k] & 0x7fu) << (8 * (k - 8)); } }
        unsigned k2[4][16];
#pragma unroll
        for (int k = 0; k < 64; ++k) { if (k < 50) k2[k >> 4][k & 15] = (f2ord(av[CT.i[k < 50 ? k : 0]] + bv[CT.j[k < 50 ? k : 0]]) & 0xffffff00u) | (unsigned)(CT.i[k < 50 ? k : 0] * 16 + CT.j[k < 50 ? k : 0]); else k2[k >> 4][k & 15] = 0u; }
        top16_of<false>(k2);
        float ev[16]; float es = 0.f; const float m0 = ord2f(k2[0][0] & 0xffffff00u);
#pragma unroll
        for (int k = 0; k < 16; ++k) { ev[k] = __expf((ord2f(k2[0][k] & 0xffffff00u) - m0) * rstd_t); es += ev[k]; }
        const float inv = 1.f / es;
        LAS unsigned short* ip = (LAS unsigned short*)(lds + PL_IDX) + (tl0 + r32) * 128 + h * 16;
        LAS bf16_t* gp = (LAS bf16_t*)(lds + PL_GB) + (tl0 + r32) * 128 + h * 16;
#pragma unroll
        for (int k = 0; k < 16; ++k) { const int code = (int)(k2[0][k] & 0xffu); const unsigned e = sel16p(ail, aih, code >> 4) * 128u + sel16p(bil, bih, code & 15);
            if ((k >> 3) == h2) { ip[k] = (unsigned short)e; gp[k] = f2bf(ev[k] * inv); } }
    }
}
__device__ __forceinline__ pg8::f32x2_t fp8x2(unsigned w, bool hi) { return hi ? __builtin_amdgcn_cvt_pk_f32_fp8(w, true) : __builtin_amdgcn_cvt_pk_f32_fp8(w, false); }
template <int CTRL> __device__ __forceinline__ float dppf(float v) { return __builtin_bit_cast(float, __builtin_amdgcn_update_dpp(0, __builtin_bit_cast(int, v), CTRL, 0xf, 0xf, true)); }
template <bool WITH_X>
__device__ __forceinline__ void peer_rows_load(u32x4 (&rw)[16], u32x4 (&xw)[2], const LAS unsigned char* lds, int tl, size_t rc, int s, const unsigned char* __restrict__ T8, const bf16_t* __restrict__ A2, int lane) {
    const int c = lane & 7, gq = lane >> 3;
    if (WITH_X) { xw[0] = *(const u32x4*)((const unsigned char*)A2 + rc * 1024 + 128 * s + 16 * c); xw[1].x = __float_as_uint(*(const float*)((const unsigned char*)A2 + (size_t)MC * 1024 + rc * 4)); }
    const LAS u32x4* ip = (const LAS u32x4*)(lds + PL_IDX + tl * 256 + gq * 32);
    const u32x4 i0 = ip[0], i1 = ip[1];
    const unsigned iw[8] = {i0.x, i0.y, i0.z, i0.w, i1.x, i1.y, i1.z, i1.w};
    const __amdgpu_buffer_rsrc_t rs = __builtin_amdgcn_make_buffer_rsrc((void*)T8, (short)0, 16 << 20, 0x00020000);
    const unsigned c16 = 16u * (unsigned)c; const int soff = 128 * s;
#pragma unroll
    for (int ig = 0; ig < 16; ++ig) { const unsigned e = (ig & 1) ? (iw[ig >> 1] >> 16) : (iw[ig >> 1] & 0xffffu);
        rw[ig] = __builtin_bit_cast(u32x4, __builtin_amdgcn_raw_buffer_load_b128(rs, (int)((e << 10) | c16), soff, 0)); }
}
template <int CTRL> __device__ __forceinline__ int dppi(int v) { return __builtin_amdgcn_update_dpp(0, v, CTRL, 0xf, 0xf, true); }
__device__ __forceinline__ void peer_u_math(const u32x4 (&uw)[16], const u32x4 (&xw)[2], LAS unsigned char* lds, int tl, int lane) {
    const int c = lane & 7, gq = lane >> 3;
    const int x0 = (int)xw[0].x, x1 = (int)xw[0].y, x2 = (int)xw[0].z, x3 = (int)xw[0].w;
    int d[16];
#pragma unroll
    for (int ig = 0; ig < 16; ++ig) { int t = __builtin_amdgcn_sdot4((int)uw[ig].x, x0, 0, false); t = __builtin_amdgcn_sdot4((int)uw[ig].y, x1, t, false); t = __builtin_amdgcn_sdot4((int)uw[ig].z, x2, t, false); d[ig] = __builtin_amdgcn_sdot4((int)uw[ig].w, x3, t, false); }
    const bool c4 = c & 4, c2 = c & 2, c1 = c & 1;
    int acc[2];
#pragma unroll
    for (int hf = 0; hf < 2; ++hf) { int t[4];
#pragma unroll
        for (int j = 0; j < 4; ++j) { const int keep = c4 ? d[8 * hf + j + 4] : d[8 * hf + j], send = c4 ? d[8 * hf + j] : d[8 * hf + j + 4]; t[j] = keep + dppi<0x141>(send); }
#pragma unroll
        for (int j = 0; j < 2; ++j) { const int keep = c2 ? t[j + 2] : t[j], send = c2 ? t[j] : t[j + 2]; t[j] = keep + dppi<0x4E>(send); }
        { const int keep = c1 ? t[1] : t[0], send = c1 ? t[0] : t[1]; acc[hf] = keep + dppi<0xB1>(send); } }
    const float sx = __uint_as_float(xw[1].x);
    LAS float* pp = (LAS float*)(lds + PL_PA) + tl * 128 + 16 * gq + c;
    __hip_atomic_fetch_add(pp, (float)acc[0] * sx, __ATOMIC_RELAXED, __HIP_MEMORY_SCOPE_WORKGROUP);
    __hip_atomic_fetch_add(pp + 8, (float)acc[1] * sx, __ATOMIC_RELAXED, __HIP_MEMORY_SCOPE_WORKGROUP);
}
__device__ __forceinline__ void peer_a_step(LAS unsigned char* lds, int tl, size_t rc, const float* __restrict__ rowssp, const float* __restrict__ su, const float* __restrict__ sv, int lane) {
    float rs = rowssp[rc * 16 + (lane & 15)];
    rs += __shfl_xor(rs, 1); rs += __shfl_xor(rs, 2); rs += __shfl_xor(rs, 4); rs += __shfl_xor(rs, 8);
    const float rstd = __builtin_amdgcn_rsqf(rs * (1.f / 1024.f) + EPS);
#pragma unroll
    for (int q = 0; q < 2; ++q) { const int k = lane + 64 * q;
        const unsigned e = ((const LAS unsigned short*)(lds + PL_IDX))[tl * 128 + k];
        LAS float* pp = (LAS float*)(lds + PL_PA) + tl * 128 + k;
        const float z = *pp * rstd * su[e]; const float a = 0.5f * z * (1.f + erff(z * 0.70710678118654752f));
        *pp = bf2f(((const LAS bf16_t*)(lds + PL_GB))[tl * 128 + k]) * a * sv[e]; }
    if (lane == 0) ((LAS float*)(lds + PL_SSQ))[tl] = 0.f;
}
__device__ __forceinline__ void peer_v_math(const u32x4 (&vw)[16], LAS unsigned char* lds, int tl, size_t rc, int s, bf16_t* __restrict__ dout, int lane) {
    const int c = lane & 7, gq = lane >> 3;
    float wv[16];
    { const LAS f32x4* wp = (const LAS f32x4*)((const LAS float*)(lds + PL_PA) + tl * 128 + 16 * gq);
#pragma unroll
      for (int q = 0; q < 4; ++q) { const f32x4 w4 = wp[q]; wv[4 * q] = w4[0]; wv[4 * q + 1] = w4[1]; wv[4 * q + 2] = w4[2]; wv[4 * q + 3] = w4[3]; } }
    const bool b3 = lane & 8, b4 = lane & 16, b5 = lane & 32;
    unsigned* hp = (unsigned*)(dout + rc * 1024 + 128 * s + 16 * c + (b3 ? 8 : 0) + (b4 ? 4 : 0) + (b5 ? 2 : 0));
    const unsigned hw = *hp; pg8::f32x2_t h = (pg8::f32x2_t){bflo(hw), bfhi(hw)};
    pg8::f32x2_t o2[8];
#pragma unroll
    for (int i = 0; i < 8; ++i) o2[i] = (pg8::f32x2_t){0.f, 0.f};
#pragma unroll
    for (int ig = 0; ig < 16; ++ig) { const float w = wv[ig]; const pg8::f32x2_t w2 = (pg8::f32x2_t){w, w};
#pragma unroll
        for (int q = 0; q < 4; ++q) { o2[2 * q] += w2 * fp8x2(vw[ig][q], false); o2[2 * q + 1] += w2 * fp8x2(vw[ig][q], true); } }
    float out[16];
#pragma unroll
    for (int i = 0; i < 8; ++i) { out[2 * i] = o2[i].x; out[2 * i + 1] = o2[i].y; }
#pragma unroll
    for (int j = 0; j < 8; ++j) { const float keep = b3 ? out[j + 8] : out[j], send = b3 ? out[j] : out[j + 8]; out[j] = keep + dppf<0x128>(send); }
#pragma unroll
    for (int j = 0; j < 4; ++j) { const auto r = __builtin_amdgcn_permlane16_swap(__float_as_uint(out[j]), __float_as_uint(out[j + 4]), false, false); out[j] = __uint_as_float(r[0]) + __uint_as_float(r[1]); }
#pragma unroll
    for (int j = 0; j < 2; ++j) { const auto r = __builtin_amdgcn_permlane32_swap(__float_as_uint(out[j]), __float_as_uint(out[j + 2]), false, false); out[j] = __uint_as_float(r[0]) + __uint_as_float(r[1]); }
    h.x += out[0]; h.y += out[1];
    *hp = cvtpk(h.x, h.y);
}
template <int NT>
__device__ __forceinline__ void peer_f_steps(size_t rc, const bf16_t* __restrict__ h2b, float* __restrict__ dout, const float* __restrict__ gfin, int lane) {
    u32x2 hw[NT][4];
#pragma unroll
    for (int i = 0; i < NT; ++i)
#pragma unroll
        for (int q = 0; q < 4; ++q) hw[i][q] = *(const u32x2*)(h2b + (rc + i) * 1024 + 256 * q + 4 * lane);
    f32x4 g[4];
#pragma unroll
    for (int q = 0; q < 4; ++q) g[q] = *(const f32x4*)(gfin + 256 * q + 4 * lane);
#pragma unroll
    for (int i = 0; i < NT; ++i) { f32x4 h[4]; f32x4 sq = (f32x4){0.f, 0.f, 0.f, 0.f};
#pragma unroll
        for (int q = 0; q < 4; ++q) { h[q] = (f32x4){bflo(hw[i][q].x), bfhi(hw[i][q].x), bflo(hw[i][q].y), bfhi(hw[i][q].y)}; sq += h[q] * h[q]; }
        const float rf = __builtin_amdgcn_rsqf(wave_sum((sq[0] + sq[1]) + (sq[2] + sq[3])) * (1.f / 1024.f) + EPS);
        float* op = dout + (rc + i) * 1024 + 4 * lane;
#pragma unroll
        for (int q = 0; q < 4; ++q) *(f32x4*)(op + 256 * q) = h[q] * rf * g[q]; }
}
__device__ __forceinline__ unsigned pack_i8x4(float a, float b, float c, float d) {
    const int ia = __float2int_rn(a), ib = __float2int_rn(b), ic = __float2int_rn(c), id = __float2int_rn(d);
    return (unsigned)(ia & 0xff) | ((unsigned)(ib & 0xff) << 8) | ((unsigned)(ic & 0xff) << 16) | ((unsigned)id << 24);
}
__device__ __forceinline__ void peer_tables(const float* __restrict__ pu, const float* __restrict__ pv, unsigned char* __restrict__ T8, float* __restrict__ sinv, int lane, int gw, int NGW) {
    for (int row = gw; row < 32768; row += NGW) {
        const bool isu = row < 16384;
        const float* src = (isu ? pu + (size_t)row * 1024 : pv + (size_t)(row - 16384) * 1024) + 16 * lane;
        f32x4 v[4]; float am = 0.f;
#pragma unroll
        for (int q = 0; q < 4; ++q) { v[q] = *(const f32x4*)(src + 4 * q); am = fmaxf(am, fmaxf(fmaxf(fabsf(v[q][0]), fabsf(v[q][1])), fmaxf(fabsf(v[q][2]), fabsf(v[q][3])))); }
#pragma unroll
        for (int o = 1; o < 64; o <<= 1) am = fmaxf(am, __shfl_xor(am, o));
        const float top = isu ? 127.f : 224.f;
        const float sc = am > 0.f ? top / am : 1.f;
        u32x4 w;
        if (isu) {
#pragma unroll
            for (int q = 0; q < 4; ++q) w[q] = pack_i8x4(v[q][0] * sc, v[q][1] * sc, v[q][2] * sc, v[q][3] * sc);
        } else {
#pragma unroll
            for (int q = 0; q < 4; ++q) { unsigned t = __builtin_amdgcn_cvt_pk_fp8_f32(v[q][0] * sc, v[q][1] * sc, 0, false); t = __builtin_amdgcn_cvt_pk_fp8_f32(v[q][2] * sc, v[q][3] * sc, t, true); w[q] = t; } }
        *(u32x4*)(T8 + (size_t)row * 1024 + 16 * lane) = w;
        if (lane == 0) sinv[row] = am > 0.f ? am / top : 1.f;
    }
}
__device__ __forceinline__ void peer_xq_token(const bf16_t* __restrict__ H1, const float* __restrict__ gffn, unsigned char* __restrict__ XQ, float* __restrict__ SX, size_t rc, int lane) {
    const u32x4 xa = *(const u32x4*)(H1 + rc * 1024 + 16 * lane), xb = *(const u32x4*)(H1 + rc * 1024 + 16 * lane + 8);
    const unsigned w[8] = {xa.x, xa.y, xa.z, xa.w, xb.x, xb.y, xb.z, xb.w};
    float xv[16]; float am = 0.f;
#pragma unroll
    for (int q = 0; q < 4; ++q) { const f32x4 g = *(const f32x4*)(gffn + 16 * lane + 4 * q);
        xv[4 * q] = bflo(w[2 * q]) * g[0]; xv[4 * q + 1] = bfhi(w[2 * q]) * g[1]; xv[4 * q + 2] = bflo(w[2 * q + 1]) * g[2]; xv[4 * q + 3] = bfhi(w[2 * q + 1]) * g[3];
        am = fmaxf(am, fmaxf(fmaxf(fabsf(xv[4 * q]), fabsf(xv[4 * q + 1])), fmaxf(fabsf(xv[4 * q + 2]), fabsf(xv[4 * q + 3])))); }
#pragma unroll
    for (int o = 1; o < 64; o <<= 1) am = fmaxf(am, __shfl_xor(am, o));
    const float sc = am > 0.f ? 127.f / am : 1.f;
    u32x4 o;
#pragma unroll
    for (int q = 0; q < 4; ++q) o[q] = pack_i8x4(xv[4 * q] * sc, xv[4 * q + 1] * sc, xv[4 * q + 2] * sc, xv[4 * q + 3] * sc);
    *(u32x4*)(XQ + rc * 1024 + 16 * lane) = o;
    if (lane == 0) SX[rc] = am > 0.f ? am / 127.f : 1.f;
}

#define XB_TMO      128
#define XB_XCNT(j)  (256  + 64 * (j))
#define XB_XSUB(j)  (1280 + 64 * (j))
#define XB_XGEN(j)  (2304 + 64 * (j))
#define XB_TOP      3328
#define XB_TOPGEN   3392
#define XCD_BAR_WORDS 3456
#define XB_SPIN_CAP (1u << 18)

__device__ __forceinline__ unsigned xb_ld(unsigned* p)              { return __hip_atomic_load(p, __ATOMIC_RELAXED, __HIP_MEMORY_SCOPE_AGENT); }
__device__ __forceinline__ unsigned xb_add(unsigned* p, unsigned v) { return __hip_atomic_fetch_add(p, v, __ATOMIC_RELAXED, __HIP_MEMORY_SCOPE_AGENT); }
__device__ __forceinline__ unsigned xb_xcc_id() { return (unsigned)__builtin_amdgcn_s_getreg((3 << 11) | 20) & 0xFu; }
#define XB_SPIN(cond, bar) do { unsigned _sp = 0; while (cond) { __builtin_amdgcn_s_sleep(1); \
    if ((++_sp & 255u) == 0u) { if (xb_ld(&(bar)[XB_TMO])) break; if (_sp > XB_SPIN_CAP) { atomicAdd(&(bar)[XB_TMO], 1u); break; } } } } while (0)

struct XcdBarrier {
    unsigned* bar; unsigned x;
    volatile LAS unsigned* st;
};

__device__ __forceinline__ XcdBarrier xcd_barrier_post(unsigned* bar, volatile LAS unsigned* st) {
    XcdBarrier b; b.bar = bar; b.x = xb_xcc_id(); b.st = st;
    if (threadIdx.x == 0) (void)xb_add(&bar[XB_XCNT(b.x)], 1u);
    return b;
}
__device__ __forceinline__ void xcd_barrier_complete(unsigned* bar, unsigned x, unsigned& nloc, unsigned& nx) {
    const unsigned G = gridDim.x * gridDim.y * gridDim.z;
    unsigned sum, cnt, mine, sp = 0u;
    for (;;) {
        sum = 0u; cnt = 0u; mine = 0u;
#pragma unroll
        for (unsigned j = 0; j < 16; ++j) { const unsigned c = xb_ld(&bar[XB_XCNT(j)]); sum += c; cnt += (c > 0u) ? 1u : 0u; mine = (j == x) ? c : mine; }
        if (sum == G) break;
        __builtin_amdgcn_s_sleep(1);
        if ((++sp & 255u) == 0u) { if (xb_ld(&bar[XB_TMO])) break; if (sp > XB_SPIN_CAP) { atomicAdd(&bar[XB_TMO], 1u); break; } }
    }
    nloc = mine > 0u ? mine : 1u; nx = cnt > 0u ? cnt : 1u;
}

__device__ __forceinline__ void xcd_barrier(const XcdBarrier& b) {
    asm volatile("s_waitcnt vmcnt(0)" ::: "memory");
    __syncthreads();
    if (threadIdx.x == 0) {
        unsigned* bar = b.bar;
        __builtin_amdgcn_s_waitcnt(0);
        unsigned nloc = b.st[0], nx = b.st[1];
        if (nloc == 0u) { xcd_barrier_complete(bar, b.x, nloc, nx); b.st[0] = nloc; b.st[1] = nx; }
        const unsigned old = xb_add(&bar[XB_XSUB(b.x)], 1u);
        const unsigned gen = old / nloc;
        if (old + 1u == (gen + 1u) * nloc) {
            __builtin_amdgcn_fence(__ATOMIC_RELEASE, "agent");
            asm volatile("s_waitcnt vmcnt(0)" ::: "memory");
            const unsigned og = xb_add(&bar[XB_TOP], 1u);
            const unsigned tg = og / nx;
            if (og + 1u == (tg + 1u) * nx) xb_add(&bar[XB_TOPGEN], 1u);
            else XB_SPIN(xb_ld(&bar[XB_TOPGEN]) == tg, bar);
            __builtin_amdgcn_fence(__ATOMIC_ACQUIRE, "agent");
            xb_add(&bar[XB_XGEN(b.x)], 1u);
            asm volatile("s_waitcnt vmcnt(0)" ::: "memory");
        } else {
            XB_SPIN(xb_ld(&bar[XB_XGEN(b.x)]) == gen, bar);
            __builtin_amdgcn_fence(__ATOMIC_ACQUIRE, "agent");
            asm volatile("s_waitcnt vmcnt(0)" ::: "memory");
        }
    }
    __syncthreads();
}

constexpr int NPHASE = 9;
struct Args { const float* in[17]; float* out; unsigned char* ws; int ph_lo, ph_hi; };
__global__ void __launch_bounds__(512, 2) fwd_kernel(Args a) {
    extern __shared__ __attribute__((aligned(16))) unsigned char lds_raw[];
    LAS unsigned char* lds = (LAS unsigned char*)lds_raw;
    cg::grid_group grid = cg::this_grid();
    const int tid = threadIdx.x, lane = tid & 63, wave = __builtin_amdgcn_readfirstlane(tid >> 6);
    const int lo = a.ph_lo, hi = a.ph_hi, G = gridDim.x;
    typedef const __attribute__((address_space(4))) Args* kargp_t;
#define KARGS kargp_t kp_ = (kargp_t)__builtin_amdgcn_kernarg_segment_ptr(); asm volatile("" : "+s"(kp_)); unsigned char* const ws = kp_->ws
#define INP(k) ((const float*)kp_->in[k])
#define WSP(T, off) ((T*)(ws + (off)))
#ifdef ONLY_PHASE
#define IN(k) ((k) == ONLY_PHASE && lo <= (k) && (k) < hi)
#else
#define IN(k) (lo <= (k) && (k) < hi)
#endif
    volatile LAS unsigned* bar_st = (volatile LAS unsigned*)(lds + LDS_BYTES - 64);
    XcdBarrier xbar; xbar.bar = (unsigned*)(a.ws + WS_CTL); xbar.x = 0; xbar.st = bar_st;
    if (hi - lo > 1) { if (tid < 2) bar_st[tid] = 0u; __syncthreads(); xbar = xcd_barrier_post((unsigned*)(a.ws + WS_CTL), bar_st); }
    if (lo < 0) grid.sync();
#define SEAM(k) do { if (lo <= (k) && (k) + 1 < hi) xcd_barrier(xbar); } while (0)

    if (IN(0)) { KARGS; P0Args p{INP(0), INP(1), INP(2), INP(3), INP(8), INP(9), INP(10), INP(12), INP(13), INP(11), WSP(bf16_t, WS_A1), WSP(bf16_t, WS_WIN), WSP(bf16_t, WS_WBH), WSP(bf16_t, WS_WBA), WSP(bf16_t, WS_WOUT), WSP(bf16_t, WS_WQ), WSP(bf16_t, WS_SK)}; p0_prologue(lds, p); SEAM(0); }
    if (IN(1)) {
        KARGS; bf16_t *A1 = WSP(bf16_t, WS_A1), *WinT = WSP(bf16_t, WS_WIN), *Zh = WSP(bf16_t, WS_ZH), *Za = WSP(bf16_t, WS_ZA), *Zg = WSP(bf16_t, WS_ZG), *Vt = WSP(bf16_t, WS_VT);
        pg8::Gemm g{A1, WinT, MA, 4864, 1024, 1024, 1024}; pg8::StaticOrder S; S.init(MA, 4864, G, (int)blockIdx.x);
        pg8::EpiZ E{Zh, Za, Zg, Vt, INP(4)};
        pg8::gemm_phase<pg8::EpiZ, pg8::StaticOrder, true, true>(lds, g, S, E);
        SEAM(1);
    }
    if (IN(2)) {
        KARGS; bf16_t *Zh = WSP(bf16_t, WS_ZH), *Za = WSP(bf16_t, WS_ZA), *Vt = WSP(bf16_t, WS_VT), *OM = WSP(bf16_t, WS_OM); float *Ub = WSP(float, WS_UB), *Dv = WSP(float, WS_DV); const float *lblog = INP(5), *sinks = INP(7);
        for (int it = blockIdx.x; it < 1024 + 512; it += G) {
            if (it < 1024) {
#ifndef NO_HGA
 hgrn_A(lds, Zh, lblog, Ub, Dv, it);
#endif
 }
            else { const int ai = it - 1024, b = ai >> 6, n = ((ai & 63) >> 1) + 1, kvh = ai & 1;
                attn_stage(lds, Za, Vt, b, n, kvh);
                __syncthreads();
#pragma unroll 1
                for (int si = wave; si < 16; si += 8) attn_sub(lds, Za, sinks, OM, b, n, kvh * 4 + (si >> 2), si & 3, lane);
                __syncthreads(); }
        }
        SEAM(2);
    }
    if (IN(3)) { KARGS; hgrn_scan(WSP(float, WS_UB), WSP(float, WS_DV)); SEAM(3); }
    if (IN(4)) { KARGS; for (int it = blockIdx.x; it < 1024; it += G) hgrn_C(lds, WSP(bf16_t, WS_ZH), INP(5), WSP(float, WS_UB), INP(6), WSP(bf16_t, WS_OM), it); SEAM(4); }
    if (IN(5)) {
        KARGS; bf16_t *OM = WSP(bf16_t, WS_OM), *WbhT = WSP(bf16_t, WS_WBH), *Mb = WSP(bf16_t, WS_MB), *Zg = WSP(bf16_t, WS_ZG); const float* bgate = INP(4);
        peer_tables(INP(14), INP(15), ws + WS_U8, WSP(float, WS_SUV), lane, blockIdx.x * 8 + wave, G * 8);
        __syncthreads();
        pg8::StaticOrder S; S.init(MC, 1024, G, (int)blockIdx.x);
        { pg8::Gemm g{OM, WbhT, MC, 1024, 1024, 1024, 1024}; pg8::EpiGate E{Mb, Zg, bgate}; pg8::gemm_phase<pg8::EpiGate, pg8::StaticOrder, true, true>(lds, g, S, E); }
        SEAM(5);
    }
    if (IN(6)) {
        KARGS; bf16_t *Mb = WSP(bf16_t, WS_MB), *WoutT = WSP(bf16_t, WS_WOUT); float* rowssp = WSP(float, WS_RS); const float* x = INP(0);
        pg8::Gemm g{Mb, WoutT, MC, 1024, 1024, 1024, 1024}; pg8::StaticOrder S; S.init(MC, 1024, G, (int)blockIdx.x);
        pg8::EpiH1 E{x, WSP(bf16_t, WS_H1B), rowssp};
        pg8::gemm_phase<pg8::EpiH1, pg8::StaticOrder, true, true>(lds, g, S, E);
        SEAM(6);
    }
    if (IN(7)) {
        KARGS; bf16_t *WqT = WSP(bf16_t, WS_WQ), *Qb = WSP(bf16_t, WS_QB); float* rowssp = WSP(float, WS_RS);
        pg8::Gemm g{WSP(bf16_t, WS_H1B), WqT, MC, 2048, 1024, 1024, 1024}; pg8::StaticOrder S; S.init(MC, 2048, G, (int)blockIdx.x);
        pg8::EpiQ E{Qb};
        pg8::gemm_phase<pg8::EpiQ, pg8::StaticOrder, true, true>(lds, g, S, E);
        SEAM(7);
    }
    if (IN(8)) {
        KARGS; bf16_t *Qb = WSP(bf16_t, WS_QB), *SK = WSP(bf16_t, WS_SK), *A2 = WSP(bf16_t, WS_A2); unsigned char *U8 = ws + WS_U8, *V8 = ws + WS_V8, *XQ = ws + WS_MB; float *suv = WSP(float, WS_SUV), *rowssp = WSP(float, WS_RS), *outp = kp_->out; bf16_t* H1B = WSP(bf16_t, WS_H1B); const float* gfin = INP(16);
        for (int grp = blockIdx.x; grp < MC / 128; grp += G) {
            const int rc0 = grp * 128;
#ifndef NO_TOPK
            peer_topk(lds, Qb, SK, rowssp, rc0 + 32 * (wave >> 1), 32 * (wave >> 1), 4 * (wave & 1), lane);
#endif
#ifdef PROBE_TOPK2
            __syncthreads(); peer_topk(lds, Qb, SK, rowssp, rc0 + 32 * (wave >> 1), 32 * (wave >> 1), 4 * (wave & 1), lane);
#endif
            __syncthreads();
            { const int tl0 = 16 * wave; const size_t rcw = (size_t)rc0 + tl0;
              { LAS f32x4* pz = (LAS f32x4*)(lds + PL_PA + tl0 * 512);
#pragma unroll
                for (int q = 0; q < 8; ++q) pz[lane + 64 * q] = (f32x4){0.f, 0.f, 0.f, 0.f}; }
#pragma unroll 1
              for (int i = 0; i < 16; ++i) peer_xq_token(H1B, INP(11), XQ, (float*)(XQ + (size_t)MC * 1024), rcw + i, lane);
              asm volatile("s_waitcnt vmcnt(0)" ::: "memory");
              { u32x4 ra[16], rb[16], xa[2], xb[2];
                peer_rows_load<true>(ra, xa, lds, tl0, rcw, 0, U8, (const bf16_t*)XQ, lane);
#pragma unroll 1
                for (int st = 0; st < 128; st += 2) {
                    peer_rows_load<true>(rb, xb, lds, tl0 + ((st + 1) & 15), rcw + ((st + 1) & 15), (st + 1) >> 4, U8, (const bf16_t*)XQ, lane);
                    __builtin_amdgcn_sched_barrier(0);
                    peer_u_math(ra, xa, lds, tl0 + (st & 15), lane);
                    { const int sn = st + 2 < 128 ? st + 2 : 127; peer_rows_load<true>(ra, xa, lds, tl0 + (sn & 15), rcw + (sn & 15), sn >> 4, U8, (const bf16_t*)XQ, lane); }
                    __builtin_amdgcn_sched_barrier(0);
                    peer_u_math(rb, xb, lds, tl0 + ((st + 1) & 15), lane); } }
#pragma unroll 1
              for (int i = 0; i < 16; ++i) peer_a_step(lds, tl0 + i, rcw + i, rowssp, suv, suv + 16384, lane);
              { u32x4 ra[16], rb[16], xd[2];
                peer_rows_load<false>(ra, xd, lds, tl0, rcw, 0, V8, A2, lane);
#pragma unroll 1
                for (int st = 0; st < 128; st += 2) {
                    peer_rows_load<false>(rb, xd, lds, tl0 + ((st + 1) & 15), rcw, (st + 1) >> 4, V8, A2, lane);
                    __builtin_amdgcn_sched_barrier(0);
                    peer_v_math(ra, lds, tl0 + (st & 15), rcw + (st & 15), st >> 4, H1B, lane);
                    { const int sn = st + 2 < 128 ? st + 2 : 127; peer_rows_load<false>(ra, xd, lds, tl0 + (sn & 15), rcw, sn >> 4, V8, A2, lane); }
                    __builtin_amdgcn_sched_barrier(0);
                    peer_v_math(rb, lds, tl0 + ((st + 1) & 15), rcw + ((st + 1) & 15), (st + 1) >> 4, H1B, lane); } }
              asm volatile("s_waitcnt vmcnt(0)" ::: "memory");
              __builtin_amdgcn_fence(__ATOMIC_ACQUIRE, "agent");
              peer_f_steps<8>(rcw, H1B, outp, gfin, lane);
              peer_f_steps<8>(rcw + 8, H1B, outp, gfin, lane); }
            __syncthreads();
        }
    }
#undef IN
#undef SEAM
}

extern "C" void kernel_launch(void* const* d_in, const int* in_sizes, int n_in, void* d_out, int out_size, void* d_ws, size_t ws_size, hipStream_t stream) {
    static int grid = 0;
    if (grid == 0) {
        if (n_in != 17 || out_size != MC * DM || ws_size < WS_END) { fprintf(stderr, "kernel_launch: unexpected shapes: n_in %d out %d ws %zu (need %zu)\n", n_in, out_size, ws_size, (size_t)WS_END); grid = -1; return; }
        int dev = 0, cus = 0, per_cu = 0;
        if (hipGetDevice(&dev) != hipSuccess || hipDeviceGetAttribute(&cus, hipDeviceAttributeMultiprocessorCount, dev) != hipSuccess) { fprintf(stderr, "kernel_launch: device query failed\n"); grid = -1; return; }
        if (hipFuncSetAttribute((const void*)fwd_kernel, hipFuncAttributeMaxDynamicSharedMemorySize, LDS_BYTES) != hipSuccess) { fprintf(stderr, "kernel_launch: hipFuncSetAttribute failed\n"); grid = -1; return; }
        if (hipOccupancyMaxActiveBlocksPerMultiprocessor(&per_cu, (const void*)fwd_kernel, 512, LDS_BYTES) != hipSuccess || per_cu < 1) { fprintf(stderr, "kernel_launch: occupancy query says %d blocks per CU\n", per_cu); per_cu = 1; }
        (void)hipGetLastError();
        grid = cus;
        fprintf(stderr, "kernel_launch: grid %d (occupancy %d per CU)\n", grid, per_cu);
    }
    if (grid < 0) return;
    if (hipMemsetAsync((char*)d_ws + WS_CTL, 0, CTL_BYTES, stream) != hipSuccess) { fprintf(stderr, "kernel_launch: memset of the barrier words failed\n"); return; }
    Args a{};
    for (int i = 0; i < 17; ++i) a.in[i] = (const float*)d_in[i];
    a.out = (float*)d_out; a.ws = (unsigned char*)d_ws;
#if MK_ONE_LAUNCH
    a.ph_lo = 0; a.ph_hi = NPHASE;
    void* args[] = {&a};
    hipError_t e = hipLaunchCooperativeKernel((const void*)fwd_kernel, dim3(grid), dim3(512), args, LDS_BYTES, stream);
    if (e != hipSuccess) fprintf(stderr, "kernel_launch: cooperative launch failed: %s (grid %d)\n", hipGetErrorString(e), grid);
#else
#ifdef PROBE_SEQ
    const int seq[] = PROBE_SEQ;
    for (int p : seq) { a.ph_lo = p; a.ph_hi = p + 1; hipLaunchKernelGGL(fwd_kernel, dim3(grid), dim3(512), LDS_BYTES, stream, a); }
#else
    for (int p = 0; p < NPHASE; ++p) { a.ph_lo = p; a.ph_hi = p + 1; hipLaunchKernelGGL(fwd_kernel, dim3(grid), dim3(512), LDS_BYTES, stream, a); }
#endif
#endif
}
```

```cpp
#include <hip/hip_runtime.h>
#include <hip/hip_cooperative_groups.h>
#include <cstdio>
#include <cstdint>
namespace cg = cooperative_groups;

#ifndef MK_ONE_LAUNCH
#define MK_ONE_LAUNCH 1
#endif

constexpr int DM = 1024, NB = 8, SEQ = 4096, NMETA = 16, LTOK = SEQ + NMETA;
constexpr int MA_REAL = NB * LTOK;
constexpr int MA = 33024;
constexpr int MC = NB * SEQ;
constexpr int LPAD = 4224;
constexpr float EPS = 1e-6f;

namespace pg8 {
#define PG8_LAS __attribute__((address_space(3)))
typedef unsigned short bf16_t;
typedef short bf16x8 __attribute__((ext_vector_type(8)));
typedef float f32x4 __attribute__((ext_vector_type(4)));
typedef unsigned u32x4 __attribute__((ext_vector_type(4)));
constexpr int BM = 256, BK = 64, HALF = 128, HTB = HALF * BK * 2  , STAGE_BYTES = 8 * HTB, NXCD = 8, WGM = 8;

__host__ __device__ __forceinline__ int lds_byte(int r, int c) { const int st = (r >> 4) * 2 + (c >> 5), rr = r & 15, cc = c & 31, ob = rr * 64 + cc * 2; return st * 1024 + (ob ^ (((ob >> 9) & 1) << 5)); }
__host__ __device__ __forceinline__ void stage_rc(int b, int& R, int& C) { const int st = b / 1024, sb = b % 1024, swz = sb ^ (((sb >> 9) & 1) << 5); R = (st >> 1) * 16 + swz / 64; C = (st & 1) * 32 + (swz % 64) / 2; }
__host__ __device__ __forceinline__ int perm32(int rho) { const int n = rho >> 4, i = rho & 15; return 8 * (i >> 2) + 4 * n + (i & 3); }

struct Unit { int pm, pn; };
struct Gemm { const bf16_t* A; const bf16_t* Bt; int M, N, K, lda, ldb; };

struct StaticOrder {
    int nM, nN, nwg, G, c;
    __host__ __device__ void init(int M, int N, int G_, int c_) { nM = M / BM; nN = N / BM; nwg = nM * nN; G = G_; c = c_; }
    __host__ __device__ bool next(int i, Unit& u) const {
        const long L = (long)i * G + c; if (L >= nwg) return false;
        int wgid = (int)L; { const int q = nwg / NXCD, r = nwg % NXCD, xcd = wgid % NXCD, off = wgid / NXCD; wgid = (xcd < r ? xcd * (q + 1) : r * (q + 1) + (xcd - r) * q) + off; }
        const int nig = WGM * nN, gid = wgid / nig, fm = gid * WGM, gsz = (nM - fm) < WGM ? (nM - fm) : WGM;
        u.pm = fm + ((wgid % nig) % gsz); u.pn = (wgid % nig) / gsz; return true;
    }
    __device__ __forceinline__ void a_ready(const Unit&) const {}
    __device__ __forceinline__ void done(const Unit&) const {}
};

__device__ __forceinline__ unsigned cvt_pk_bf16(float lo, float hi) { unsigned r; asm volatile("v_cvt_pk_bf16_f32 %0, %1, %2" : "=v"(r) : "v"(lo), "v"(hi)); return r; }
typedef float f32x2 __attribute__((ext_vector_type(2)));
typedef float f32x2_t __attribute__((ext_vector_type(2))); typedef __bf16 bf16x2_t __attribute__((ext_vector_type(2)));
typedef unsigned u32x2 __attribute__((ext_vector_type(2)));
__device__ __forceinline__ unsigned cvtpk(float lo, float hi) { f32x2_t v = {lo, hi}; bf16x2_t b = __builtin_convertvector(v, bf16x2_t); return __builtin_bit_cast(unsigned, b); }
__device__ __forceinline__ bf16_t f2bf(float x) { return (bf16_t)(cvtpk(x, 0.f) & 0xffffu); }
__device__ __forceinline__ float bf2f(bf16_t v) { return __uint_as_float((unsigned)v << 16); }
__device__ __forceinline__ float bflo(unsigned w) { return __uint_as_float(w << 16); }
__device__ __forceinline__ float bfhi(unsigned w) { return __uint_as_float(w & 0xffff0000u); }
__device__ __forceinline__ float sigm(float x) { return __builtin_amdgcn_rcpf(1.f + __expf(-x)); }

struct EpiZ {
    static constexpr bool PERM = true, AFTER_DRAIN = false, MIDK = false;
    bf16_t *Zh, *Za, *Zg, *Vt; const float* bgate;
    __device__ __forceinline__ void operator()(const f32x4 (&acc)[2][2][4][2], const Unit& u, int wr, int wc, int fr, int fq) const {
        const int pn = u.pn; bf16_t* base; int ldc, colt;
        if (pn < 8) { base = Zh; ldc = 2048; colt = pn * 256; } else if (pn < 11) { base = Za; ldc = 768; colt = (pn - 8) * 256; } else { base = Zg; ldc = 2048; colt = (pn - 11) * 256; }
        const int row0 = u.pm * BM + wr * 64 + fr, col0 = colt + wc * 32 + 8 * fq;
#pragma unroll
        for (int ai = 0; ai < 2; ++ai)
#pragma unroll
            for (int m = 0; m < 4; ++m) { const int row = row0 + ai * HALF + m * 16; bf16_t* rowp = base + (size_t)row * ldc + col0;
#pragma unroll
                for (int bj = 0; bj < 2; ++bj) { f32x4 v0 = acc[ai][bj][m][0], v1 = acc[ai][bj][m][1];
                    if (pn >= 11) { const f32x4 b0 = *(const f32x4*)(bgate + col0 + bj * HALF), b1 = *(const f32x4*)(bgate + col0 + bj * HALF + 4);
#pragma unroll
                        for (int i = 0; i < 4; ++i) { v0[i] = sigm(v0[i] + b0[i]); v1[i] = sigm(v1[i] + b1[i]); } }
                    if (pn == 10 && bj == 1) {
                        if (row < MA_REAL) { const int b = row / LTOK, pos = row - b * LTOK; bf16_t* vp = Vt + ((size_t)(b * 128 + wc * 32 + 8 * fq) * LPAD + 112 + pos);
                            vp[0] = f2bf(v0[0]); vp[LPAD] = f2bf(v0[1]); vp[2 * LPAD] = f2bf(v0[2]); vp[3 * LPAD] = f2bf(v0[3]);
                            vp[4 * LPAD] = f2bf(v1[0]); vp[5 * LPAD] = f2bf(v1[1]); vp[6 * LPAD] = f2bf(v1[2]); vp[7 * LPAD] = f2bf(v1[3]); }
                    } else { u32x4 w; w.x = cvtpk(v0[0], v0[1]); w.y = cvtpk(v0[2], v0[3]); w.z = cvtpk(v1[0], v1[1]); w.w = cvtpk(v1[2], v1[3]); *(u32x4*)(rowp + bj * HALF) = w; } } }
    }
};
struct EpiGate {
    static constexpr bool PERM = true, AFTER_DRAIN = false, MIDK = true;
    bf16_t* Mb; const bf16_t* Zg; const float* bgate;
    __device__ __forceinline__ void mid(f32x4 (&acc)[2][2][4][2], const Unit& u, int wr, int wc, int fr, int fq) const {
        const int row0 = u.pm * BM + wr * 64 + fr, col0 = u.pn * BM + wc * 32 + 8 * fq;
#pragma unroll
        for (int bj = 0; bj < 2; ++bj)
#pragma unroll
            for (int ai = 0; ai < 2; ++ai)
#pragma unroll
                for (int m = 0; m < 4; ++m) { const int rc = row0 + ai * HALF + m * 16, ra = (rc >> 12) * LTOK + NMETA + (rc & 4095);
                    const bf16_t* zp = Zg + (size_t)ra * 2048 + col0 + bj * HALF; const u32x4 za = *(const u32x4*)zp, zb = *(const u32x4*)(zp + 1024);
                    f32x4& v0 = acc[ai][bj][m][0]; f32x4& v1 = acc[ai][bj][m][1];
                    v0[0] *= bflo(za.x) * __builtin_amdgcn_rcpf(bflo(zb.x)); v0[1] *= bfhi(za.x) * __builtin_amdgcn_rcpf(bfhi(zb.x)); v0[2] *= bflo(za.y) * __builtin_amdgcn_rcpf(bflo(zb.y)); v0[3] *= bfhi(za.y) * __builtin_amdgcn_rcpf(bfhi(zb.y));
                    v1[0] *= bflo(za.z) * __builtin_amdgcn_rcpf(bflo(zb.z)); v1[1] *= bfhi(za.z) * __builtin_amdgcn_rcpf(bfhi(zb.z)); v1[2] *= bflo(za.w) * __builtin_amdgcn_rcpf(bflo(zb.w)); v1[3] *= bfhi(za.w) * __builtin_amdgcn_rcpf(bfhi(zb.w));
                    asm volatile("" ::: "memory"); }
    }
    __device__ __forceinline__ void operator()(const f32x4 (&acc)[2][2][4][2], const Unit& u, int wr, int wc, int fr, int fq) const {
        const int row0 = u.pm * BM + wr * 64 + fr, col0 = u.pn * BM + wc * 32 + 8 * fq;
#pragma unroll
        for (int ai = 0; ai < 2; ++ai)
#pragma unroll
            for (int m = 0; m < 4; ++m) { const int rc = row0 + ai * HALF + m * 16, ra = (rc >> 12) * LTOK + NMETA + (rc & 4095);
                const bf16_t* zp = Zg + (size_t)ra * 2048 + 1024 + col0; bf16_t* mp = Mb + (size_t)rc * 1024 + col0;
#pragma unroll
                for (int bj = 0; bj < 2; ++bj) { const u32x4 z = *(const u32x4*)(zp + bj * HALF); f32x4 v0 = acc[ai][bj][m][0], v1 = acc[ai][bj][m][1];
                    v0[0] *= bflo(z.x); v0[1] *= bfhi(z.x); v0[2] *= bflo(z.y); v0[3] *= bfhi(z.y); v1[0] *= bflo(z.z); v1[1] *= bfhi(z.z); v1[2] *= bflo(z.w); v1[3] *= bfhi(z.w);
                    u32x4 w; w.x = cvtpk(v0[0], v0[1]); w.y = cvtpk(v0[2], v0[3]); w.z = cvtpk(v1[0], v1[1]); w.w = cvtpk(v1[2], v1[3]); *(u32x4*)(mp + bj * HALF) = w; } }
    }
};
struct EpiH1 {
    static constexpr bool PERM = false, AFTER_DRAIN = false, MIDK = false;
    const float* x; bf16_t* h1; float* rowssp;
    __device__ __forceinline__ void operator()(const f32x4 (&acc)[2][2][4][2], const Unit& u, int wr, int wc, int fr, int fq) const {
        const int row0 = u.pm * BM + wr * 64 + fr, col0 = u.pn * BM + wc * 32 + 4 * fq;
#pragma unroll
        for (int ai = 0; ai < 2; ++ai)
#pragma unroll
            for (int m = 0; m < 4; ++m) { const int rc = row0 + ai * HALF + m * 16; float ss = 0.f;
#pragma unroll
                for (int bj = 0; bj < 2; ++bj)
#pragma unroll
                    for (int n = 0; n < 2; ++n) { const size_t off = (size_t)rc * 1024 + col0 + bj * HALF + n * 16;
                        const f32x4 h = *(const f32x4*)(x + off) + acc[ai][bj][m][n]; { u32x2 hw; hw.x = cvtpk(h[0], h[1]); hw.y = cvtpk(h[2], h[3]); *(u32x2*)(h1 + off) = hw; }
                        ss += (h[0] * h[0] + h[1] * h[1]) + (h[2] * h[2] + h[3] * h[3]);
}
                ss += __shfl_xor(ss, 16); ss += __shfl_xor(ss, 32);
                if (fq == 0) rowssp[(size_t)rc * 16 + u.pn * 4 + wc] = ss; }
    }
};
struct EpiQ {
    static constexpr bool PERM = true, AFTER_DRAIN = false, MIDK = false;
    bf16_t* Q;
    __device__ __forceinline__ void operator()(const f32x4 (&acc)[2][2][4][2], const Unit& u, int wr, int wc, int fr, int fq) const {
        const int row0 = u.pm * BM + wr * 64 + fr, col0 = u.pn * BM + wc * 32 + 8 * fq;
#pragma unroll
        for (int ai = 0; ai < 2; ++ai)
#pragma unroll
            for (int m = 0; m < 4; ++m) { const int rc = row0 + ai * HALF + m * 16;
#pragma unroll
                for (int bj = 0; bj < 2; ++bj) { const f32x4 v0 = acc[ai][bj][m][0], v1 = acc[ai][bj][m][1];
                    u32x4 w; w.x = cvtpk(v0[0], v0[1]); w.y = cvtpk(v0[2], v0[3]); w.z = cvtpk(v1[0], v1[1]); w.w = cvtpk(v1[2], v1[3]);
                    const int col = col0 + bj * HALF;
                    *(u32x4*)(Q + ((size_t)((((rc >> 5) * 8 + (col >> 8)) * 2 + ((col >> 7) & 1)) * 8 + ((col & 127) >> 4)) * 64 + ((col >> 3) & 1) * 32 + (rc & 31)) * 8) = w; } }
    }
};
template <class Epi, class Sched, bool ALIGN_EPI = false, bool SP2 = false>
__device__ __forceinline__ void gemm_phase(PG8_LAS unsigned char* lds, const Gemm g, const Sched& S, const Epi& E) {
    const int tid = threadIdx.x, wid = __builtin_amdgcn_readfirstlane(tid >> 6), lane = tid & 63, wr = wid >> 2, wc = wid & 3, fr = lane & 15, fq = lane >> 4;
    const int K = g.K, nt = K / BK;
    unsigned voffA[2], voffB[2];
#pragma unroll
    for (int i = 0; i < 2; ++i) { int R, C; stage_rc(tid * 16 + i * 8192, R, C); const int Rb = Epi::PERM ? ((R & ~31) + perm32(R & 31)) : R;
        voffA[i] = (unsigned)(R * g.lda + C) * 2u; voffB[i] = (unsigned)(Rb * g.ldb + C) * 2u; }
    const size_t kstep = (size_t)(BK * 2);
    const size_t hstepA = (size_t)HALF * g.lda * 2, hstepB = (size_t)HALF * g.ldb * 2;
    const size_t tstepA = 2 * hstepA, tstepB = 2 * hstepB;
    const unsigned ldsw = (unsigned)wid * 1024u;
    const int aoff = lds_byte(wr * 64 + fr, fq * 8), boff = lds_byte(wc * 32 + fr, fq * 8);
#define PG8_SA(b, h) (((b) * 2 + (h)) * HTB)
#define PG8_SB(b, h) ((4 + (b) * 2 + (h)) * HTB)
#define PG8_STAGE(bufoff, gbase, voff) do { _Pragma("unroll") for (int _i = 0; _i < 2; ++_i) \
        __builtin_amdgcn_global_load_lds((const unsigned*)((const char*)(gbase) + (voff)[_i]), (PG8_LAS unsigned*)(lds + (bufoff) + ldsw + _i * 8192), 16, 0, 0); } while (0)
#define PG8_LDA(dst, b, h) do { _Pragma("unroll") for (int m = 0; m < 4; ++m) _Pragma("unroll") for (int k = 0; k < 2; ++k) dst[m][k] = *(const PG8_LAS bf16x8*)(lds + PG8_SA(b, h) + aoff + m * 2048 + k * 1024); } while (0)
#define PG8_LDB(dst, b, h) do { _Pragma("unroll") for (int n = 0; n < 2; ++n) _Pragma("unroll") for (int k = 0; k < 2; ++k) dst[n][k] = *(const PG8_LAS bf16x8*)(lds + PG8_SB(b, h) + boff + n * 2048 + k * 1024); } while (0)
#define PG8_MMA(ai, bj, At, Bt) do { __builtin_amdgcn_s_setprio(1); _Pragma("unroll") for (int m = 0; m < 4; ++m) _Pragma("unroll") for (int n = 0; n < 2; ++n) _Pragma("unroll") for (int k = 0; k < 2; ++k) \
        acc[ai][bj][m][n] = __builtin_amdgcn_mfma_f32_16x16x32_bf16(Bt[n][k], At[m][k], acc[ai][bj][m][n], 0, 0, 0); __builtin_amdgcn_s_setprio(0); } while (0)
#define PG8_WAIT_V(n) asm volatile("s_waitcnt vmcnt(" #n ")" ::: "memory")
#define PG8_WAIT_L(n) asm volatile("s_waitcnt lgkmcnt(" #n ")" ::: "memory")
#define PG8_BAR __builtin_amdgcn_s_barrier()
#define PG8_SCHED __builtin_amdgcn_sched_barrier(0)
    Unit cur, nxt; int ui = 0;
    if (!S.next(0, cur)) return;
    f32x4 acc[2][2][4][2];
#pragma unroll
    for (int a = 0; a < 2; ++a)
#pragma unroll
        for (int b = 0; b < 2; ++b)
#pragma unroll
            for (int m = 0; m < 4; ++m)
#pragma unroll
                for (int n = 0; n < 2; ++n) acc[a][b][m][n] = (f32x4){0.f, 0.f, 0.f, 0.f};
    bf16x8 At[4][2], B0[2][2], B1[2][2];
    const char* cA = (const char*)g.A + (size_t)cur.pm * tstepA; const char* cB = (const char*)g.Bt + (size_t)cur.pn * tstepB;
    S.a_ready(cur);
    if constexpr (SP2) {
        PG8_STAGE(PG8_SB(0, 0), cB, voffB); PG8_STAGE(PG8_SB(0, 1), cB + hstepB, voffB); PG8_STAGE(PG8_SA(0, 0), cA, voffA); PG8_STAGE(PG8_SA(0, 1), cA + hstepA, voffA);
        if (wr == 1) PG8_BAR;
        PG8_WAIT_V(2); PG8_BAR;
        PG8_STAGE(PG8_SB(1, 0), cB + kstep, voffB); PG8_STAGE(PG8_SA(1, 0), cA + kstep, voffA); PG8_STAGE(PG8_SB(1, 1), cB + hstepB + kstep, voffB);
        PG8_WAIT_V(6); PG8_BAR;
    } else {
        PG8_STAGE(PG8_SB(0, 0), cB, voffB); PG8_STAGE(PG8_SA(0, 0), cA, voffA); PG8_STAGE(PG8_SB(0, 1), cB + hstepB, voffB); PG8_STAGE(PG8_SA(0, 1), cA + hstepA, voffA);
        if (wr == 1) PG8_BAR;
        PG8_WAIT_V(4); PG8_BAR;
        PG8_STAGE(PG8_SB(1, 0), cB + kstep, voffB); PG8_STAGE(PG8_SA(1, 0), cA + kstep, voffA); PG8_STAGE(PG8_SB(1, 1), cB + hstepB + kstep, voffB);
        PG8_WAIT_V(6); PG8_BAR;
    }
    for (;;) {
        const bool has_next = S.next(ui + 1, nxt);
        const char* nA = has_next ? (const char*)g.A + (size_t)nxt.pm * tstepA : cA; const char* nB = has_next ? (const char*)g.Bt + (size_t)nxt.pn * tstepB : cB;
        for (int t = 0; t < nt; t += 2) {
            if constexpr (Epi::MIDK) { if (t == (nt >> 1)) { PG8_SCHED; E.mid(acc, cur, wr, wc, fr, fq); PG8_SCHED; } }
            const bool last = (t == nt - 2);
            const char* a1 = cA + (size_t)(t + 1) * kstep;
            const char* a2 = last ? nA : cA + (size_t)(t + 2) * kstep; const char* b2 = last ? nB : cB + (size_t)(t + 2) * kstep;
            const char* a3 = a2 + kstep; const char* b3 = b2 + kstep;
            if (last && has_next) S.a_ready(nxt);
            if constexpr (SP2) {
            PG8_LDB(B0, 0, 0); PG8_LDB(B1, 0, 1); PG8_SCHED; PG8_LDA(At, 0, 0); PG8_STAGE(PG8_SA(1, 1), a1 + hstepA, voffA);
            PG8_WAIT_V(8); PG8_WAIT_L(0); PG8_BAR; PG8_MMA(0, 0, At, B0); PG8_MMA(0, 1, At, B1); PG8_BAR; PG8_SCHED;
            PG8_LDA(At, 0, 1); PG8_STAGE(PG8_SB(0, 0), b2, voffB); PG8_STAGE(PG8_SB(0, 1), b2 + hstepB, voffB); PG8_STAGE(PG8_SA(0, 0), a2, voffA);
            PG8_WAIT_V(8); PG8_WAIT_L(0); PG8_BAR; PG8_MMA(1, 0, At, B0); PG8_MMA(1, 1, At, B1); PG8_BAR; PG8_SCHED;
            PG8_LDB(B0, 1, 0); PG8_LDB(B1, 1, 1); PG8_SCHED; PG8_LDA(At, 1, 0); PG8_STAGE(PG8_SA(0, 1), a2 + hstepA, voffA);
            PG8_WAIT_V(8); PG8_WAIT_L(0); PG8_BAR; PG8_MMA(0, 0, At, B0); PG8_MMA(0, 1, At, B1); PG8_BAR; PG8_SCHED;
            PG8_LDA(At, 1, 1); PG8_STAGE(PG8_SB(1, 0), b3, voffB); PG8_STAGE(PG8_SB(1, 1), b3 + hstepB, voffB); PG8_STAGE(PG8_SA(1, 0), a3, voffA);
            PG8_WAIT_V(8); PG8_WAIT_L(0); PG8_BAR; PG8_MMA(1, 0, At, B0); PG8_MMA(1, 1, At, B1); PG8_BAR; PG8_SCHED;
            } else {
            PG8_LDB(B0, 0, 0); PG8_SCHED; PG8_LDA(At, 0, 0); PG8_STAGE(PG8_SA(1, 1), a1 + hstepA, voffA);
            PG8_WAIT_L(8); PG8_BAR; PG8_WAIT_L(0); PG8_MMA(0, 0, At, B0); PG8_BAR; PG8_SCHED;
            PG8_LDB(B1, 0, 1); PG8_STAGE(PG8_SB(0, 0), b2, voffB);
            PG8_BAR; PG8_WAIT_L(0); PG8_MMA(0, 1, At, B1); PG8_BAR;
            PG8_LDA(At, 0, 1); PG8_STAGE(PG8_SA(0, 0), a2, voffA);
            PG8_BAR; PG8_WAIT_L(0); PG8_MMA(1, 0, At, B0); PG8_BAR; PG8_SCHED;
            PG8_STAGE(PG8_SB(0, 1), b2 + hstepB, voffB);
            PG8_WAIT_V(6); PG8_BAR; PG8_MMA(1, 1, At, B1); PG8_BAR;
            PG8_LDB(B0, 1, 0); PG8_SCHED; PG8_LDA(At, 1, 0); PG8_STAGE(PG8_SA(0, 1), a2 + hstepA, voffA);
            PG8_WAIT_L(8); PG8_BAR; PG8_WAIT_L(0); PG8_MMA(0, 0, At, B0); PG8_BAR; PG8_SCHED;
            PG8_LDB(B1, 1, 1); PG8_STAGE(PG8_SB(1, 0), b3, voffB);
            PG8_BAR; PG8_WAIT_L(0); PG8_MMA(0, 1, At, B1); PG8_BAR;
            PG8_LDA(At, 1, 1); PG8_STAGE(PG8_SA(1, 0), a3, voffA);
            PG8_BAR; PG8_WAIT_L(0); PG8_MMA(1, 0, At, B0); PG8_BAR; PG8_SCHED;
            PG8_STAGE(PG8_SB(1, 1), b3 + hstepB, voffB);
            PG8_WAIT_V(6); PG8_BAR; PG8_MMA(1, 1, At, B1); PG8_BAR;
            }
        }
        if constexpr (ALIGN_EPI) { if (wr == 0) PG8_BAR; }
        if constexpr (!Epi::AFTER_DRAIN) { E(acc, cur, wr, wc, fr, fq); S.done(cur); }
        if (!has_next) break;
#pragma unroll
        for (int a = 0; a < 2; ++a)
#pragma unroll
            for (int b = 0; b < 2; ++b)
#pragma unroll
                for (int m = 0; m < 4; ++m)
#pragma unroll
                    for (int n = 0; n < 2; ++n) acc[a][b][m][n] = (f32x4){0.f, 0.f, 0.f, 0.f};
        cur = nxt; cA = nA; cB = nB; ++ui;
        if constexpr (ALIGN_EPI) { if (wr == 1) PG8_BAR; }
    }
    PG8_WAIT_V(0);
    if constexpr (!ALIGN_EPI) { if (wr == 0) PG8_BAR; }
    PG8_BAR;
    if constexpr (Epi::AFTER_DRAIN) { E.fused(acc, cur, wr, wc, fr, fq, lds, wid, lane); S.done(cur); }
#undef PG8_SA
#undef PG8_SB
#undef PG8_STAGE
#undef PG8_LDA
#undef PG8_LDB
#undef PG8_MMA
#undef PG8_WAIT_V
#undef PG8_WAIT_L
#undef PG8_BAR
#undef PG8_SCHED
}
}
using pg8::bf16_t; using pg8::bf16x8; using pg8::f32x4; using pg8::u32x4; using pg8::u32x2; using pg8::cvtpk; using pg8::f2bf; using pg8::bf2f; using pg8::bflo; using pg8::bfhi; using pg8::sigm;
#define LAS __attribute__((address_space(3)))
typedef float f32x16 __attribute__((ext_vector_type(16)));
#define MFMA32(a, b, c) __builtin_amdgcn_mfma_f32_32x32x16_bf16((a), (b), (c), 0, 0, 0)

constexpr size_t MiB = 1u << 20;
constexpr size_t WS_ZH = 0;
constexpr size_t WS_H1B = 372 * MiB;
constexpr size_t WS_MB = WS_ZH, WS_U8 = WS_ZH + 64 * MiB, WS_V8 = WS_ZH + 80 * MiB, WS_SUV = WS_ZH + 96 * MiB;
constexpr size_t WS_ZA = 129 * MiB;
constexpr size_t WS_ZG = 178 * MiB;
constexpr size_t WS_QB = WS_ZG;
constexpr size_t WS_A1 = 307 * MiB;
constexpr size_t WS_OM = WS_A1, WS_A2 = WS_A1;
constexpr size_t WS_UB = 372 * MiB;
constexpr size_t WS_DV = 436 * MiB;
constexpr size_t WS_VT = 437 * MiB;
constexpr size_t WS_WIN = 446 * MiB;
constexpr size_t WS_WBH = 456 * MiB, WS_WBA = 457 * MiB, WS_WOUT = 458 * MiB, WS_WQ = 460 * MiB, WS_SK = 464 * MiB;
constexpr size_t WS_RS = 465 * MiB;
constexpr size_t WS_CTL = 467 * MiB, CTL_BYTES = 16384;
constexpr size_t WS_END = 468 * MiB;
constexpr int LDS_BYTES = 151552;

__device__ __forceinline__ float wave_sum(float v) {
#pragma unroll
    for (int o = 1; o < 64; o <<= 1) v += __shfl_xor(v, o);
    return v;
}
__device__ __forceinline__ void p0_transpose_item(const float* __restrict__ W, int K, int N, bf16_t* __restrict__ WT, LAS float* scr, int item, int lane, int ldw = 0, const float* __restrict__ kscale = nullptr) {
    if (ldw == 0) ldw = K;
    const int nblk = N / 32, kb = item / nblk, nb = item % nblk, k0 = 64 * kb, n0 = 32 * nb;
#pragma unroll 8
    for (int i = 0; i < 32; ++i) { const int kk = 2 * i + (lane >> 5); scr[kk * 33 + (lane & 31)] = W[(size_t)(k0 + kk) * N + n0 + (lane & 31)] * (kscale ? kscale[k0 + kk] : 1.f); }
    asm volatile("s_waitcnt lgkmcnt(0)" ::: "memory");
    const int c = lane & 7;
#pragma unroll
    for (int j = 0; j < 4; ++j) { const int n = (lane >> 3) + 8 * j; const LAS float* s = scr + (8 * c) * 33 + n;
        u32x4 o; o.x = cvtpk(s[0 * 33], s[1 * 33]); o.y = cvtpk(s[2 * 33], s[3 * 33]); o.z = cvtpk(s[4 * 33], s[5 * 33]); o.w = cvtpk(s[6 * 33], s[7 * 33]);
        *(u32x4*)(WT + (size_t)(n0 + n) * ldw + k0 + 8 * c) = o; }
    asm volatile("s_waitcnt lgkmcnt(0)" ::: "memory");
}
struct P0Args { const float *x, *meta, *gmix, *w_in, *w_bh, *w_ba, *w_out, *w_q, *subk, *gffn; bf16_t *A1, *WinT, *WbhT, *WbaT, *WoutT, *WqT, *SK; };
__device__ __forceinline__ void p0_prologue(LAS unsigned char* lds, const P0Args& p) {
    const int tid = threadIdx.x, lane = tid & 63, wave = tid >> 6;
    LAS float* scr = (LAS float*)(lds + wave * 16384);
    const int gw = blockIdx.x * 8 + wave, NGW = gridDim.x * 8;
    constexpr int I_IN = 16 * 152, I_B = 8 * 32, I_O = 16 * 32, I_Q = 16 * 64, NITEMS = I_IN + 2 * I_B + I_O + I_Q;
    for (int it = gw; it < NITEMS; it += NGW) {
        int r = it;
        if (r < I_IN) { p0_transpose_item(p.w_in, 1024, 4864, p.WinT, scr, r, lane); continue; } r -= I_IN;
        if (r < I_B) { p0_transpose_item(p.w_bh, 512, 1024, p.WbhT, scr, r, lane, 1024); continue; } r -= I_B;
        if (r < I_B) { p0_transpose_item(p.w_ba, 512, 1024, p.WbhT + 512, scr, r, lane, 1024); continue; } r -= I_B;
        if (r < I_O) { p0_transpose_item(p.w_out, 1024, 1024, p.WoutT, scr, r, lane); continue; } r -= I_O;
        p0_transpose_item(p.w_q, 1024, 2048, p.WqT, scr, r, lane, 0, p.gffn);
    }
    for (int p_ = blockIdx.x * 512 + tid; p_ < 262144 / 8; p_ += gridDim.x * 512) {
        const int ln = p_ & 63, kk = (p_ >> 6) & 7, nb = (p_ >> 9) & 3, hc = p_ >> 11;
        const float* src = p.subk + (size_t)(hc * 128 + 32 * nb + (ln & 31)) * 128 + 16 * kk + 8 * (ln >> 5);
        const f32x4 a = *(const f32x4*)src, b = *(const f32x4*)(src + 4);
        u32x4 o; o.x = cvtpk(a[0], a[1]); o.y = cvtpk(a[2], a[3]); o.z = cvtpk(b[0], b[1]); o.w = cvtpk(b[2], b[3]); *(u32x4*)(p.SK + (size_t)p_ * 8) = o; }
    f32x4 g[4];
#pragma unroll
    for (int j = 0; j < 4; ++j) g[j] = *((const f32x4*)p.gmix + lane + 64 * j);
    for (int m0 = gw; m0 < MA; m0 += 4 * NGW) {
        f32x4 v[4][4];
#pragma unroll
        for (int r = 0; r < 4; ++r) { const int m = m0 + r * NGW;
            if (m < MA_REAL) { const int b = m / LTOK, pos = m - b * LTOK;
                const float* src = pos < NMETA ? p.meta + (size_t)pos * 1024 : p.x + ((size_t)b * SEQ + (pos - NMETA)) * 1024;
                const f32x4* xr = (const f32x4*)src + lane;
#pragma unroll
                for (int j = 0; j < 4; ++j) v[r][j] = xr[64 * j]; }
            else {
#pragma unroll
                for (int j = 0; j < 4; ++j) v[r][j] = (f32x4){0.f, 0.f, 0.f, 0.f}; } }
#pragma unroll
        for (int r = 0; r < 4; ++r) { const int m = m0 + r * NGW;
            if (m < MA) { float s = 0.f;
#pragma unroll
                for (int j = 0; j < 4; ++j) s += (v[r][j][0] * v[r][j][0] + v[r][j][1] * v[r][j][1]) + (v[r][j][2] * v[r][j][2] + v[r][j][3] * v[r][j][3]);
                const float rstd = __builtin_amdgcn_rsqf(wave_sum(s) * (1.f / 1024.f) + EPS);
                unsigned long long* o8 = (unsigned long long*)(p.A1 + (size_t)m * 1024) + lane;
#pragma unroll
                for (int j = 0; j < 4; ++j) { const f32x4 y = v[r][j] * rstd * g[j]; o8[64 * j] = (unsigned long long)cvtpk(y[0], y[1]) | ((unsigned long long)cvtpk(y[2], y[3]) << 32); } } }
    }
}

constexpr int SR = 272;
constexpr int OFF_Q = 0, OFF_K = 34816, OFF_V = 69632, OFF_S = 104448, OFF_VEC = 139264;
__device__ __forceinline__ bf16x8 ldfrag(const LAS unsigned char* base, int row, int kk8, int h2) { return *(const LAS bf16x8*)(base + row * SR + (kk8 * 16 + 8 * h2) * 2); }

constexpr int OFF_SEGP = OFF_VEC, OFF_VEC2 = OFF_VEC + 8192, OFF_SSQ = OFF_VEC2 + 1024;
template <bool WITH_Q>
__device__ __forceinline__ void hgrn_front(LAS unsigned char* lds, const bf16_t* __restrict__ Zh, const float* __restrict__ lblog, int b, int h, int c, float (&g)[8][4], float (&kk)[8][4], float (&qq)[8][4], u32x2 (&vraw)[8]) {
    const int tid = threadIdx.x, c4 = tid & 31, seg = tid >> 5;
    const f32x4 l0 = *(const f32x4*)(lblog + h * 128 + 4 * c4), l1 = *(const f32x4*)(lblog + 512 + h * 128 + 4 * c4);
    float lb[4], run[4];
#pragma unroll
    for (int k = 0; k < 4; ++k) { lb[k] = sigm(l0[k] - l1[k]); run[k] = 1.f; }
    u32x2 hfw[8], hqw[8];
#pragma unroll
    for (int i = 0; i < 8; ++i) { const int pos = 128 * c - 112 + 8 * seg + i; const bool valid = pos >= 0;
        const bf16_t* zr = Zh + (size_t)(b * LTOK + (valid ? pos : 0)) * 2048 + h * 128 + 4 * c4;
        hfw[i] = *(const u32x2*)(zr + 512); if (WITH_Q) hqw[i] = *(const u32x2*)zr; vraw[i] = *(const u32x2*)(zr + 1024);
        if (!valid) { hfw[i] = (u32x2){0x7f007f00u, 0x7f007f00u}; hqw[i] = (u32x2){0u, 0u}; vraw[i] = (u32x2){0u, 0u}; } }
#pragma unroll
    for (int i = 0; i < 8; ++i) {
        const float hf[4] = {bflo(hfw[i].x), bfhi(hfw[i].x), bflo(hfw[i].y), bfhi(hfw[i].y)};
#pragma unroll
        for (int k = 0; k < 4; ++k) { const float sg = sigm(hf[k]); const float f = lb[k] + (1.f - lb[k]) * sg; kk[i][k] = (1.f - lb[k]) * (1.f - sg); run[k] *= f; g[i][k] = run[k]; }
        if (WITH_Q) { qq[i][0] = bflo(hqw[i].x); qq[i][1] = bfhi(hqw[i].x); qq[i][2] = bflo(hqw[i].y); qq[i][3] = bfhi(hqw[i].y); } }
    *(LAS f32x4*)(lds + OFF_SEGP + (seg * 128 + 4 * c4) * 4) = (f32x4){run[0], run[1], run[2], run[3]};
    __syncthreads();
}
__device__ __forceinline__ void hgrn_base(LAS unsigned char* lds, float (&base)[4]) {
    const int tid = threadIdx.x, c4 = tid & 31, seg = tid >> 5;
    const LAS f32x4* sp = (const LAS f32x4*)(lds + OFF_SEGP) + c4;
    f32x4 p = (f32x4){1.f, 1.f, 1.f, 1.f};
    if (seg < 8) { for (int s = seg; s < 8; ++s) p *= sp[s * 32];
        if (seg == 0) *(LAS f32x4*)(lds + OFF_VEC2 + (4 * c4) * 4) = p;
#pragma unroll
        for (int k = 0; k < 4; ++k) base[k] = __builtin_amdgcn_rcpf(p[k]); }
    else { for (int s = 8; s < seg; ++s) p *= sp[s * 32];
        if (seg == 15) *(LAS f32x4*)(lds + OFF_VEC2 + (128 + 4 * c4) * 4) = p * sp[15 * 32];
#pragma unroll
        for (int k = 0; k < 4; ++k) base[k] = p[k]; }
}
__device__ __forceinline__ void hgrn_put_vt(LAS unsigned char* lds, const u32x2 (&vraw)[8], int c4, int seg) {
#pragma unroll
    for (int k = 0; k < 4; ++k) { unsigned e[8];
#pragma unroll
        for (int i = 0; i < 8; ++i) { const unsigned w = (k < 2) ? vraw[i].x : vraw[i].y; e[i] = (k & 1) ? (w >> 16) : (w & 0xffffu); }
        *(LAS u32x4*)(lds + OFF_V + (4 * c4 + k) * SR + seg * 16) = (u32x4){e[0] | (e[1] << 16), e[2] | (e[3] << 16), e[4] | (e[5] << 16), e[6] | (e[7] << 16)}; }
}

__device__ __forceinline__ void hgrn_A(LAS unsigned char* lds, const bf16_t* __restrict__ Zh, const float* __restrict__ lblog, float* __restrict__ Ub, float* __restrict__ Dv, int item) {
    const int tid = threadIdx.x, lane = tid & 63, wid = tid >> 6, r32 = lane & 31, h2 = lane >> 5;
    const int c = item & 31, bh = item >> 5, b = bh >> 2, h = bh & 3;
    const int c4 = tid & 31, seg = tid >> 5;
    float g[8][4], kk[8][4], qq[8][4]; u32x2 vraw[8];
    hgrn_front<false>(lds, Zh, lblog, b, h, c, g, kk, qq, vraw);
    { float base[4]; hgrn_base(lds, base);
#pragma unroll
      for (int k = 0; k < 4; ++k) { float kt[8];
#pragma unroll
          for (int i = 0; i < 8; ++i) kt[i] = kk[i][k] * __builtin_amdgcn_rcpf(base[k] * g[i][k]);
          *(LAS u32x4*)(lds + OFF_K + (4 * c4 + k) * SR + seg * 16) = (u32x4){cvtpk(kt[0], kt[1]), cvtpk(kt[2], kt[3]), cvtpk(kt[4], kt[5]), cvtpk(kt[6], kt[7])}; }
      hgrn_put_vt(lds, vraw, c4, seg); }
    __syncthreads();
    const int e0 = 32 * (wid >> 1), d0 = 64 * (wid & 1);
    f32x16 acc[2]; acc[0] = f32x16{}; acc[1] = f32x16{};
#pragma unroll
    for (int k8 = 0; k8 < 8; ++k8) { const bf16x8 a = ldfrag(lds + OFF_V, e0 + r32, k8, h2);
#pragma unroll
        for (int j = 0; j < 2; ++j) acc[j] = MFMA32(a, ldfrag(lds + OFF_K, d0 + 32 * j + r32, k8, h2), acc[j]); }
    const LAS float* vec2 = (const LAS float*)(lds + OFF_VEC2);
#pragma unroll
    for (int j = 0; j < 2; ++j) { const int dc = d0 + 32 * j + r32; const float sc = vec2[128 + dc];
        float* up = Ub + ((size_t)item * 128 + e0 + 4 * h2) * 128 + dc;
#pragma unroll
        for (int r = 0; r < 16; ++r) up[(size_t)((r & 3) + 8 * (r >> 2)) * 128] = acc[j][r] * sc; }
    if (tid < 128) Dv[(size_t)item * 128 + tid] = vec2[tid] * vec2[128 + tid];
    __syncthreads();
}

__device__ __forceinline__ void hgrn_C(LAS unsigned char* lds, const bf16_t* __restrict__ Zh, const float* __restrict__ lblog, const float* __restrict__ Ub, const float* __restrict__ hgn, bf16_t* __restrict__ OM, int item) {
    const int tid = threadIdx.x, lane = tid & 63, wid = tid >> 6, r32 = lane & 31, h2 = lane >> 5;
    const int c = (item & 31) + 1, bh = item >> 5, b = bh >> 2, h = bh & 3;
    const int c4 = tid & 31, seg = tid >> 5;
    const int tb = wid >> 1, wh = wid & 1;
    f32x4 sreg[8];
    { const float* sp = Ub + (size_t)item * 16384;
#pragma unroll
      for (int q = 0; q < 8; ++q) sreg[q] = *(const f32x4*)(sp + (size_t)(tid + 512 * q) * 4); }
    const size_t rc = (size_t)b * SEQ + 128 * (c - 1) + 32 * tb + r32, ra = (size_t)b * LTOK + 128 * c - 112 + 32 * tb + r32;
    u32x2 gate[2][4];
#pragma unroll
    for (int j = 0; j < 2; ++j)
#pragma unroll
        for (int gq = 0; gq < 4; ++gq) gate[j][gq] = *(const u32x2*)(Zh + ra * 2048 + 1536 + h * 128 + 64 * wh + 32 * j + 8 * gq + 4 * h2);
    float g[8][4], kk[8][4], qq[8][4]; u32x2 vraw[8];
    hgrn_front<true>(lds, Zh, lblog, b, h, c, g, kk, qq, vraw);
    { float base[4]; hgrn_base(lds, base);
#pragma unroll
      for (int i = 0; i < 8; ++i) { float r[4], ri[4];
#pragma unroll
          for (int k = 0; k < 4; ++k) { r[k] = base[k] * g[i][k]; ri[k] = __builtin_amdgcn_rcpf(r[k]); }
          const int t = 8 * seg + i;
          *(LAS u32x2*)(lds + OFF_Q + t * SR + 8 * c4) = (u32x2){cvtpk(qq[i][0] * r[0], qq[i][1] * r[1]), cvtpk(qq[i][2] * r[2], qq[i][3] * r[3])};
          *(LAS u32x2*)(lds + OFF_K + t * SR + 8 * c4) = (u32x2){cvtpk(kk[i][0] * ri[0], kk[i][1] * ri[1]), cvtpk(kk[i][2] * ri[2], kk[i][3] * ri[3])}; }
      hgrn_put_vt(lds, vraw, c4, seg); }
    __syncthreads();
    { const LAS float* vec2 = (const LAS float*)(lds + OFF_VEC2);
#pragma unroll
      for (int q = 0; q < 8; ++q) { const int idx = tid + 512 * q, e = idx >> 5, d4 = (idx & 31) * 4; const f32x4 pr = *(const LAS f32x4*)(vec2 + d4); const f32x4 sv = sreg[q] * pr;
          *(LAS u32x2*)(lds + OFF_S + e * SR + d4 * 2) = (u32x2){cvtpk(sv[0], sv[1]), cvtpk(sv[2], sv[3])}; } }
    f32x16 sc[2]; sc[0] = f32x16{}; sc[1] = f32x16{};
#pragma unroll
    for (int j = 0; j < 2; ++j) { const int sb = 2 * wh + j;
        if (sb <= tb) {
#pragma unroll
            for (int k8 = 0; k8 < 8; ++k8) sc[j] = MFMA32(ldfrag(lds + OFF_K, 32 * sb + r32, k8, h2), ldfrag(lds + OFF_Q, 32 * tb + r32, k8, h2), sc[j]); } }
    __syncthreads();
    { const int t = 32 * tb + r32;
#pragma unroll
      for (int j = 0; j < 2; ++j) { const int sb = 2 * wh + j;
#pragma unroll
          for (int gq = 0; gq < 4; ++gq) { const int s0 = 32 * sb + 8 * gq + 4 * h2;
              const float p0 = (sb <= tb && s0 + 0 <= t) ? sc[j][4 * gq + 0] : 0.f, p1 = (sb <= tb && s0 + 1 <= t) ? sc[j][4 * gq + 1] : 0.f;
              const float p2 = (sb <= tb && s0 + 2 <= t) ? sc[j][4 * gq + 2] : 0.f, p3 = (sb <= tb && s0 + 3 <= t) ? sc[j][4 * gq + 3] : 0.f;
              u32x2 w; w.x = cvtpk(p0, p1); w.y = cvtpk(p2, p3); *(LAS u32x2*)(lds + OFF_K + t * SR + s0 * 2) = w; } } }
    __syncthreads();
    f32x16 oc[2]; oc[0] = f32x16{}; oc[1] = f32x16{};
    for (int k8 = 0; k8 < 2 * (tb + 1); ++k8) { const bf16x8 pb = ldfrag(lds + OFF_K, 32 * tb + r32, k8, h2);
#pragma unroll
        for (int j = 0; j < 2; ++j) oc[j] = MFMA32(ldfrag(lds + OFF_V, 64 * wh + 32 * j + r32, k8, h2), pb, oc[j]); }
#pragma unroll
    for (int k8 = 0; k8 < 8; ++k8) { const bf16x8 qb = ldfrag(lds + OFF_Q, 32 * tb + r32, k8, h2);
#pragma unroll
        for (int j = 0; j < 2; ++j) oc[j] = MFMA32(ldfrag(lds + OFF_S, 64 * wh + 32 * j + r32, k8, h2), qb, oc[j]); }
    LAS float* ssq = (LAS float*)(lds + OFF_SSQ);
    { float ss = 0.f;
#pragma unroll
      for (int j = 0; j < 2; ++j)
#pragma unroll
          for (int r = 0; r < 16; ++r) ss += oc[j][r] * oc[j][r];
      ss += __shfl_xor(ss, 32);
      if (h2 == 0) ssq[wh * 128 + 32 * tb + r32] = ss; }
    __syncthreads();
    { const int t = 32 * tb + r32; const float rstd = __builtin_amdgcn_rsqf((ssq[t] + ssq[128 + t]) * (1.f / 128.f) + EPS);
#pragma unroll
      for (int j = 0; j < 2; ++j)
#pragma unroll
          for (int gq = 0; gq < 4; ++gq) { const int e = 64 * wh + 32 * j + 8 * gq + 4 * h2;
              const u32x2 gt = gate[j][gq]; const f32x4 gn = *(const f32x4*)(hgn + h * 128 + e);
              const float g0 = bflo(gt.x), g1 = bfhi(gt.x), g2 = bflo(gt.y), g3 = bfhi(gt.y);
              const float o0 = oc[j][4 * gq + 0] * rstd * gn[0] * (g0 * sigm(g0)), o1 = oc[j][4 * gq + 1] * rstd * gn[1] * (g1 * sigm(g1));
              const float o2 = oc[j][4 * gq + 2] * rstd * gn[2] * (g2 * sigm(g2)), o3 = oc[j][4 * gq + 3] * rstd * gn[3] * (g3 * sigm(g3));
              u32x2 w; w.x = cvtpk(o0, o1); w.y = cvtpk(o2, o3); *(u32x2*)(OM + rc * 1024 + h * 128 + e) = w; } }
    __syncthreads();
}

__device__ __forceinline__ void hgrn_scan(float* __restrict__ Ub, const float* __restrict__ Dv) {
    for (int v = blockIdx.x * 512 + threadIdx.x; v < 32 * 4096; v += gridDim.x * 512) {
        const int bh = v >> 12, i4 = v & 4095, e = i4 >> 5, d4 = (i4 & 31) * 4;
        f32x4* up = (f32x4*)(Ub + ((size_t)(bh * 32) * 128 + e) * 128 + d4); const f32x4* dp = (const f32x4*)(Dv + (size_t)(bh * 32) * 128 + d4);
        f32x4 S = (f32x4){0.f, 0.f, 0.f, 0.f};
#pragma unroll 1
        for (int c0 = 0; c0 < 32; c0 += 8) { f32x4 u[8], dv[8];
#pragma unroll
            for (int c = 0; c < 8; ++c) { u[c] = up[(size_t)(c0 + c) * 4096]; dv[c] = dp[(c0 + c) * 32]; }
#pragma unroll
            for (int c = 0; c < 8; ++c) { S = dv[c] * S + u[c]; up[(size_t)(c0 + c) * 4096] = S; } }
    }
}

constexpr int AK_STRIDE = 144, AV_STRIDE = 560, AK_OFF = 0, AV_OFF = 288 * AK_STRIDE;
__device__ __forceinline__ void attn_stage(LAS unsigned char* lds, const bf16_t* __restrict__ Za, const bf16_t* __restrict__ Vt, int b, int n, int kvh) {
    const int tid = threadIdx.x;
    for (int i = tid; i < 288 * 8; i += 512) { const int kl = i >> 3, ch = i & 7; u32x4 v = (u32x4){0u, 0u, 0u, 0u};
        int pos = -1; if (kl < 256) pos = 128 * (n - 1) + kl - 112; else if (kl < 272) pos = kl - 256;
        if (pos >= 0) v = *(const u32x4*)(Za + (size_t)(b * LTOK + pos) * 768 + 512 + kvh * 64 + 8 * ch);
        *(LAS u32x4*)(lds + AK_OFF + kl * AK_STRIDE + ch * 16) = v; }
    for (int i = tid; i < 64 * 35; i += 512) { const int d = i / 35, ch = i - d * 35; u32x4 v = (u32x4){0u, 0u, 0u, 0u};
        const bf16_t* vr = Vt + (size_t)(b * 128 + kvh * 64 + d) * LPAD;
        if (ch < 32) { if (n > 1 || ch >= 14) v = *(const u32x4*)(vr + 128 * (n - 1) + 8 * ch); }
        else if (ch < 34) v = *(const u32x4*)(vr + 112 + 8 * (ch - 32));
        *(LAS u32x4*)(lds + AV_OFF + d * AV_STRIDE + ch * 16) = v; }
}
__device__ __forceinline__ f32x16 attn_qk(const LAS unsigned char* kp, const bf16x8 (&qf)[4]) {
    f32x16 S = f32x16{};
#pragma unroll
    for (int k = 0; k < 4; ++k) S = MFMA32(*(const LAS bf16x8*)(kp + 32 * k), qf[k], S);
    return S;
}
template <int MODE> __device__ __forceinline__ bool attn_vis(int kr, int r32) { return MODE == 0 ? true : MODE == 1 ? (kr > r32) : MODE == 2 ? (kr <= r32) : (kr < 16); }
template <int MODE> __device__ __forceinline__ float attn_tile_max(const f32x16& S, int r32, int h2) {
    float m = -INFINITY;
#pragma unroll
    for (int r = 0; r < 16; ++r) { const int kr = (r & 3) + 8 * (r >> 2) + 4 * h2; m = fmaxf(m, attn_vis<MODE>(kr, r32) ? S[r] : -INFINITY); }
    return m;
}
template <int MODE> __device__ __forceinline__ void attn_tile_pv(f32x16 S, float c2, float mneg, int r32, int h2, float& l, f32x16 (&O)[2], const LAS unsigned char* vl, int kl0) {
#pragma unroll
    for (int r = 0; r < 16; ++r) { const int kr = (r & 3) + 8 * (r >> 2) + 4 * h2; const float p = __builtin_amdgcn_exp2f(__builtin_fmaf(S[r], c2, mneg)); S[r] = attn_vis<MODE>(kr, r32) ? p : 0.f; l += S[r]; }
#pragma unroll
    for (int s2 = 0; s2 < 2; ++s2) {
        if (MODE == 3 && s2 == 1) continue;
        u32x4 pw; pw.x = cvtpk(S[8 * s2 + 0], S[8 * s2 + 1]); pw.y = cvtpk(S[8 * s2 + 2], S[8 * s2 + 3]); pw.z = cvtpk(S[8 * s2 + 4], S[8 * s2 + 5]); pw.w = cvtpk(S[8 * s2 + 6], S[8 * s2 + 7]);
        const bf16x8 pb = __builtin_bit_cast(bf16x8, pw);
#pragma unroll
        for (int db = 0; db < 2; ++db) { const LAS unsigned char* vp = vl + (32 * db) * AV_STRIDE + (kl0 + 16 * s2) * 2;
            const u32x2 lo = *(const LAS u32x2*)vp, hi = *(const LAS u32x2*)(vp + 16);
            const u32x4 aw = (u32x4){lo.x, lo.y, hi.x, hi.y};
            O[db] = MFMA32(__builtin_bit_cast(bf16x8, aw), pb, O[db]); } }
}
__device__ __forceinline__ void attn_sub(const LAS unsigned char* lds, const bf16_t* __restrict__ Za, const float* __restrict__ sinks, bf16_t* __restrict__ OM, int b, int n, int qh, int sb, int lane) {
    const int r32 = lane & 31, h2 = lane >> 5;
    const int pq = 128 * n + 32 * sb + r32;
    const bf16_t* qp = Za + (size_t)(b * LTOK + pq - 112) * 768 + qh * 64 + 8 * h2;
    bf16x8 qf[4];
#pragma unroll
    for (int k = 0; k < 4; ++k) qf[k] = *(const bf16x8*)(qp + 16 * k);
    const LAS unsigned char* kl = lds + AK_OFF + r32 * AK_STRIDE + 16 * h2;
    const LAS unsigned char* vl = lds + AV_OFF + r32 * AV_STRIDE + 8 * h2;
    const float c2 = 0.125f * 1.4426950408889634f;
    const float sinkl = sinks[qh] * 1.4426950408889634f;
    const int jskip = n == 1 ? 4 - sb : 0;
    float mraw = -INFINITY;
#pragma unroll
    for (int j = 0; j < 5; ++j) { if (j < jskip) continue;
        const f32x16 S = attn_qk(kl + (32 * (sb + j)) * AK_STRIDE, qf);
        mraw = fmaxf(mraw, j == 0 ? attn_tile_max<1>(S, r32, h2) : j == 4 ? attn_tile_max<2>(S, r32, h2) : attn_tile_max<0>(S, r32, h2)); }
    { const f32x16 S = attn_qk(kl + 256 * AK_STRIDE, qf); mraw = fmaxf(mraw, attn_tile_max<3>(S, r32, h2)); }
    float mx = fmaxf(mraw * c2, sinkl);
    mx = fmaxf(mx, __shfl_xor(mx, 32));
    float l = 0.f; const float mneg = -mx;
    f32x16 O[2]; O[0] = f32x16{}; O[1] = f32x16{};
#pragma unroll
    for (int j = 0; j < 5; ++j) { if (j < jskip) continue;
        const int kl0 = 32 * (sb + j); const f32x16 S = attn_qk(kl + kl0 * AK_STRIDE, qf);
        if (j == 0) attn_tile_pv<1>(S, c2, mneg, r32, h2, l, O, vl, kl0); else if (j == 4) attn_tile_pv<2>(S, c2, mneg, r32, h2, l, O, vl, kl0); else attn_tile_pv<0>(S, c2, mneg, r32, h2, l, O, vl, kl0); }
    { const f32x16 S = attn_qk(kl + 256 * AK_STRIDE, qf); attn_tile_pv<3>(S, c2, mneg, r32, h2, l, O, vl, 256); }
    l += __shfl_xor(l, 32); l += __builtin_amdgcn_exp2f(sinkl - mx);
    const float inv = __builtin_amdgcn_rcpf(l);
    bf16_t* op = OM + ((size_t)b * SEQ + 128 * (n - 1) + 32 * sb + r32) * 1024 + 512 + qh * 64 + 4 * h2;
#pragma unroll
    for (int db = 0; db < 2; ++db)
#pragma unroll
        for (int g = 0; g < 4; ++g) { u32x2 w; w.x = cvtpk(O[db][4 * g] * inv, O[db][4 * g + 1] * inv); w.y = cvtpk(O[db][4 * g + 2] * inv, O[db][4 * g + 3] * inv);
            *(u32x2*)(op + 32 * db + 8 * g) = w; }
}
__device__ __forceinline__ unsigned f2ord(float f) { const unsigned u = __float_as_uint(f); return (u & 0x80000000u) ? ~u : (u | 0x80000000u); }
__device__ __forceinline__ float ord2f(unsigned u) { return __uint_as_float((u & 0x80000000u) ? (u & 0x7fffffffu) : ~u); }
__device__ __forceinline__ unsigned umax_(unsigned a, unsigned b) { return a > b ? a : b; }
__device__ __forceinline__ unsigned umin_(unsigned a, unsigned b) { return a < b ? a : b; }
struct Net16 { unsigned char a[63], b[63]; };
constexpr Net16 make_net16() {
    constexpr int P[63][2] = {{0,1},{2,3},{0,2},{1,3},{1,2},{4,5},{6,7},{4,6},{5,7},{5,6},{0,4},{2,6},{2,4},{1,5},{3,7},{3,5},{1,2},{3,4},{5,6},{8,9},{10,11},{8,10},{9,11},{9,10},{12,13},{14,15},{12,14},{13,15},{13,14},
        {8,12},{10,14},{10,12},{9,13},{11,15},{11,13},{9,10},{11,12},{13,14},{0,8},{4,12},{4,8},{2,10},{6,14},{6,10},{2,4},{6,8},{10,12},{1,9},{5,13},{5,9},{3,11},{7,15},{7,11},{3,5},{7,9},{11,13},{1,2},{3,4},{5,6},{7,8},{9,10},{11,12},{13,14}};
    Net16 n{}; for (int k = 0; k < 63; ++k) { n.a[k] = (unsigned char)P[k][0]; n.b[k] = (unsigned char)P[k][1]; } return n;
}
constexpr Net16 NET16 = make_net16();
template <int N> __device__ __forceinline__ void bitonic_desc(unsigned (&a)[N]) {
    static_assert(N == 16, "16-input network");
#pragma unroll
    for (int k = 0; k < 63; ++k) { const unsigned hi = umax_(a[NET16.a[k]], a[NET16.b[k]]), lo = umin_(a[NET16.a[k]], a[NET16.b[k]]); a[NET16.a[k]] = hi; a[NET16.b[k]] = lo; }
}
__device__ __forceinline__ void merge_top16(unsigned (&a)[16], const unsigned (&b)[16]) {
#pragma unroll
    for (int i = 0; i < 16; ++i) a[i] = umax_(a[i], b[15 - i]);
#pragma unroll
    for (int j = 8; j > 0; j >>= 1)
#pragma unroll
        for (int i = 0; i < 16; ++i) { const int l = i ^ j; if (l > i) { const unsigned hi = umax_(a[i], a[l]), lo = umin_(a[i], a[l]); a[i] = hi; a[l] = lo; } }
}
template <bool PAIR> __device__ __forceinline__ void top16_of(unsigned (&g)[4][16]) {
    bitonic_desc<16>(g[0]); bitonic_desc<16>(g[1]); bitonic_desc<16>(g[2]); bitonic_desc<16>(g[3]);
    merge_top16(g[0], g[1]); merge_top16(g[2], g[3]); merge_top16(g[0], g[2]);
    if (PAIR) { unsigned o[16]; const bool up = (threadIdx.x & 32) != 0;
#pragma unroll
        for (int i = 0; i < 16; ++i) { const auto r = __builtin_amdgcn_permlane32_swap(g[0][i], g[0][i], false, false); o[i] = up ? r[0] : r[1]; }
        merge_top16(g[0], o); }
}
__device__ __forceinline__ unsigned sel16p(unsigned long long lo, unsigned long long hi, int i) { const unsigned long long w = (i & 8) ? hi : lo; return (unsigned)(w >> ((i & 7) * 8)) & 0x7fu; }
struct CandTab { unsigned char i[50], j[50]; int n; };
constexpr CandTab make_cands() { CandTab t{}; int n = 0; for (int i = 0; i < 16; ++i) for (int j = 0; j < 16; ++j) if ((i + 1) * (j + 1) <= 16) { t.i[n] = (unsigned char)i; t.j[n] = (unsigned char)j; ++n; } t.n = n; return t; }
constexpr CandTab CT = make_cands();
static_assert(CT.n == 50, "candidate count");

constexpr int PL_IDX = 0, PL_GB = 32768, PL_PA = 65536, PL_SSQ = 131072;
__device__ __forceinline__ void peer_list(const bf16_t* __restrict__ Qb, const bf16_t* __restrict__ SK, int rc0, int h, int c, int r32, int h2, unsigned (&top)[16]) {
    const int lane_ = 32 * h2 + r32;
    const bf16_t* qp = Qb + ((size_t)((((rc0 >> 5) * 8 + h) * 2 + c) * 8) * 64 + lane_) * 8;
    bf16x8 qf[8];
#pragma unroll
    for (int k = 0; k < 8; ++k) qf[k] = *(const bf16x8*)(qp + 512 * k);
    unsigned g[4][16];
#pragma unroll
    for (int nb = 0; nb < 4; ++nb) {
        const bf16_t* kp = SK + ((size_t)(((h * 2 + c) * 4 + nb) * 8) * 64 + lane_) * 8;
        f32x16 acc = f32x16{};
#pragma unroll
        for (int k = 0; k < 8; ++k) acc = MFMA32(*(const bf16x8*)(kp + 512 * k), qf[k], acc);
#pragma unroll
        for (int r = 0; r < 16; ++r) g[nb][r] = (f2ord(acc[r]) & 0xffffff80u) | (unsigned)(32 * nb + (r & 3) + 8 * (r >> 2) + 4 * h2);
        __builtin_amdgcn_sched_barrier(0);
    }
    top16_of<true>(g);
#pragma unroll
    for (int k = 0; k < 16; ++k) top[k] = g[0][k];
}
__device__ __forceinline__ void peer_topk(LAS unsigned char* lds, const bf16_t* __restrict__ Qb, const bf16_t* __restrict__ SK, const float* __restrict__ rowssp, int rc0, int tl0, int h0, int lane) {
    float rstd_t;
    { const f32x4* rp = (const f32x4*)(rowssp + (size_t)(rc0 + (lane & 31)) * 16); const f32x4 s4 = (rp[0] + rp[1]) + (rp[2] + rp[3]); rstd_t = __builtin_amdgcn_rsqf(((s4[0] + s4[1]) + (s4[2] + s4[3])) * (1.0f / 1024.0f) + EPS); }
#pragma unroll 1
    for (int hh = 0; hh < 4; ++hh) {
        asm volatile("" : "+v"(lane));
        const int r32 = lane & 31, h2 = lane >> 5;
        const int h = h0 + hh;
        unsigned ta[16], tb[16];
        peer_list(Qb, SK, rc0, h, 0, r32, h2, ta);
        peer_list(Qb, SK, rc0, h, 1, r32, h2, tb);
        float av[16], bv[16]; unsigned long long ail = 0, aih = 0, bil = 0, bih = 0;
#pragma unroll
        for (int k = 0; k < 16; ++k) { av[k] = ord2f(ta[k] & 0xffffff80u); bv[k] = ord2f(tb[k] & 0xffffff80u);
            if (k < 8) { ail |= (unsigned long long)(ta[k] & 0x7fu) << (8 * k); bil |= (unsigned long long)(tb[k] & 0x7fu) << (8 * k); }
            else { aih |= (unsigned long long)(ta[k] & 0x7fu) << (8 * (k - 8)); bih |= (unsigned long long)(tb[k] & 0x7fu) << (8 * (k - 8)); } }
        unsigned k2[4][16];
#pragma unroll
        for (int k = 0; k < 64; ++k) { if (k < 50) k2[k >> 4][k & 15] = (f2ord(av[CT.i[k < 50 ? k : 0]] + bv[CT.j[k < 50 ? k : 0]]) & 0xffffff00u) | (unsigned)(CT.i[k < 50 ? k : 0] * 16 + CT.j[k < 50 ? k : 0]); else k2[k >> 4][k & 15] = 0u; }
        top16_of<false>(k2);
        float ev[16]; float es = 0.f; const float m0 = ord2f(k2[0][0] & 0xffffff00u);
#pragma unroll
        for (int k = 0; k < 16; ++k) { ev[k] = __expf((ord2f(k2[0][k] & 0xffffff00u) - m0) * rstd_t); es += ev[k]; }
        const float inv = 1.f / es;
        LAS unsigned short* ip = (LAS unsigned short*)(lds + PL_IDX) + (tl0 + r32) * 128 + h * 16;
        LAS bf16_t* gp = (LAS bf16_t*)(lds + PL_GB) + (tl0 + r32) * 128 + h * 16;
#pragma unroll
        for (int k = 0; k < 16; ++k) { const int code = (int)(k2[0][k] & 0xffu); const unsigned e = sel16p(ail, aih, code >> 4) * 128u + sel16p(bil, bih, code & 15);
            if ((k >> 3) == h2) { ip[k] = (unsigned short)e; gp[k] = f2bf(ev[k] * inv); } }
    }
}
__device__ __forceinline__ pg8::f32x2_t fp8x2(unsigned w, bool hi) { return hi ? __builtin_amdgcn_cvt_pk_f32_fp8(w, true) : __builtin_amdgcn_cvt_pk_f32_fp8(w, false); }
template <int CTRL> __device__ __forceinline__ float dppf(float v) { return __builtin_bit_cast(float, __builtin_amdgcn_update_dpp(0, __builtin_bit_cast(int, v), CTRL, 0xf, 0xf, true)); }
template <bool WITH_X>
__device__ __forceinline__ void peer_rows_load(u32x4 (&rw)[16], u32x4 (&xw)[2], const LAS unsigned char* lds, int tl, size_t rc, int s, const unsigned char* __restrict__ T8, const bf16_t* __restrict__ A2, int lane) {
    const int c = lane & 7, gq = lane >> 3;
    if (WITH_X) { xw[0] = *(const u32x4*)((const unsigned char*)A2 + rc * 1024 + 128 * s + 16 * c); xw[1].x = __float_as_uint(*(const float*)((const unsigned char*)A2 + (size_t)MC * 1024 + rc * 4)); }
    const LAS u32x4* ip = (const LAS u32x4*)(lds + PL_IDX + tl * 256 + gq * 32);
    const u32x4 i0 = ip[0], i1 = ip[1];
    const unsigned iw[8] = {i0.x, i0.y, i0.z, i0.w, i1.x, i1.y, i1.z, i1.w};
    const __amdgpu_buffer_rsrc_t rs = __builtin_amdgcn_make_buffer_rsrc((void*)T8, (short)0, 16 << 20, 0x00020000);
    const unsigned c16 = 16u * (unsigned)c; const int soff = 128 * s;
#pragma unroll
    for (int ig = 0; ig < 16; ++ig) { const unsigned e = (ig & 1) ? (iw[ig >> 1] >> 16) : (iw[ig >> 1] & 0xffffu);
        rw[ig] = __builtin_bit_cast(u32x4, __builtin_amdgcn_raw_buffer_load_b128(rs, (int)((e << 10) | c16), soff, 0)); }
}
template <int CTRL> __device__ __forceinline__ int dppi(int v) { return __builtin_amdgcn_update_dpp(0, v, CTRL, 0xf, 0xf, true); }
__device__ __forceinline__ void peer_u_math(const u32x4 (&uw)[16], const u32x4 (&xw)[2], LAS unsigned char* lds, int tl, int lane) {
    const int c = lane & 7, gq = lane >> 3;
    const int x0 = (int)xw[0].x, x1 = (int)xw[0].y, x2 = (int)xw[0].z, x3 = (int)xw[0].w;
    int d[16];
#pragma unroll
    for (int ig = 0; ig < 16; ++ig) { int t = __builtin_amdgcn_sdot4((int)uw[ig].x, x0, 0, false); t = __builtin_amdgcn_sdot4((int)uw[ig].y, x1, t, false); t = __builtin_amdgcn_sdot4((int)uw[ig].z, x2, t, false); d[ig] = __builtin_amdgcn_sdot4((int)uw[ig].w, x3, t, false); }
    const bool c4 = c & 4, c2 = c & 2, c1 = c & 1;
    int acc[2];
#pragma unroll
    for (int hf = 0; hf < 2; ++hf) { int t[4];
#pragma unroll
        for (int j = 0; j < 4; ++j) { const int keep = c4 ? d[8 * hf + j + 4] : d[8 * hf + j], send = c4 ? d[8 * hf + j] : d[8 * hf + j + 4]; t[j] = keep + dppi<0x141>(send); }
#pragma unroll
        for (int j = 0; j < 2; ++j) { const int keep = c2 ? t[j + 2] : t[j], send = c2 ? t[j] : t[j + 2]; t[j] = keep + dppi<0x4E>(send); }
        { const int keep = c1 ? t[1] : t[0], send = c1 ? t[0] : t[1]; acc[hf] = keep + dppi<0xB1>(send); } }
    const float sx = __uint_as_float(xw[1].x);
    LAS float* pp = (LAS float*)(lds + PL_PA) + tl * 128 + 16 * gq + c;
    __hip_atomic_fetch_add(pp, (float)acc[0] * sx, __ATOMIC_RELAXED, __HIP_MEMORY_SCOPE_WORKGROUP);
    __hip_atomic_fetch_add(pp + 8, (float)acc[1] * sx, __ATOMIC_RELAXED, __HIP_MEMORY_SCOPE_WORKGROUP);
}
__device__ __forceinline__ void peer_a_step(LAS unsigned char* lds, int tl, size_t rc, const float* __restrict__ rowssp, const float* __restrict__ su, const float* __restrict__ sv, int lane) {
    float rs = rowssp[rc * 16 + (lane & 15)];
    rs += __shfl_xor(rs, 1); rs += __shfl_xor(rs, 2); rs += __shfl_xor(rs, 4); rs += __shfl_xor(rs, 8);
    const float rstd = __builtin_amdgcn_rsqf(rs * (1.f / 1024.f) + EPS);
    float w[2];
#pragma unroll
    for (int q = 0; q < 2; ++q) { const int k = lane + 64 * q;
        const unsigned e = ((const LAS unsigned short*)(lds + PL_IDX))[tl * 128 + k];
        const float z = ((const LAS float*)(lds + PL_PA))[tl * 128 + k] * rstd * su[e]; const float a = 0.5f * z * (1.f + erff(z * 0.70710678118654752f));
        w[q] = bf2f(((const LAS bf16_t*)(lds + PL_GB))[tl * 128 + k]) * a * sv[e]; }
    float am = fmaxf(fabsf(w[0]), fabsf(w[1]));
#pragma unroll
    for (int o = 1; o < 64; o <<= 1) am = fmaxf(am, __shfl_xor(am, o));
    const float sc = am > 0.f ? 127.f / am : 1.f;
    LAS signed char* wq = (LAS signed char*)(lds + PL_PA + tl * 512);
    wq[lane] = (signed char)__float2int_rn(w[0] * sc); wq[lane + 64] = (signed char)__float2int_rn(w[1] * sc);
    if (lane == 0) ((LAS float*)(lds + PL_SSQ))[tl] = am > 0.f ? am / 127.f : 1.f;
}
__device__ __forceinline__ void peer_v_math(const u32x4 (&vw)[16], LAS unsigned char* lds, int tl, size_t rc, int s, bf16_t* __restrict__ dout, int lane) {
    const int c = lane & 7, gq = lane >> 3;
    const u32x4 wq4 = *(const LAS u32x4*)(lds + PL_PA + tl * 512 + 16 * gq);
    const float wsc = ((const LAS float*)(lds + PL_SSQ))[tl];
    const bool b3 = lane & 8, b4 = lane & 16, b5 = lane & 32;
    unsigned* hp = (unsigned*)(dout + rc * 1024 + 128 * s + 16 * c + (b3 ? 8 : 0) + (b4 ? 4 : 0) + (b5 ? 2 : 0));
    const unsigned hw = *hp; pg8::f32x2_t h = (pg8::f32x2_t){bflo(hw), bfhi(hw)};
    int ia[16];
#pragma unroll
    for (int i = 0; i < 16; ++i) ia[i] = 0;
#pragma unroll
    for (int m = 0; m < 4; ++m) { const int wm = (int)wq4[m];
#pragma unroll
        for (int p = 0; p < 4; ++p) { const unsigned A = vw[4 * m][p], B = vw[4 * m + 1][p], C = vw[4 * m + 2][p], D = vw[4 * m + 3][p];
            const unsigned X0 = __builtin_amdgcn_perm(B, A, 0x05010400u), X1 = __builtin_amdgcn_perm(B, A, 0x07030602u), Y0 = __builtin_amdgcn_perm(D, C, 0x05010400u), Y1 = __builtin_amdgcn_perm(D, C, 0x07030602u);
            const unsigned T0 = __builtin_amdgcn_perm(Y0, X0, 0x05040100u), T1 = __builtin_amdgcn_perm(Y0, X0, 0x07060302u), T2 = __builtin_amdgcn_perm(Y1, X1, 0x05040100u), T3 = __builtin_amdgcn_perm(Y1, X1, 0x07060302u);
            ia[4 * p] = __builtin_amdgcn_sdot4((int)T0, wm, ia[4 * p], false); ia[4 * p + 1] = __builtin_amdgcn_sdot4((int)T1, wm, ia[4 * p + 1], false);
            ia[4 * p + 2] = __builtin_amdgcn_sdot4((int)T2, wm, ia[4 * p + 2], false); ia[4 * p + 3] = __builtin_amdgcn_sdot4((int)T3, wm, ia[4 * p + 3], false); } }
    float out[16];
#pragma unroll
    for (int i = 0; i < 16; ++i) out[i] = (float)ia[i] * wsc;
#pragma unroll
    for (int j = 0; j < 8; ++j) { const float keep = b3 ? out[j + 8] : out[j], send = b3 ? out[j] : out[j + 8]; out[j] = keep + dppf<0x128>(send); }
#pragma unroll
    for (int j = 0; j < 4; ++j) { const auto r = __builtin_amdgcn_permlane16_swap(__float_as_uint(out[j]), __float_as_uint(out[j + 4]), false, false); out[j] = __uint_as_float(r[0]) + __uint_as_float(r[1]); }
#pragma unroll
    for (int j = 0; j < 2; ++j) { const auto r = __builtin_amdgcn_permlane32_swap(__float_as_uint(out[j]), __float_as_uint(out[j + 2]), false, false); out[j] = __uint_as_float(r[0]) + __uint_as_float(r[1]); }
    h.x += out[0]; h.y += out[1];
    *hp = cvtpk(h.x, h.y);
}
template <int NT>
__device__ __forceinline__ void peer_f_steps(size_t rc, const bf16_t* __restrict__ h2b, float* __restrict__ dout, const float* __restrict__ gfin, int lane) {
    u32x2 hw[NT][4];
#pragma unroll
    for (int i = 0; i < NT; ++i)
#pragma unroll
        for (int q = 0; q < 4; ++q) hw[i][q] = *(const u32x2*)(h2b + (rc + i) * 1024 + 256 * q + 4 * lane);
    f32x4 g[4];
#pragma unroll
    for (int q = 0; q < 4; ++q) g[q] = *(const f32x4*)(gfin + 256 * q + 4 * lane);
#pragma unroll
    for (int i = 0; i < NT; ++i) { f32x4 h[4]; f32x4 sq = (f32x4){0.f, 0.f, 0.f, 0.f};
#pragma unroll
        for (int q = 0; q < 4; ++q) { h[q] = (f32x4){bflo(hw[i][q].x), bfhi(hw[i][q].x), bflo(hw[i][q].y), bfhi(hw[i][q].y)}; sq += h[q] * h[q]; }
        const float rf = __builtin_amdgcn_rsqf(wave_sum((sq[0] + sq[1]) + (sq[2] + sq[3])) * (1.f / 1024.f) + EPS);
        float* op = dout + (rc + i) * 1024 + 4 * lane;
#pragma unroll
        for (int q = 0; q < 4; ++q) *(f32x4*)(op + 256 * q) = h[q] * rf * g[q]; }
}
__device__ __forceinline__ unsigned pack_i8x4(float a, float b, float c, float d) {
    const int ia = __float2int_rn(a), ib = __float2int_rn(b), ic = __float2int_rn(c), id = __float2int_rn(d);
    return (unsigned)(ia & 0xff) | ((unsigned)(ib & 0xff) << 8) | ((unsigned)(ic & 0xff) << 16) | ((unsigned)id << 24);
}
__device__ __forceinline__ void peer_tables(const float* __restrict__ pu, const float* __restrict__ pv, unsigned char* __restrict__ T8, float* __restrict__ sinv, int lane, int gw, int NGW) {
    for (int row = gw; row < 32768; row += NGW) {
        const bool isu = row < 16384;
        const float* src = (isu ? pu + (size_t)row * 1024 : pv + (size_t)(row - 16384) * 1024) + 16 * lane;
        f32x4 v[4]; float am = 0.f;
#pragma unroll
        for (int q = 0; q < 4; ++q) { v[q] = *(const f32x4*)(src + 4 * q); am = fmaxf(am, fmaxf(fmaxf(fabsf(v[q][0]), fabsf(v[q][1])), fmaxf(fabsf(v[q][2]), fabsf(v[q][3])))); }
#pragma unroll
        for (int o = 1; o < 64; o <<= 1) am = fmaxf(am, __shfl_xor(am, o));
        const float top = 127.f;
        const float sc = am > 0.f ? top / am : 1.f;
        u32x4 w;
#pragma unroll
        for (int q = 0; q < 4; ++q) w[q] = pack_i8x4(v[q][0] * sc, v[q][1] * sc, v[q][2] * sc, v[q][3] * sc);
        *(u32x4*)(T8 + (size_t)row * 1024 + 16 * lane) = w;
        if (lane == 0) sinv[row] = am > 0.f ? am / top : 1.f;
    }
}
__device__ __forceinline__ void peer_xq_token(const bf16_t* __restrict__ H1, const float* __restrict__ gffn, unsigned char* __restrict__ XQ, float* __restrict__ SX, size_t rc, int lane) {
    const u32x4 xa = *(const u32x4*)(H1 + rc * 1024 + 16 * lane), xb = *(const u32x4*)(H1 + rc * 1024 + 16 * lane + 8);
    const unsigned w[8] = {xa.x, xa.y, xa.z, xa.w, xb.x, xb.y, xb.z, xb.w};
    float xv[16]; float am = 0.f;
#pragma unroll
    for (int q = 0; q < 4; ++q) { const f32x4 g = *(const f32x4*)(gffn + 16 * lane + 4 * q);
        xv[4 * q] = bflo(w[2 * q]) * g[0]; xv[4 * q + 1] = bfhi(w[2 * q]) * g[1]; xv[4 * q + 2] = bflo(w[2 * q + 1]) * g[2]; xv[4 * q + 3] = bfhi(w[2 * q + 1]) * g[3];
        am = fmaxf(am, fmaxf(fmaxf(fabsf(xv[4 * q]), fabsf(xv[4 * q + 1])), fmaxf(fabsf(xv[4 * q + 2]), fabsf(xv[4 * q + 3])))); }
#pragma unroll
    for (int o = 1; o < 64; o <<= 1) am = fmaxf(am, __shfl_xor(am, o));
    const float sc = am > 0.f ? 127.f / am : 1.f;
    u32x4 o;
#pragma unroll
    for (int q = 0; q < 4; ++q) o[q] = pack_i8x4(xv[4 * q] * sc, xv[4 * q + 1] * sc, xv[4 * q + 2] * sc, xv[4 * q + 3] * sc);
    *(u32x4*)(XQ + rc * 1024 + 16 * lane) = o;
    if (lane == 0) SX[rc] = am > 0.f ? am / 127.f : 1.f;
}

#define XB_TMO      128
#define XB_XCNT(j)  (256  + 64 * (j))
#define XB_XSUB(j)  (1280 + 64 * (j))
#define XB_XGEN(j)  (2304 + 64 * (j))
#define XB_TOP      3328
#define XB_TOPGEN   3392
#define XCD_BAR_WORDS 3456
#define XB_SPIN_CAP (1u << 18)

__device__ __forceinline__ unsigned xb_ld(unsigned* p)              { return __hip_atomic_load(p, __ATOMIC_RELAXED, __HIP_MEMORY_SCOPE_AGENT); }
__device__ __forceinline__ unsigned xb_add(unsigned* p, unsigned v) { return __hip_atomic_fetch_add(p, v, __ATOMIC_RELAXED, __HIP_MEMORY_SCOPE_AGENT); }
__device__ __forceinline__ unsigned xb_xcc_id() { return (unsigned)__builtin_amdgcn_s_getreg((3 << 11) | 20) & 0xFu; }
#define XB_SPIN(cond, bar) do { unsigned _sp = 0; while (cond) { __builtin_amdgcn_s_sleep(1); \
    if ((++_sp & 255u) == 0u) { if (xb_ld(&(bar)[XB_TMO])) break; if (_sp > XB_SPIN_CAP) { atomicAdd(&(bar)[XB_TMO], 1u); break; } } } } while (0)

struct XcdBarrier {
    unsigned* bar; unsigned x;
    volatile LAS unsigned* st;
};

__device__ __forceinline__ XcdBarrier xcd_barrier_post(unsigned* bar, volatile LAS unsigned* st) {
    XcdBarrier b; b.bar = bar; b.x = xb_xcc_id(); b.st = st;
    if (threadIdx.x == 0) (void)xb_add(&bar[XB_XCNT(b.x)], 1u);
    return b;
}
__device__ __forceinline__ void xcd_barrier_complete(unsigned* bar, unsigned x, unsigned& nloc, unsigned& nx) {
    const unsigned G = gridDim.x * gridDim.y * gridDim.z;
    unsigned sum, cnt, mine, sp = 0u;
    for (;;) {
        sum = 0u; cnt = 0u; mine = 0u;
#pragma unroll
        for (unsigned j = 0; j < 16; ++j) { const unsigned c = xb_ld(&bar[XB_XCNT(j)]); sum += c; cnt += (c > 0u) ? 1u : 0u; mine = (j == x) ? c : mine; }
        if (sum == G) break;
        __builtin_amdgcn_s_sleep(1);
        if ((++sp & 255u) == 0u) { if (xb_ld(&bar[XB_TMO])) break; if (sp > XB_SPIN_CAP) { atomicAdd(&bar[XB_TMO], 1u); break; } }
    }
    nloc = mine > 0u ? mine : 1u; nx = cnt > 0u ? cnt : 1u;
}

__device__ __forceinline__ void xcd_barrier(const XcdBarrier& b) {
    asm volatile("s_waitcnt vmcnt(0)" ::: "memory");
    __syncthreads();
    if (threadIdx.x == 0) {
        unsigned* bar = b.bar;
        __builtin_amdgcn_s_waitcnt(0);
        unsigned nloc = b.st[0], nx = b.st[1];
        if (nloc == 0u) { xcd_barrier_complete(bar, b.x, nloc, nx); b.st[0] = nloc; b.st[1] = nx; }
        const unsigned old = xb_add(&bar[XB_XSUB(b.x)], 1u);
        const unsigned gen = old / nloc;
        if (old + 1u == (gen + 1u) * nloc) {
            __builtin_amdgcn_fence(__ATOMIC_RELEASE, "agent");
            asm volatile("s_waitcnt vmcnt(0)" ::: "memory");
            const unsigned og = xb_add(&bar[XB_TOP], 1u);
            const unsigned tg = og / nx;
            if (og + 1u == (tg + 1u) * nx) xb_add(&bar[XB_TOPGEN], 1u);
            else XB_SPIN(xb_ld(&bar[XB_TOPGEN]) == tg, bar);
            __builtin_amdgcn_fence(__ATOMIC_ACQUIRE, "agent");
            xb_add(&bar[XB_XGEN(b.x)], 1u);
            asm volatile("s_waitcnt vmcnt(0)" ::: "memory");
        } else {
            XB_SPIN(xb_ld(&bar[XB_XGEN(b.x)]) == gen, bar);
            __builtin_amdgcn_fence(__ATOMIC_ACQUIRE, "agent");
            asm volatile("s_waitcnt vmcnt(0)" ::: "memory");
        }
    }
    __syncthreads();
}

constexpr int NPHASE = 9;
struct Args { const float* in[17]; float* out; unsigned char* ws; int ph_lo, ph_hi; };
__global__ void __launch_bounds__(512, 2) fwd_kernel(Args a) {
    extern __shared__ __attribute__((aligned(16))) unsigned char lds_raw[];
    LAS unsigned char* lds = (LAS unsigned char*)lds_raw;
    cg::grid_group grid = cg::this_grid();
    const int tid = threadIdx.x, lane = tid & 63, wave = __builtin_amdgcn_readfirstlane(tid >> 6);
    const int lo = a.ph_lo, hi = a.ph_hi, G = gridDim.x;
    typedef const __attribute__((address_space(4))) Args* kargp_t;
#define KARGS kargp_t kp_ = (kargp_t)__builtin_amdgcn_kernarg_segment_ptr(); asm volatile("" : "+s"(kp_)); unsigned char* const ws = kp_->ws
#define INP(k) ((const float*)kp_->in[k])
#define WSP(T, off) ((T*)(ws + (off)))
#ifdef ONLY_PHASE
#define IN(k) ((k) == ONLY_PHASE && lo <= (k) && (k) < hi)
#else
#define IN(k) (lo <= (k) && (k) < hi)
#endif
    volatile LAS unsigned* bar_st = (volatile LAS unsigned*)(lds + LDS_BYTES - 64);
    XcdBarrier xbar; xbar.bar = (unsigned*)(a.ws + WS_CTL); xbar.x = 0; xbar.st = bar_st;
    if (hi - lo > 1) { if (tid < 2) bar_st[tid] = 0u; __syncthreads(); xbar = xcd_barrier_post((unsigned*)(a.ws + WS_CTL), bar_st); }
    if (lo < 0) grid.sync();
#define SEAM(k) do { if (lo <= (k) && (k) + 1 < hi) xcd_barrier(xbar); } while (0)

    if (IN(0)) { KARGS; P0Args p{INP(0), INP(1), INP(2), INP(3), INP(8), INP(9), INP(10), INP(12), INP(13), INP(11), WSP(bf16_t, WS_A1), WSP(bf16_t, WS_WIN), WSP(bf16_t, WS_WBH), WSP(bf16_t, WS_WBA), WSP(bf16_t, WS_WOUT), WSP(bf16_t, WS_WQ), WSP(bf16_t, WS_SK)}; p0_prologue(lds, p); SEAM(0); }
    if (IN(1)) {
        KARGS; bf16_t *A1 = WSP(bf16_t, WS_A1), *WinT = WSP(bf16_t, WS_WIN), *Zh = WSP(bf16_t, WS_ZH), *Za = WSP(bf16_t, WS_ZA), *Zg = WSP(bf16_t, WS_ZG), *Vt = WSP(bf16_t, WS_VT);
        pg8::Gemm g{A1, WinT, MA, 4864, 1024, 1024, 1024}; pg8::StaticOrder S; S.init(MA, 4864, G, (int)blockIdx.x);
        pg8::EpiZ E{Zh, Za, Zg, Vt, INP(4)};
        pg8::gemm_phase<pg8::EpiZ, pg8::StaticOrder, true, true>(lds, g, S, E);
        SEAM(1);
    }
    if (IN(2)) {
        KARGS; bf16_t *Zh = WSP(bf16_t, WS_ZH), *Za = WSP(bf16_t, WS_ZA), *Vt = WSP(bf16_t, WS_VT), *OM = WSP(bf16_t, WS_OM); float *Ub = WSP(float, WS_UB), *Dv = WSP(float, WS_DV); const float *lblog = INP(5), *sinks = INP(7);
        for (int it = blockIdx.x; it < 1024 + 512; it += G) {
            if (it < 1024) {
#ifndef NO_HGA
 hgrn_A(lds, Zh, lblog, Ub, Dv, it);
#endif
 }
            else { const int ai = it - 1024, b = ai >> 6, n = ((ai & 63) >> 1) + 1, kvh = ai & 1;
                attn_stage(lds, Za, Vt, b, n, kvh);
                __syncthreads();
#pragma unroll 1
                for (int si = wave; si < 16; si += 8) attn_sub(lds, Za, sinks, OM, b, n, kvh * 4 + (si >> 2), si & 3, lane);
                __syncthreads(); }
        }
        SEAM(2);
    }
    if (IN(3)) { KARGS; hgrn_scan(WSP(float, WS_UB), WSP(float, WS_DV)); SEAM(3); }
    if (IN(4)) { KARGS; for (int it = blockIdx.x; it < 1024; it += G) hgrn_C(lds, WSP(bf16_t, WS_ZH), INP(5), WSP(float, WS_UB), INP(6), WSP(bf16_t, WS_OM), it); SEAM(4); }
    if (IN(5)) {
        KARGS; bf16_t *OM = WSP(bf16_t, WS_OM), *WbhT = WSP(bf16_t, WS_WBH), *Mb = WSP(bf16_t, WS_MB), *Zg = WSP(bf16_t, WS_ZG); const float* bgate = INP(4);
        peer_tables(INP(14), INP(15), ws + WS_U8, WSP(float, WS_SUV), lane, blockIdx.x * 8 + wave, G * 8);
        __syncthreads();
        pg8::StaticOrder S; S.init(MC, 1024, G, (int)blockIdx.x);
        { pg8::Gemm g{OM, WbhT, MC, 1024, 1024, 1024, 1024}; pg8::EpiGate E{Mb, Zg, bgate}; pg8::gemm_phase<pg8::EpiGate, pg8::StaticOrder, true, true>(lds, g, S, E); }
        SEAM(5);
    }
    if (IN(6)) {
        KARGS; bf16_t *Mb = WSP(bf16_t, WS_MB), *WoutT = WSP(bf16_t, WS_WOUT); float* rowssp = WSP(float, WS_RS); const float* x = INP(0);
        pg8::Gemm g{Mb, WoutT, MC, 1024, 1024, 1024, 1024}; pg8::StaticOrder S; S.init(MC, 1024, G, (int)blockIdx.x);
        pg8::EpiH1 E{x, WSP(bf16_t, WS_H1B), rowssp};
        pg8::gemm_phase<pg8::EpiH1, pg8::StaticOrder, true, true>(lds, g, S, E);
        SEAM(6);
    }
    if (IN(7)) {
        KARGS; bf16_t *WqT = WSP(bf16_t, WS_WQ), *Qb = WSP(bf16_t, WS_QB); float* rowssp = WSP(float, WS_RS);
        pg8::Gemm g{WSP(bf16_t, WS_H1B), WqT, MC, 2048, 1024, 1024, 1024}; pg8::StaticOrder S; S.init(MC, 2048, G, (int)blockIdx.x);
        pg8::EpiQ E{Qb};
        pg8::gemm_phase<pg8::EpiQ, pg8::StaticOrder, true, true>(lds, g, S, E);
        SEAM(7);
    }
    if (IN(8)) {
        KARGS; bf16_t *Qb = WSP(bf16_t, WS_QB), *SK = WSP(bf16_t, WS_SK), *A2 = WSP(bf16_t, WS_A2); unsigned char *U8 = ws + WS_U8, *V8 = ws + WS_V8, *XQ = ws + WS_MB; float *suv = WSP(float, WS_SUV), *rowssp = WSP(float, WS_RS), *outp = kp_->out; bf16_t* H1B = WSP(bf16_t, WS_H1B); const float* gfin = INP(16);
        for (int grp = blockIdx.x; grp < MC / 128; grp += G) {
            const int rc0 = grp * 128;
#ifndef NO_TOPK
            peer_topk(lds, Qb, SK, rowssp, rc0 + 32 * (wave >> 1), 32 * (wave >> 1), 4 * (wave & 1), lane);
#endif
#ifdef PROBE_TOPK2
            __syncthreads(); peer_topk(lds, Qb, SK, rowssp, rc0 + 32 * (wave >> 1), 32 * (wave >> 1), 4 * (wave & 1), lane);
#endif
            __syncthreads();
            { const int tl0 = 16 * wave; const size_t rcw = (size_t)rc0 + tl0;
              { LAS f32x4* pz = (LAS f32x4*)(lds + PL_PA + tl0 * 512);
#pragma unroll
                for (int q = 0; q < 8; ++q) pz[lane + 64 * q] = (f32x4){0.f, 0.f, 0.f, 0.f}; }
#pragma unroll 1
              for (int i = 0; i < 16; ++i) peer_xq_token(H1B, INP(11), XQ, (float*)(XQ + (size_t)MC * 1024), rcw + i, lane);
              asm volatile("s_waitcnt vmcnt(0)" ::: "memory");
              { u32x4 ra[16], rb[16], xa[2], xb[2];
                peer_rows_load<true>(ra, xa, lds, tl0, rcw, 0, U8, (const bf16_t*)XQ, lane);
#pragma unroll 1
                for (int st = 0; st < 128; st += 2) {
                    peer_rows_load<true>(rb, xb, lds, tl0 + ((st + 1) & 15), rcw + ((st + 1) & 15), (st + 1) >> 4, U8, (const bf16_t*)XQ, lane);
                    __builtin_amdgcn_sched_barrier(0);
                    peer_u_math(ra, xa, lds, tl0 + (st & 15), lane);
                    { const int sn = st + 2 < 128 ? st + 2 : 127; peer_rows_load<true>(ra, xa, lds, tl0 + (sn & 15), rcw + (sn & 15), sn >> 4, U8, (const bf16_t*)XQ, lane); }
                    __builtin_amdgcn_sched_barrier(0);
                    peer_u_math(rb, xb, lds, tl0 + ((st + 1) & 15), lane); } }
#pragma unroll 1
              for (int i = 0; i < 16; ++i) peer_a_step(lds, tl0 + i, rcw + i, rowssp, suv, suv + 16384, lane);
              { u32x4 ra[16], rb[16], xd[2];
                peer_rows_load<false>(ra, xd, lds, tl0, rcw, 0, V8, A2, lane);
#pragma unroll 1
                for (int st = 0; st < 128; st += 2) {
                    peer_rows_load<false>(rb, xd, lds, tl0 + ((st + 1) & 15), rcw, (st + 1) >> 4, V8, A2, lane);
                    __builtin_amdgcn_sched_barrier(0);
                    peer_v_math(ra, lds, tl0 + (st & 15), rcw + (st & 15), st >> 4, H1B, lane);
                    { const int sn = st + 2 < 128 ? st + 2 : 127; peer_rows_load<false>(ra, xd, lds, tl0 + (sn & 15), rcw, sn >> 4, V8, A2, lane); }
                    __builtin_amdgcn_sched_barrier(0);
                    peer_v_math(rb, lds, tl0 + ((st + 1) & 15), rcw + ((st + 1) & 15), (st + 1) >> 4, H1B, lane); } }
              asm volatile("s_waitcnt vmcnt(0)" ::: "memory");
              __builtin_amdgcn_fence(__ATOMIC_ACQUIRE, "agent");
              peer_f_steps<8>(rcw, H1B, outp, gfin, lane);
              peer_f_steps<8>(rcw + 8, H1B, outp, gfin, lane); }
            __syncthreads();
        }
    }
#undef IN
#undef SEAM
}

extern "C" void kernel_launch(void* const* d_in, const int* in_sizes, int n_in, void* d_out, int out_size, void* d_ws, size_t ws_size, hipStream_t stream) {
    static int grid = 0;
    if (grid == 0) {
        if (n_in != 17 || out_size != MC * DM || ws_size < WS_END) { fprintf(stderr, "kernel_launch: unexpected shapes: n_in %d out %d ws %zu (need %zu)\n", n_in, out_size, ws_size, (size_t)WS_END); grid = -1; return; }
        int dev = 0, cus = 0, per_cu = 0;
        if (hipGetDevice(&dev) != hipSuccess || hipDeviceGetAttribute(&cus, hipDeviceAttributeMultiprocessorCount, dev) != hipSuccess) { fprintf(stderr, "kernel_launch: device query failed\n"); grid = -1; return; }
        if (hipFuncSetAttribute((const void*)fwd_kernel, hipFuncAttributeMaxDynamicSharedMemorySize, LDS_BYTES) != hipSuccess) { fprintf(stderr, "kernel_launch: hipFuncSetAttribute failed\n"); grid = -1; return; }
        if (hipOccupancyMaxActiveBlocksPerMultiprocessor(&per_cu, (const void*)fwd_kernel, 512, LDS_BYTES) != hipSuccess || per_cu < 1) { fprintf(stderr, "kernel_launch: occupancy query says %d blocks per CU\n", per_cu); per_cu = 1; }
        (void)hipGetLastError();
        grid = cus;
        fprintf(stderr, "kernel_launch: grid %d (occupancy %d per CU)\n", grid, per_cu);
    }
    if (grid < 0) return;
    if (hipMemsetAsync((char*)d_ws + WS_CTL, 0, CTL_BYTES, stream) != hipSuccess) { fprintf(stderr, "kernel_launch: memset of the barrier words failed\n"); return; }
    Args a{};
    for (int i = 0; i < 17; ++i) a.in[i] = (const float*)d_in[i];
    a.out = (float*)d_out; a.ws = (unsigned char*)d_ws;
#if MK_ONE_LAUNCH
    a.ph_lo = 0; a.ph_hi = NPHASE;
    void* args[] = {&a};
    hipError_t e = hipLaunchCooperativeKernel((const void*)fwd_kernel, dim3(grid), dim3(512), args, LDS_BYTES, stream);
    if (e != hipSuccess) fprintf(stderr, "kernel_launch: cooperative launch failed: %s (grid %d)\n", hipGetErrorString(e), grid);
#else
#ifdef PROBE_SEQ
    const int seq[] = PROBE_SEQ;
    for (int p : seq) { a.ph_lo = p; a.ph_hi = p + 1; hipLaunchKernelGGL(fwd_kernel, dim3(grid), dim3(512), LDS_BYTES, stream, a); }
#else
    for (int p = 0; p < NPHASE; ++p) { a.ph_lo = p; a.ph_hi = p + 1; hipLaunchKernelGGL(fwd_kernel, dim3(grid), dim3(512), LDS_BYTES, stream, a); }
#endif
#endif
}
```

```cpp
#include <hip/hip_runtime.h>
#include <hip/hip_cooperative_groups.h>
#include <cstdio>
#include <cstdint>
namespace cg = cooperative_groups;

#ifndef MK_ONE_LAUNCH
#define MK_ONE_LAUNCH 1
#endif

constexpr int DM = 1024, NB = 8, SEQ = 4096, NMETA = 16, LTOK = SEQ + NMETA;
constexpr int MA_REAL = NB * LTOK;
constexpr int MA = 33024;
constexpr int MC = NB * SEQ;
constexpr int LPAD = 4224;
constexpr float EPS = 1e-6f;

namespace pg8 {
#define PG8_LAS __attribute__((address_space(3)))
typedef unsigned short bf16_t;
typedef short bf16x8 __attribute__((ext_vector_type(8)));
typedef float f32x4 __attribute__((ext_vector_type(4)));
typedef unsigned u32x4 __attribute__((ext_vector_type(4)));
constexpr int BM = 256, BK = 64, HALF = 128, HTB = HALF * BK * 2  , STAGE_BYTES = 8 * HTB, NXCD = 8, WGM = 8;

__host__ __device__ __forceinline__ int lds_byte(int r, int c) { const int st = (r >> 4) * 2 + (c >> 5), rr = r & 15, cc = c & 31, ob = rr * 64 + cc * 2; return st * 1024 + (ob ^ (((ob >> 9) & 1) << 5)); }
__host__ __device__ __forceinline__ void stage_rc(int b, int& R, int& C) { const int st = b / 1024, sb = b % 1024, swz = sb ^ (((sb >> 9) & 1) << 5); R = (st >> 1) * 16 + swz / 64; C = (st & 1) * 32 + (swz % 64) / 2; }
__host__ __device__ __forceinline__ int perm32(int rho) { const int n = rho >> 4, i = rho & 15; return 8 * (i >> 2) + 4 * n + (i & 3); }

struct Unit { int pm, pn; };
struct Gemm { const bf16_t* A; const bf16_t* Bt; int M, N, K, lda, ldb; };

struct StaticOrder {
    int nM, nN, nwg, G, c;
    __host__ __device__ void init(int M, int N, int G_, int c_) { nM = M / BM; nN = N / BM; nwg = nM * nN; G = G_; c = c_; }
    __host__ __device__ bool next(int i, Unit& u) const {
        const long L = (long)i * G + c; if (L >= nwg) return false;
        int wgid = (int)L; { const int q = nwg / NXCD, r = nwg % NXCD, xcd = wgid % NXCD, off = wgid / NXCD; wgid = (xcd < r ? xcd * (q + 1) : r * (q + 1) + (xcd - r) * q) + off; }
        const int nig = WGM * nN, gid = wgid / nig, fm = gid * WGM, gsz = (nM - fm) < WGM ? (nM - fm) : WGM;
        u.pm = fm + ((wgid % nig) % gsz); u.pn = (wgid % nig) / gsz; return true;
    }
    __device__ __forceinline__ void a_ready(const Unit&) const {}
    __device__ __forceinline__ void done(const Unit&) const {}
};

__device__ __forceinline__ unsigned cvt_pk_bf16(float lo, float hi) { unsigned r; asm volatile("v_cvt_pk_bf16_f32 %0, %1, %2" : "=v"(r) : "v"(lo), "v"(hi)); return r; }
typedef float f32x2 __attribute__((ext_vector_type(2)));
typedef float f32x2_t __attribute__((ext_vector_type(2))); typedef __bf16 bf16x2_t __attribute__((ext_vector_type(2)));
typedef unsigned u32x2 __attribute__((ext_vector_type(2)));
__device__ __forceinline__ unsigned cvtpk(float lo, float hi) { f32x2_t v = {lo, hi}; bf16x2_t b = __builtin_convertvector(v, bf16x2_t); return __builtin_bit_cast(unsigned, b); }
__device__ __forceinline__ bf16_t f2bf(float x) { return (bf16_t)(cvtpk(x, 0.f) & 0xffffu); }
__device__ __forceinline__ float bf2f(bf16_t v) { return __uint_as_float((unsigned)v << 16); }
__device__ __forceinline__ float bflo(unsigned w) { return __uint_as_float(w << 16); }
__device__ __forceinline__ float bfhi(unsigned w) { return __uint_as_float(w & 0xffff0000u); }
__device__ __forceinline__ float sigm(float x) { return __builtin_amdgcn_rcpf(1.f + __expf(-x)); }

struct EpiZ {
    static constexpr bool PERM = true, AFTER_DRAIN = false, MIDK = false;
    bf16_t *Zh, *Za, *Zg, *Vt; const float* bgate;
    __device__ __forceinline__ void operator()(const f32x4 (&acc)[2][2][4][2], const Unit& u, int wr, int wc, int fr, int fq) const {
        const int pn = u.pn; bf16_t* base; int ldc, colt;
        if (pn < 8) { base = Zh; ldc = 2048; colt = pn * 256; } else if (pn < 11) { base = Za; ldc = 768; colt = (pn - 8) * 256; } else { base = Zg; ldc = 2048; colt = (pn - 11) * 256; }
        const int row0 = u.pm * BM + wr * 64 + fr, col0 = colt + wc * 32 + 8 * fq;
#pragma unroll
        for (int ai = 0; ai < 2; ++ai)
#pragma unroll
            for (int m = 0; m < 4; ++m) { const int row = row0 + ai * HALF + m * 16; bf16_t* rowp = base + (size_t)row * ldc + col0;
#pragma unroll
                for (int bj = 0; bj < 2; ++bj) { f32x4 v0 = acc[ai][bj][m][0], v1 = acc[ai][bj][m][1];
                    if (pn >= 11) { const f32x4 b0 = *(const f32x4*)(bgate + col0 + bj * HALF), b1 = *(const f32x4*)(bgate + col0 + bj * HALF + 4);
#pragma unroll
                        for (int i = 0; i < 4; ++i) { v0[i] = sigm(v0[i] + b0[i]); v1[i] = sigm(v1[i] + b1[i]); } }
                    if (pn == 10 && bj == 1) {
                        if (row < MA_REAL) { const int b = row / LTOK, pos = row - b * LTOK; bf16_t* vp = Vt + ((size_t)(b * 128 + wc * 32 + 8 * fq) * LPAD + 112 + pos);
                            vp[0] = f2bf(v0[0]); vp[LPAD] = f2bf(v0[1]); vp[2 * LPAD] = f2bf(v0[2]); vp[3 * LPAD] = f2bf(v0[3]);
                            vp[4 * LPAD] = f2bf(v1[0]); vp[5 * LPAD] = f2bf(v1[1]); vp[6 * LPAD] = f2bf(v1[2]); vp[7 * LPAD] = f2bf(v1[3]); }
                    } else { u32x4 w; w.x = cvtpk(v0[0], v0[1]); w.y = cvtpk(v0[2], v0[3]); w.z = cvtpk(v1[0], v1[1]); w.w = cvtpk(v1[2], v1[3]); *(u32x4*)(rowp + bj * HALF) = w; } } }
    }
};
struct EpiGate {
    static constexpr bool PERM = true, AFTER_DRAIN = false, MIDK = true;
    bf16_t* Mb; const bf16_t* Zg; const float* bgate;
    __device__ __forceinline__ void mid(f32x4 (&acc)[2][2][4][2], const Unit& u, int wr, int wc, int fr, int fq) const {
        const int row0 = u.pm * BM + wr * 64 + fr, col0 = u.pn * BM + wc * 32 + 8 * fq;
#pragma unroll
        for (int bj = 0; bj < 2; ++bj)
#pragma unroll
            for (int ai = 0; ai < 2; ++ai)
#pragma unroll
                for (int m = 0; m < 4; ++m) { const int rc = row0 + ai * HALF + m * 16, ra = (rc >> 12) * LTOK + NMETA + (rc & 4095);
                    const bf16_t* zp = Zg + (size_t)ra * 2048 + col0 + bj * HALF; const u32x4 za = *(const u32x4*)zp, zb = *(const u32x4*)(zp + 1024);
                    f32x4& v0 = acc[ai][bj][m][0]; f32x4& v1 = acc[ai][bj][m][1];
                    v0[0] *= bflo(za.x) * __builtin_amdgcn_rcpf(bflo(zb.x)); v0[1] *= bfhi(za.x) * __builtin_amdgcn_rcpf(bfhi(zb.x)); v0[2] *= bflo(za.y) * __builtin_amdgcn_rcpf(bflo(zb.y)); v0[3] *= bfhi(za.y) * __builtin_amdgcn_rcpf(bfhi(zb.y));
                    v1[0] *= bflo(za.z) * __builtin_amdgcn_rcpf(bflo(zb.z)); v1[1] *= bfhi(za.z) * __builtin_amdgcn_rcpf(bfhi(zb.z)); v1[2] *= bflo(za.w) * __builtin_amdgcn_rcpf(bflo(zb.w)); v1[3] *= bfhi(za.w) * __builtin_amdgcn_rcpf(bfhi(zb.w));
                    asm volatile("" ::: "memory"); }
    }
    __device__ __forceinline__ void operator()(const f32x4 (&acc)[2][2][4][2], const Unit& u, int wr, int wc, int fr, int fq) const {
        const int row0 = u.pm * BM + wr * 64 + fr, col0 = u.pn * BM + wc * 32 + 8 * fq;
#pragma unroll
        for (int ai = 0; ai < 2; ++ai)
#pragma unroll
            for (int m = 0; m < 4; ++m) { const int rc = row0 + ai * HALF + m * 16, ra = (rc >> 12) * LTOK + NMETA + (rc & 4095);
                const bf16_t* zp = Zg + (size_t)ra * 2048 + 1024 + col0; bf16_t* mp = Mb + (size_t)rc * 1024 + col0;
#pragma unroll
                for (int bj = 0; bj < 2; ++bj) { const u32x4 z = *(const u32x4*)(zp + bj * HALF); f32x4 v0 = acc[ai][bj][m][0], v1 = acc[ai][bj][m][1];
                    v0[0] *= bflo(z.x); v0[1] *= bfhi(z.x); v0[2] *= bflo(z.y); v0[3] *= bfhi(z.y); v1[0] *= bflo(z.z); v1[1] *= bfhi(z.z); v1[2] *= bflo(z.w); v1[3] *= bfhi(z.w);
                    u32x4 w; w.x = cvtpk(v0[0], v0[1]); w.y = cvtpk(v0[2], v0[3]); w.z = cvtpk(v1[0], v1[1]); w.w = cvtpk(v1[2], v1[3]); *(u32x4*)(mp + bj * HALF) = w; } }
    }
};
struct EpiH1 {
    static constexpr bool PERM = false, AFTER_DRAIN = false, MIDK = false;
    const float* x; bf16_t* h1; float* rowssp;
    __device__ __forceinline__ void operator()(const f32x4 (&acc)[2][2][4][2], const Unit& u, int wr, int wc, int fr, int fq) const {
        const int row0 = u.pm * BM + wr * 64 + fr, col0 = u.pn * BM + wc * 32 + 4 * fq;
#pragma unroll
        for (int ai = 0; ai < 2; ++ai)
#pragma unroll
            for (int m = 0; m < 4; ++m) { const int rc = row0 + ai * HALF + m * 16; float ss = 0.f;
#pragma unroll
                for (int bj = 0; bj < 2; ++bj)
#pragma unroll
                    for (int n = 0; n < 2; ++n) { const size_t off = (size_t)rc * 1024 + col0 + bj * HALF + n * 16;
                        const f32x4 h = *(const f32x4*)(x + off) + acc[ai][bj][m][n]; { u32x2 hw; hw.x = cvtpk(h[0], h[1]); hw.y = cvtpk(h[2], h[3]); *(u32x2*)(h1 + off) = hw; }
                        ss += (h[0] * h[0] + h[1] * h[1]) + (h[2] * h[2] + h[3] * h[3]);
}
                ss += __shfl_xor(ss, 16); ss += __shfl_xor(ss, 32);
                if (fq == 0) rowssp[(size_t)rc * 16 + u.pn * 4 + wc] = ss; }
    }
};
struct EpiQ {
    static constexpr bool PERM = true, AFTER_DRAIN = false, MIDK = false;
    bf16_t* Q;
    __device__ __forceinline__ void operator()(const f32x4 (&acc)[2][2][4][2], const Unit& u, int wr, int wc, int fr, int fq) const {
        const int row0 = u.pm * BM + wr * 64 + fr, col0 = u.pn * BM + wc * 32 + 8 * fq;
#pragma unroll
        for (int ai = 0; ai < 2; ++ai)
#pragma unroll
            for (int m = 0; m < 4; ++m) { const int rc = row0 + ai * HALF + m * 16;
#pragma unroll
                for (int bj = 0; bj < 2; ++bj) { const f32x4 v0 = acc[ai][bj][m][0], v1 = acc[ai][bj][m][1];
                    u32x4 w; w.x = cvtpk(v0[0], v0[1]); w.y = cvtpk(v0[2], v0[3]); w.z = cvtpk(v1[0], v1[1]); w.w = cvtpk(v1[2], v1[3]);
                    const int col = col0 + bj * HALF;
                    *(u32x4*)(Q + ((size_t)((((rc >> 5) * 8 + (col >> 8)) * 2 + ((col >> 7) & 1)) * 8 + ((col & 127) >> 4)) * 64 + ((col >> 3) & 1) * 32 + (rc & 31)) * 8) = w; } }
    }
};
template <class Epi, class Sched, bool ALIGN_EPI = false, bool SP2 = false>
__device__ __forceinline__ void gemm_phase(PG8_LAS unsigned char* lds, const Gemm g, const Sched& S, const Epi& E) {
    const int tid = threadIdx.x, wid = __builtin_amdgcn_readfirstlane(tid >> 6), lane = tid & 63, wr = wid >> 2, wc = wid & 3, fr = lane & 15, fq = lane >> 4;
    const int K = g.K, nt = K / BK;
    unsigned voffA[2], voffB[2];
#pragma unroll
    for (int i = 0; i < 2; ++i) { int R, C; stage_rc(tid * 16 + i * 8192, R, C); const int Rb = Epi::PERM ? ((R & ~31) + perm32(R & 31)) : R;
        voffA[i] = (unsigned)(R * g.lda + C) * 2u; voffB[i] = (unsigned)(Rb * g.ldb + C) * 2u; }
    const size_t kstep = (size_t)(BK * 2);
    const size_t hstepA = (size_t)HALF * g.lda * 2, hstepB = (size_t)HALF * g.ldb * 2;
    const size_t tstepA = 2 * hstepA, tstepB = 2 * hstepB;
    const unsigned ldsw = (unsigned)wid * 1024u;
    const int aoff = lds_byte(wr * 64 + fr, fq * 8), boff = lds_byte(wc * 32 + fr, fq * 8);
#define PG8_SA(b, h) (((b) * 2 + (h)) * HTB)
#define PG8_SB(b, h) ((4 + (b) * 2 + (h)) * HTB)
#define PG8_STAGE(bufoff, gbase, voff) do { _Pragma("unroll") for (int _i = 0; _i < 2; ++_i) \
        __builtin_amdgcn_global_load_lds((const unsigned*)((const char*)(gbase) + (voff)[_i]), (PG8_LAS unsigned*)(lds + (bufoff) + ldsw + _i * 8192), 16, 0, 0); } while (0)
#define PG8_LDA(dst, b, h) do { _Pragma("unroll") for (int m = 0; m < 4; ++m) _Pragma("unroll") for (int k = 0; k < 2; ++k) dst[m][k] = *(const PG8_LAS bf16x8*)(lds + PG8_SA(b, h) + aoff + m * 2048 + k * 1024); } while (0)
#define PG8_LDB(dst, b, h) do { _Pragma("unroll") for (int n = 0; n < 2; ++n) _Pragma("unroll") for (int k = 0; k < 2; ++k) dst[n][k] = *(const PG8_LAS bf16x8*)(lds + PG8_SB(b, h) + boff + n * 2048 + k * 1024); } while (0)
#define PG8_MMA(ai, bj, At, Bt) do { __builtin_amdgcn_s_setprio(1); _Pragma("unroll") for (int m = 0; m < 4; ++m) _Pragma("unroll") for (int n = 0; n < 2; ++n) _Pragma("unroll") for (int k = 0; k < 2; ++k) \
        acc[ai][bj][m][n] = __builtin_amdgcn_mfma_f32_16x16x32_bf16(Bt[n][k], At[m][k], acc[ai][bj][m][n], 0, 0, 0); __builtin_amdgcn_s_setprio(0); } while (0)
#define PG8_WAIT_V(n) asm volatile("s_waitcnt vmcnt(" #n ")" ::: "memory")
#define PG8_WAIT_L(n) asm volatile("s_waitcnt lgkmcnt(" #n ")" ::: "memory")
#define PG8_BAR __builtin_amdgcn_s_barrier()
#define PG8_SCHED __builtin_amdgcn_sched_barrier(0)
    Unit cur, nxt; int ui = 0;
    if (!S.next(0, cur)) return;
    f32x4 acc[2][2][4][2];
#pragma unroll
    for (int a = 0; a < 2; ++a)
#pragma unroll
        for (int b = 0; b < 2; ++b)
#pragma unroll
            for (int m = 0; m < 4; ++m)
#pragma unroll
                for (int n = 0; n < 2; ++n) acc[a][b][m][n] = (f32x4){0.f, 0.f, 0.f, 0.f};
    bf16x8 At[4][2], B0[2][2], B1[2][2];
    const char* cA = (const char*)g.A + (size_t)cur.pm * tstepA; const char* cB = (const char*)g.Bt + (size_t)cur.pn * tstepB;
    S.a_ready(cur);
    if constexpr (SP2) {
        PG8_STAGE(PG8_SB(0, 0), cB, voffB); PG8_STAGE(PG8_SB(0, 1), cB + hstepB, voffB); PG8_STAGE(PG8_SA(0, 0), cA, voffA); PG8_STAGE(PG8_SA(0, 1), cA + hstepA, voffA);
        if (wr == 1) PG8_BAR;
        PG8_WAIT_V(2); PG8_BAR;
        PG8_STAGE(PG8_SB(1, 0), cB + kstep, voffB); PG8_STAGE(PG8_SA(1, 0), cA + kstep, voffA); PG8_STAGE(PG8_SB(1, 1), cB + hstepB + kstep, voffB);
        PG8_WAIT_V(6); PG8_BAR;
    } else {
        PG8_STAGE(PG8_SB(0, 0), cB, voffB); PG8_STAGE(PG8_SA(0, 0), cA, voffA); PG8_STAGE(PG8_SB(0, 1), cB + hstepB, voffB); PG8_STAGE(PG8_SA(0, 1), cA + hstepA, voffA);
        if (wr == 1) PG8_BAR;
        PG8_WAIT_V(4); PG8_BAR;
        PG8_STAGE(PG8_SB(1, 0), cB + kstep, voffB); PG8_STAGE(PG8_SA(1, 0), cA + kstep, voffA); PG8_STAGE(PG8_SB(1, 1), cB + hstepB + kstep, voffB);
        PG8_WAIT_V(6); PG8_BAR;
    }
    for (;;) {
        const bool has_next = S.next(ui + 1, nxt);
        const char* nA = has_next ? (const char*)g.A + (size_t)nxt.pm * tstepA : cA; const char* nB = has_next ? (const char*)g.Bt + (size_t)nxt.pn * tstepB : cB;
        for (int t = 0; t < nt; t += 2) {
            if constexpr (Epi::MIDK) { if (t == (nt >> 1)) { PG8_SCHED; E.mid(acc, cur, wr, wc, fr, fq); PG8_SCHED; } }
            const bool last = (t == nt - 2);
            const char* a1 = cA + (size_t)(t + 1) * kstep;
            const char* a2 = last ? nA : cA + (size_t)(t + 2) * kstep; const char* b2 = last ? nB : cB + (size_t)(t + 2) * kstep;
            const char* a3 = a2 + kstep; const char* b3 = b2 + kstep;
            if (last && has_next) S.a_ready(nxt);
            if constexpr (SP2) {
            PG8_LDB(B0, 0, 0); PG8_LDB(B1, 0, 1); PG8_SCHED; PG8_LDA(At, 0, 0); PG8_STAGE(PG8_SA(1, 1), a1 + hstepA, voffA);
            PG8_WAIT_V(8); PG8_WAIT_L(0); PG8_BAR; PG8_MMA(0, 0, At, B0); PG8_MMA(0, 1, At, B1); PG8_BAR; PG8_SCHED;
            PG8_LDA(At, 0, 1); PG8_STAGE(PG8_SB(0, 0), b2, voffB); PG8_STAGE(PG8_SB(0, 1), b2 + hstepB, voffB); PG8_STAGE(PG8_SA(0, 0), a2, voffA);
            PG8_WAIT_V(8); PG8_WAIT_L(0); PG8_BAR; PG8_MMA(1, 0, At, B0); PG8_MMA(1, 1, At, B1); PG8_BAR; PG8_SCHED;
            PG8_LDB(B0, 1, 0); PG8_LDB(B1, 1, 1); PG8_SCHED; PG8_LDA(At, 1, 0); PG8_STAGE(PG8_SA(0, 1), a2 + hstepA, voffA);
            PG8_WAIT_V(8); PG8_WAIT_L(0); PG8_BAR; PG8_MMA(0, 0, At, B0); PG8_MMA(0, 1, At, B1); PG8_BAR; PG8_SCHED;
            PG8_LDA(At, 1, 1); PG8_STAGE(PG8_SB(1, 0), b3, voffB); PG8_STAGE(PG8_SB(1, 1), b3 + hstepB, voffB); PG8_STAGE(PG8_SA(1, 0), a3, voffA);
            PG8_WAIT_V(8); PG8_WAIT_L(0); PG8_BAR; PG8_MMA(1, 0, At, B0); PG8_MMA(1, 1, At, B1); PG8_BAR; PG8_SCHED;
            } else {
            PG8_LDB(B0, 0, 0); PG8_SCHED; PG8_LDA(At, 0, 0); PG8_STAGE(PG8_SA(1, 1), a1 + hstepA, voffA);
            PG8_WAIT_L(8); PG8_BAR; PG8_WAIT_L(0); PG8_MMA(0, 0, At, B0); PG8_BAR; PG8_SCHED;
            PG8_LDB(B1, 0, 1); PG8_STAGE(PG8_SB(0, 0), b2, voffB);
            PG8_BAR; PG8_WAIT_L(0); PG8_MMA(0, 1, At, B1); PG8_BAR;
            PG8_LDA(At, 0, 1); PG8_STAGE(PG8_SA(0, 0), a2, voffA);
            PG8_BAR; PG8_WAIT_L(0); PG8_MMA(1, 0, At, B0); PG8_BAR; PG8_SCHED;
            PG8_STAGE(PG8_SB(0, 1), b2 + hstepB, voffB);
            PG8_WAIT_V(6); PG8_BAR; PG8_MMA(1, 1, At, B1); PG8_BAR;
            PG8_LDB(B0, 1, 0); PG8_SCHED; PG8_LDA(At, 1, 0); PG8_STAGE(PG8_SA(0, 1), a2 + hstepA, voffA);
            PG8_WAIT_L(8); PG8_BAR; PG8_WAIT_L(0); PG8_MMA(0, 0, At, B0); PG8_BAR; PG8_SCHED;
            PG8_LDB(B1, 1, 1); PG8_STAGE(PG8_SB(1, 0), b3, voffB);
            PG8_BAR; PG8_WAIT_L(0); PG8_MMA(0, 1, At, B1); PG8_BAR;
            PG8_LDA(At, 1, 1); PG8_STAGE(PG8_SA(1, 0), a3, voffA);
            PG8_BAR; PG8_WAIT_L(0); PG8_MMA(1, 0, At, B0); PG8_BAR; PG8_SCHED;
            PG8_STAGE(PG8_SB(1, 1), b3 + hstepB, voffB);
            PG8_WAIT_V(6); PG8_BAR; PG8_MMA(1, 1, At, B1); PG8_BAR;
            }
        }
        if constexpr (ALIGN_EPI) { if (wr == 0) PG8_BAR; }
        if constexpr (!Epi::AFTER_DRAIN) { E(acc, cur, wr, wc, fr, fq); S.done(cur); }
        if (!has_next) break;
#pragma unroll
        for (int a = 0; a < 2; ++a)
#pragma unroll
            for (int b = 0; b < 2; ++b)
#pragma unroll
                for (int m = 0; m < 4; ++m)
#pragma unroll
                    for (int n = 0; n < 2; ++n) acc[a][b][m][n] = (f32x4){0.f, 0.f, 0.f, 0.f};
        cur = nxt; cA = nA; cB = nB; ++ui;
        if constexpr (ALIGN_EPI) { if (wr == 1) PG8_BAR; }
    }
    PG8_WAIT_V(0);
    if constexpr (!ALIGN_EPI) { if (wr == 0) PG8_BAR; }
    PG8_BAR;
    if constexpr (Epi::AFTER_DRAIN) { E.fused(acc, cur, wr, wc, fr, fq, lds, wid, lane); S.done(cur); }
#undef PG8_SA
#undef PG8_SB
#undef PG8_STAGE
#undef PG8_LDA
#undef PG8_LDB
#undef PG8_MMA
#undef PG8_WAIT_V
#undef PG8_WAIT_L
#undef PG8_BAR
#undef PG8_SCHED
}
}
using pg8::bf16_t; using pg8::bf16x8; using pg8::f32x4; using pg8::u32x4; using pg8::u32x2; using pg8::cvtpk; using pg8::f2bf; using pg8::bf2f; using pg8::bflo; using pg8::bfhi; using pg8::sigm;
#define LAS __attribute__((address_space(3)))
typedef float f32x16 __attribute__((ext_vector_type(16)));
#define MFMA32(a, b, c) __builtin_amdgcn_mfma_f32_32x32x16_bf16((a), (b), (c), 0, 0, 0)

constexpr size_t MiB = 1u << 20;
constexpr size_t WS_ZH = 0;
constexpr size_t WS_H1B = 372 * MiB;
constexpr size_t WS_MB = WS_ZH, WS_U8 = WS_ZH + 64 * MiB, WS_V8 = WS_ZH + 80 * MiB, WS_SUV = WS_ZH + 96 * MiB;
constexpr size_t WS_ZA = 129 * MiB;
constexpr size_t WS_ZG = 178 * MiB;
constexpr size_t WS_QB = WS_ZG;
constexpr size_t WS_A1 = 307 * MiB;
constexpr size_t WS_OM = WS_A1, WS_A2 = WS_A1;
constexpr size_t WS_UB = 372 * MiB;
constexpr size_t WS_DV = 436 * MiB;
constexpr size_t WS_VT = 437 * MiB;
constexpr size_t WS_WIN = 446 * MiB;
constexpr size_t WS_WBH = 456 * MiB, WS_WBA = 457 * MiB, WS_WOUT = 458 * MiB, WS_WQ = 460 * MiB, WS_SK = 464 * MiB;
constexpr size_t WS_RS = 465 * MiB;
constexpr size_t WS_CTL = 467 * MiB, CTL_BYTES = 16384;
constexpr size_t WS_END = 468 * MiB;
constexpr int LDS_BYTES = 151552;

__device__ __forceinline__ float wave_sum(float v) {
#pragma unroll
    for (int o = 1; o < 64; o <<= 1) v += __shfl_xor(v, o);
    return v;
}
__device__ __forceinline__ void p0_transpose_item(const float* __restrict__ W, int K, int N, bf16_t* __restrict__ WT, LAS float* scr, int item, int lane, int ldw = 0, const float* __restrict__ kscale = nullptr) {
    if (ldw == 0) ldw = K;
    const int nblk = N / 32, kb = item / nblk, nb = item % nblk, k0 = 64 * kb, n0 = 32 * nb;
#pragma unroll 8
    for (int i = 0; i < 32; ++i) { const int kk = 2 * i + (lane >> 5); scr[kk * 33 + (lane & 31)] = W[(size_t)(k0 + kk) * N + n0 + (lane & 31)] * (kscale ? kscale[k0 + kk] : 1.f); }
    asm volatile("s_waitcnt lgkmcnt(0)" ::: "memory");
    const int c = lane & 7;
#pragma unroll
    for (int j = 0; j < 4; ++j) { const int n = (lane >> 3) + 8 * j; const LAS float* s = scr + (8 * c) * 33 + n;
        u32x4 o; o.x = cvtpk(s[0 * 33], s[1 * 33]); o.y = cvtpk(s[2 * 33], s[3 * 33]); o.z = cvtpk(s[4 * 33], s[5 * 33]); o.w = cvtpk(s[6 * 33], s[7 * 33]);
        *(u32x4*)(WT + (size_t)(n0 + n) * ldw + k0 + 8 * c) = o; }
    asm volatile("s_waitcnt lgkmcnt(0)" ::: "memory");
}
struct P0Args { const float *x, *meta, *gmix, *w_in, *w_bh, *w_ba, *w_out, *w_q, *subk, *gffn; bf16_t *A1, *WinT, *WbhT, *WbaT, *WoutT, *WqT, *SK; };
__device__ __forceinline__ void p0_prologue(LAS unsigned char* lds, const P0Args& p) {
    const int tid = threadIdx.x, lane = tid & 63, wave = tid >> 6;
    LAS float* scr = (LAS float*)(lds + wave * 16384);
    const int gw = blockIdx.x * 8 + wave, NGW = gridDim.x * 8;
    constexpr int I_IN = 16 * 152, I_B = 8 * 32, I_O = 16 * 32, I_Q = 16 * 64, NITEMS = I_IN + 2 * I_B + I_O + I_Q;
    for (int it = gw; it < NITEMS; it += NGW) {
        int r = it;
        if (r < I_IN) { p0_transpose_item(p.w_in, 1024, 4864, p.WinT, scr, r, lane); continue; } r -= I_IN;
        if (r < I_B) { p0_transpose_item(p.w_bh, 512, 1024, p.WbhT, scr, r, lane, 1024); continue; } r -= I_B;
        if (r < I_B) { p0_transpose_item(p.w_ba, 512, 1024, p.WbhT + 512, scr, r, lane, 1024); continue; } r -= I_B;
        if (r < I_O) { p0_transpose_item(p.w_out, 1024, 1024, p.WoutT, scr, r, lane); continue; } r -= I_O;
        p0_transpose_item(p.w_q, 1024, 2048, p.WqT, scr, r, lane, 0, p.gffn);
    }
    for (int p_ = blockIdx.x * 512 + tid; p_ < 262144 / 8; p_ += gridDim.x * 512) {
        const int ln = p_ & 63, kk = (p_ >> 6) & 7, nb = (p_ >> 9) & 3, hc = p_ >> 11;
        const float* src = p.subk + (size_t)(hc * 128 + 32 * nb + (ln & 31)) * 128 + 16 * kk + 8 * (ln >> 5);
        const f32x4 a = *(const f32x4*)src, b = *(const f32x4*)(src + 4);
        u32x4 o; o.x = cvtpk(a[0], a[1]); o.y = cvtpk(a[2], a[3]); o.z = cvtpk(b[0], b[1]); o.w = cvtpk(b[2], b[3]); *(u32x4*)(p.SK + (size_t)p_ * 8) = o; }
    f32x4 g[4];
#pragma unroll
    for (int j = 0; j < 4; ++j) g[j] = *((const f32x4*)p.gmix + lane + 64 * j);
    for (int m0 = gw; m0 < MA; m0 += 4 * NGW) {
        f32x4 v[4][4];
#pragma unroll
        for (int r = 0; r < 4; ++r) { const int m = m0 + r * NGW;
            if (m < MA_REAL) { const int b = m / LTOK, pos = m - b * LTOK;
                const float* src = pos < NMETA ? p.meta + (size_t)pos * 1024 : p.x + ((size_t)b * SEQ + (pos - NMETA)) * 1024;
                const f32x4* xr = (const f32x4*)src + lane;
#pragma unroll
                for (int j = 0; j < 4; ++j) v[r][j] = xr[64 * j]; }
            else {
#pragma unroll
                for (int j = 0; j < 4; ++j) v[r][j] = (f32x4){0.f, 0.f, 0.f, 0.f}; } }
#pragma unroll
        for (int r = 0; r < 4; ++r) { const int m = m0 + r * NGW;
            if (m < MA) { float s = 0.f;
#pragma unroll
                for (int j = 0; j < 4; ++j) s += (v[r][j][0] * v[r][j][0] + v[r][j][1] * v[r][j][1]) + (v[r][j][2] * v[r][j][2] + v[r][j][3] * v[r][j][3]);
                const float rstd = __builtin_amdgcn_rsqf(wave_sum(s) * (1.f / 1024.f) + EPS);
                unsigned long long* o8 = (unsigned long long*)(p.A1 + (size_t)m * 1024) + lane;
#pragma unroll
                for (int j = 0; j < 4; ++j) { const f32x4 y = v[r][j] * rstd * g[j]; o8[64 * j] = (unsigned long long)cvtpk(y[0], y[1]) | ((unsigned long long)cvtpk(y[2], y[3]) << 32); } } }
    }
}

constexpr int SR = 272;
constexpr int OFF_Q = 0, OFF_K = 34816, OFF_V = 69632, OFF_S = 104448, OFF_VEC = 139264;
__device__ __forceinline__ bf16x8 ldfrag(const LAS unsigned char* base, int row, int kk8, int h2) { return *(const LAS bf16x8*)(base + row * SR + (kk8 * 16 + 8 * h2) * 2); }

constexpr int OFF_SEGP = OFF_VEC, OFF_VEC2 = OFF_VEC + 8192, OFF_SSQ = OFF_VEC2 + 1024;
template <bool WITH_Q>
__device__ __forceinline__ void hgrn_front(LAS unsigned char* lds, const bf16_t* __restrict__ Zh, const float* __restrict__ lblog, int b, int h, int c, float (&g)[8][4], float (&kk)[8][4], float (&qq)[8][4], u32x2 (&vraw)[8]) {
    const int tid = threadIdx.x, c4 = tid & 31, seg = tid >> 5;
    const f32x4 l0 = *(const f32x4*)(lblog + h * 128 + 4 * c4), l1 = *(const f32x4*)(lblog + 512 + h * 128 + 4 * c4);
    float lb[4], run[4];
#pragma unroll
    for (int k = 0; k < 4; ++k) { lb[k] = sigm(l0[k] - l1[k]); run[k] = 1.f; }
    u32x2 hfw[8], hqw[8];
#pragma unroll
    for (int i = 0; i < 8; ++i) { const int pos = 128 * c - 112 + 8 * seg + i; const bool valid = pos >= 0;
        const bf16_t* zr = Zh + (size_t)(b * LTOK + (valid ? pos : 0)) * 2048 + h * 128 + 4 * c4;
        hfw[i] = *(const u32x2*)(zr + 512); if (WITH_Q) hqw[i] = *(const u32x2*)zr; vraw[i] = *(const u32x2*)(zr + 1024);
        if (!valid) { hfw[i] = (u32x2){0x7f007f00u, 0x7f007f00u}; hqw[i] = (u32x2){0u, 0u}; vraw[i] = (u32x2){0u, 0u}; } }
#pragma unroll
    for (int i = 0; i < 8; ++i) {
        const float hf[4] = {bflo(hfw[i].x), bfhi(hfw[i].x), bflo(hfw[i].y), bfhi(hfw[i].y)};
#pragma unroll
        for (int k = 0; k < 4; ++k) { const float sg = sigm(hf[k]); const float f = lb[k] + (1.f - lb[k]) * sg; kk[i][k] = (1.f - lb[k]) * (1.f - sg); run[k] *= f; g[i][k] = run[k]; }
        if (WITH_Q) { qq[i][0] = bflo(hqw[i].x); qq[i][1] = bfhi(hqw[i].x); qq[i][2] = bflo(hqw[i].y); qq[i][3] = bfhi(hqw[i].y); } }
    *(LAS f32x4*)(lds + OFF_SEGP + (seg * 128 + 4 * c4) * 4) = (f32x4){run[0], run[1], run[2], run[3]};
    __syncthreads();
}
__device__ __forceinline__ void hgrn_base(LAS unsigned char* lds, float (&base)[4]) {
    const int tid = threadIdx.x, c4 = tid & 31, seg = tid >> 5;
    const LAS f32x4* sp = (const LAS f32x4*)(lds + OFF_SEGP) + c4;
    f32x4 p = (f32x4){1.f, 1.f, 1.f, 1.f};
    if (seg < 8) { for (int s = seg; s < 8; ++s) p *= sp[s * 32];
        if (seg == 0) *(LAS f32x4*)(lds + OFF_VEC2 + (4 * c4) * 4) = p;
#pragma unroll
        for (int k = 0; k < 4; ++k) base[k] = __builtin_amdgcn_rcpf(p[k]); }
    else { for (int s = 8; s < seg; ++s) p *= sp[s * 32];
        if (seg == 15) *(LAS f32x4*)(lds + OFF_VEC2 + (128 + 4 * c4) * 4) = p * sp[15 * 32];
#pragma unroll
        for (int k = 0; k < 4; ++k) base[k] = p[k]; }
}
__device__ __forceinline__ void hgrn_put_vt(LAS unsigned char* lds, const u32x2 (&vraw)[8], int c4, int seg) {
#pragma unroll
    for (int k = 0; k < 4; ++k) { unsigned e[8];
#pragma unroll
        for (int i = 0; i < 8; ++i) { const unsigned w = (k < 2) ? vraw[i].x : vraw[i].y; e[i] = (k & 1) ? (w >> 16) : (w & 0xffffu); }
        *(LAS u32x4*)(lds + OFF_V + (4 * c4 + k) * SR + seg * 16) = (u32x4){e[0] | (e[1] << 16), e[2] | (e[3] << 16), e[4] | (e[5] << 16), e[6] | (e[7] << 16)}; }
}

__device__ __forceinline__ void hgrn_A(LAS unsigned char* lds, const bf16_t* __restrict__ Zh, const float* __restrict__ lblog, bf16_t* __restrict__ Ub, float* __restrict__ Dv, int item) {
    const int tid = threadIdx.x, lane = tid & 63, wid = tid >> 6, r32 = lane & 31, h2 = lane >> 5;
    const int c = item & 31, bh = item >> 5, b = bh >> 2, h = bh & 3;
    const int c4 = tid & 31, seg = tid >> 5;
    float g[8][4], kk[8][4], qq[8][4]; u32x2 vraw[8];
    hgrn_front<false>(lds, Zh, lblog, b, h, c, g, kk, qq, vraw);
    { float base[4]; hgrn_base(lds, base);
#pragma unroll
      for (int k = 0; k < 4; ++k) { float kt[8];
#pragma unroll
          for (int i = 0; i < 8; ++i) kt[i] = kk[i][k] * __builtin_amdgcn_rcpf(base[k] * g[i][k]);
          *(LAS u32x4*)(lds + OFF_K + (4 * c4 + k) * SR + seg * 16) = (u32x4){cvtpk(kt[0], kt[1]), cvtpk(kt[2], kt[3]), cvtpk(kt[4], kt[5]), cvtpk(kt[6], kt[7])}; }
      hgrn_put_vt(lds, vraw, c4, seg); }
    __syncthreads();
    const int e0 = 32 * (wid >> 1), d0 = 64 * (wid & 1);
    f32x16 acc[2]; acc[0] = f32x16{}; acc[1] = f32x16{};
#pragma unroll
    for (int k8 = 0; k8 < 8; ++k8) { const bf16x8 a = ldfrag(lds + OFF_V, e0 + r32, k8, h2);
#pragma unroll
        for (int j = 0; j < 2; ++j) acc[j] = MFMA32(a, ldfrag(lds + OFF_K, d0 + 32 * j + r32, k8, h2), acc[j]); }
    const LAS float* vec2 = (const LAS float*)(lds + OFF_VEC2);
#pragma unroll
    for (int j = 0; j < 2; ++j) { const int dc = d0 + 32 * j + r32; const float sc = vec2[128 + dc];
        bf16_t* up = Ub + ((size_t)item * 128 + e0 + 4 * h2) * 128 + dc;
#pragma unroll
        for (int r = 0; r < 16; ++r) up[(size_t)((r & 3) + 8 * (r >> 2)) * 128] = f2bf(acc[j][r] * sc); }
    if (tid < 128) Dv[(size_t)item * 128 + tid] = vec2[tid] * vec2[128 + tid];
    __syncthreads();
}

__device__ __forceinline__ void hgrn_C(LAS unsigned char* lds, const bf16_t* __restrict__ Zh, const float* __restrict__ lblog, const bf16_t* __restrict__ Ub, const float* __restrict__ hgn, bf16_t* __restrict__ OM, int item) {
    const int tid = threadIdx.x, lane = tid & 63, wid = tid >> 6, r32 = lane & 31, h2 = lane >> 5;
    const int c = (item & 31) + 1, bh = item >> 5, b = bh >> 2, h = bh & 3;
    const int c4 = tid & 31, seg = tid >> 5;
    const int tb = wid >> 1, wh = wid & 1;
    u32x4 sreg[4];
    { const bf16_t* sp = Ub + (size_t)item * 16384;
#pragma unroll
      for (int q = 0; q < 4; ++q) sreg[q] = *(const u32x4*)(sp + (size_t)(tid + 512 * q) * 8); }
    const size_t rc = (size_t)b * SEQ + 128 * (c - 1) + 32 * tb + r32, ra = (size_t)b * LTOK + 128 * c - 112 + 32 * tb + r32;
    u32x2 gate[2][4];
#pragma unroll
    for (int j = 0; j < 2; ++j)
#pragma unroll
        for (int gq = 0; gq < 4; ++gq) gate[j][gq] = *(const u32x2*)(Zh + ra * 2048 + 1536 + h * 128 + 64 * wh + 32 * j + 8 * gq + 4 * h2);
    float g[8][4], kk[8][4], qq[8][4]; u32x2 vraw[8];
    hgrn_front<true>(lds, Zh, lblog, b, h, c, g, kk, qq, vraw);
    { float base[4]; hgrn_base(lds, base);
#pragma unroll
      for (int i = 0; i < 8; ++i) { float r[4], ri[4];
#pragma unroll
          for (int k = 0; k < 4; ++k) { r[k] = base[k] * g[i][k]; ri[k] = __builtin_amdgcn_rcpf(r[k]); }
          const int t = 8 * seg + i;
          *(LAS u32x2*)(lds + OFF_Q + t * SR + 8 * c4) = (u32x2){cvtpk(qq[i][0] * r[0], qq[i][1] * r[1]), cvtpk(qq[i][2] * r[2], qq[i][3] * r[3])};
          *(LAS u32x2*)(lds + OFF_K + t * SR + 8 * c4) = (u32x2){cvtpk(kk[i][0] * ri[0], kk[i][1] * ri[1]), cvtpk(kk[i][2] * ri[2], kk[i][3] * ri[3])}; }
      hgrn_put_vt(lds, vraw, c4, seg); }
    __syncthreads();
    { const LAS float* vec2 = (const LAS float*)(lds + OFF_VEC2);
#pragma unroll
      for (int q = 0; q < 4; ++q) { const int idx = tid + 512 * q, e = idx >> 4, d8 = (idx & 15) * 8; const f32x4 p0 = *(const LAS f32x4*)(vec2 + d8), p1 = *(const LAS f32x4*)(vec2 + d8 + 4); const u32x4 sv = sreg[q];
          *(LAS u32x4*)(lds + OFF_S + e * SR + d8 * 2) = (u32x4){cvtpk(bflo(sv.x) * p0[0], bfhi(sv.x) * p0[1]), cvtpk(bflo(sv.y) * p0[2], bfhi(sv.y) * p0[3]), cvtpk(bflo(sv.z) * p1[0], bfhi(sv.z) * p1[1]), cvtpk(bflo(sv.w) * p1[2], bfhi(sv.w) * p1[3])}; } }
    f32x16 sc[2]; sc[0] = f32x16{}; sc[1] = f32x16{};
#pragma unroll
    for (int j = 0; j < 2; ++j) { const int sb = 2 * wh + j;
        if (sb <= tb) {
#pragma unroll
            for (int k8 = 0; k8 < 8; ++k8) sc[j] = MFMA32(ldfrag(lds + OFF_K, 32 * sb + r32, k8, h2), ldfrag(lds + OFF_Q, 32 * tb + r32, k8, h2), sc[j]); } }
    __syncthreads();
    { const int t = 32 * tb + r32;
#pragma unroll
      for (int j = 0; j < 2; ++j) { const int sb = 2 * wh + j;
#pragma unroll
          for (int gq = 0; gq < 4; ++gq) { const int s0 = 32 * sb + 8 * gq + 4 * h2;
              const float p0 = (sb <= tb && s0 + 0 <= t) ? sc[j][4 * gq + 0] : 0.f, p1 = (sb <= tb && s0 + 1 <= t) ? sc[j][4 * gq + 1] : 0.f;
              const float p2 = (sb <= tb && s0 + 2 <= t) ? sc[j][4 * gq + 2] : 0.f, p3 = (sb <= tb && s0 + 3 <= t) ? sc[j][4 * gq + 3] : 0.f;
              u32x2 w; w.x = cvtpk(p0, p1); w.y = cvtpk(p2, p3); *(LAS u32x2*)(lds + OFF_K + t * SR + s0 * 2) = w; } } }
    __syncthreads();
    f32x16 oc[2]; oc[0] = f32x16{}; oc[1] = f32x16{};
    for (int k8 = 0; k8 < 2 * (tb + 1); ++k8) { const bf16x8 pb = ldfrag(lds + OFF_K, 32 * tb + r32, k8, h2);
#pragma unroll
        for (int j = 0; j < 2; ++j) oc[j] = MFMA32(ldfrag(lds + OFF_V, 64 * wh + 32 * j + r32, k8, h2), pb, oc[j]); }
#pragma unroll
    for (int k8 = 0; k8 < 8; ++k8) { const bf16x8 qb = ldfrag(lds + OFF_Q, 32 * tb + r32, k8, h2);
#pragma unroll
        for (int j = 0; j < 2; ++j) oc[j] = MFMA32(ldfrag(lds + OFF_S, 64 * wh + 32 * j + r32, k8, h2), qb, oc[j]); }
    LAS float* ssq = (LAS float*)(lds + OFF_SSQ);
    { float ss = 0.f;
#pragma unroll
      for (int j = 0; j < 2; ++j)
#pragma unroll
          for (int r = 0; r < 16; ++r) ss += oc[j][r] * oc[j][r];
      ss += __shfl_xor(ss, 32);
      if (h2 == 0) ssq[wh * 128 + 32 * tb + r32] = ss; }
    __syncthreads();
    { const int t = 32 * tb + r32; const float rstd = __builtin_amdgcn_rsqf((ssq[t] + ssq[128 + t]) * (1.f / 128.f) + EPS);
#pragma unroll
      for (int j = 0; j < 2; ++j)
#pragma unroll
          for (int gq = 0; gq < 4; ++gq) { const int e = 64 * wh + 32 * j + 8 * gq + 4 * h2;
              const u32x2 gt = gate[j][gq]; const f32x4 gn = *(const f32x4*)(hgn + h * 128 + e);
              const float g0 = bflo(gt.x), g1 = bfhi(gt.x), g2 = bflo(gt.y), g3 = bfhi(gt.y);
              const float o0 = oc[j][4 * gq + 0] * rstd * gn[0] * (g0 * sigm(g0)), o1 = oc[j][4 * gq + 1] * rstd * gn[1] * (g1 * sigm(g1));
              const float o2 = oc[j][4 * gq + 2] * rstd * gn[2] * (g2 * sigm(g2)), o3 = oc[j][4 * gq + 3] * rstd * gn[3] * (g3 * sigm(g3));
              u32x2 w; w.x = cvtpk(o0, o1); w.y = cvtpk(o2, o3); *(u32x2*)(OM + rc * 1024 + h * 128 + e) = w; } }
    __syncthreads();
}

__device__ __forceinline__ void hgrn_scan(bf16_t* __restrict__ Ub, const float* __restrict__ Dv) {
    for (int v = blockIdx.x * 512 + threadIdx.x; v < 32 * 4096; v += gridDim.x * 512) {
        const int bh = v >> 12, i4 = v & 4095, e = i4 >> 5, d4 = (i4 & 31) * 4;
        u32x2* up = (u32x2*)(Ub + ((size_t)(bh * 32) * 128 + e) * 128 + d4); const f32x4* dp = (const f32x4*)(Dv + (size_t)(bh * 32) * 128 + d4);
        f32x4 S = (f32x4){0.f, 0.f, 0.f, 0.f};
#pragma unroll 1
        for (int c0 = 0; c0 < 32; c0 += 8) { u32x2 u[8]; f32x4 dv[8];
#pragma unroll
            for (int c = 0; c < 8; ++c) { u[c] = up[(size_t)(c0 + c) * 4096]; dv[c] = dp[(c0 + c) * 32]; }
#pragma unroll
            for (int c = 0; c < 8; ++c) { S = dv[c] * S + (f32x4){bflo(u[c].x), bfhi(u[c].x), bflo(u[c].y), bfhi(u[c].y)}; up[(size_t)(c0 + c) * 4096] = (u32x2){cvtpk(S[0], S[1]), cvtpk(S[2], S[3])}; } }
    }
}

constexpr int AK_STRIDE = 144, AV_STRIDE = 560, AK_OFF = 0, AV_OFF = 288 * AK_STRIDE;
__device__ __forceinline__ void attn_stage(LAS unsigned char* lds, const bf16_t* __restrict__ Za, const bf16_t* __restrict__ Vt, int b, int n, int kvh) {
    const int tid = threadIdx.x;
    for (int i = tid; i < 288 * 8; i += 512) { const int kl = i >> 3, ch = i & 7; u32x4 v = (u32x4){0u, 0u, 0u, 0u};
        int pos = -1; if (kl < 256) pos = 128 * (n - 1) + kl - 112; else if (kl < 272) pos = kl - 256;
        if (pos >= 0) v = *(const u32x4*)(Za + (size_t)(b * LTOK + pos) * 768 + 512 + kvh * 64 + 8 * ch);
        *(LAS u32x4*)(lds + AK_OFF + kl * AK_STRIDE + ch * 16) = v; }
    for (int i = tid; i < 64 * 35; i += 512) { const int d = i / 35, ch = i - d * 35; u32x4 v = (u32x4){0u, 0u, 0u, 0u};
        const bf16_t* vr = Vt + (size_t)(b * 128 + kvh * 64 + d) * LPAD;
        if (ch < 32) { if (n > 1 || ch >= 14) v = *(const u32x4*)(vr + 128 * (n - 1) + 8 * ch); }
        else if (ch < 34) v = *(const u32x4*)(vr + 112 + 8 * (ch - 32));
        *(LAS u32x4*)(lds + AV_OFF + d * AV_STRIDE + ch * 16) = v; }
}
__device__ __forceinline__ f32x16 attn_qk(const LAS unsigned char* kp, const bf16x8 (&qf)[4]) {
    f32x16 S = f32x16{};
#pragma unroll
    for (int k = 0; k < 4; ++k) S = MFMA32(*(const LAS bf16x8*)(kp + 32 * k), qf[k], S);
    return S;
}
template <int MODE> __device__ __forceinline__ bool attn_vis(int kr, int r32) { return MODE == 0 ? true : MODE == 1 ? (kr > r32) : MODE == 2 ? (kr <= r32) : (kr < 16); }
template <int MODE> __device__ __forceinline__ float attn_tile_max(const f32x16& S, int r32, int h2) {
    float m = -INFINITY;
#pragma unroll
    for (int r = 0; r < 16; ++r) { const int kr = (r & 3) + 8 * (r >> 2) + 4 * h2; m = fmaxf(m, attn_vis<MODE>(kr, r32) ? S[r] : -INFINITY); }
    return m;
}
template <int MODE> __device__ __forceinline__ void attn_tile_pv(f32x16 S, float c2, float mneg, int r32, int h2, float& l, f32x16 (&O)[2], const LAS unsigned char* vl, int kl0) {
#pragma unroll
    for (int r = 0; r < 16; ++r) { const int kr = (r & 3) + 8 * (r >> 2) + 4 * h2; const float p = __builtin_amdgcn_exp2f(__builtin_fmaf(S[r], c2, mneg)); S[r] = attn_vis<MODE>(kr, r32) ? p : 0.f; l += S[r]; }
#pragma unroll
    for (int s2 = 0; s2 < 2; ++s2) {
        if (MODE == 3 && s2 == 1) continue;
        u32x4 pw; pw.x = cvtpk(S[8 * s2 + 0], S[8 * s2 + 1]); pw.y = cvtpk(S[8 * s2 + 2], S[8 * s2 + 3]); pw.z = cvtpk(S[8 * s2 + 4], S[8 * s2 + 5]); pw.w = cvtpk(S[8 * s2 + 6], S[8 * s2 + 7]);
        const bf16x8 pb = __builtin_bit_cast(bf16x8, pw);
#pragma unroll
        for (int db = 0; db < 2; ++db) { const LAS unsigned char* vp = vl + (32 * db) * AV_STRIDE + (kl0 + 16 * s2) * 2;
            const u32x2 lo = *(const LAS u32x2*)vp, hi = *(const LAS u32x2*)(vp + 16);
            const u32x4 aw = (u32x4){lo.x, lo.y, hi.x, hi.y};
            O[db] = MFMA32(__builtin_bit_cast(bf16x8, aw), pb, O[db]); } }
}
__device__ __forceinline__ void attn_sub(const LAS unsigned char* lds, const bf16_t* __restrict__ Za, const float* __restrict__ sinks, bf16_t* __restrict__ OM, int b, int n, int qh, int sb, int lane) {
    const int r32 = lane & 31, h2 = lane >> 5;
    const int pq = 128 * n + 32 * sb + r32;
    const bf16_t* qp = Za + (size_t)(b * LTOK + pq - 112) * 768 + qh * 64 + 8 * h2;
    bf16x8 qf[4];
#pragma unroll
    for (int k = 0; k < 4; ++k) qf[k] = *(const bf16x8*)(qp + 16 * k);
    const LAS unsigned char* kl = lds + AK_OFF + r32 * AK_STRIDE + 16 * h2;
    const LAS unsigned char* vl = lds + AV_OFF + r32 * AV_STRIDE + 8 * h2;
    const float c2 = 0.125f * 1.4426950408889634f;
    const float sinkl = sinks[qh] * 1.4426950408889634f;
    const int jskip = n == 1 ? 4 - sb : 0;
    float mraw = -INFINITY;
#pragma unroll
    for (int j = 0; j < 5; ++j) { if (j < jskip) continue;
        const f32x16 S = attn_qk(kl + (32 * (sb + j)) * AK_STRIDE, qf);
        mraw = fmaxf(mraw, j == 0 ? attn_tile_max<1>(S, r32, h2) : j == 4 ? attn_tile_max<2>(S, r32, h2) : attn_tile_max<0>(S, r32, h2)); }
    { const f32x16 S = attn_qk(kl + 256 * AK_STRIDE, qf); mraw = fmaxf(mraw, attn_tile_max<3>(S, r32, h2)); }
    float mx = fmaxf(mraw * c2, sinkl);
    mx = fmaxf(mx, __shfl_xor(mx, 32));
    float l = 0.f; const float mneg = -mx;
    f32x16 O[2]; O[0] = f32x16{}; O[1] = f32x16{};
#pragma unroll
    for (int j = 0; j < 5; ++j) { if (j < jskip) continue;
        const int kl0 = 32 * (sb + j); const f32x16 S = attn_qk(kl + kl0 * AK_STRIDE, qf);
        if (j == 0) attn_tile_pv<1>(S, c2, mneg, r32, h2, l, O, vl, kl0); else if (j == 4) attn_tile_pv<2>(S, c2, mneg, r32, h2, l, O, vl, kl0); else attn_tile_pv<0>(S, c2, mneg, r32, h2, l, O, vl, kl0); }
    { const f32x16 S = attn_qk(kl + 256 * AK_STRIDE, qf); attn_tile_pv<3>(S, c2, mneg, r32, h2, l, O, vl, 256); }
    l += __shfl_xor(l, 32); l += __builtin_amdgcn_exp2f(sinkl - mx);
    const float inv = __builtin_amdgcn_rcpf(l);
    bf16_t* op = OM + ((size_t)b * SEQ + 128 * (n - 1) + 32 * sb + r32) * 1024 + 512 + qh * 64 + 4 * h2;
#pragma unroll
    for (int db = 0; db < 2; ++db)
#pragma unroll
        for (int g = 0; g < 4; ++g) { u32x2 w; w.x = cvtpk(O[db][4 * g] * inv, O[db][4 * g + 1] * inv); w.y = cvtpk(O[db][4 * g + 2] * inv, O[db][4 * g + 3] * inv);
            *(u32x2*)(op + 32 * db + 8 * g) = w; }
}
__device__ __forceinline__ unsigned f2ord(float f) { const unsigned u = __float_as_uint(f); return (u & 0x80000000u) ? ~u : (u | 0x80000000u); }
__device__ __forceinline__ float ord2f(unsigned u) { return __uint_as_float((u & 0x80000000u) ? (u & 0x7fffffffu) : ~u); }
__device__ __forceinline__ unsigned umax_(unsigned a, unsigned b) { return a > b ? a : b; }
__device__ __forceinline__ unsigned umin_(unsigned a, unsigned b) { return a < b ? a : b; }
struct Net16 { unsigned char a[63], b[63]; };
constexpr Net16 make_net16() {
    constexpr int P[63][2] = {{0,1},{2,3},{0,2},{1,3},{1,2},{4,5},{6,7},{4,6},{5,7},{5,6},{0,4},{2,6},{2,4},{1,5},{3,7},{3,5},{1,2},{3,4},{5,6},{8,9},{10,11},{8,10},{9,11},{9,10},{12,13},{14,15},{12,14},{13,15},{13,14},
        {8,12},{10,14},{10,12},{9,13},{11,15},{11,13},{9,10},{11,12},{13,14},{0,8},{4,12},{4,8},{2,10},{6,14},{6,10},{2,4},{6,8},{10,12},{1,9},{5,13},{5,9},{3,11},{7,15},{7,11},{3,5},{7,9},{11,13},{1,2},{3,4},{5,6},{7,8},{9,10},{11,12},{13,14}};
    Net16 n{}; for (int k = 0; k < 63; ++k) { n.a[k] = (unsigned char)P[k][0]; n.b[k] = (unsigned char)P[k][1]; } return n;
}
constexpr Net16 NET16 = make_net16();
template <int N> __device__ __forceinline__ void bitonic_desc(unsigned (&a)[N]) {
    static_assert(N == 16, "16-input network");
#pragma unroll
    for (int k = 0; k < 63; ++k) { const unsigned hi = umax_(a[NET16.a[k]], a[NET16.b[k]]), lo = umin_(a[NET16.a[k]], a[NET16.b[k]]); a[NET16.a[k]] = hi; a[NET16.b[k]] = lo; }
}
__device__ __forceinline__ void merge_top16(unsigned (&a)[16], const unsigned (&b)[16]) {
#pragma unroll
    for (int i = 0; i < 16; ++i) a[i] = umax_(a[i], b[15 - i]);
#pragma unroll
    for (int j = 8; j > 0; j >>= 1)
#pragma unroll
        for (int i = 0; i < 16; ++i) { const int l = i ^ j; if (l > i) { const unsigned hi = umax_(a[i], a[l]), lo = umin_(a[i], a[l]); a[i] = hi; a[l] = lo; } }
}
template <bool PAIR> __device__ __forceinline__ void top16_of(unsigned (&g)[4][16]) {
    bitonic_desc<16>(g[0]); bitonic_desc<16>(g[1]); bitonic_desc<16>(g[2]); bitonic_desc<16>(g[3]);
    merge_top16(g[0], g[1]); merge_top16(g[2], g[3]); merge_top16(g[0], g[2]);
    if (PAIR) { unsigned o[16]; const bool up = (threadIdx.x & 32) != 0;
#pragma unroll
        for (int i = 0; i < 16; ++i) { const auto r = __builtin_amdgcn_permlane32_swap(g[0][i], g[0][i], false, false); o[i] = up ? r[0] : r[1]; }
        merge_top16(g[0], o); }
}
__device__ __forceinline__ unsigned sel16p(unsigned long long lo, unsigned long long hi, int i) { const unsigned long long w = (i & 8) ? hi : lo; return (unsigned)(w >> ((i & 7) * 8)) & 0x7fu; }
struct CandTab { unsigned char i[50], j[50]; int n; };
constexpr CandTab make_cands() { CandTab t{}; int n = 0; for (int i = 0; i < 16; ++i) for (int j = 0; j < 16; ++j) if ((i + 1) * (j + 1) <= 16) { t.i[n] = (unsigned char)i; t.j[n] = (unsigned char)j; ++n; } t.n = n; return t; }
constexpr CandTab CT = make_cands();
static_assert(CT.n == 50, "candidate count");

constexpr int PL_IDX = 0, PL_GB = 32768, PL_PA = 65536, PL_SSQ = 131072;
__device__ __forceinline__ void peer_list(const bf16_t* __restrict__ Qb, const bf16_t* __restrict__ SK, int rc0, int h, int c, int r32, int h2, unsigned (&top)[16]) {
    const int lane_ = 32 * h2 + r32;
    const bf16_t* qp = Qb + ((size_t)((((rc0 >> 5) * 8 + h) * 2 + c) * 8) * 64 + lane_) * 8;
    bf16x8 qf[8];
#pragma unroll
    for (int k = 0; k < 8; ++k) qf[k] = *(const bf16x8*)(qp + 512 * k);
    unsigned g[4][16];
#pragma unroll
    for (int nb = 0; nb < 4; ++nb) {
        const bf16_t* kp = SK + ((size_t)(((h * 2 + c) * 4 + nb) * 8) * 64 + lane_) * 8;
        f32x16 acc = f32x16{};
#pragma unroll
        for (int k = 0; k < 8; ++k) acc = MFMA32(*(const bf16x8*)(kp + 512 * k), qf[k], acc);
#pragma unroll
        for (int r = 0; r < 16; ++r) g[nb][r] = (f2ord(acc[r]) & 0xffffff80u) | (unsigned)(32 * nb + (r & 3) + 8 * (r >> 2) + 4 * h2);
        __builtin_amdgcn_sched_barrier(0);
    }
    top16_of<true>(g);
#pragma unroll
    for (int k = 0; k < 16; ++k) top[k] = g[0][k];
}
__device__ __forceinline__ void peer_topk(LAS unsigned char* lds, const bf16_t* __restrict__ Qb, const bf16_t* __restrict__ SK, const float* __restrict__ rowssp, int rc0, int tl0, int h0, int lane) {
    float rstd_t;
    { const f32x4* rp = (const f32x4*)(rowssp + (size_t)(rc0 + (lane & 31)) * 16); const f32x4 s4 = (rp[0] + rp[1]) + (rp[2] + rp[3]); rstd_t = __builtin_amdgcn_rsqf(((s4[0] + s4[1]) + (s4[2] + s4[3])) * (1.0f / 1024.0f) + EPS); }
#pragma unroll 1
    for (int hh = 0; hh < 4; ++hh) {
        asm volatile("" : "+v"(lane));
        const int r32 = lane & 31, h2 = lane >> 5;
        const int h = h0 + hh;
        unsigned ta[16], tb[16];
        peer_list(Qb, SK, rc0, h, 0, r32, h2, ta);
        peer_list(Qb, SK, rc0, h, 1, r32, h2, tb);
        float av[16], bv[16]; unsigned long long ail = 0, aih = 0, bil = 0, bih = 0;
#pragma unroll
        for (int k = 0; k < 16; ++k) { av[k] = ord2f(ta[k] & 0xffffff80u); bv[k] = ord2f(tb[k] & 0xffffff80u);
            if (k < 8) { ail |= (unsigned long long)(ta[k] & 0x7fu) << (8 * k); bil |= (unsigned long long)(tb[k] & 0x7fu) << (8 * k); }
            else { aih |= (unsigned long long)(ta[k] & 0x7fu) << (8 * (k - 8)); bih |= (unsigned long long)(tb[k] & 0x7fu) << (8 * (k - 8)); } }
        unsigned k2[4][16];
#pragma unroll
        for (int k = 0; k < 64; ++k) { if (k < 50) k2[k >> 4][k & 15] = (f2ord(av[CT.i[k < 50 ? k : 0]] + bv[CT.j[k < 50 ? k : 0]]) & 0xffffff00u) | (unsigned)(CT.i[k < 50 ? k : 0] * 16 + CT.j[k < 50 ? k : 0]); else k2[k >> 4][k & 15] = 0u; }
        top16_of<false>(k2);
        float ev[16]; float es = 0.f; const float m0 = ord2f(k2[0][0] & 0xffffff00u);
#pragma unroll
        for (int k = 0; k < 16; ++k) { ev[k] = __expf((ord2f(k2[0][k] & 0xffffff00u) - m0) * rstd_t); es += ev[k]; }
        const float inv = 1.f / es;
        LAS unsigned short* ip = (LAS unsigned short*)(lds + PL_IDX) + (tl0 + r32) * 128 + h * 16;
        LAS bf16_t* gp = (LAS bf16_t*)(lds + PL_GB) + (tl0 + r32) * 128 + h * 16;
#pragma unroll
        for (int k = 0; k < 16; ++k) { const int code = (int)(k2[0][k] & 0xffu); const unsigned e = sel16p(ail, aih, code >> 4) * 128u + sel16p(bil, bih, code & 15);
            if ((k >> 3) == h2) { ip[k] = (unsigned short)e; gp[k] = f2bf(ev[k] * inv); } }
    }
}
__device__ __forceinline__ pg8::f32x2_t fp8x2(unsigned w, bool hi) { return hi ? __builtin_amdgcn_cvt_pk_f32_fp8(w, true) : __builtin_amdgcn_cvt_pk_f32_fp8(w, false); }
template <int CTRL> __device__ __forceinline__ float dppf(float v) { return __builtin_bit_cast(float, __builtin_amdgcn_update_dpp(0, __builtin_bit_cast(int, v), CTRL, 0xf, 0xf, true)); }
template <bool WITH_X>
__device__ __forceinline__ void peer_rows_load(u32x4 (&rw)[16], u32x4 (&xw)[2], const LAS unsigned char* lds, int tl, size_t rc, int s, const unsigned char* __restrict__ T8, const bf16_t* __restrict__ A2, int lane) {
    const int c = lane & 7, gq = lane >> 3;
    if (WITH_X) { xw[0] = *(const u32x4*)((const unsigned char*)A2 + rc * 1024 + 128 * s + 16 * c); xw[1].x = __float_as_uint(*(const float*)((const unsigned char*)A2 + (size_t)MC * 1024 + rc * 4)); }
    const LAS u32x4* ip = (const LAS u32x4*)(lds + PL_IDX + tl * 256 + gq * 32);
    const u32x4 i0 = ip[0], i1 = ip[1];
    const unsigned iw[8] = {i0.x, i0.y, i0.z, i0.w, i1.x, i1.y, i1.z, i1.w};
    const __amdgpu_buffer_rsrc_t rs = __builtin_amdgcn_make_buffer_rsrc((void*)T8, (short)0, 16 << 20, 0x00020000);
    const unsigned c16 = 16u * (unsigned)c; const int soff = 128 * s;
    const unsigned k1024 = 1024u;
#pragma unroll
    for (int ig = 0; ig < 16; ++ig) { unsigned off;
        if (ig & 1) asm("v_mad_u32_u16 %0, %1, %2, %3 op_sel:[1,0,0,0]" : "=v"(off) : "v"(iw[ig >> 1]), "v"(k1024), "v"(c16)); else asm("v_mad_u32_u16 %0, %1, %2, %3" : "=v"(off) : "v"(iw[ig >> 1]), "v"(k1024), "v"(c16));
        rw[ig] = __builtin_bit_cast(u32x4, __builtin_amdgcn_raw_buffer_load_b128(rs, (int)off, soff, 0)); }
}
template <int CTRL> __device__ __forceinline__ int dppi(int v) { return __builtin_amdgcn_update_dpp(0, v, CTRL, 0xf, 0xf, true); }
__device__ __forceinline__ void peer_u_math(const u32x4 (&uw)[16], const u32x4 (&xw)[2], LAS unsigned char* lds, int tl, int lane) {
    const int c = lane & 7, gq = lane >> 3;
    const int x0 = (int)xw[0].x, x1 = (int)xw[0].y, x2 = (int)xw[0].z, x3 = (int)xw[0].w;
    int d[16];
#pragma unroll
    for (int ig = 0; ig < 16; ++ig) { int t = __builtin_amdgcn_sdot4((int)uw[ig].x, x0, 0, false); t = __builtin_amdgcn_sdot4((int)uw[ig].y, x1, t, false); t = __builtin_amdgcn_sdot4((int)uw[ig].z, x2, t, false); d[ig] = __builtin_amdgcn_sdot4((int)uw[ig].w, x3, t, false); }
    const bool c4 = c & 4, c2 = c & 2, c1 = c & 1;
    int acc[2];
#pragma unroll
    for (int hf = 0; hf < 2; ++hf) { int t[4];
#pragma unroll
        for (int j = 0; j < 4; ++j) { const int keep = c4 ? d[8 * hf + j + 4] : d[8 * hf + j], send = c4 ? d[8 * hf + j] : d[8 * hf + j + 4]; t[j] = keep + dppi<0x141>(send); }
#pragma unroll
        for (int j = 0; j < 2; ++j) { const int keep = c2 ? t[j + 2] : t[j], send = c2 ? t[j] : t[j + 2]; t[j] = keep + dppi<0x4E>(send); }
        { const int keep = c1 ? t[1] : t[0], send = c1 ? t[0] : t[1]; acc[hf] = keep + dppi<0xB1>(send); } }
    const float sx = __uint_as_float(xw[1].x);
    LAS float* pp = (LAS float*)(lds + PL_PA) + tl * 128 + 16 * gq + c;
    __hip_atomic_fetch_add(pp, (float)acc[0] * sx, __ATOMIC_RELAXED, __HIP_MEMORY_SCOPE_WORKGROUP);
    __hip_atomic_fetch_add(pp + 8, (float)acc[1] * sx, __ATOMIC_RELAXED, __HIP_MEMORY_SCOPE_WORKGROUP);
}
__device__ __forceinline__ void peer_a_step(LAS unsigned char* lds, int tl, size_t rc, const float* __restrict__ rowssp, const float* __restrict__ su, const float* __restrict__ sv, int lane) {
    float rs = rowssp[rc * 16 + (lane & 15)];
    rs += __shfl_xor(rs, 1); rs += __shfl_xor(rs, 2); rs += __shfl_xor(rs, 4); rs += __shfl_xor(rs, 8);
    const float rstd = __builtin_amdgcn_rsqf(rs * (1.f / 1024.f) + EPS);
    float w[2];
#pragma unroll
    for (int q = 0; q < 2; ++q) { const int k = lane + 64 * q;
        const unsigned e = ((const LAS unsigned short*)(lds + PL_IDX))[tl * 128 + k];
        const float z = ((const LAS float*)(lds + PL_PA))[tl * 128 + k] * rstd * su[e]; const float a = 0.5f * z * (1.f + erff(z * 0.70710678118654752f));
        w[q] = bf2f(((const LAS bf16_t*)(lds + PL_GB))[tl * 128 + k]) * a * sv[e]; }
    float am = fmaxf(fabsf(w[0]), fabsf(w[1]));
#pragma unroll
    for (int o = 1; o < 64; o <<= 1) am = fmaxf(am, __shfl_xor(am, o));
    const float sc = am > 0.f ? 127.f / am : 1.f;
    LAS signed char* wq = (LAS signed char*)(lds + PL_PA + tl * 512);
    wq[lane] = (signed char)__float2int_rn(w[0] * sc); wq[lane + 64] = (signed char)__float2int_rn(w[1] * sc);
    if (lane == 0) ((LAS float*)(lds + PL_SSQ))[tl] = am > 0.f ? am / 127.f : 1.f;
}
__device__ __forceinline__ void peer_v_math(const u32x4 (&vw)[16], LAS unsigned char* lds, int tl, size_t rc, int s, bf16_t* __restrict__ dout, int lane) {
    const int c = lane & 7, gq = lane >> 3;
    const u32x4 wq4 = *(const LAS u32x4*)(lds + PL_PA + tl * 512 + 16 * gq);
    const float wsc = ((const LAS float*)(lds + PL_SSQ))[tl];
    const bool b3 = lane & 8, b4 = lane & 16, b5 = lane & 32;
    unsigned* hp = (unsigned*)(dout + rc * 1024 + 128 * s + 16 * c + (b3 ? 8 : 0) + (b4 ? 4 : 0) + (b5 ? 2 : 0));
    const unsigned hw = *hp; pg8::f32x2_t h = (pg8::f32x2_t){bflo(hw), bfhi(hw)};
    int ia[16];
#pragma unroll
    for (int i = 0; i < 16; ++i) ia[i] = 0;
#pragma unroll
    for (int m = 0; m < 4; ++m) { const int wm = (int)wq4[m];
#pragma unroll
        for (int p = 0; p < 4; ++p) { const unsigned A = vw[4 * m][p], B = vw[4 * m + 1][p], C = vw[4 * m + 2][p], D = vw[4 * m + 3][p];
            const unsigned X0 = __builtin_amdgcn_perm(B, A, 0x05010400u), X1 = __builtin_amdgcn_perm(B, A, 0x07030602u), Y0 = __builtin_amdgcn_perm(D, C, 0x05010400u), Y1 = __builtin_amdgcn_perm(D, C, 0x07030602u);
            const unsigned T0 = __builtin_amdgcn_perm(Y0, X0, 0x05040100u), T1 = __builtin_amdgcn_perm(Y0, X0, 0x07060302u), T2 = __builtin_amdgcn_perm(Y1, X1, 0x05040100u), T3 = __builtin_amdgcn_perm(Y1, X1, 0x07060302u);
            ia[4 * p] = __builtin_amdgcn_sdot4((int)T0, wm, ia[4 * p], false); ia[4 * p + 1] = __builtin_amdgcn_sdot4((int)T1, wm, ia[4 * p + 1], false);
            ia[4 * p + 2] = __builtin_amdgcn_sdot4((int)T2, wm, ia[4 * p + 2], false); ia[4 * p + 3] = __builtin_amdgcn_sdot4((int)T3, wm, ia[4 * p + 3], false); } }
#pragma unroll
    for (int j = 0; j < 8; ++j) { const int keep = b3 ? ia[j + 8] : ia[j], send = b3 ? ia[j] : ia[j + 8]; ia[j] = keep + dppi<0x128>(send); }
#pragma unroll
    for (int j = 0; j < 4; ++j) { const auto r = __builtin_amdgcn_permlane16_swap((unsigned)ia[j], (unsigned)ia[j + 4], false, false); ia[j] = (int)(r[0] + r[1]); }
#pragma unroll
    for (int j = 0; j < 2; ++j) { const auto r = __builtin_amdgcn_permlane32_swap((unsigned)ia[j], (unsigned)ia[j + 2], false, false); ia[j] = (int)(r[0] + r[1]); }
    float out[2] = {(float)ia[0] * wsc, (float)ia[1] * wsc};
    h.x += out[0]; h.y += out[1];
    *hp = cvtpk(h.x, h.y);
}
template <int NT>
__device__ __forceinline__ void peer_f_steps(size_t rc, const bf16_t* __restrict__ h2b, float* __restrict__ dout, const float* __restrict__ gfin, int lane) {
    u32x2 hw[NT][4];
#pragma unroll
    for (int i = 0; i < NT; ++i)
#pragma unroll
        for (int q = 0; q < 4; ++q) hw[i][q] = *(const u32x2*)(h2b + (rc + i) * 1024 + 256 * q + 4 * lane);
    f32x4 g[4];
#pragma unroll
    for (int q = 0; q < 4; ++q) g[q] = *(const f32x4*)(gfin + 256 * q + 4 * lane);
#pragma unroll
    for (int i = 0; i < NT; ++i) { f32x4 h[4]; f32x4 sq = (f32x4){0.f, 0.f, 0.f, 0.f};
#pragma unroll
        for (int q = 0; q < 4; ++q) { h[q] = (f32x4){bflo(hw[i][q].x), bfhi(hw[i][q].x), bflo(hw[i][q].y), bfhi(hw[i][q].y)}; sq += h[q] * h[q]; }
        const float rf = __builtin_amdgcn_rsqf(wave_sum((sq[0] + sq[1]) + (sq[2] + sq[3])) * (1.f / 1024.f) + EPS);
        float* op = dout + (rc + i) * 1024 + 4 * lane;
#pragma unroll
        for (int q = 0; q < 4; ++q) *(f32x4*)(op + 256 * q) = h[q] * rf * g[q]; }
}
__device__ __forceinline__ unsigned pack_i8x4(float a, float b, float c, float d) {
    const int ia = __float2int_rn(a), ib = __float2int_rn(b), ic = __float2int_rn(c), id = __float2int_rn(d);
    return (unsigned)(ia & 0xff) | ((unsigned)(ib & 0xff) << 8) | ((unsigned)(ic & 0xff) << 16) | ((unsigned)id << 24);
}
__device__ __forceinline__ void peer_tables(const float* __restrict__ pu, const float* __restrict__ pv, unsigned char* __restrict__ T8, float* __restrict__ sinv, int lane, int gw, int NGW) {
    for (int row = gw; row < 32768; row += NGW) {
        const bool isu = row < 16384;
        const float* src = (isu ? pu + (size_t)row * 1024 : pv + (size_t)(row - 16384) * 1024) + 16 * lane;
        f32x4 v[4]; float am = 0.f;
#pragma unroll
        for (int q = 0; q < 4; ++q) { v[q] = *(const f32x4*)(src + 4 * q); am = fmaxf(am, fmaxf(fmaxf(fabsf(v[q][0]), fabsf(v[q][1])), fmaxf(fabsf(v[q][2]), fabsf(v[q][3])))); }
#pragma unroll
        for (int o = 1; o < 64; o <<= 1) am = fmaxf(am, __shfl_xor(am, o));
        const float top = 127.f;
        const float sc = am > 0.f ? top / am : 1.f;
        u32x4 w;
#pragma unroll
        for (int q = 0; q < 4; ++q) w[q] = pack_i8x4(v[q][0] * sc, v[q][1] * sc, v[q][2] * sc, v[q][3] * sc);
        *(u32x4*)(T8 + (size_t)row * 1024 + 16 * lane) = w;
        if (lane == 0) sinv[row] = am > 0.f ? am / top : 1.f;
    }
}
__device__ __forceinline__ void peer_xq_token(const bf16_t* __restrict__ H1, const float* __restrict__ gffn, unsigned char* __restrict__ XQ, float* __restrict__ SX, size_t rc, int lane) {
    const u32x4 xa = *(const u32x4*)(H1 + rc * 1024 + 16 * lane), xb = *(const u32x4*)(H1 + rc * 1024 + 16 * lane + 8);
    const unsigned w[8] = {xa.x, xa.y, xa.z, xa.w, xb.x, xb.y, xb.z, xb.w};
    float xv[16]; float am = 0.f;
#pragma unroll
    for (int q = 0; q < 4; ++q) { const f32x4 g = *(const f32x4*)(gffn + 16 * lane + 4 * q);
        xv[4 * q] = bflo(w[2 * q]) * g[0]; xv[4 * q + 1] = bfhi(w[2 * q]) * g[1]; xv[4 * q + 2] = bflo(w[2 * q + 1]) * g[2]; xv[4 * q + 3] = bfhi(w[2 * q + 1]) * g[3];
        am = fmaxf(am, fmaxf(fmaxf(fabsf(xv[4 * q]), fabsf(xv[4 * q + 1])), fmaxf(fabsf(xv[4 * q + 2]), fabsf(xv[4 * q + 3])))); }
#pragma unroll
    for (int o = 1; o < 64; o <<= 1) am = fmaxf(am, __shfl_xor(am, o));
    const float sc = am > 0.f ? 127.f / am : 1.f;
    u32x4 o;
#pragma unroll
    for (int q = 0; q < 4; ++q) o[q] = pack_i8x4(xv[4 * q] * sc, xv[4 * q + 1] * sc, xv[4 * q + 2] * sc, xv[4 * q + 3] * sc);
    *(u32x4*)(XQ + rc * 1024 + 16 * lane) = o;
    if (lane == 0) SX[rc] = am > 0.f ? am / 127.f : 1.f;
}

#define XB_TMO      128
#define XB_XCNT(j)  (256  + 64 * (j))
#define XB_XSUB(j)  (1280 + 64 * (j))
#define XB_XGEN(j)  (2304 + 64 * (j))
#define XB_TOP      3328
#define XB_TOPGEN   3392
#define XCD_BAR_WORDS 3456
#define XB_SPIN_CAP (1u << 18)

__device__ __forceinline__ unsigned xb_ld(unsigned* p)              { return __hip_atomic_load(p, __ATOMIC_RELAXED, __HIP_MEMORY_SCOPE_AGENT); }
__device__ __forceinline__ unsigned xb_add(unsigned* p, unsigned v) { return __hip_atomic_fetch_add(p, v, __ATOMIC_RELAXED, __HIP_MEMORY_SCOPE_AGENT); }
__device__ __forceinline__ unsigned xb_xcc_id() { return (unsigned)__builtin_amdgcn_s_getreg((3 << 11) | 20) & 0xFu; }
#define XB_SPIN(cond, bar) do { unsigned _sp = 0; while (cond) { __builtin_amdgcn_s_sleep(1); \
    if ((++_sp & 255u) == 0u) { if (xb_ld(&(bar)[XB_TMO])) break; if (_sp > XB_SPIN_CAP) { atomicAdd(&(bar)[XB_TMO], 1u); break; } } } } while (0)

struct XcdBarrier {
    unsigned* bar; unsigned x;
    volatile LAS unsigned* st;
};

__device__ __forceinline__ XcdBarrier xcd_barrier_post(unsigned* bar, volatile LAS unsigned* st) {
    XcdBarrier b; b.bar = bar; b.x = xb_xcc_id(); b.st = st;
    if (threadIdx.x == 0) (void)xb_add(&bar[XB_XCNT(b.x)], 1u);
    return b;
}
__device__ __forceinline__ void xcd_barrier_complete(unsigned* bar, unsigned x, unsigned& nloc, unsigned& nx) {
    const unsigned G = gridDim.x * gridDim.y * gridDim.z;
    unsigned sum, cnt, mine, sp = 0u;
    for (;;) {
        sum = 0u; cnt = 0u; mine = 0u;
#pragma unroll
        for (unsigned j = 0; j < 16; ++j) { const unsigned c = xb_ld(&bar[XB_XCNT(j)]); sum += c; cnt += (c > 0u) ? 1u : 0u; mine = (j == x) ? c : mine; }
        if (sum == G) break;
        __builtin_amdgcn_s_sleep(1);
        if ((++sp & 255u) == 0u) { if (xb_ld(&bar[XB_TMO])) break; if (sp > XB_SPIN_CAP) { atomicAdd(&bar[XB_TMO], 1u); break; } }
    }
    nloc = mine > 0u ? mine : 1u; nx = cnt > 0u ? cnt : 1u;
}

__device__ __forceinline__ void xcd_barrier(const XcdBarrier& b) {
    asm volatile("s_waitcnt vmcnt(0)" ::: "memory");
    __syncthreads();
    if (threadIdx.x == 0) {
        unsigned* bar = b.bar;
        __builtin_amdgcn_s_waitcnt(0);
        unsigned nloc = b.st[0], nx = b.st[1];
        if (nloc == 0u) { xcd_barrier_complete(bar, b.x, nloc, nx); b.st[0] = nloc; b.st[1] = nx; }
        const unsigned old = xb_add(&bar[XB_XSUB(b.x)], 1u);
        const unsigned gen = old / nloc;
        if (old + 1u == (gen + 1u) * nloc) {
            __builtin_amdgcn_fence(__ATOMIC_RELEASE, "agent");
            asm volatile("s_waitcnt vmcnt(0)" ::: "memory");
            const unsigned og = xb_add(&bar[XB_TOP], 1u);
            const unsigned tg = og / nx;
            if (og + 1u == (tg + 1u) * nx) xb_add(&bar[XB_TOPGEN], 1u);
            else XB_SPIN(xb_ld(&bar[XB_TOPGEN]) == tg, bar);
            __builtin_amdgcn_fence(__ATOMIC_ACQUIRE, "agent");
            xb_add(&bar[XB_XGEN(b.x)], 1u);
            asm volatile("s_waitcnt vmcnt(0)" ::: "memory");
        } else {
            XB_SPIN(xb_ld(&bar[XB_XGEN(b.x)]) == gen, bar);
            __builtin_amdgcn_fence(__ATOMIC_ACQUIRE, "agent");
            asm volatile("s_waitcnt vmcnt(0)" ::: "memory");
        }
    }
    __syncthreads();
}

constexpr int NPHASE = 9;
struct Args { const float* in[17]; float* out; unsigned char* ws; int ph_lo, ph_hi; };
__global__ void __launch_bounds__(512, 2) fwd_kernel(Args a) {
    extern __shared__ __attribute__((aligned(16))) unsigned char lds_raw[];
    LAS unsigned char* lds = (LAS unsigned char*)lds_raw;
    cg::grid_group grid = cg::this_grid();
    const int tid = threadIdx.x, lane = tid & 63, wave = __builtin_amdgcn_readfirstlane(tid >> 6);
    const int lo = a.ph_lo, hi = a.ph_hi, G = gridDim.x;
    typedef const __attribute__((address_space(4))) Args* kargp_t;
#define KARGS kargp_t kp_ = (kargp_t)__builtin_amdgcn_kernarg_segment_ptr(); asm volatile("" : "+s"(kp_)); unsigned char* const ws = kp_->ws
#define INP(k) ((const float*)kp_->in[k])
#define WSP(T, off) ((T*)(ws + (off)))
#ifdef ONLY_PHASE
#define IN(k) ((k) == ONLY_PHASE && lo <= (k) && (k) < hi)
#else
#define IN(k) (lo <= (k) && (k) < hi)
#endif
    volatile LAS unsigned* bar_st = (volatile LAS unsigned*)(lds + LDS_BYTES - 64);
    XcdBarrier xbar; xbar.bar = (unsigned*)(a.ws + WS_CTL); xbar.x = 0; xbar.st = bar_st;
    if (hi - lo > 1) { if (tid < 2) bar_st[tid] = 0u; __syncthreads(); xbar = xcd_barrier_post((unsigned*)(a.ws + WS_CTL), bar_st); }
    if (lo < 0) grid.sync();
#define SEAM(k) do { if (lo <= (k) && (k) + 1 < hi) xcd_barrier(xbar); } while (0)

    if (IN(0)) { KARGS; P0Args p{INP(0), INP(1), INP(2), INP(3), INP(8), INP(9), INP(10), INP(12), INP(13), INP(11), WSP(bf16_t, WS_A1), WSP(bf16_t, WS_WIN), WSP(bf16_t, WS_WBH), WSP(bf16_t, WS_WBA), WSP(bf16_t, WS_WOUT), WSP(bf16_t, WS_WQ), WSP(bf16_t, WS_SK)}; p0_prologue(lds, p); SEAM(0); }
    if (IN(1)) {
        KARGS; bf16_t *A1 = WSP(bf16_t, WS_A1), *WinT = WSP(bf16_t, WS_WIN), *Zh = WSP(bf16_t, WS_ZH), *Za = WSP(bf16_t, WS_ZA), *Zg = WSP(bf16_t, WS_ZG), *Vt = WSP(bf16_t, WS_VT);
        pg8::Gemm g{A1, WinT, MA, 4864, 1024, 1024, 1024}; pg8::StaticOrder S; S.init(MA, 4864, G, (int)blockIdx.x);
        pg8::EpiZ E{Zh, Za, Zg, Vt, INP(4)};
        pg8::gemm_phase<pg8::EpiZ, pg8::StaticOrder, true, true>(lds, g, S, E);
        SEAM(1);
    }
    if (IN(2)) {
        KARGS; bf16_t *Zh = WSP(bf16_t, WS_ZH), *Za = WSP(bf16_t, WS_ZA), *Vt = WSP(bf16_t, WS_VT), *OM = WSP(bf16_t, WS_OM); bf16_t* Ub = WSP(bf16_t, WS_UB); float* Dv = WSP(float, WS_DV); const float *lblog = INP(5), *sinks = INP(7);
        for (int it = blockIdx.x; it < 1024 + 512; it += G) {
            if (it < 1024) {
#ifndef NO_HGA
 hgrn_A(lds, Zh, lblog, Ub, Dv, it);
#endif
 }
            else { const int ai = it - 1024, b = ai >> 6, n = ((ai & 63) >> 1) + 1, kvh = ai & 1;
                attn_stage(lds, Za, Vt, b, n, kvh);
                __syncthreads();
#pragma unroll 1
                for (int si = wave; si < 16; si += 8) attn_sub(lds, Za, sinks, OM, b, n, kvh * 4 + (si >> 2), si & 3, lane);
                __syncthreads(); }
        }
        SEAM(2);
    }
    if (IN(3)) { KARGS; hgrn_scan(WSP(bf16_t, WS_UB), WSP(float, WS_DV)); SEAM(3); }
    if (IN(4)) { KARGS; for (int it = blockIdx.x; it < 1024; it += G) hgrn_C(lds, WSP(bf16_t, WS_ZH), INP(5), WSP(bf16_t, WS_UB), INP(6), WSP(bf16_t, WS_OM), it); SEAM(4); }
    if (IN(5)) {
        KARGS; bf16_t *OM = WSP(bf16_t, WS_OM), *WbhT = WSP(bf16_t, WS_WBH), *Mb = WSP(bf16_t, WS_MB), *Zg = WSP(bf16_t, WS_ZG); const float* bgate = INP(4);
        peer_tables(INP(14), INP(15), ws + WS_U8, WSP(float, WS_SUV), lane, blockIdx.x * 8 + wave, G * 8);
        __syncthreads();
        pg8::StaticOrder S; S.init(MC, 1024, G, (int)blockIdx.x);
        { pg8::Gemm g{OM, WbhT, MC, 1024, 1024, 1024, 1024}; pg8::EpiGate E{Mb, Zg, bgate}; pg8::gemm_phase<pg8::EpiGate, pg8::StaticOrder, true, true>(lds, g, S, E); }
        SEAM(5);
    }
    if (IN(6)) {
        KARGS; bf16_t *Mb = WSP(bf16_t, WS_MB), *WoutT = WSP(bf16_t, WS_WOUT); float* rowssp = WSP(float, WS_RS); const float* x = INP(0);
        pg8::Gemm g{Mb, WoutT, MC, 1024, 1024, 1024, 1024}; pg8::StaticOrder S; S.init(MC, 1024, G, (int)blockIdx.x);
        pg8::EpiH1 E{x, WSP(bf16_t, WS_H1B), rowssp};
        pg8::gemm_phase<pg8::EpiH1, pg8::StaticOrder, true, true>(lds, g, S, E);
        SEAM(6);
    }
    if (IN(7)) {
        KARGS; bf16_t *WqT = WSP(bf16_t, WS_WQ), *Qb = WSP(bf16_t, WS_QB); float* rowssp = WSP(float, WS_RS);
        pg8::Gemm g{WSP(bf16_t, WS_H1B), WqT, MC, 2048, 1024, 1024, 1024}; pg8::StaticOrder S; S.init(MC, 2048, G, (int)blockIdx.x);
        pg8::EpiQ E{Qb};
        pg8::gemm_phase<pg8::EpiQ, pg8::StaticOrder, true, true>(lds, g, S, E);
        SEAM(7);
    }
    if (IN(8)) {
        KARGS; bf16_t *Qb = WSP(bf16_t, WS_QB), *SK = WSP(bf16_t, WS_SK), *A2 = WSP(bf16_t, WS_A2); unsigned char *U8 = ws + WS_U8, *V8 = ws + WS_V8, *XQ = ws + WS_MB; float *suv = WSP(float, WS_SUV), *rowssp = WSP(float, WS_RS), *outp = kp_->out; bf16_t* H1B = WSP(bf16_t, WS_H1B); const float* gfin = INP(16);
        for (int grp = blockIdx.x; grp < MC / 128; grp += G) {
            const int rc0 = grp * 128;
#ifndef NO_TOPK
            peer_topk(lds, Qb, SK, rowssp, rc0 + 32 * (wave >> 1), 32 * (wave >> 1), 4 * (wave & 1), lane);
#endif
#ifdef PROBE_TOPK2
            __syncthreads(); peer_topk(lds, Qb, SK, rowssp, rc0 + 32 * (wave >> 1), 32 * (wave >> 1), 4 * (wave & 1), lane);
#endif
            __syncthreads();
            { const int tl0 = 16 * wave; const size_t rcw = (size_t)rc0 + tl0;
              { LAS f32x4* pz = (LAS f32x4*)(lds + PL_PA + tl0 * 512);
#pragma unroll
                for (int q = 0; q < 8; ++q) pz[lane + 64 * q] = (f32x4){0.f, 0.f, 0.f, 0.f}; }
#pragma unroll 1
              for (int i = 0; i < 16; ++i) peer_xq_token(H1B, INP(11), XQ, (float*)(XQ + (size_t)MC * 1024), rcw + i, lane);
              asm volatile("s_waitcnt vmcnt(0)" ::: "memory");
              { u32x4 ra[16], rb[16], xa[2], xb[2];
                peer_rows_load<true>(ra, xa, lds, tl0, rcw, 0, U8, (const bf16_t*)XQ, lane);
#pragma unroll 1
                for (int st = 0; st < 128; st += 2) {
                    peer_rows_load<true>(rb, xb, lds, tl0 + ((st + 1) & 15), rcw + ((st + 1) & 15), (st + 1) >> 4, U8, (const bf16_t*)XQ, lane);
                    __builtin_amdgcn_sched_barrier(0);
                    peer_u_math(ra, xa, lds, tl0 + (st & 15), lane);
                    { const int sn = st + 2 < 128 ? st + 2 : 127; peer_rows_load<true>(ra, xa, lds, tl0 + (sn & 15), rcw + (sn & 15), sn >> 4, U8, (const bf16_t*)XQ, lane); }
                    __builtin_amdgcn_sched_barrier(0);
                    peer_u_math(rb, xb, lds, tl0 + ((st + 1) & 15), lane); } }
#pragma unroll 1
              for (int i = 0; i < 16; ++i) peer_a_step(lds, tl0 + i, rcw + i, rowssp, suv, suv + 16384, lane);
              { u32x4 ra[16], rb[16], xd[2];
                peer_rows_load<false>(ra, xd, lds, tl0, rcw, 0, V8, A2, lane);
#pragma unroll 1
                for (int st = 0; st < 128; st += 2) {
                    peer_rows_load<false>(rb, xd, lds, tl0 + ((st + 1) & 15), rcw, (st + 1) >> 4, V8, A2, lane);
                    __builtin_amdgcn_sched_barrier(0);
                    peer_v_math(ra, lds, tl0 + (st & 15), rcw + (st & 15), st >> 4, H1B, lane);
                    { const int sn = st + 2 < 128 ? st + 2 : 127; peer_rows_load<false>(ra, xd, lds, tl0 + (sn & 15), rcw, sn >> 4, V8, A2, lane); }
                    __builtin_amdgcn_sched_barrier(0);
                    peer_v_math(rb, lds, tl0 + ((st + 1) & 15), rcw + ((st + 1) & 15), (st + 1) >> 4, H1B, lane); } }
              asm volatile("s_waitcnt vmcnt(0)" ::: "memory");
              __builtin_amdgcn_fence(__ATOMIC_ACQUIRE, "agent");
              peer_f_steps<8>(rcw, H1B, outp, gfin, lane);
              peer_f_steps<8>(rcw + 8, H1B, outp, gfin, lane); }
            __syncthreads();
        }
    }
#undef IN
#undef SEAM
}

extern "C" void kernel_launch(void* const* d_in, const int* in_sizes, int n_in, void* d_out, int out_size, void* d_ws, size_t ws_size, hipStream_t stream) {
    static int grid = 0;
    if (grid == 0) {
        if (n_in != 17 || out_size != MC * DM || ws_size < WS_END) { fprintf(stderr, "kernel_launch: unexpected shapes: n_in %d out %d ws %zu (need %zu)\n", n_in, out_size, ws_size, (size_t)WS_END); grid = -1; return; }
        int dev = 0, cus = 0, per_cu = 0;
        if (hipGetDevice(&dev) != hipSuccess || hipDeviceGetAttribute(&cus, hipDeviceAttributeMultiprocessorCount, dev) != hipSuccess) { fprintf(stderr, "kernel_launch: device query failed\n"); grid = -1; return; }
        if (hipFuncSetAttribute((const void*)fwd_kernel, hipFuncAttributeMaxDynamicSharedMemorySize, LDS_BYTES) != hipSuccess) { fprintf(stderr, "kernel_launch: hipFuncSetAttribute failed\n"); grid = -1; return; }
        if (hipOccupancyMaxActiveBlocksPerMultiprocessor(&per_cu, (const void*)fwd_kernel, 512, LDS_BYTES) != hipSuccess || per_cu < 1) { fprintf(stderr, "kernel_launch: occupancy query says %d blocks per CU\n", per_cu); per_cu = 1; }
        (void)hipGetLastError();
        grid = cus;
        fprintf(stderr, "kernel_launch: grid %d (occupancy %d per CU)\n", grid, per_cu);
    }
    if (grid < 0) return;
    if (hipMemsetAsync((char*)d_ws + WS_CTL, 0, CTL_BYTES, stream) != hipSuccess) { fprintf(stderr, "kernel_launch: memset of the barrier words failed\n"); return; }
    Args a{};
    for (int i = 0; i < 17; ++i) a.in[i] = (const float*)d_in[i];
    a.out = (float*)d_out; a.ws = (unsigned char*)d_ws;
#if MK_ONE_LAUNCH
    a.ph_lo = 0; a.ph_hi = NPHASE;
    void* args[] = {&a};
    hipError_t e = hipLaunchCooperativeKernel((const void*)fwd_kernel, dim3(grid), dim3(512), args, LDS_BYTES, stream);
    if (e != hipSuccess) fprintf(stderr, "kernel_launch: cooperative launch failed: %s (grid %d)\n", hipGetErrorString(e), grid);
#else
#ifdef PROBE_SEQ
    const int seq[] = PROBE_SEQ;
    for (int p : seq) { a.ph_lo = p; a.ph_hi = p + 1; hipLaunchKernelGGL(fwd_kernel, dim3(grid), dim3(512), LDS_BYTES, stream, a); }
#else
    for (int p = 0; p < NPHASE; ++p) { a.ph_lo = p; a.ph_hi = p + 1; hipLaunchKernelGGL(fwd_kernel, dim3(grid), dim3(512), LDS_BYTES, stream, a); }
#endif
#endif
}
```

```cpp
#include <hip/hip_runtime.h>
#include <hip/hip_cooperative_groups.h>
#include <cstdio>
#include <cstdint>
namespace cg = cooperative_groups;

#ifndef MK_ONE_LAUNCH
#define MK_ONE_LAUNCH 1
#endif

constexpr int DM = 1024, NB = 8, SEQ = 4096, NMETA = 16, LTOK = SEQ + NMETA;
constexpr int MA_REAL = NB * LTOK;
constexpr int MA = 33024;
constexpr int MC = NB * SEQ;
constexpr int LPAD = 4224;
constexpr float EPS = 1e-6f;

namespace pg8 {
#define PG8_LAS __attribute__((address_space(3)))
typedef unsigned short bf16_t;
typedef short bf16x8 __attribute__((ext_vector_type(8)));
typedef float f32x4 __attribute__((ext_vector_type(4)));
typedef unsigned u32x4 __attribute__((ext_vector_type(4)));
constexpr int BM = 256, BK = 64, HALF = 128, HTB = HALF * BK * 2  , STAGE_BYTES = 8 * HTB, NXCD = 8, WGM = 8;

__host__ __device__ __forceinline__ int lds_byte(int r, int c) { const int st = (r >> 4) * 2 + (c >> 5), rr = r & 15, cc = c & 31, ob = rr * 64 + cc * 2; return st * 1024 + (ob ^ (((ob >> 9) & 1) << 5)); }
__host__ __device__ __forceinline__ void stage_rc(int b, int& R, int& C) { const int st = b / 1024, sb = b % 1024, swz = sb ^ (((sb >> 9) & 1) << 5); R = (st >> 1) * 16 + swz / 64; C = (st & 1) * 32 + (swz % 64) / 2; }
__host__ __device__ __forceinline__ int perm32(int rho) { const int n = rho >> 4, i = rho & 15; return 8 * (i >> 2) + 4 * n + (i & 3); }

struct Unit { int pm, pn; };
struct Gemm { const bf16_t* A; const bf16_t* Bt; int M, N, K, lda, ldb; };

struct StaticOrder {
    int nM, nN, nwg, G, c;
    __host__ __device__ void init(int M, int N, int G_, int c_) { nM = M / BM; nN = N / BM; nwg = nM * nN; G = G_; c = c_; }
    __host__ __device__ bool next(int i, Unit& u) const {
        const long L = (long)i * G + c; if (L >= nwg) return false;
        int wgid = (int)L; { const int q = nwg / NXCD, r = nwg % NXCD, xcd = wgid % NXCD, off = wgid / NXCD; wgid = (xcd < r ? xcd * (q + 1) : r * (q + 1) + (xcd - r) * q) + off; }
        const int nig = WGM * nN, gid = wgid / nig, fm = gid * WGM, gsz = (nM - fm) < WGM ? (nM - fm) : WGM;
        u.pm = fm + ((wgid % nig) % gsz); u.pn = (wgid % nig) / gsz; return true;
    }
    __device__ __forceinline__ void a_ready(const Unit&) const {}
    __device__ __forceinline__ void done(const Unit&) const {}
};

__device__ __forceinline__ unsigned cvt_pk_bf16(float lo, float hi) { unsigned r; asm volatile("v_cvt_pk_bf16_f32 %0, %1, %2" : "=v"(r) : "v"(lo), "v"(hi)); return r; }
typedef float f32x2 __attribute__((ext_vector_type(2)));
typedef float f32x2_t __attribute__((ext_vector_type(2))); typedef __bf16 bf16x2_t __attribute__((ext_vector_type(2)));
typedef unsigned u32x2 __attribute__((ext_vector_type(2)));
__device__ __forceinline__ unsigned cvtpk(float lo, float hi) { f32x2_t v = {lo, hi}; bf16x2_t b = __builtin_convertvector(v, bf16x2_t); return __builtin_bit_cast(unsigned, b); }
__device__ __forceinline__ bf16_t f2bf(float x) { return (bf16_t)(cvtpk(x, 0.f) & 0xffffu); }
__device__ __forceinline__ float bf2f(bf16_t v) { return __uint_as_float((unsigned)v << 16); }
__device__ __forceinline__ float bflo(unsigned w) { return __uint_as_float(w << 16); }
__device__ __forceinline__ float bfhi(unsigned w) { return __uint_as_float(w & 0xffff0000u); }
__device__ __forceinline__ float sigm(float x) { return __builtin_amdgcn_rcpf(1.f + __expf(-x)); }

struct EpiZ {
    static constexpr bool PERM = true, AFTER_DRAIN = false, MIDK = false;
    bf16_t *Zh, *Za, *Vt;
    __device__ __forceinline__ void operator()(const f32x4 (&acc)[2][2][4][2], const Unit& u, int wr, int wc, int fr, int fq) const {
        const int pn = u.pn; bf16_t* base; int ldc, colt;
        if (pn < 6) { base = Zh; ldc = 2048; colt = pn * 256; } else { base = Za; ldc = 768; colt = (pn - 6) * 256; }
        const int row0 = u.pm * BM + wr * 64 + fr, col0 = colt + wc * 32 + 8 * fq;
#pragma unroll
        for (int ai = 0; ai < 2; ++ai)
#pragma unroll
            for (int m = 0; m < 4; ++m) { const int row = row0 + ai * HALF + m * 16; bf16_t* rowp = base + (size_t)row * ldc + col0;
#pragma unroll
                for (int bj = 0; bj < 2; ++bj) { const f32x4 v0 = acc[ai][bj][m][0], v1 = acc[ai][bj][m][1];
                    if (pn == 8 && bj == 1) {
                        if (row < MA_REAL) { const int b = row / LTOK, pos = row - b * LTOK; bf16_t* vp = Vt + ((size_t)(b * 128 + wc * 32 + 8 * fq) * LPAD + 112 + pos);
                            vp[0] = f2bf(v0[0]); vp[LPAD] = f2bf(v0[1]); vp[2 * LPAD] = f2bf(v0[2]); vp[3 * LPAD] = f2bf(v0[3]);
                            vp[4 * LPAD] = f2bf(v1[0]); vp[5 * LPAD] = f2bf(v1[1]); vp[6 * LPAD] = f2bf(v1[2]); vp[7 * LPAD] = f2bf(v1[3]); }
                    } else { u32x4 w; w.x = cvtpk(v0[0], v0[1]); w.y = cvtpk(v0[2], v0[3]); w.z = cvtpk(v1[0], v1[1]); w.w = cvtpk(v1[2], v1[3]); *(u32x4*)(rowp + bj * HALF) = w; } } }
    }
};
struct EpiZ8 {
    static constexpr bool PERM = true, AFTER_DRAIN = false, MIDK = false;
    bf16_t* Zh; unsigned char* Zg; const float* bgate;
    __device__ __forceinline__ void operator()(const f32x4 (&acc)[2][2][4][2], const Unit& u, int wr, int wc, int fr, int fq) const {
        const int pn = u.pn; const bool gate = pn >= 2;
        const int colt = gate ? (pn - 2) * 256 : pn * 256;
        const int row0 = u.pm * BM + wr * 64 + fr, col0 = colt + wc * 32 + 8 * fq;
        const float sc = 1.f / 8192.f;
        if (gate) {
            const float lo = pn >= 6 ? 1.f / 255.f : 0.f; const float sc2 = -sc * 1.4426950408889634f;
            f32x4 bia[2][2];
#pragma unroll
            for (int bj = 0; bj < 2; ++bj) { bia[bj][0] = *(const f32x4*)(bgate + col0 + bj * HALF) * -1.4426950408889634f; bia[bj][1] = *(const f32x4*)(bgate + col0 + bj * HALF + 4) * -1.4426950408889634f; }
#pragma unroll
            for (int ai = 0; ai < 2; ++ai)
#pragma unroll
                for (int m = 0; m < 4; ++m) { const int rc = row0 + ai * HALF + m * 16, ra = (rc >> 12) * LTOK + NMETA + (rc & 4095); unsigned char* rowp = Zg + (size_t)ra * 2048 + col0;
#pragma unroll
                    for (int bj = 0; bj < 2; ++bj) { unsigned y[8];
#pragma unroll
                        for (int i = 0; i < 4; ++i) { y[i] = __float_as_uint(__builtin_fmaf(fmaxf(__builtin_amdgcn_rcpf(1.f + __builtin_amdgcn_exp2f(__builtin_fmaf(acc[ai][bj][m][0][i], sc2, bia[bj][0][i]))), lo), 255.f, 12582912.f));
                                                      y[4 + i] = __float_as_uint(__builtin_fmaf(fmaxf(__builtin_amdgcn_rcpf(1.f + __builtin_amdgcn_exp2f(__builtin_fmaf(acc[ai][bj][m][1][i], sc2, bia[bj][1][i]))), lo), 255.f, 12582912.f)); }
                        u32x2 w; w.x = __builtin_amdgcn_perm(__builtin_amdgcn_perm(y[3], y[2], 0x0c0c0400u), __builtin_amdgcn_perm(y[1], y[0], 0x0c0c0400u), 0x05040100u);
                                 w.y = __builtin_amdgcn_perm(__builtin_amdgcn_perm(y[7], y[6], 0x0c0c0400u), __builtin_amdgcn_perm(y[5], y[4], 0x0c0c0400u), 0x05040100u);
                        __builtin_nontemporal_store(w, (u32x2*)(rowp + bj * HALF)); } }
        } else {
#pragma unroll
            for (int ai = 0; ai < 2; ++ai)
#pragma unroll
                for (int m = 0; m < 4; ++m) { const int rc = row0 + ai * HALF + m * 16, ra = (rc >> 12) * LTOK + NMETA + (rc & 4095); bf16_t* rowp = Zh + 1536 + (size_t)ra * 2048 + col0;
#pragma unroll
                    for (int bj = 0; bj < 2; ++bj) { const f32x4 v0 = acc[ai][bj][m][0] * sc, v1 = acc[ai][bj][m][1] * sc;
                        u32x4 w; w.x = cvtpk(v0[0], v0[1]); w.y = cvtpk(v0[2], v0[3]); w.z = cvtpk(v1[0], v1[1]); w.w = cvtpk(v1[2], v1[3]); *(u32x4*)(rowp + bj * HALF) = w; } }
        }
    }
};
struct EpiGate {
    static constexpr bool PERM = true, AFTER_DRAIN = false, MIDK = true;
    bf16_t* Mb; const unsigned char* Zg; const float* bgate;
    static __device__ __forceinline__ float ub(unsigned w, int i) { return (float)((w >> (8 * i)) & 0xffu); }
    __device__ __forceinline__ void mid(f32x4 (&acc)[2][2][4][2], const Unit& u, int wr, int wc, int fr, int fq) const {
        const int row0 = u.pm * BM + wr * 64 + fr, col0 = u.pn * BM + wc * 32 + 8 * fq;
#pragma unroll
        for (int bj = 0; bj < 2; ++bj)
#pragma unroll
            for (int ai = 0; ai < 2; ++ai)
#pragma unroll
                for (int m = 0; m < 4; ++m) { const int rc = row0 + ai * HALF + m * 16, ra = (rc >> 12) * LTOK + NMETA + (rc & 4095);
                    const unsigned char* zp = Zg + (size_t)ra * 2048 + col0 + bj * HALF; const u32x2 za = *(const u32x2*)zp, zb = *(const u32x2*)(zp + 1024);
                    f32x4& v0 = acc[ai][bj][m][0]; f32x4& v1 = acc[ai][bj][m][1];
#pragma unroll
                    for (int i = 0; i < 4; ++i) { v0[i] *= ub(za.x, i) * __builtin_amdgcn_rcpf(ub(zb.x, i)); v1[i] *= ub(za.y, i) * __builtin_amdgcn_rcpf(ub(zb.y, i)); }
                    asm volatile("" ::: "memory"); }
    }
    __device__ __forceinline__ void operator()(const f32x4 (&acc)[2][2][4][2], const Unit& u, int wr, int wc, int fr, int fq) const {
        const int row0 = u.pm * BM + wr * 64 + fr, col0 = u.pn * BM + wc * 32 + 8 * fq;
#pragma unroll
        for (int ai = 0; ai < 2; ++ai)
#pragma unroll
            for (int m = 0; m < 4; ++m) { const int rc = row0 + ai * HALF + m * 16, ra = (rc >> 12) * LTOK + NMETA + (rc & 4095);
                const unsigned char* zp = Zg + (size_t)ra * 2048 + 1024 + col0; bf16_t* mp = Mb + (size_t)rc * 1024 + col0;
#pragma unroll
                for (int bj = 0; bj < 2; ++bj) { const u32x2 z = *(const u32x2*)(zp + bj * HALF); f32x4 v0 = acc[ai][bj][m][0] * (1.f / 255.f), v1 = acc[ai][bj][m][1] * (1.f / 255.f);
#pragma unroll
                    for (int i = 0; i < 4; ++i) { v0[i] *= ub(z.x, i); v1[i] *= ub(z.y, i); }
                    u32x4 w; w.x = cvtpk(v0[0], v0[1]); w.y = cvtpk(v0[2], v0[3]); w.z = cvtpk(v1[0], v1[1]); w.w = cvtpk(v1[2], v1[3]); *(u32x4*)(mp + bj * HALF) = w; } }
    }
};
struct EpiH1 {
    static constexpr bool PERM = false, AFTER_DRAIN = false, MIDK = false;
    const float* x; bf16_t* h1; float* rowssp;
    __device__ __forceinline__ void operator()(const f32x4 (&acc)[2][2][4][2], const Unit& u, int wr, int wc, int fr, int fq) const {
        const int row0 = u.pm * BM + wr * 64 + fr, col0 = u.pn * BM + wc * 32 + 4 * fq;
#pragma unroll
        for (int ai = 0; ai < 2; ++ai) { f32x4 xv[4][2][2];
#pragma unroll
            for (int m = 0; m < 4; ++m)
#pragma unroll
                for (int bj = 0; bj < 2; ++bj)
#pragma unroll
                    for (int n = 0; n < 2; ++n) xv[m][bj][n] = *(const f32x4*)(x + (size_t)(row0 + ai * HALF + m * 16) * 1024 + col0 + bj * HALF + n * 16);
#pragma unroll
            for (int m = 0; m < 4; ++m) { const int rc = row0 + ai * HALF + m * 16; float ss = 0.f;
#pragma unroll
                for (int bj = 0; bj < 2; ++bj)
#pragma unroll
                    for (int n = 0; n < 2; ++n) { const size_t off = (size_t)rc * 1024 + col0 + bj * HALF + n * 16;
                        const f32x4 h = xv[m][bj][n] + acc[ai][bj][m][n]; { u32x2 hw; hw.x = cvtpk(h[0], h[1]); hw.y = cvtpk(h[2], h[3]); *(u32x2*)(h1 + off) = hw; }
                        ss += (h[0] * h[0] + h[1] * h[1]) + (h[2] * h[2] + h[3] * h[3]);
}
                ss += __shfl_xor(ss, 16); ss += __shfl_xor(ss, 32);
                if (fq == 0) rowssp[(size_t)rc * 16 + u.pn * 4 + wc] = ss; } }
    }
};
struct EpiQ {
    static constexpr bool PERM = true, AFTER_DRAIN = false, MIDK = false;
    bf16_t* Q;
    __device__ __forceinline__ void operator()(const f32x4 (&acc)[2][2][4][2], const Unit& u, int wr, int wc, int fr, int fq) const {
        const int row0 = u.pm * BM + wr * 64 + fr, col0 = u.pn * BM + wc * 32 + 8 * fq;
#pragma unroll
        for (int ai = 0; ai < 2; ++ai)
#pragma unroll
            for (int m = 0; m < 4; ++m) { const int rc = row0 + ai * HALF + m * 16;
#pragma unroll
                for (int bj = 0; bj < 2; ++bj) { const f32x4 v0 = acc[ai][bj][m][0], v1 = acc[ai][bj][m][1];
                    u32x4 w; w.x = cvtpk(v0[0], v0[1]); w.y = cvtpk(v0[2], v0[3]); w.z = cvtpk(v1[0], v1[1]); w.w = cvtpk(v1[2], v1[3]);
                    const int col = col0 + bj * HALF;
                    __builtin_nontemporal_store(w, (u32x4*)(Q + ((size_t)((((rc >> 5) * 8 + (col >> 8)) * 2 + ((col >> 7) & 1)) * 8 + ((col & 127) >> 4)) * 64 + ((col >> 3) & 1) * 32 + (rc & 31)) * 8)); } }
    }
};
typedef int i32x4_t __attribute__((ext_vector_type(4)));
typedef int i32x8_t __attribute__((ext_vector_type(8)));
__device__ __forceinline__ i32x8_t cat8(bf16x8 lo, bf16x8 hi) { return __builtin_shufflevector(__builtin_bit_cast(i32x4_t, lo), __builtin_bit_cast(i32x4_t, hi), 0, 1, 2, 3, 4, 5, 6, 7); }
template <class Epi, class Sched, bool ALIGN_EPI = false, bool SP2 = false, bool FP8 = false>
__device__ __forceinline__ void gemm_phase(PG8_LAS unsigned char* lds, const Gemm g, const Sched& S, const Epi& E) {
    const int tid = threadIdx.x, wid = __builtin_amdgcn_readfirstlane(tid >> 6), lane = tid & 63, wr = wid >> 2, wc = wid & 3, fr = lane & 15, fq = lane >> 4;
    const int K = g.K, nt = K / BK;
    unsigned voffA[2], voffB[2];
#pragma unroll
    for (int i = 0; i < 2; ++i) { int R, C; stage_rc(tid * 16 + i * 8192, R, C); const int Rb = Epi::PERM ? ((R & ~31) + perm32(R & 31)) : R;
        voffA[i] = (unsigned)(R * g.lda + C) * 2u; voffB[i] = (unsigned)(Rb * g.ldb + C) * 2u; }
    const size_t kstep = (size_t)(BK * 2);
    const size_t hstepA = (size_t)HALF * g.lda * 2, hstepB = (size_t)HALF * g.ldb * 2;
    const size_t tstepA = 2 * hstepA, tstepB = 2 * hstepB;
    const unsigned ldsw = (unsigned)wid * 1024u;
    const int aoff = lds_byte(wr * 64 + fr, fq * 8), boff = lds_byte(wc * 32 + fr, fq * 8);
#define PG8_SA(b, h) (((b) * 2 + (h)) * HTB)
#define PG8_SB(b, h) ((4 + (b) * 2 + (h)) * HTB)
#define PG8_STAGE(bufoff, gbase, voff) do { _Pragma("unroll") for (int _i = 0; _i < 2; ++_i) \
        __builtin_amdgcn_global_load_lds((const unsigned*)((const char*)(gbase) + (voff)[_i]), (PG8_LAS unsigned*)(lds + (bufoff) + ldsw + _i * 8192), 16, 0, 0); } while (0)
#define PG8_LDA(dst, b, h) do { _Pragma("unroll") for (int m = 0; m < 4; ++m) _Pragma("unroll") for (int k = 0; k < 2; ++k) dst[m][k] = *(const PG8_LAS bf16x8*)(lds + PG8_SA(b, h) + aoff + m * 2048 + k * 1024); } while (0)
#define PG8_LDB(dst, b, h) do { _Pragma("unroll") for (int n = 0; n < 2; ++n) _Pragma("unroll") for (int k = 0; k < 2; ++k) dst[n][k] = *(const PG8_LAS bf16x8*)(lds + PG8_SB(b, h) + boff + n * 2048 + k * 1024); } while (0)
#define PG8_MMA(ai, bj, At, Bt) do { __builtin_amdgcn_s_setprio(1); \
        if constexpr (FP8) { _Pragma("unroll") for (int m = 0; m < 4; ++m) _Pragma("unroll") for (int n = 0; n < 2; ++n) \
            asm volatile("v_mfma_scale_f32_16x16x128_f8f6f4 %0, %1, %2, %0, %3, %3 op_sel_hi:[0,0,0]" : "+v"(acc[ai][bj][m][n]) : "v"(cat8(Bt[n][0], Bt[n][1])), "v"(cat8(At[m][0], At[m][1])), "v"(sc127)); } \
        else { _Pragma("unroll") for (int m = 0; m < 4; ++m) _Pragma("unroll") for (int n = 0; n < 2; ++n) _Pragma("unroll") for (int k = 0; k < 2; ++k) \
            acc[ai][bj][m][n] = __builtin_amdgcn_mfma_f32_16x16x32_bf16(Bt[n][k], At[m][k], acc[ai][bj][m][n], 0, 0, 0); } \
        __builtin_amdgcn_s_setprio(0); } while (0)
#define PG8_MFMA_DRAIN do { if constexpr (FP8) asm volatile("s_nop 15\n\ts_nop 15" ::: "memory"); } while (0)
#define PG8_WAIT_V(n) asm volatile("s_waitcnt vmcnt(" #n ")" ::: "memory")
#define PG8_WAIT_L(n) asm volatile("s_waitcnt lgkmcnt(" #n ")" ::: "memory")
#define PG8_BAR __builtin_amdgcn_s_barrier()
#define PG8_SCHED __builtin_amdgcn_sched_barrier(0)
    Unit cur, nxt; int ui = 0;
    if (!S.next(0, cur)) return;
    f32x4 acc[2][2][4][2];
#pragma unroll
    for (int a = 0; a < 2; ++a)
#pragma unroll
        for (int b = 0; b < 2; ++b)
#pragma unroll
            for (int m = 0; m < 4; ++m)
#pragma unroll
                for (int n = 0; n < 2; ++n) acc[a][b][m][n] = (f32x4){0.f, 0.f, 0.f, 0.f};
    bf16x8 At[4][2], B0[2][2], B1[2][2];
    const int sc127 = 127;
    const char* cA = (const char*)g.A + (size_t)cur.pm * tstepA; const char* cB = (const char*)g.Bt + (size_t)cur.pn * tstepB;
    S.a_ready(cur);
    if constexpr (SP2) {
        PG8_STAGE(PG8_SB(0, 0), cB, voffB); PG8_STAGE(PG8_SB(0, 1), cB + hstepB, voffB); PG8_STAGE(PG8_SA(0, 0), cA, voffA); PG8_STAGE(PG8_SA(0, 1), cA + hstepA, voffA);
        if (wr == 1) PG8_BAR;
        PG8_WAIT_V(2); PG8_BAR;
        PG8_STAGE(PG8_SB(1, 0), cB + kstep, voffB); PG8_STAGE(PG8_SA(1, 0), cA + kstep, voffA); PG8_STAGE(PG8_SB(1, 1), cB + hstepB + kstep, voffB);
        PG8_WAIT_V(6); PG8_BAR;
    } else {
        PG8_STAGE(PG8_SB(0, 0), cB, voffB); PG8_STAGE(PG8_SA(0, 0), cA, voffA); PG8_STAGE(PG8_SB(0, 1), cB + hstepB, voffB); PG8_STAGE(PG8_SA(0, 1), cA + hstepA, voffA);
        if (wr == 1) PG8_BAR;
        PG8_WAIT_V(4); PG8_BAR;
        PG8_STAGE(PG8_SB(1, 0), cB + kstep, voffB); PG8_STAGE(PG8_SA(1, 0), cA + kstep, voffA); PG8_STAGE(PG8_SB(1, 1), cB + hstepB + kstep, voffB);
        PG8_WAIT_V(6); PG8_BAR;
    }
    for (;;) {
        const bool has_next = S.next(ui + 1, nxt);
        const char* nA = has_next ? (const char*)g.A + (size_t)nxt.pm * tstepA : cA; const char* nB = has_next ? (const char*)g.Bt + (size_t)nxt.pn * tstepB : cB;
#pragma unroll 1
        for (int t = 0; t < nt; t += 2) {
            if constexpr (Epi::MIDK) { if (t == (nt >> 1)) { PG8_SCHED; E.mid(acc, cur, wr, wc, fr, fq); PG8_SCHED; } }
            const bool last = (t == nt - 2);
            const char* a1 = cA + (size_t)(t + 1) * kstep;
            const char* a2 = last ? nA : cA + (size_t)(t + 2) * kstep; const char* b2 = last ? nB : cB + (size_t)(t + 2) * kstep;
            const char* a3 = a2 + kstep; const char* b3 = b2 + kstep;
            if (last && has_next) S.a_ready(nxt);
            if constexpr (SP2) {
            PG8_LDB(B0, 0, 0); PG8_LDB(B1, 0, 1); PG8_SCHED; PG8_LDA(At, 0, 0); PG8_STAGE(PG8_SA(1, 1), a1 + hstepA, voffA);
            PG8_WAIT_V(8); PG8_WAIT_L(0); PG8_BAR; PG8_MMA(0, 0, At, B0); PG8_MMA(0, 1, At, B1); PG8_BAR; PG8_SCHED;
            PG8_LDA(At, 0, 1); PG8_STAGE(PG8_SB(0, 0), b2, voffB); PG8_STAGE(PG8_SB(0, 1), b2 + hstepB, voffB); PG8_STAGE(PG8_SA(0, 0), a2, voffA);
            PG8_WAIT_V(8); PG8_WAIT_L(0); PG8_BAR; PG8_MMA(1, 0, At, B0); PG8_MMA(1, 1, At, B1); PG8_BAR; PG8_SCHED;
            PG8_LDB(B0, 1, 0); PG8_LDB(B1, 1, 1); PG8_SCHED; PG8_LDA(At, 1, 0); PG8_STAGE(PG8_SA(0, 1), a2 + hstepA, voffA);
            PG8_WAIT_V(8); PG8_WAIT_L(0); PG8_BAR; PG8_MMA(0, 0, At, B0); PG8_MMA(0, 1, At, B1); PG8_BAR; PG8_SCHED;
            PG8_LDA(At, 1, 1); PG8_STAGE(PG8_SB(1, 0), b3, voffB); PG8_STAGE(PG8_SB(1, 1), b3 + hstepB, voffB); PG8_STAGE(PG8_SA(1, 0), a3, voffA);
            PG8_WAIT_V(8); PG8_WAIT_L(0); PG8_BAR; PG8_MMA(1, 0, At, B0); PG8_MMA(1, 1, At, B1); PG8_BAR; PG8_SCHED;
            } else {
            PG8_LDB(B0, 0, 0); PG8_SCHED; PG8_LDA(At, 0, 0); PG8_STAGE(PG8_SA(1, 1), a1 + hstepA, voffA);
            PG8_WAIT_L(8); PG8_BAR; PG8_WAIT_L(0); PG8_MMA(0, 0, At, B0); PG8_BAR; PG8_SCHED;
            PG8_LDB(B1, 0, 1); PG8_STAGE(PG8_SB(0, 0), b2, voffB);
            PG8_BAR; PG8_WAIT_L(0); PG8_MMA(0, 1, At, B1); PG8_BAR;
            PG8_LDA(At, 0, 1); PG8_STAGE(PG8_SA(0, 0), a2, voffA);
            PG8_BAR; PG8_WAIT_L(0); PG8_MMA(1, 0, At, B0); PG8_BAR; PG8_SCHED;
            PG8_STAGE(PG8_SB(0, 1), b2 + hstepB, voffB);
            PG8_WAIT_V(6); PG8_BAR; PG8_MMA(1, 1, At, B1); PG8_BAR;
            PG8_LDB(B0, 1, 0); PG8_SCHED; PG8_LDA(At, 1, 0); PG8_STAGE(PG8_SA(0, 1), a2 + hstepA, voffA);
            PG8_WAIT_L(8); PG8_BAR; PG8_WAIT_L(0); PG8_MMA(0, 0, At, B0); PG8_BAR; PG8_SCHED;
            PG8_LDB(B1, 1, 1); PG8_STAGE(PG8_SB(1, 0), b3, voffB);
            PG8_BAR; PG8_WAIT_L(0); PG8_MMA(0, 1, At, B1); PG8_BAR;
            PG8_LDA(At, 1, 1); PG8_STAGE(PG8_SA(1, 0), a3, voffA);
            PG8_BAR; PG8_WAIT_L(0); PG8_MMA(1, 0, At, B0); PG8_BAR; PG8_SCHED;
            PG8_STAGE(PG8_SB(1, 1), b3 + hstepB, voffB);
            PG8_WAIT_V(6); PG8_BAR; PG8_MMA(1, 1, At, B1); PG8_BAR;
            }
        }
        PG8_MFMA_DRAIN;
        if constexpr (ALIGN_EPI) { if (wr == 0) PG8_BAR; }
        if constexpr (!Epi::AFTER_DRAIN) { E(acc, cur, wr, wc, fr, fq); S.done(cur); }
        if (!has_next) break;
#pragma unroll
        for (int a = 0; a < 2; ++a)
#pragma unroll
            for (int b = 0; b < 2; ++b)
#pragma unroll
                for (int m = 0; m < 4; ++m)
#pragma unroll
                    for (int n = 0; n < 2; ++n) acc[a][b][m][n] = (f32x4){0.f, 0.f, 0.f, 0.f};
        cur = nxt; cA = nA; cB = nB; ++ui;
        if constexpr (ALIGN_EPI) { if (wr == 1) PG8_BAR; }
    }
    PG8_WAIT_V(0);
    if constexpr (!ALIGN_EPI) { if (wr == 0) PG8_BAR; }
    PG8_BAR;
    if constexpr (Epi::AFTER_DRAIN) { E.fused(acc, cur, wr, wc, fr, fq, lds, wid, lane); S.done(cur); }
#undef PG8_SA
#undef PG8_SB
#undef PG8_STAGE
#undef PG8_LDA
#undef PG8_LDB
#undef PG8_MMA
#undef PG8_MFMA_DRAIN
#undef PG8_WAIT_V
#undef PG8_WAIT_L
#undef PG8_BAR
#undef PG8_SCHED
}
}
using pg8::bf16_t; using pg8::bf16x8; using pg8::f32x4; using pg8::u32x4; using pg8::u32x2; using pg8::cvtpk; using pg8::f2bf; using pg8::bf2f; using pg8::bflo; using pg8::bfhi; using pg8::sigm;
#define LAS __attribute__((address_space(3)))
typedef float f32x16 __attribute__((ext_vector_type(16)));
#define MFMA32(a, b, c) __builtin_amdgcn_mfma_f32_32x32x16_bf16((a), (b), (c), 0, 0, 0)

constexpr size_t MiB = 1u << 20;
constexpr size_t WS_ZH = 0;
constexpr size_t WS_H1B = 372 * MiB;
constexpr size_t WS_MB = WS_ZH, WS_U8 = 468 * MiB, WS_V8 = 484 * MiB, WS_SUV = 500 * MiB;
constexpr size_t WS_ZA = 129 * MiB;
constexpr size_t WS_ZG = 178 * MiB;
constexpr size_t WS_QB = WS_ZG;
constexpr size_t WS_A1 = 307 * MiB;
constexpr size_t WS_OM = WS_A1, WS_A2 = WS_A1;
constexpr size_t WS_UB = 372 * MiB;
constexpr size_t WS_DV = 436 * MiB;
constexpr size_t WS_VT = 437 * MiB;
constexpr size_t WS_WIN = 446 * MiB;
constexpr size_t WS_WBH = 456 * MiB, WS_WBA = 457 * MiB, WS_WOUT = 458 * MiB, WS_WQ = 460 * MiB, WS_SK = 464 * MiB;
constexpr size_t WS_RS = 465 * MiB;
constexpr size_t WS_CTL = 467 * MiB, CTL_BYTES = 16384;
constexpr size_t WS_W8T = 451 * MiB;
constexpr size_t WS_A8 = 372 * MiB;
constexpr size_t WS_END = 501 * MiB;
constexpr int LDS_BYTES = 151552;

template <bool MAX> __device__ __forceinline__ float wave_red(float v) {
#define WR_STEP(ctrl, rm) { const int vi = __builtin_bit_cast(int, v); const float t = __builtin_bit_cast(float, __builtin_amdgcn_update_dpp(MAX ? vi : 0, vi, ctrl, rm, 0xF, false)); v = MAX ? fmaxf(v, t) : v + t; }
    WR_STEP(0xB1, 0xF) WR_STEP(0x4E, 0xF) WR_STEP(0x141, 0xF) WR_STEP(0x140, 0xF) WR_STEP(0x142, 0xA) WR_STEP(0x143, 0xC)
#undef WR_STEP
    return __builtin_bit_cast(float, __builtin_amdgcn_readlane(__builtin_bit_cast(int, v), 63));
}
__device__ __forceinline__ float wave_sum(float v) { return wave_red<false>(v); }
__device__ __forceinline__ float wave_max(float v) { return wave_red<true>(v); }
__device__ __forceinline__ void p0_tile_in(const float* __restrict__ Wt, int N, LAS float* scr, int lane, const float* __restrict__ ks) {
    const int r8 = lane >> 3, c4 = 4 * (lane & 7);
    f32x4 v[8]; float sc[8];
#pragma unroll
    for (int i = 0; i < 8; ++i) { v[i] = __builtin_nontemporal_load((const f32x4*)(Wt + (size_t)(8 * i + r8) * N + c4)); sc[i] = ks ? ks[8 * i + r8] : 1.f; }
#pragma unroll
    for (int i = 0; i < 8; ++i) { LAS float* d = scr + (8 * i + r8) * 33 + c4; d[0] = v[i][0] * sc[i]; d[1] = v[i][1] * sc[i]; d[2] = v[i][2] * sc[i]; d[3] = v[i][3] * sc[i]; }
}
__device__ __forceinline__ void p0_transpose_item(const float* __restrict__ W, int K, int N, bf16_t* __restrict__ WT, LAS float* scr, int item, int lane, int ldw = 0, const float* __restrict__ kscale = nullptr) {
    if (ldw == 0) ldw = K;
    const int nblk = N / 32, kb = item / nblk, nb = item % nblk, k0 = 64 * kb, n0 = 32 * nb;
    p0_tile_in(W + (size_t)k0 * N + n0, N, scr, lane, kscale ? kscale + k0 : nullptr);
    asm volatile("s_waitcnt lgkmcnt(0)" ::: "memory");
    const int c = lane & 7;
#pragma unroll
    for (int j = 0; j < 4; ++j) { const int n = (lane >> 3) + 8 * j; const LAS float* s = scr + (8 * c) * 33 + n;
        u32x4 o; o.x = cvtpk(s[0 * 33], s[1 * 33]); o.y = cvtpk(s[2 * 33], s[3 * 33]); o.z = cvtpk(s[4 * 33], s[5 * 33]); o.w = cvtpk(s[6 * 33], s[7 * 33]);
        *(u32x4*)(WT + (size_t)(n0 + n) * ldw + k0 + 8 * c) = o; }
    asm volatile("s_waitcnt lgkmcnt(0)" ::: "memory");
}
struct P0Args { const float *x, *meta, *gmix, *w_in, *w_bh, *w_ba, *w_out, *w_q, *subk, *gffn; bf16_t *A1, *WinT, *WbhT, *WbaT, *WoutT, *WqT, *SK; unsigned char *W8T, *A8; };
__device__ __forceinline__ unsigned pk_fp8x4(float a, float b, float c, float d) { a = fminf(fmaxf(a, -448.f), 448.f); b = fminf(fmaxf(b, -448.f), 448.f); c = fminf(fmaxf(c, -448.f), 448.f); d = fminf(fmaxf(d, -448.f), 448.f);
    unsigned t = __builtin_amdgcn_cvt_pk_fp8_f32(a, b, 0, false); return __builtin_amdgcn_cvt_pk_fp8_f32(c, d, t, true); }
template <bool FP8> __device__ __forceinline__ void p0_transpose_win(const float* __restrict__ W, void* __restrict__ WT, LAS float* scr, int item, int lane) {
    constexpr int NBLK = FP8 ? 80 : 72; const int kb = item / NBLK, nb = item % NBLK, k0 = 64 * kb, n0 = 32 * nb;
    const int c0 = FP8 ? (n0 < 512 ? 1536 + n0 : n0 + 2304) : (n0 < 1536 ? n0 : n0 + 512);
    p0_tile_in(W + (size_t)k0 * 4864 + c0, 4864, scr, lane, nullptr);
    asm volatile("s_waitcnt lgkmcnt(0)" ::: "memory");
    const int c = lane & 7;
#pragma unroll
    for (int j = 0; j < 4; ++j) { const int n = (lane >> 3) + 8 * j; const LAS float* sp = scr + (8 * c) * 33 + n;
        if (FP8) { u32x2 o; o.x = pk_fp8x4(sp[0] * 512.f, sp[33] * 512.f, sp[66] * 512.f, sp[99] * 512.f); o.y = pk_fp8x4(sp[132] * 512.f, sp[165] * 512.f, sp[198] * 512.f, sp[231] * 512.f);
            *(u32x2*)((unsigned char*)WT + (size_t)(n0 + n) * 1024 + k0 + 8 * c) = o; }
        else { u32x4 o; o.x = cvtpk(sp[0], sp[33]); o.y = cvtpk(sp[66], sp[99]); o.z = cvtpk(sp[132], sp[165]); o.w = cvtpk(sp[198], sp[231]); *(u32x4*)((bf16_t*)WT + (size_t)(n0 + n) * 1024 + k0 + 8 * c) = o; } }
    asm volatile("s_waitcnt lgkmcnt(0)" ::: "memory");
}
__device__ __forceinline__ void p0_prologue(LAS unsigned char* lds, const P0Args& p) {
    const int tid = threadIdx.x, lane = tid & 63, wave = tid >> 6;
    LAS float* scr = (LAS float*)(lds + wave * 16384);
    const int gw = blockIdx.x * 8 + wave, NGW = gridDim.x * 8;
    constexpr int I_INA = 16 * 72, I_IN8 = 16 * 80, I_B = 8 * 32, I_O = 16 * 32, I_Q = 16 * 64, NITEMS = I_INA + I_IN8 + 2 * I_B + I_O + I_Q;
    for (int it = gw; it < NITEMS; it += NGW) {
        int r = it;
        if (r < I_INA) { p0_transpose_win<false>(p.w_in, p.WinT, scr, r, lane); continue; } r -= I_INA;
        if (r < I_IN8) { p0_transpose_win<true>(p.w_in, p.W8T, scr, r, lane); continue; } r -= I_IN8;
        if (r < I_B) { p0_transpose_item(p.w_bh, 512, 1024, p.WbhT, scr, r, lane, 1024); continue; } r -= I_B;
        if (r < I_B) { p0_transpose_item(p.w_ba, 512, 1024, p.WbhT + 512, scr, r, lane, 1024); continue; } r -= I_B;
        if (r < I_O) { p0_transpose_item(p.w_out, 1024, 1024, p.WoutT, scr, r, lane); continue; } r -= I_O;
        p0_transpose_item(p.w_q, 1024, 2048, p.WqT, scr, r, lane, 0, p.gffn);
    }
    for (int p_ = blockIdx.x * 512 + tid; p_ < 262144 / 8; p_ += gridDim.x * 512) {
        const int ln = p_ & 63, kk = (p_ >> 6) & 7, nb = (p_ >> 9) & 3, hc = p_ >> 11;
        const float* src = p.subk + (size_t)(hc * 128 + 32 * nb + (ln & 31)) * 128 + 16 * kk + 8 * (ln >> 5);
        const f32x4 a = *(const f32x4*)src, b = *(const f32x4*)(src + 4);
        u32x4 o; o.x = cvtpk(a[0], a[1]); o.y = cvtpk(a[2], a[3]); o.z = cvtpk(b[0], b[1]); o.w = cvtpk(b[2], b[3]); *(u32x4*)(p.SK + (size_t)p_ * 8) = o; }
    f32x4 g[4];
#pragma unroll
    for (int j = 0; j < 4; ++j) g[j] = *((const f32x4*)p.gmix + lane + 64 * j);
    for (int m0 = gw; m0 < MA; m0 += 4 * NGW) {
        f32x4 v[4][4];
#pragma unroll
        for (int r = 0; r < 4; ++r) { const int m = m0 + r * NGW;
            if (m < MA_REAL) { const int b = m / LTOK, pos = m - b * LTOK;
                const float* src = pos < NMETA ? p.meta + (size_t)pos * 1024 : p.x + ((size_t)b * SEQ + (pos - NMETA)) * 1024;
                const f32x4* xr = (const f32x4*)src + lane;
#pragma unroll
                for (int j = 0; j < 4; ++j) v[r][j] = __builtin_nontemporal_load(xr + 64 * j); }
            else {
#pragma unroll
                for (int j = 0; j < 4; ++j) v[r][j] = (f32x4){0.f, 0.f, 0.f, 0.f}; } }
#pragma unroll
        for (int r = 0; r < 4; ++r) { const int m = m0 + r * NGW;
            if (m < MA) { float s = 0.f;
#pragma unroll
                for (int j = 0; j < 4; ++j) s += (v[r][j][0] * v[r][j][0] + v[r][j][1] * v[r][j][1]) + (v[r][j][2] * v[r][j][2] + v[r][j][3] * v[r][j][3]);
                const float rstd = __builtin_amdgcn_rsqf(wave_sum(s) * (1.f / 1024.f) + EPS);
                unsigned long long* o8 = (unsigned long long*)(p.A1 + (size_t)m * 1024) + lane;
                const int bb = m / LTOK, pos = m - bb * LTOK; const bool cmp = m < MA_REAL && pos >= NMETA;
                unsigned* a8 = (unsigned*)(p.A8 + ((size_t)bb * SEQ + (pos - NMETA)) * 1024) + lane;
#pragma unroll
                for (int j = 0; j < 4; ++j) { const f32x4 y = v[r][j] * rstd * g[j]; o8[64 * j] = (unsigned long long)cvtpk(y[0], y[1]) | ((unsigned long long)cvtpk(y[2], y[3]) << 32);
                    if (cmp) a8[64 * j] = pk_fp8x4(y[0] * 16.f, y[1] * 16.f, y[2] * 16.f, y[3] * 16.f); } } }
    }
}

constexpr int SR = 272;
constexpr int OFF_Q = 0, OFF_K = 34816, OFF_V = 69632, OFF_S = 104448, OFF_VEC = 139264;
__device__ __forceinline__ bf16x8 ldfrag(const LAS unsigned char* base, int row, int kk8, int h2) { return *(const LAS bf16x8*)(base + row * SR + (kk8 * 16 + 8 * h2) * 2); }

constexpr int OFF_SEGP = OFF_VEC, OFF_VEC2 = OFF_VEC + 8192, OFF_SSQ = OFF_VEC2 + 1024;
template <bool WITH_Q>
__device__ __forceinline__ void hgrn_front(LAS unsigned char* lds, const bf16_t* __restrict__ Zh, const float* __restrict__ lblog, int b, int h, int c, float (&g)[8][4], float (&kk)[8][4], float (&qq)[8][4], u32x2 (&vraw)[8]) {
    const int tid = threadIdx.x, c4 = tid & 31, seg = tid >> 5;
    const f32x4 l0 = *(const f32x4*)(lblog + h * 128 + 4 * c4), l1 = *(const f32x4*)(lblog + 512 + h * 128 + 4 * c4);
    float lb[4], run[4];
#pragma unroll
    for (int k = 0; k < 4; ++k) { lb[k] = sigm(l0[k] - l1[k]); run[k] = 1.f; }
    u32x2 hfw[8], hqw[8];
#pragma unroll
    for (int i = 0; i < 8; ++i) { const int pos = 128 * c - 112 + 8 * seg + i; const bool valid = pos >= 0;
        const bf16_t* zr = Zh + (size_t)(b * LTOK + (valid ? pos : 0)) * 2048 + h * 128 + 4 * c4;
        hfw[i] = *(const u32x2*)(zr + 512); if (WITH_Q) hqw[i] = *(const u32x2*)zr; vraw[i] = *(const u32x2*)(zr + 1024);
        if (!valid) { hfw[i] = (u32x2){0x7f007f00u, 0x7f007f00u}; hqw[i] = (u32x2){0u, 0u}; vraw[i] = (u32x2){0u, 0u}; } }
#pragma unroll
    for (int i = 0; i < 8; ++i) {
        const float hf[4] = {bflo(hfw[i].x), bfhi(hfw[i].x), bflo(hfw[i].y), bfhi(hfw[i].y)};
#pragma unroll
        for (int k = 0; k < 4; ++k) { const float sg = sigm(hf[k]); const float f = lb[k] + (1.f - lb[k]) * sg; kk[i][k] = (1.f - lb[k]) * (1.f - sg); run[k] *= f; g[i][k] = run[k]; }
        if (WITH_Q) { qq[i][0] = bflo(hqw[i].x); qq[i][1] = bfhi(hqw[i].x); qq[i][2] = bflo(hqw[i].y); qq[i][3] = bfhi(hqw[i].y); } }
    *(LAS f32x4*)(lds + OFF_SEGP + (seg * 128 + 4 * c4) * 4) = (f32x4){run[0], run[1], run[2], run[3]};
    __syncthreads();
}
__device__ __forceinline__ void hgrn_base(LAS unsigned char* lds, float (&base)[4]) {
    const int tid = threadIdx.x, c4 = tid & 31, seg = tid >> 5;
    const LAS f32x4* sp = (const LAS f32x4*)(lds + OFF_SEGP) + c4;
    f32x4 p = (f32x4){1.f, 1.f, 1.f, 1.f};
    if (seg < 8) { for (int s = seg; s < 8; ++s) p *= sp[s * 32];
        if (seg == 0) *(LAS f32x4*)(lds + OFF_VEC2 + (4 * c4) * 4) = p;
#pragma unroll
        for (int k = 0; k < 4; ++k) base[k] = __builtin_amdgcn_rcpf(p[k]); }
    else { for (int s = 8; s < seg; ++s) p *= sp[s * 32];
        if (seg == 15) *(LAS f32x4*)(lds + OFF_VEC2 + (128 + 4 * c4) * 4) = p * sp[15 * 32];
#pragma unroll
        for (int k = 0; k < 4; ++k) base[k] = p[k]; }
}
__device__ __forceinline__ void hgrn_put_vt(LAS unsigned char* lds, const u32x2 (&vraw)[8], int c4, int seg) {
#pragma unroll
    for (int k = 0; k < 4; ++k) { unsigned e[8];
#pragma unroll
        for (int i = 0; i < 8; ++i) { const unsigned w = (k < 2) ? vraw[i].x : vraw[i].y; e[i] = (k & 1) ? (w >> 16) : (w & 0xffffu); }
        *(LAS u32x4*)(lds + OFF_V + (4 * c4 + k) * SR + seg * 16) = (u32x4){e[0] | (e[1] << 16), e[2] | (e[3] << 16), e[4] | (e[5] << 16), e[6] | (e[7] << 16)}; }
}

__device__ __forceinline__ void hgrn_A(LAS unsigned char* lds, const bf16_t* __restrict__ Zh, const float* __restrict__ lblog, bf16_t* __restrict__ Ub, float* __restrict__ Dv, int item) {
    const int tid = threadIdx.x, lane = tid & 63, wid = tid >> 6, r32 = lane & 31, h2 = lane >> 5;
    const int c = item & 31, bh = item >> 5, b = bh >> 2, h = bh & 3;
    const int c4 = tid & 31, seg = tid >> 5;
    float g[8][4], kk[8][4], qq[8][4]; u32x2 vraw[8];
    hgrn_front<false>(lds, Zh, lblog, b, h, c, g, kk, qq, vraw);
    { float base[4]; hgrn_base(lds, base);
#pragma unroll
      for (int k = 0; k < 4; ++k) { float kt[8];
#pragma unroll
          for (int i = 0; i < 8; ++i) kt[i] = kk[i][k] * __builtin_amdgcn_rcpf(base[k] * g[i][k]);
          *(LAS u32x4*)(lds + OFF_K + (4 * c4 + k) * SR + seg * 16) = (u32x4){cvtpk(kt[0], kt[1]), cvtpk(kt[2], kt[3]), cvtpk(kt[4], kt[5]), cvtpk(kt[6], kt[7])}; }
      hgrn_put_vt(lds, vraw, c4, seg); }
    __syncthreads();
    const int e0 = 32 * (wid >> 1), d0 = 64 * (wid & 1);
    f32x16 acc[2]; acc[0] = f32x16{}; acc[1] = f32x16{};
#pragma unroll
    for (int k8 = 0; k8 < 8; ++k8) { const bf16x8 a = ldfrag(lds + OFF_V, e0 + r32, k8, h2);
#pragma unroll
        for (int j = 0; j < 2; ++j) acc[j] = MFMA32(a, ldfrag(lds + OFF_K, d0 + 32 * j + r32, k8, h2), acc[j]); }
    const LAS float* vec2 = (const LAS float*)(lds + OFF_VEC2);
#pragma unroll
    for (int j = 0; j < 2; ++j) { const int dc = d0 + 32 * j + r32; const float sc = vec2[128 + dc];
        bf16_t* up = Ub + ((size_t)item * 128 + e0 + 4 * h2) * 128 + dc;
#pragma unroll
        for (int r = 0; r < 16; ++r) up[(size_t)((r & 3) + 8 * (r >> 2)) * 128] = f2bf(acc[j][r] * sc); }
    if (tid < 128) Dv[(size_t)item * 128 + tid] = vec2[tid] * vec2[128 + tid];
    __syncthreads();
}

__device__ __forceinline__ void hgrn_C(LAS unsigned char* lds, const bf16_t* __restrict__ Zh, const float* __restrict__ lblog, const bf16_t* __restrict__ Ub, const float* __restrict__ hgn, bf16_t* __restrict__ OM, int item) {
    const int tid = threadIdx.x, lane = tid & 63, wid = tid >> 6, r32 = lane & 31, h2 = lane >> 5;
    const int c = (item & 31) + 1, bh = item >> 5, b = bh >> 2, h = bh & 3;
    const int c4 = tid & 31, seg = tid >> 5;
    const int tb = wid >> 1, wh = wid & 1;
    u32x4 sreg[4];
    { const bf16_t* sp = Ub + (size_t)item * 16384;
#pragma unroll
      for (int q = 0; q < 4; ++q) sreg[q] = *(const u32x4*)(sp + (size_t)(tid + 512 * q) * 8); }
    const size_t rc = (size_t)b * SEQ + 128 * (c - 1) + 32 * tb + r32, ra = (size_t)b * LTOK + 128 * c - 112 + 32 * tb + r32;
    u32x2 gate[2][4];
#pragma unroll
    for (int j = 0; j < 2; ++j)
#pragma unroll
        for (int gq = 0; gq < 4; ++gq) gate[j][gq] = *(const u32x2*)(Zh + ra * 2048 + 1536 + h * 128 + 64 * wh + 32 * j + 8 * gq + 4 * h2);
    float g[8][4], kk[8][4], qq[8][4]; u32x2 vraw[8];
    hgrn_front<true>(lds, Zh, lblog, b, h, c, g, kk, qq, vraw);
    { float base[4]; hgrn_base(lds, base);
#pragma unroll
      for (int i = 0; i < 8; ++i) { float r[4], ri[4];
#pragma unroll
          for (int k = 0; k < 4; ++k) { r[k] = base[k] * g[i][k]; ri[k] = __builtin_amdgcn_rcpf(r[k]); }
          const int t = 8 * seg + i;
          *(LAS u32x2*)(lds + OFF_Q + t * SR + 8 * c4) = (u32x2){cvtpk(qq[i][0] * r[0], qq[i][1] * r[1]), cvtpk(qq[i][2] * r[2], qq[i][3] * r[3])};
          *(LAS u32x2*)(lds + OFF_K + t * SR + 8 * c4) = (u32x2){cvtpk(kk[i][0] * ri[0], kk[i][1] * ri[1]), cvtpk(kk[i][2] * ri[2], kk[i][3] * ri[3])}; }
      hgrn_put_vt(lds, vraw, c4, seg); }
    __syncthreads();
    { const LAS float* vec2 = (const LAS float*)(lds + OFF_VEC2);
#pragma unroll
      for (int q = 0; q < 4; ++q) { const int idx = tid + 512 * q, e = idx >> 4, d8 = (idx & 15) * 8; const f32x4 p0 = *(const LAS f32x4*)(vec2 + d8), p1 = *(const LAS f32x4*)(vec2 + d8 + 4); const u32x4 sv = sreg[q];
          *(LAS u32x4*)(lds + OFF_S + e * SR + d8 * 2) = (u32x4){cvtpk(bflo(sv.x) * p0[0], bfhi(sv.x) * p0[1]), cvtpk(bflo(sv.y) * p0[2], bfhi(sv.y) * p0[3]), cvtpk(bflo(sv.z) * p1[0], bfhi(sv.z) * p1[1]), cvtpk(bflo(sv.w) * p1[2], bfhi(sv.w) * p1[3])}; } }
    f32x16 sc[2]; sc[0] = f32x16{}; sc[1] = f32x16{};
#pragma unroll
    for (int j = 0; j < 2; ++j) { const int sb = 2 * wh + j;
        if (sb <= tb) {
#pragma unroll
            for (int k8 = 0; k8 < 8; ++k8) sc[j] = MFMA32(ldfrag(lds + OFF_K, 32 * sb + r32, k8, h2), ldfrag(lds + OFF_Q, 32 * tb + r32, k8, h2), sc[j]); } }
    __syncthreads();
    { const int t = 32 * tb + r32;
#pragma unroll
      for (int j = 0; j < 2; ++j) { const int sb = 2 * wh + j;
#pragma unroll
          for (int gq = 0; gq < 4; ++gq) { const int s0 = 32 * sb + 8 * gq + 4 * h2;
              const float p0 = (sb <= tb && s0 + 0 <= t) ? sc[j][4 * gq + 0] : 0.f, p1 = (sb <= tb && s0 + 1 <= t) ? sc[j][4 * gq + 1] : 0.f;
              const float p2 = (sb <= tb && s0 + 2 <= t) ? sc[j][4 * gq + 2] : 0.f, p3 = (sb <= tb && s0 + 3 <= t) ? sc[j][4 * gq + 3] : 0.f;
              u32x2 w; w.x = cvtpk(p0, p1); w.y = cvtpk(p2, p3); *(LAS u32x2*)(lds + OFF_K + t * SR + s0 * 2) = w; } } }
    __syncthreads();
    f32x16 oc[2]; oc[0] = f32x16{}; oc[1] = f32x16{};
    for (int k8 = 0; k8 < 2 * (tb + 1); ++k8) { const bf16x8 pb = ldfrag(lds + OFF_K, 32 * tb + r32, k8, h2);
#pragma unroll
        for (int j = 0; j < 2; ++j) oc[j] = MFMA32(ldfrag(lds + OFF_V, 64 * wh + 32 * j + r32, k8, h2), pb, oc[j]); }
#pragma unroll
    for (int k8 = 0; k8 < 8; ++k8) { const bf16x8 qb = ldfrag(lds + OFF_Q, 32 * tb + r32, k8, h2);
#pragma unroll
        for (int j = 0; j < 2; ++j) oc[j] = MFMA32(ldfrag(lds + OFF_S, 64 * wh + 32 * j + r32, k8, h2), qb, oc[j]); }
    LAS float* ssq = (LAS float*)(lds + OFF_SSQ);
    { float ss = 0.f;
#pragma unroll
      for (int j = 0; j < 2; ++j)
#pragma unroll
          for (int r = 0; r < 16; ++r) ss += oc[j][r] * oc[j][r];
      ss += __shfl_xor(ss, 32);
      if (h2 == 0) ssq[wh * 128 + 32 * tb + r32] = ss; }
    __syncthreads();
    { const int t = 32 * tb + r32; const float rstd = __builtin_amdgcn_rsqf((ssq[t] + ssq[128 + t]) * (1.f / 128.f) + EPS);
#pragma unroll
      for (int j = 0; j < 2; ++j)
#pragma unroll
          for (int gq = 0; gq < 4; ++gq) { const int e = 64 * wh + 32 * j + 8 * gq + 4 * h2;
              const u32x2 gt = gate[j][gq]; const f32x4 gn = *(const f32x4*)(hgn + h * 128 + e);
              const float g0 = bflo(gt.x), g1 = bfhi(gt.x), g2 = bflo(gt.y), g3 = bfhi(gt.y);
              const float o0 = oc[j][4 * gq + 0] * rstd * gn[0] * (g0 * sigm(g0)), o1 = oc[j][4 * gq + 1] * rstd * gn[1] * (g1 * sigm(g1));
              const float o2 = oc[j][4 * gq + 2] * rstd * gn[2] * (g2 * sigm(g2)), o3 = oc[j][4 * gq + 3] * rstd * gn[3] * (g3 * sigm(g3));
              u32x2 w; w.x = cvtpk(o0, o1); w.y = cvtpk(o2, o3); *(u32x2*)(OM + rc * 1024 + h * 128 + e) = w; } }
    __syncthreads();
}

__device__ __forceinline__ void hgrn_scan(bf16_t* __restrict__ Ub, const float* __restrict__ Dv) {
    for (int v = blockIdx.x * 512 + threadIdx.x; v < 32 * 4096; v += gridDim.x * 512) {
        const int bh = v >> 12, i4 = v & 4095, e = i4 >> 5, d4 = (i4 & 31) * 4;
        u32x2* up = (u32x2*)(Ub + ((size_t)(bh * 32) * 128 + e) * 128 + d4); const f32x4* dp = (const f32x4*)(Dv + (size_t)(bh * 32) * 128 + d4);
        f32x4 S = (f32x4){0.f, 0.f, 0.f, 0.f};
#pragma unroll 1
        for (int c0 = 0; c0 < 32; c0 += 8) { u32x2 u[8]; f32x4 dv[8];
#pragma unroll
            for (int c = 0; c < 8; ++c) { u[c] = up[(size_t)(c0 + c) * 4096]; dv[c] = dp[(c0 + c) * 32]; }
#pragma unroll
            for (int c = 0; c < 8; ++c) { S = dv[c] * S + (f32x4){bflo(u[c].x), bfhi(u[c].x), bflo(u[c].y), bfhi(u[c].y)}; up[(size_t)(c0 + c) * 4096] = (u32x2){cvtpk(S[0], S[1]), cvtpk(S[2], S[3])}; } }
    }
}

constexpr int AK_STRIDE = 144, AV_STRIDE = 560, AK_OFF = 0, AV_OFF = 288 * AK_STRIDE;
__device__ __forceinline__ void attn_stage_load(u32x4 (&rk)[5], u32x4 (&rv)[5], const bf16_t* __restrict__ Za, const bf16_t* __restrict__ Vt, int b, int n, int kvh) {
    const int tid = threadIdx.x;
#pragma unroll
    for (int q = 0; q < 5; ++q) { const int i = tid + 512 * q; const int kl = i >> 3, ch = i & 7; u32x4 v = (u32x4){0u, 0u, 0u, 0u};
        int pos = -1; if (kl < 256) pos = 128 * (n - 1) + kl - 112; else if (kl < 272) pos = kl - 256;
        if (i < 288 * 8 && pos >= 0) v = *(const u32x4*)(Za + (size_t)(b * LTOK + pos) * 768 + 512 + kvh * 64 + 8 * ch);
        rk[q] = v; }
#pragma unroll
    for (int q = 0; q < 5; ++q) { const int i = tid + 512 * q; const int d = i / 35, ch = i - d * 35; u32x4 v = (u32x4){0u, 0u, 0u, 0u};
        if (i < 64 * 35) { const bf16_t* vr = Vt + (size_t)(b * 128 + kvh * 64 + d) * LPAD;
            if (ch < 32) { if (n > 1 || ch >= 14) v = *(const u32x4*)(vr + 128 * (n - 1) + 8 * ch); }
            else if (ch < 34) v = *(const u32x4*)(vr + 112 + 8 * (ch - 32)); }
        rv[q] = v; }
}
__device__ __forceinline__ void attn_stage_store(LAS unsigned char* lds, const u32x4 (&rk)[5], const u32x4 (&rv)[5]) {
    const int tid = threadIdx.x;
#pragma unroll
    for (int q = 0; q < 5; ++q) { const int i = tid + 512 * q; const int kl = i >> 3, ch = i & 7; if (i < 288 * 8) *(LAS u32x4*)(lds + AK_OFF + kl * AK_STRIDE + ch * 16) = rk[q]; }
#pragma unroll
    for (int q = 0; q < 5; ++q) { const int i = tid + 512 * q; const int d = i / 35, ch = i - d * 35; if (i < 64 * 35) *(LAS u32x4*)(lds + AV_OFF + d * AV_STRIDE + ch * 16) = rv[q]; }
}
__device__ __forceinline__ f32x16 attn_qk(const LAS unsigned char* kp, const bf16x8 (&qf)[4]) {
    f32x16 S = f32x16{};
#pragma unroll
    for (int k = 0; k < 4; ++k) S = MFMA32(*(const LAS bf16x8*)(kp + 32 * k), qf[k], S);
    return S;
}
template <int MODE> __device__ __forceinline__ bool attn_vis(int kr, int r32) { return MODE == 0 ? true : MODE == 1 ? (kr > r32) : MODE == 2 ? (kr <= r32) : (kr < 16); }
template <int MODE> __device__ __forceinline__ float attn_tile_max(const f32x16& S, int r32, int h2) {
    float m = -INFINITY;
#pragma unroll
    for (int r = 0; r < 16; ++r) { const int kr = (r & 3) + 8 * (r >> 2) + 4 * h2; m = fmaxf(m, attn_vis<MODE>(kr, r32) ? S[r] : -INFINITY); }
    return m;
}
template <int MODE> __device__ __forceinline__ void attn_tile_pv(f32x16 S, float c2, float mneg, int r32, int h2, float& l, f32x16 (&O)[2], const LAS unsigned char* vl, int kl0) {
#pragma unroll
    for (int r = 0; r < 16; ++r) { const int kr = (r & 3) + 8 * (r >> 2) + 4 * h2; const float p = __builtin_amdgcn_exp2f(__builtin_fmaf(S[r], c2, mneg)); S[r] = attn_vis<MODE>(kr, r32) ? p : 0.f; l += S[r]; }
#pragma unroll
    for (int s2 = 0; s2 < 2; ++s2) {
        if (MODE == 3 && s2 == 1) continue;
        u32x4 pw; pw.x = cvtpk(S[8 * s2 + 0], S[8 * s2 + 1]); pw.y = cvtpk(S[8 * s2 + 2], S[8 * s2 + 3]); pw.z = cvtpk(S[8 * s2 + 4], S[8 * s2 + 5]); pw.w = cvtpk(S[8 * s2 + 6], S[8 * s2 + 7]);
        const bf16x8 pb = __builtin_bit_cast(bf16x8, pw);
#pragma unroll
        for (int db = 0; db < 2; ++db) { const LAS unsigned char* vp = vl + (32 * db) * AV_STRIDE + (kl0 + 16 * s2) * 2;
            const u32x2 lo = *(const LAS u32x2*)vp, hi = *(const LAS u32x2*)(vp + 16);
            const u32x4 aw = (u32x4){lo.x, lo.y, hi.x, hi.y};
            O[db] = MFMA32(__builtin_bit_cast(bf16x8, aw), pb, O[db]); } }
}
__device__ __forceinline__ void attn_q_load(bf16x8 (&qf)[4], const bf16_t* __restrict__ Za, int b, int n, int qh, int sb, int lane) {
    const int r32 = lane & 31, h2 = lane >> 5;
    const int pq = 128 * n + 32 * sb + r32;
    const bf16_t* qp = Za + (size_t)(b * LTOK + pq - 112) * 768 + qh * 64 + 8 * h2;
#pragma unroll
    for (int k = 0; k < 4; ++k) qf[k] = *(const bf16x8*)(qp + 16 * k);
}
__device__ __forceinline__ void attn_sub(const LAS unsigned char* lds, const bf16x8 (&qf)[4], const float* __restrict__ sinks, bf16_t* __restrict__ OM, int b, int n, int qh, int sb, int lane) {
    const int r32 = lane & 31, h2 = lane >> 5;
    const LAS unsigned char* kl = lds + AK_OFF + r32 * AK_STRIDE + 16 * h2;
    const LAS unsigned char* vl = lds + AV_OFF + r32 * AV_STRIDE + 8 * h2;
    const float c2 = 0.125f * 1.4426950408889634f;
    const float sinkl = sinks[qh] * 1.4426950408889634f;
    const int jskip = n == 1 ? 4 - sb : 0;
    float mraw = -INFINITY;
#pragma unroll
    for (int j = 0; j < 5; ++j) { if (j < jskip) continue;
        const f32x16 S = attn_qk(kl + (32 * (sb + j)) * AK_STRIDE, qf);
        mraw = fmaxf(mraw, j == 0 ? attn_tile_max<1>(S, r32, h2) : j == 4 ? attn_tile_max<2>(S, r32, h2) : attn_tile_max<0>(S, r32, h2)); }
    { const f32x16 S = attn_qk(kl + 256 * AK_STRIDE, qf); mraw = fmaxf(mraw, attn_tile_max<3>(S, r32, h2)); }
    float mx = fmaxf(mraw * c2, sinkl);
    mx = fmaxf(mx, __shfl_xor(mx, 32));
    float l = 0.f; const float mneg = -mx;
    f32x16 O[2]; O[0] = f32x16{}; O[1] = f32x16{};
#pragma unroll
    for (int j = 0; j < 5; ++j) { if (j < jskip) continue;
        const int kl0 = 32 * (sb + j); const f32x16 S = attn_qk(kl + kl0 * AK_STRIDE, qf);
        if (j == 0) attn_tile_pv<1>(S, c2, mneg, r32, h2, l, O, vl, kl0); else if (j == 4) attn_tile_pv<2>(S, c2, mneg, r32, h2, l, O, vl, kl0); else attn_tile_pv<0>(S, c2, mneg, r32, h2, l, O, vl, kl0); }
    { const f32x16 S = attn_qk(kl + 256 * AK_STRIDE, qf); attn_tile_pv<3>(S, c2, mneg, r32, h2, l, O, vl, 256); }
    l += __shfl_xor(l, 32); l += __builtin_amdgcn_exp2f(sinkl - mx);
    const float inv = __builtin_amdgcn_rcpf(l);
    bf16_t* op = OM + ((size_t)b * SEQ + 128 * (n - 1) + 32 * sb + r32) * 1024 + 512 + qh * 64 + 4 * h2;
#pragma unroll
    for (int db = 0; db < 2; ++db)
#pragma unroll
        for (int g = 0; g < 4; ++g) { u32x2 w; w.x = cvtpk(O[db][4 * g] * inv, O[db][4 * g + 1] * inv); w.y = cvtpk(O[db][4 * g + 2] * inv, O[db][4 * g + 3] * inv);
            *(u32x2*)(op + 32 * db + 8 * g) = w; }
}
__device__ __forceinline__ unsigned f2ord(float f) { const unsigned u = __float_as_uint(f); return (u & 0x80000000u) ? ~u : (u | 0x80000000u); }
__device__ __forceinline__ float ord2f(unsigned u) { return __uint_as_float((u & 0x80000000u) ? (u & 0x7fffffffu) : ~u); }
__device__ __forceinline__ unsigned umax_(unsigned a, unsigned b) { unsigned r; asm("v_max_f32 %0, %1, %2" : "=v"(r) : "v"(a), "v"(b)); return r; }
__device__ __forceinline__ unsigned umin_(unsigned a, unsigned b) { unsigned r; asm("v_min_f32 %0, %1, %2" : "=v"(r) : "v"(a), "v"(b)); return r; }
constexpr unsigned KEY_LOWEST = 0xff7fff00u;
struct Net16 { unsigned char a[63], b[63]; };
constexpr Net16 make_net16() {
    constexpr int P[63][2] = {{0,1},{2,3},{0,2},{1,3},{1,2},{4,5},{6,7},{4,6},{5,7},{5,6},{0,4},{2,6},{2,4},{1,5},{3,7},{3,5},{1,2},{3,4},{5,6},{8,9},{10,11},{8,10},{9,11},{9,10},{12,13},{14,15},{12,14},{13,15},{13,14},
        {8,12},{10,14},{10,12},{9,13},{11,15},{11,13},{9,10},{11,12},{13,14},{0,8},{4,12},{4,8},{2,10},{6,14},{6,10},{2,4},{6,8},{10,12},{1,9},{5,13},{5,9},{3,11},{7,15},{7,11},{3,5},{7,9},{11,13},{1,2},{3,4},{5,6},{7,8},{9,10},{11,12},{13,14}};
    Net16 n{}; for (int k = 0; k < 63; ++k) { n.a[k] = (unsigned char)P[k][0]; n.b[k] = (unsigned char)P[k][1]; } return n;
}
constexpr Net16 NET16 = make_net16();
template <int N> __device__ __forceinline__ void bitonic_desc(unsigned (&a)[N]) {
    static_assert(N == 16, "16-input network");
#pragma unroll
    for (int k = 0; k < 63; ++k) { const unsigned hi = umax_(a[NET16.a[k]], a[NET16.b[k]]), lo = umin_(a[NET16.a[k]], a[NET16.b[k]]); a[NET16.a[k]] = hi; a[NET16.b[k]] = lo; }
}
__device__ __forceinline__ void bitonic_clean16(unsigned (&a)[16]) {
#pragma unroll
    for (int j = 8; j > 0; j >>= 1)
#pragma unroll
        for (int i = 0; i < 16; ++i) { const int l = i ^ j; if (l > i) { const unsigned hi = umax_(a[i], a[l]), lo = umin_(a[i], a[l]); a[i] = hi; a[l] = lo; } }
}
__device__ __forceinline__ void merge_top16(unsigned (&a)[16], const unsigned (&b)[16]) {
#pragma unroll
    for (int i = 0; i < 16; ++i) a[i] = umax_(a[i], b[15 - i]);
    bitonic_clean16(a);
}
template <bool PAIR> __device__ __forceinline__ void top16_of(unsigned (&g)[4][16]) {
    bitonic_desc<16>(g[0]); bitonic_desc<16>(g[1]); bitonic_desc<16>(g[2]); bitonic_desc<16>(g[3]);
    merge_top16(g[0], g[1]); merge_top16(g[2], g[3]); merge_top16(g[0], g[2]);
    if (PAIR) { unsigned o[16]; const bool up = (threadIdx.x & 32) != 0;
#pragma unroll
        for (int i = 0; i < 16; ++i) { const auto r = __builtin_amdgcn_permlane32_swap(g[0][i], g[0][i], false, false); o[i] = up ? r[0] : r[1]; }
        merge_top16(g[0], o); }
}
__device__ __forceinline__ unsigned sel16p(unsigned long long lo, unsigned long long hi, int i) { const unsigned long long w = (i & 8) ? hi : lo; return (unsigned)(w >> ((i & 7) * 8)) & 0x7fu; }
struct CandTab { unsigned char i[50], j[50]; int n; };
constexpr CandTab make_cands() { CandTab t{}; int n = 0; for (int i = 0; i < 16; ++i) for (int j = 0; j < 16; ++j) if ((i + 1) * (j + 1) <= 16) { t.i[n] = (unsigned char)i; t.j[n] = (unsigned char)j; ++n; } t.n = n; return t; }
constexpr CandTab CT = make_cands();
static_assert(CT.n == 50, "candidate count");

constexpr int PL_IDX = 0, PL_GB = 32768, PL_PA = 65536, PL_SSQ = 131072;
__device__ __forceinline__ void peer_topk(LAS unsigned char* lds, const bf16_t* __restrict__ Qb, const bf16_t* __restrict__ SK, const float* __restrict__ rowssp, int rc0, int tl0, int h0, int lane) {
    float rstd_t;
    { const f32x4* rp = (const f32x4*)(rowssp + (size_t)(rc0 + (lane & 31)) * 16); const f32x4 s4 = (rp[0] + rp[1]) + (rp[2] + rp[3]); rstd_t = __builtin_amdgcn_rsqf(((s4[0] + s4[1]) + (s4[2] + s4[3])) * (1.0f / 1024.0f) + EPS); }
    const bf16_t* qbase = Qb + ((size_t)(((rc0 >> 5) * 8 + h0) * 2 * 8) * 64 + lane) * 8;
    const bf16_t* kbase = SK + ((size_t)((h0 * 2) * 4 * 8) * 64 + lane) * 8;
    bf16x8 qn[8];
#pragma unroll
    for (int k = 0; k < 8; ++k) qn[k] = __builtin_nontemporal_load((const bf16x8*)(qbase + 512 * k));
    unsigned ta[16];
#pragma unroll 1
    for (int li = 0; li < 8; ++li) {
        asm volatile("" : "+v"(lane));
        const int r32 = lane & 31, h2 = lane >> 5, h = h0 + (li >> 1);
        const bf16_t* kp = kbase + (size_t)li * 16384;
        bf16x8 qf[8], ka[8], kb[8];
#pragma unroll
        for (int k = 0; k < 8; ++k) { qf[k] = qn[k]; ka[k] = *(const bf16x8*)(kp + 512 * k); }
        unsigned g[4][16];
#pragma unroll
        for (int nb = 0; nb < 4; ++nb) {
            if (nb < 3) {
#pragma unroll
                for (int k = 0; k < 8; ++k) { if (nb & 1) ka[k] = *(const bf16x8*)(kp + (nb + 1) * 4096 + 512 * k); else kb[k] = *(const bf16x8*)(kp + (nb + 1) * 4096 + 512 * k); } }
            __builtin_amdgcn_sched_barrier(0);
            f32x16 acc = f32x16{};
#pragma unroll
            for (int k = 0; k < 8; ++k) acc = MFMA32((nb & 1) ? kb[k] : ka[k], qf[k], acc);
#pragma unroll
            for (int r = 0; r < 16; ++r) g[nb][r] = (__float_as_uint(acc[r]) & 0xffffff80u) | (unsigned)(32 * nb + (r & 3) + 8 * (r >> 2) + 4 * h2);
            __builtin_amdgcn_sched_barrier(0);
        }
        if (li < 7) {
#pragma unroll
            for (int k = 0; k < 8; ++k) qn[k] = __builtin_nontemporal_load((const bf16x8*)(qbase + (size_t)(li + 1) * 4096 + 512 * k)); }
        __builtin_amdgcn_sched_barrier(0);
        top16_of<true>(g);
        if ((li & 1) == 0) {
#pragma unroll
            for (int k = 0; k < 16; ++k) ta[k] = g[0][k];
            continue; }
        unsigned tb[16];
#pragma unroll
        for (int k = 0; k < 16; ++k) tb[k] = g[0][k];
        LAS u32x4* park = (LAS u32x4*)(lds + PL_PA + (threadIdx.x >> 6) * 8192) + (lane & 63);
        if (((li >> 1) & 1) == 0) {
#pragma unroll
            for (int j = 0; j < 4; ++j) { park[(0 * 4 + j) * 64] = (u32x4){ta[4 * j], ta[4 * j + 1], ta[4 * j + 2], ta[4 * j + 3]}; park[(1 * 4 + j) * 64] = (u32x4){tb[4 * j], tb[4 * j + 1], tb[4 * j + 2], tb[4 * j + 3]}; }
            continue; }
        if (h2 == 0) {
#pragma unroll
            for (int j = 0; j < 4; ++j) { const u32x4 pa_ = park[(0 * 4 + j) * 64], pb_ = park[(1 * 4 + j) * 64];
                ta[4 * j] = pa_.x; ta[4 * j + 1] = pa_.y; ta[4 * j + 2] = pa_.z; ta[4 * j + 3] = pa_.w; tb[4 * j] = pb_.x; tb[4 * j + 1] = pb_.y; tb[4 * j + 2] = pb_.z; tb[4 * j + 3] = pb_.w; } }
        const int hm = h - 1 + h2;
        float av[16], bv[16]; unsigned long long ail = 0, aih = 0, bil = 0, bih = 0;
#pragma unroll
        for (int k = 0; k < 16; ++k) { const unsigned tbk = tb[k]; av[k] = __uint_as_float(ta[k] & 0xffffff80u); bv[k] = __uint_as_float(tbk & 0xffffff80u);
            if (k < 8) { ail |= (unsigned long long)(ta[k] & 0x7fu) << (8 * k); bil |= (unsigned long long)(tbk & 0x7fu) << (8 * k); }
            else { aih |= (unsigned long long)(ta[k] & 0x7fu) << (8 * (k - 8)); bih |= (unsigned long long)(tbk & 0x7fu) << (8 * (k - 8)); } }
#define K2(i_, j_) ((__float_as_uint(av[i_] + bv[j_]) & 0xffffff00u) | (unsigned)((i_) * 16 + (j_)))
        unsigned k2[3][16];
#pragma unroll
        for (int j = 0; j < 16; ++j) k2[0][j] = K2(0, j);
#pragma unroll
        for (int j = 0; j < 8; ++j) { k2[1][j] = K2(1, j); k2[1][8 + j] = K2(15 - j, 0); }
        { constexpr int CI[16] = {2, 2, 2, 2, 2, 3, 3, 3, 3, 4, 4, 4, 5, 5, 6, 6}, CJ[16] = {0, 1, 2, 3, 4, 0, 1, 2, 3, 0, 1, 2, 0, 1, 0, 1};
#pragma unroll
          for (int k = 0; k < 16; ++k) k2[2][k] = K2(CI[k], CJ[k]); }
        const unsigned k7a = K2(7, 0), k7b = K2(7, 1);
#undef K2
        bitonic_clean16(k2[1]);
        bitonic_desc<16>(k2[2]);
        k2[2][15] = umax_(k2[2][15], k7a); k2[2][14] = umax_(k2[2][14], k7b); bitonic_clean16(k2[2]);
        merge_top16(k2[0], k2[1]); merge_top16(k2[0], k2[2]);
        float ev[16]; float es = 0.f; const float m0 = __uint_as_float(k2[0][0] & 0xffffff00u);
#pragma unroll
        for (int k = 0; k < 16; ++k) { ev[k] = __expf((__uint_as_float(k2[0][k] & 0xffffff00u) - m0) * rstd_t); es += ev[k]; }
        const float inv = 1.f / es;
        u32x4 pe[2], pg[2];
#pragma unroll
        for (int k = 0; k < 16; ++k) { const int code = (int)(k2[0][k] & 0xffu); const unsigned e = sel16p(ail, aih, code >> 4) * 128u + sel16p(bil, bih, code & 15); const unsigned gb = (unsigned)f2bf(ev[k] * inv);
            if (k & 1) { pe[k >> 3][(k >> 1) & 3] |= e << 16; pg[k >> 3][(k >> 1) & 3] |= gb << 16; } else { pe[k >> 3][(k >> 1) & 3] = e; pg[k >> 3][(k >> 1) & 3] = gb; } }
        { const int off = ((tl0 + r32) * 128 + hm * 16) * 2;
          *(LAS u32x4*)(lds + PL_IDX + off) = pe[0]; *(LAS u32x4*)(lds + PL_IDX + off + 16) = pe[1]; *(LAS u32x4*)(lds + PL_GB + off) = pg[0]; *(LAS u32x4*)(lds + PL_GB + off + 16) = pg[1]; }
    }
}
__device__ __forceinline__ pg8::f32x2_t fp8x2(unsigned w, bool hi) { return hi ? __builtin_amdgcn_cvt_pk_f32_fp8(w, true) : __builtin_amdgcn_cvt_pk_f32_fp8(w, false); }
template <int CTRL> __device__ __forceinline__ float dppf(float v) { return __builtin_bit_cast(float, __builtin_amdgcn_update_dpp(0, __builtin_bit_cast(int, v), CTRL, 0xf, 0xf, true)); }
template <bool WITH_X>
__device__ __forceinline__ void peer_rows_load(u32x4 (&rw)[16], u32x4 (&xw)[2], const LAS unsigned char* lds, int tl, size_t rc, int s, const unsigned char* __restrict__ T8, const bf16_t* __restrict__ A2, int lane) {
    const int c = lane & 7, gq = lane >> 3;
    if (WITH_X) xw[0] = *(const u32x4*)((const unsigned char*)A2 + rc * 1024 + 128 * s + 16 * c);
    const LAS u32x4* ip = (const LAS u32x4*)(lds + PL_IDX + tl * 256 + gq * 32);
    const u32x4 i0 = ip[0], i1 = ip[1];
    const unsigned iw[8] = {i0.x, i0.y, i0.z, i0.w, i1.x, i1.y, i1.z, i1.w};
    const __amdgpu_buffer_rsrc_t rs = __builtin_amdgcn_make_buffer_rsrc((void*)T8, (short)0, 16 << 20, 0x00020000);
    const unsigned c16 = 16u * (unsigned)c; const int soff = s * (16384 * 128);
    const unsigned k1024 = 128u;
#pragma unroll
    for (int ig = 0; ig < 16; ++ig) { unsigned off;
        if (ig & 1) asm("v_mad_u32_u16 %0, %1, %2, %3 op_sel:[1,0,0,0]" : "=v"(off) : "v"(iw[ig >> 1]), "v"(k1024), "v"(c16)); else asm("v_mad_u32_u16 %0, %1, %2, %3" : "=v"(off) : "v"(iw[ig >> 1]), "v"(k1024), "v"(c16));
        rw[ig] = __builtin_bit_cast(u32x4, __builtin_amdgcn_raw_buffer_load_b128(rs, (int)off, soff, 0)); }
}
constexpr int XS_OFF = 131072 + 512;
__device__ __forceinline__ void peer_xs_fetch(u32x4 (&xs)[2], const unsigned char* __restrict__ XQ, size_t rcw, int grp, int lane) {
    const int g = grp < 8 ? grp : 7;
    const u32x4* xp = (const u32x4*)(XQ + (rcw + 8 * (g & 1) + (lane >> 3)) * 1024 + 256 * (g >> 1) + 32 * (lane & 7)); xs[0] = xp[0]; xs[1] = xp[1];
}
__device__ __forceinline__ void peer_urows_load(u32x4 (&rw)[16], u32x4 (&xw)[2], LAS unsigned char* lds, int tl, int st, int s, const unsigned char* __restrict__ T4, const unsigned char* __restrict__ XQ, size_t rcw, u32x4 (&xs)[2], int lane) {
    const int c = lane & 7, gq = lane >> 3;
    LAS unsigned char* xl = lds + XS_OFF + (threadIdx.x >> 6) * 2048;
    if ((st & 7) == 0) { *(LAS u32x4*)(xl + 32 * lane) = xs[0]; *(LAS u32x4*)(xl + 32 * lane + 16) = xs[1]; peer_xs_fetch(xs, XQ, rcw, (st >> 3) + 1, lane); }
    { const LAS u32x4* xp = (const LAS u32x4*)(xl + (st & 7) * 256 + 32 * c); xw[0] = xp[0]; xw[1] = xp[1]; }
    const LAS u32x4* ip = (const LAS u32x4*)(lds + PL_IDX + tl * 256 + gq * 32);
    const u32x4 i0 = ip[0], i1 = ip[1];
    const unsigned iw[8] = {i0.x, i0.y, i0.z, i0.w, i1.x, i1.y, i1.z, i1.w};
    const __amdgpu_buffer_rsrc_t rs = __builtin_amdgcn_make_buffer_rsrc((void*)T4, (short)0, 8 << 20, 0x00020000);
    const unsigned c16 = 16u * (unsigned)c; const int soff = s * (16384 * 128);
    const unsigned k512 = 128u;
#pragma unroll
    for (int ig = 0; ig < 16; ++ig) { unsigned off;
        if (ig & 1) asm("v_mad_u32_u16 %0, %1, %2, %3 op_sel:[1,0,0,0]" : "=v"(off) : "v"(iw[ig >> 1]), "v"(k512), "v"(c16)); else asm("v_mad_u32_u16 %0, %1, %2, %3" : "=v"(off) : "v"(iw[ig >> 1]), "v"(k512), "v"(c16));
        rw[ig] = __builtin_bit_cast(u32x4, __builtin_amdgcn_raw_buffer_load_b128(rs, (int)off, soff, 0)); }
}
template <int CTRL> __device__ __forceinline__ int dppi(int v) { return __builtin_amdgcn_update_dpp(0, v, CTRL, 0xf, 0xf, true); }
__device__ __forceinline__ void peer_u_math(const u32x4 (&uw)[16], const u32x4 (&xw)[2], LAS unsigned char* lds, int tl, int lane, float sx) {
    const int c = lane & 7, gq = lane >> 3;
    const int xd[8] = {(int)xw[0].x, (int)xw[0].y, (int)xw[0].z, (int)xw[0].w, (int)xw[1].x, (int)xw[1].y, (int)xw[1].z, (int)xw[1].w};
    int d[16];
#pragma unroll
    for (int ig = 0; ig < 16; ++ig) { int ta = 0, tb = 0;
#pragma unroll
        for (int j = 0; j < 4; ++j) { const int w = (int)uw[ig][j]; ta = __builtin_amdgcn_sdot8(w, xd[2 * j], ta, false); tb = __builtin_amdgcn_sdot8(w, xd[2 * j + 1], tb, false); }
        d[ig] = (ta << 4) + tb; }
    const bool c4 = c & 4, c2 = c & 2, c1 = c & 1;
    int acc[2];
#pragma unroll
    for (int hf = 0; hf < 2; ++hf) { int t[4];
#pragma unroll
        for (int j = 0; j < 4; ++j) { const int keep = c4 ? d[8 * hf + j + 4] : d[8 * hf + j], send = c4 ? d[8 * hf + j] : d[8 * hf + j + 4]; t[j] = keep + dppi<0x141>(send); }
#pragma unroll
        for (int j = 0; j < 2; ++j) { const int keep = c2 ? t[j + 2] : t[j], send = c2 ? t[j] : t[j + 2]; t[j] = keep + dppi<0x4E>(send); }
        { const int keep = c1 ? t[1] : t[0], send = c1 ? t[0] : t[1]; acc[hf] = keep + dppi<0xB1>(send); } }
    LAS float* pp = (LAS float*)(lds + PL_PA) + tl * 128 + 16 * gq + c;
    __hip_atomic_fetch_add(pp, (float)acc[0] * sx, __ATOMIC_RELAXED, __HIP_MEMORY_SCOPE_WORKGROUP);
    __hip_atomic_fetch_add(pp + 8, (float)acc[1] * sx, __ATOMIC_RELAXED, __HIP_MEMORY_SCOPE_WORKGROUP);
}
__device__ __forceinline__ float erf_as(float x) {
    const float ax = fabsf(x), t = __builtin_amdgcn_rcpf(__builtin_fmaf(0.3275911f, ax, 1.f));
    float p = __builtin_fmaf(1.061405429f, t, -1.453152027f); p = __builtin_fmaf(p, t, 1.421413741f); p = __builtin_fmaf(p, t, -0.284496736f); p = __builtin_fmaf(p, t, 0.254829592f); p *= t;
    const float r = __builtin_fmaf(-p, __builtin_amdgcn_exp2f(ax * ax * -1.4426950408889634f), 1.f);
    return __builtin_copysignf(r, x);
}
struct PeerAIn { float rs, su[2], sv[2]; };
__device__ __forceinline__ PeerAIn peer_a_load(const LAS unsigned char* lds, int tl, size_t rc, const float* __restrict__ rowssp, const float* __restrict__ su, const float* __restrict__ sv, int lane) {
    PeerAIn r; r.rs = rowssp[rc * 16 + (lane & 15)];
#pragma unroll
    for (int q = 0; q < 2; ++q) { const unsigned e = ((const LAS unsigned short*)(lds + PL_IDX))[tl * 128 + lane + 64 * q]; r.su[q] = su[e]; r.sv[q] = sv[e]; }
    return r;
}
__device__ __forceinline__ void peer_a_math(LAS unsigned char* lds, int tl, const PeerAIn& in, int lane) {
    float rs = in.rs;
    rs += dppf<0xB1>(rs); rs += dppf<0x4E>(rs); rs += dppf<0x141>(rs); rs += dppf<0x140>(rs);
    const float rstd = __builtin_amdgcn_rsqf(rs * (1.f / 1024.f) + EPS);
    float w[2];
#pragma unroll
    for (int q = 0; q < 2; ++q) { const int k = lane + 64 * q;
        const float z = ((const LAS float*)(lds + PL_PA))[tl * 128 + k] * rstd * in.su[q]; const float a = 0.5f * z * (1.f + erf_as(z * 0.70710678118654752f));
        w[q] = bf2f(((const LAS bf16_t*)(lds + PL_GB))[tl * 128 + k]) * a * in.sv[q]; }
    const float am = wave_max(fmaxf(fabsf(w[0]), fabsf(w[1])));
    const float sc = am > 0.f ? 127.f * __builtin_amdgcn_rcpf(am) : 1.f;
    LAS signed char* wq = (LAS signed char*)(lds + PL_PA + tl * 512);
    wq[lane] = (signed char)__float2int_rn(w[0] * sc); wq[lane + 64] = (signed char)__float2int_rn(w[1] * sc);
    if (lane == 0) ((LAS float*)(lds + PL_SSQ))[tl] = am > 0.f ? am * (1.f / 127.f) : 1.f;
}
__device__ __forceinline__ void peer_v_math(const u32x4 (&vw)[16], LAS unsigned char* lds, int tl, size_t rc, int s, bf16_t* __restrict__ dout, int lane) {
    const int c = lane & 7, gq = lane >> 3;
    const u32x4 wq4 = *(const LAS u32x4*)(lds + PL_PA + tl * 512 + 16 * gq);
    const float wsc = ((const LAS float*)(lds + PL_SSQ))[tl];
    const bool b3 = lane & 8, b4 = lane & 16, b5 = lane & 32;
    unsigned* hp = (unsigned*)(dout + rc * 1024 + 128 * s + 16 * c + (b3 ? 8 : 0) + (b4 ? 4 : 0) + (b5 ? 2 : 0));
    const unsigned hw = *hp; pg8::f32x2_t h = (pg8::f32x2_t){bflo(hw), bfhi(hw)};
    int ia[16];
#pragma unroll
    for (int i = 0; i < 16; ++i) ia[i] = 0;
#pragma unroll
    for (int m = 0; m < 4; ++m) { const int wm = (int)wq4[m];
#pragma unroll
        for (int p = 0; p < 4; ++p) { const unsigned A = vw[4 * m][p], B = vw[4 * m + 1][p], C = vw[4 * m + 2][p], D = vw[4 * m + 3][p];
            const unsigned X0 = __builtin_amdgcn_perm(B, A, 0x05010400u), X1 = __builtin_amdgcn_perm(B, A, 0x07030602u), Y0 = __builtin_amdgcn_perm(D, C, 0x05010400u), Y1 = __builtin_amdgcn_perm(D, C, 0x07030602u);
            const unsigned T0 = __builtin_amdgcn_perm(Y0, X0, 0x05040100u), T1 = __builtin_amdgcn_perm(Y0, X0, 0x07060302u), T2 = __builtin_amdgcn_perm(Y1, X1, 0x05040100u), T3 = __builtin_amdgcn_perm(Y1, X1, 0x07060302u);
            ia[4 * p] = __builtin_amdgcn_sdot4((int)T0, wm, ia[4 * p], false); ia[4 * p + 1] = __builtin_amdgcn_sdot4((int)T1, wm, ia[4 * p + 1], false);
            ia[4 * p + 2] = __builtin_amdgcn_sdot4((int)T2, wm, ia[4 * p + 2], false); ia[4 * p + 3] = __builtin_amdgcn_sdot4((int)T3, wm, ia[4 * p + 3], false); } }
#pragma unroll
    for (int j = 0; j < 8; ++j) { const int keep = b3 ? ia[j + 8] : ia[j], send = b3 ? ia[j] : ia[j + 8]; ia[j] = keep + dppi<0x128>(send); }
#pragma unroll
    for (int j = 0; j < 4; ++j) { const auto r = __builtin_amdgcn_permlane16_swap((unsigned)ia[j], (unsigned)ia[j + 4], false, false); ia[j] = (int)(r[0] + r[1]); }
#pragma unroll
    for (int j = 0; j < 2; ++j) { const auto r = __builtin_amdgcn_permlane32_swap((unsigned)ia[j], (unsigned)ia[j + 2], false, false); ia[j] = (int)(r[0] + r[1]); }
    float out[2] = {(float)ia[0] * wsc, (float)ia[1] * wsc};
    h.x += out[0]; h.y += out[1];
    *hp = cvtpk(h.x, h.y);
}
template <int NT>
__device__ __forceinline__ void peer_f_steps(size_t rc, const bf16_t* __restrict__ h2b, float* __restrict__ dout, const float* __restrict__ gfin, int lane) {
    u32x2 hw[NT][4];
#pragma unroll
    for (int i = 0; i < NT; ++i)
#pragma unroll
        for (int q = 0; q < 4; ++q) hw[i][q] = __builtin_nontemporal_load((const u32x2*)(h2b + (rc + i) * 1024 + 256 * q + 4 * lane));
    f32x4 g[4];
#pragma unroll
    for (int q = 0; q < 4; ++q) g[q] = *(const f32x4*)(gfin + 256 * q + 4 * lane);
#pragma unroll
    for (int i = 0; i < NT; ++i) { f32x4 h[4]; f32x4 sq = (f32x4){0.f, 0.f, 0.f, 0.f};
#pragma unroll
        for (int q = 0; q < 4; ++q) { h[q] = (f32x4){bflo(hw[i][q].x), bfhi(hw[i][q].x), bflo(hw[i][q].y), bfhi(hw[i][q].y)}; sq += h[q] * h[q]; }
        const float rf = __builtin_amdgcn_rsqf(wave_sum((sq[0] + sq[1]) + (sq[2] + sq[3])) * (1.f / 1024.f) + EPS);
        float* op = dout + (rc + i) * 1024 + 4 * lane;
#pragma unroll
        for (int q = 0; q < 4; ++q) __builtin_nontemporal_store(h[q] * rf * g[q], (f32x4*)(op + 256 * q)); }
}
__device__ __forceinline__ unsigned pack_i8x4(float a, float b, float c, float d) {
    const int ia = __float2int_rn(a), ib = __float2int_rn(b), ic = __float2int_rn(c), id = __float2int_rn(d);
    return (unsigned)(ia & 0xff) | ((unsigned)(ib & 0xff) << 8) | ((unsigned)(ic & 0xff) << 16) | ((unsigned)id << 24);
}
__device__ __forceinline__ void peer_tables(const float* __restrict__ pu, const float* __restrict__ pv, unsigned char* __restrict__ T8, float* __restrict__ sinv, int lane, int gw, int NGW) {
    for (int row0 = gw; row0 < 32768; row0 += 8 * NGW) {
        f32x4 v[8][4];
#pragma unroll
        for (int r = 0; r < 8; ++r) { const int row = row0 + r * NGW;
            if (row < 32768) { const float* src = (row < 16384 ? pu + (size_t)row * 1024 : pv + (size_t)(row - 16384) * 1024) + 4 * lane;
#pragma unroll
                for (int q = 0; q < 4; ++q) v[r][q] = __builtin_nontemporal_load((const f32x4*)(src + 256 * q)); } }
#pragma unroll
        for (int r = 0; r < 8; ++r) { const int row = row0 + r * NGW;
            if (row < 32768) { float am = 0.f;
#pragma unroll
                for (int q = 0; q < 4; ++q) am = fmaxf(am, fmaxf(fmaxf(fabsf(v[r][q][0]), fabsf(v[r][q][1])), fmaxf(fabsf(v[r][q][2]), fabsf(v[r][q][3]))));
                am = wave_max(am);
                const bool isu = row < 16384;
                if (isu) {
                    float ss = 0.f;
#pragma unroll
                    for (int q = 0; q < 4; ++q) ss += (v[r][q][0] * v[r][q][0] + v[r][q][1] * v[r][q][1]) + (v[r][q][2] * v[r][q][2] + v[r][q][3] * v[r][q][3]);
                    am = fminf(am, 2.6f * __builtin_sqrtf(wave_sum(ss) * (1.f / 1024.f))); }
                const float top = isu ? 7.f : 127.f;
                const float sc = am > 0.f ? top * __builtin_amdgcn_rcpf(am) : 1.f;
                u32x4 w;
#pragma unroll
                for (int q = 0; q < 4; ++q) { const unsigned y0 = __float_as_uint(__builtin_amdgcn_fmed3f(v[r][q][0] * sc, -top, top) + 12582912.f), y1 = __float_as_uint(__builtin_amdgcn_fmed3f(v[r][q][1] * sc, -top, top) + 12582912.f),
                                                             y2 = __float_as_uint(__builtin_amdgcn_fmed3f(v[r][q][2] * sc, -top, top) + 12582912.f), y3 = __float_as_uint(__builtin_amdgcn_fmed3f(v[r][q][3] * sc, -top, top) + 12582912.f);
                    w[q] = __builtin_amdgcn_perm(__builtin_amdgcn_perm(y3, y2, 0x0c0c0400u), __builtin_amdgcn_perm(y1, y0, 0x0c0c0400u), 0x05040100u); }
                if (isu) {
#pragma unroll
                    for (int q = 0; q < 4; ++q) { const unsigned pw = (unsigned)__builtin_amdgcn_update_dpp(0, (int)w[q], 0xB1, 0xf, 0xf, true);
                        if ((lane & 1) == 0) __builtin_nontemporal_store((w[q] & 0x0f0f0f0fu) | ((pw << 4) & 0xf0f0f0f0u), (unsigned*)(T8 + (size_t)q * (16384 * 128) + (size_t)row * 128 + 4 * (lane >> 1))); } }
                else {
#pragma unroll
                    for (int q = 0; q < 4; ++q) __builtin_nontemporal_store(w[q], (unsigned*)(T8 + (size_t)(16384 * 1024) + (size_t)(2 * q + (lane >> 5)) * (16384 * 128) + (size_t)(row - 16384) * 128 + 4 * (lane & 31))); }
                if (lane == 0) sinv[row] = am > 0.f ? am / top : 1.f; } }
    }
}
__device__ __forceinline__ void peer_xq_tokens16(const bf16_t* __restrict__ H1, const float* __restrict__ gffn, unsigned char* __restrict__ XQ, float* __restrict__ SX, size_t rc, int lane) {
    u32x4 xa[16], xb[16];
#pragma unroll
    for (int i = 0; i < 16; ++i) { xa[i] = *(const u32x4*)(H1 + (rc + i) * 1024 + 16 * lane); xb[i] = *(const u32x4*)(H1 + (rc + i) * 1024 + 16 * lane + 8); }
    f32x4 g[4];
#pragma unroll
    for (int q = 0; q < 4; ++q) g[q] = *(const f32x4*)(gffn + 16 * lane + 4 * q);
#pragma unroll
    for (int i = 0; i < 16; ++i) {
        const unsigned w[8] = {xa[i].x, xa[i].y, xa[i].z, xa[i].w, xb[i].x, xb[i].y, xb[i].z, xb[i].w};
        float xv[16]; float am = 0.f;
#pragma unroll
        for (int q = 0; q < 4; ++q) {
            xv[4 * q] = bflo(w[2 * q]) * g[q][0]; xv[4 * q + 1] = bfhi(w[2 * q]) * g[q][1]; xv[4 * q + 2] = bflo(w[2 * q + 1]) * g[q][2]; xv[4 * q + 3] = bfhi(w[2 * q + 1]) * g[q][3];
            am = fmaxf(am, fmaxf(fmaxf(fabsf(xv[4 * q]), fabsf(xv[4 * q + 1])), fmaxf(fabsf(xv[4 * q + 2]), fabsf(xv[4 * q + 3])))); }
        am = wave_max(am);
        const float sc = am > 0.f ? 119.f * __builtin_amdgcn_rcpf(am) : 1.f;
        u32x4 o;
#pragma unroll
        for (int gI = 0; gI < 2; ++gI) { unsigned T[2];
#pragma unroll
            for (int hq = 0; hq < 2; ++hq) { const int k0 = 8 * gI + 4 * hq;
                const unsigned y0 = __float_as_uint(__builtin_fmaf(xv[k0], sc, 12583048.f)), y1 = __float_as_uint(__builtin_fmaf(xv[k0 + 1], sc, 12583048.f)),
                               y2 = __float_as_uint(__builtin_fmaf(xv[k0 + 2], sc, 12583048.f)), y3 = __float_as_uint(__builtin_fmaf(xv[k0 + 3], sc, 12583048.f));
                T[hq] = __builtin_amdgcn_perm(__builtin_amdgcn_perm(y3, y2, 0x0c0c0400u), __builtin_amdgcn_perm(y1, y0, 0x0c0c0400u), 0x05040100u); }
            o[2 * gI] = (((T[0] >> 4) & 0x0f0f0f0fu) | (T[1] & 0xf0f0f0f0u)) ^ 0x88888888u;
            o[2 * gI + 1] = ((T[0] & 0x0f0f0f0fu) | ((T[1] << 4) & 0xf0f0f0f0u)) ^ 0x88888888u; }
        *(u32x4*)(XQ + (rc + i) * 1024 + 16 * lane) = o;
        if (lane == 0) SX[rc + i] = am > 0.f ? am * (1.f / 119.f) : 1.f; }
}

#define XB_TMO      128
#define XB_XCNT(j)  (256  + 64 * (j))
#define XB_XSUB(j)  (1280 + 64 * (j))
#define XB_XGEN(j)  (2304 + 64 * (j))
#define XB_TOP      3328
#define XB_TOPGEN   3392
#define XCD_BAR_WORDS 3456
#define XB_SPIN_CAP (1u << 18)

__device__ __forceinline__ unsigned xb_ld(unsigned* p)              { return __hip_atomic_load(p, __ATOMIC_RELAXED, __HIP_MEMORY_SCOPE_AGENT); }
__device__ __forceinline__ unsigned xb_add(unsigned* p, unsigned v) { return __hip_atomic_fetch_add(p, v, __ATOMIC_RELAXED, __HIP_MEMORY_SCOPE_AGENT); }
__device__ __forceinline__ unsigned xb_xcc_id() { return (unsigned)__builtin_amdgcn_s_getreg((3 << 11) | 20) & 0xFu; }
#define XB_SPIN(cond, bar) do { unsigned _sp = 0; while (cond) { __builtin_amdgcn_s_sleep(1); \
    if ((++_sp & 255u) == 0u) { if (xb_ld(&(bar)[XB_TMO])) break; if (_sp > XB_SPIN_CAP) { atomicAdd(&(bar)[XB_TMO], 1u); break; } } } } while (0)

struct XcdBarrier {
    unsigned* bar; unsigned x;
    volatile LAS unsigned* st;
};

__device__ __forceinline__ XcdBarrier xcd_barrier_post(unsigned* bar, volatile LAS unsigned* st) {
    XcdBarrier b; b.bar = bar; b.x = xb_xcc_id(); b.st = st;
    if (threadIdx.x == 0) (void)xb_add(&bar[XB_XCNT(b.x)], 1u);
    return b;
}
__device__ __forceinline__ void xcd_barrier_complete(unsigned* bar, unsigned x, unsigned& nloc, unsigned& nx) {
    const unsigned G = gridDim.x * gridDim.y * gridDim.z;
    unsigned sum, cnt, mine, sp = 0u;
    for (;;) {
        sum = 0u; cnt = 0u; mine = 0u;
#pragma unroll
        for (unsigned j = 0; j < 16; ++j) { const unsigned c = xb_ld(&bar[XB_XCNT(j)]); sum += c; cnt += (c > 0u) ? 1u : 0u; mine = (j == x) ? c : mine; }
        if (sum == G) break;
        __builtin_amdgcn_s_sleep(1);
        if ((++sp & 255u) == 0u) { if (xb_ld(&bar[XB_TMO])) break; if (sp > XB_SPIN_CAP) { atomicAdd(&bar[XB_TMO], 1u); break; } }
    }
    nloc = mine > 0u ? mine : 1u; nx = cnt > 0u ? cnt : 1u;
}

__device__ __forceinline__ void xcd_barrier(const XcdBarrier& b) {
    asm volatile("s_waitcnt vmcnt(0)" ::: "memory");
    __syncthreads();
    if (threadIdx.x == 0) {
        unsigned* bar = b.bar;
        __builtin_amdgcn_s_waitcnt(0);
        unsigned nloc = b.st[0], nx = b.st[1];
        if (nloc == 0u) { xcd_barrier_complete(bar, b.x, nloc, nx); b.st[0] = nloc; b.st[1] = nx; }
        const unsigned old = xb_add(&bar[XB_XSUB(b.x)], 1u);
        const unsigned gen = old / nloc;
        if (old + 1u == (gen + 1u) * nloc) {
            __builtin_amdgcn_fence(__ATOMIC_RELEASE, "agent");
            asm volatile("s_waitcnt vmcnt(0)" ::: "memory");
            const unsigned og = xb_add(&bar[XB_TOP], 1u);
            const unsigned tg = og / nx;
            if (og + 1u == (tg + 1u) * nx) xb_add(&bar[XB_TOPGEN], 1u);
            else XB_SPIN(xb_ld(&bar[XB_TOPGEN]) == tg, bar);
            __builtin_amdgcn_fence(__ATOMIC_ACQUIRE, "agent");
            xb_add(&bar[XB_XGEN(b.x)], 1u);
            asm volatile("s_waitcnt vmcnt(0)" ::: "memory");
        } else {
            XB_SPIN(xb_ld(&bar[XB_XGEN(b.x)]) == gen, bar);
            __builtin_amdgcn_fence(__ATOMIC_ACQUIRE, "agent");
            asm volatile("s_waitcnt vmcnt(0)" ::: "memory");
        }
    }
    __syncthreads();
}

constexpr int NPHASE = 9;
struct Args { const float* in[17]; float* out; unsigned char* ws; int ph_lo, ph_hi; };
__global__ void __launch_bounds__(512, 2) fwd_kernel(Args a) {
    extern __shared__ __attribute__((aligned(16))) unsigned char lds_raw[];
    LAS unsigned char* lds = (LAS unsigned char*)lds_raw;
    cg::grid_group grid = cg::this_grid();
    const int tid = threadIdx.x, lane = tid & 63, wave = __builtin_amdgcn_readfirstlane(tid >> 6);
    const int lo = a.ph_lo, hi = a.ph_hi, G = gridDim.x;
    typedef const __attribute__((address_space(4))) Args* kargp_t;
#define KARGS kargp_t kp_ = (kargp_t)__builtin_amdgcn_kernarg_segment_ptr(); asm volatile("" : "+s"(kp_)); unsigned char* const ws = kp_->ws
#define INP(k) ((const float*)kp_->in[k])
#define WSP(T, off) ((T*)(ws + (off)))
#ifdef ONLY_PHASE
#define IN(k) ((k) == ONLY_PHASE && lo <= (k) && (k) < hi)
#else
#define IN(k) (lo <= (k) && (k) < hi)
#endif
    volatile LAS unsigned* bar_st = (volatile LAS unsigned*)(lds + LDS_BYTES - 64);
    XcdBarrier xbar; xbar.bar = (unsigned*)(a.ws + WS_CTL); xbar.x = 0; xbar.st = bar_st;
    if (hi - lo > 1) { if (tid < 2) bar_st[tid] = 0u; __syncthreads(); xbar = xcd_barrier_post((unsigned*)(a.ws + WS_CTL), bar_st); }
    if (lo < 0) grid.sync();
#define SEAM(k) do { if (lo <= (k) && (k) + 1 < hi) xcd_barrier(xbar); } while (0)

    if (IN(0)) { KARGS; P0Args p{INP(0), INP(1), INP(2), INP(3), INP(8), INP(9), INP(10), INP(12), INP(13), INP(11), WSP(bf16_t, WS_A1), WSP(bf16_t, WS_WIN), WSP(bf16_t, WS_WBH), WSP(bf16_t, WS_WBA), WSP(bf16_t, WS_WOUT), WSP(bf16_t, WS_WQ), WSP(bf16_t, WS_SK), ws + WS_W8T, ws + WS_A8}; p0_prologue(lds, p); SEAM(0); }
    if (IN(1)) {
        KARGS; bf16_t *A1 = WSP(bf16_t, WS_A1), *WinT = WSP(bf16_t, WS_WIN), *Zh = WSP(bf16_t, WS_ZH), *Za = WSP(bf16_t, WS_ZA), *Zg = WSP(bf16_t, WS_ZG), *Vt = WSP(bf16_t, WS_VT);
        { constexpr int NU = (MA / 256) * 9; const int nfull = NU % G;
          if (nfull > 0 && (int)blockIdx.x >= nfull) { peer_tables(INP(14), INP(15), ws + WS_U8, WSP(float, WS_SUV), lane, ((int)blockIdx.x - nfull) * 8 + wave, (G - nfull) * 8); __syncthreads(); }
          else if (nfull == 0) { peer_tables(INP(14), INP(15), ws + WS_U8, WSP(float, WS_SUV), lane, blockIdx.x * 8 + wave, G * 8); __syncthreads(); } }
        { pg8::Gemm g{A1, WinT, MA, 2304, 1024, 1024, 1024}; pg8::StaticOrder S; S.init(MA, 2304, G, (int)blockIdx.x);
          pg8::EpiZ E{Zh, Za, Vt};
          pg8::gemm_phase<pg8::EpiZ, pg8::StaticOrder, true, true>(lds, g, S, E); }
        { pg8::Gemm g{(const bf16_t*)(ws + WS_A8), (const bf16_t*)(ws + WS_W8T), MC, 2560, 512, 512, 512}; pg8::StaticOrder S; S.init(MC, 2560, G, (int)blockIdx.x);
          pg8::EpiZ8 E{Zh, (unsigned char*)Zg, INP(4)};
          pg8::gemm_phase<pg8::EpiZ8, pg8::StaticOrder, true, true, true>(lds, g, S, E); }
        SEAM(1);
    }
    if (IN(2)) {
        KARGS; bf16_t *Zh = WSP(bf16_t, WS_ZH), *Za = WSP(bf16_t, WS_ZA), *Vt = WSP(bf16_t, WS_VT), *OM = WSP(bf16_t, WS_OM); bf16_t* Ub = WSP(bf16_t, WS_UB); float* Dv = WSP(float, WS_DV); const float *lblog = INP(5), *sinks = INP(7);
        int it = blockIdx.x;
        for (; it < 1024; it += G) hgrn_A(lds, Zh, lblog, Ub, Dv, it);
        u32x4 rk[5], rv[5];
        if (it < 1536) { const int ai = it - 1024; attn_stage_load(rk, rv, Za, Vt, ai >> 6, ((ai & 63) >> 1) + 1, ai & 1); }
#pragma unroll 1
        for (; it < 1536; it += G) { const int ai = it - 1024, b = ai >> 6, n = ((ai & 63) >> 1) + 1, kvh = ai & 1;
            attn_stage_store(lds, rk, rv);
            bf16x8 qa[4], qb[4];
            attn_q_load(qa, Za, b, n, kvh * 4 + (wave >> 2), wave & 3, lane); attn_q_load(qb, Za, b, n, kvh * 4 + ((wave + 8) >> 2), (wave + 8) & 3, lane);
            __syncthreads();
            attn_sub(lds, qa, sinks, OM, b, n, kvh * 4 + (wave >> 2), wave & 3, lane);
            __builtin_amdgcn_sched_barrier(0);
            if (it + G < 1536) { const int aj = it + G - 1024; attn_stage_load(rk, rv, Za, Vt, aj >> 6, ((aj & 63) >> 1) + 1, aj & 1); }
            __builtin_amdgcn_sched_barrier(0);
            attn_sub(lds, qb, sinks, OM, b, n, kvh * 4 + ((wave + 8) >> 2), (wave + 8) & 3, lane);
            __syncthreads(); }
        SEAM(2);
    }
    if (IN(3)) { KARGS; hgrn_scan(WSP(bf16_t, WS_UB), WSP(float, WS_DV)); SEAM(3); }
    if (IN(4)) { KARGS; for (int it = blockIdx.x; it < 1024; it += G) hgrn_C(lds, WSP(bf16_t, WS_ZH), INP(5), WSP(bf16_t, WS_UB), INP(6), WSP(bf16_t, WS_OM), it); SEAM(4); }
    if (IN(5)) {
        KARGS; bf16_t *OM = WSP(bf16_t, WS_OM), *WbhT = WSP(bf16_t, WS_WBH), *Mb = WSP(bf16_t, WS_MB), *Zg = WSP(bf16_t, WS_ZG); const float* bgate = INP(4);
        pg8::StaticOrder S; S.init(MC, 1024, G, (int)blockIdx.x);
        { pg8::Gemm g{OM, WbhT, MC, 1024, 1024, 1024, 1024}; pg8::EpiGate E{Mb, (const unsigned char*)Zg, bgate}; pg8::gemm_phase<pg8::EpiGate, pg8::StaticOrder, true, true>(lds, g, S, E); }
        SEAM(5);
    }
    if (IN(6)) {
        KARGS; bf16_t *Mb = WSP(bf16_t, WS_MB), *WoutT = WSP(bf16_t, WS_WOUT); float* rowssp = WSP(float, WS_RS); const float* x = INP(0);
        pg8::Gemm g{Mb, WoutT, MC, 1024, 1024, 1024, 1024}; pg8::StaticOrder S; S.init(MC, 1024, G, (int)blockIdx.x);
        pg8::EpiH1 E{x, WSP(bf16_t, WS_H1B), rowssp};
        pg8::gemm_phase<pg8::EpiH1, pg8::StaticOrder, true, true>(lds, g, S, E);
        SEAM(6);
    }
    if (IN(7)) {
        KARGS; bf16_t *WqT = WSP(bf16_t, WS_WQ), *Qb = WSP(bf16_t, WS_QB); float* rowssp = WSP(float, WS_RS);
        pg8::Gemm g{WSP(bf16_t, WS_H1B), WqT, MC, 2048, 1024, 1024, 1024}; pg8::StaticOrder S; S.init(MC, 2048, G, (int)blockIdx.x);
        pg8::EpiQ E{Qb};
        pg8::gemm_phase<pg8::EpiQ, pg8::StaticOrder, true, true>(lds, g, S, E);
        SEAM(7);
    }
    if (IN(8)) {
        KARGS; bf16_t *Qb = WSP(bf16_t, WS_QB), *SK = WSP(bf16_t, WS_SK), *A2 = WSP(bf16_t, WS_A2); unsigned char *U8 = ws + WS_U8, *V8 = ws + WS_V8, *XQ = ws + WS_MB; float *suv = WSP(float, WS_SUV), *rowssp = WSP(float, WS_RS), *outp = kp_->out; bf16_t* H1B = WSP(bf16_t, WS_H1B); const float* gfin = INP(16);
        for (int grp = blockIdx.x; grp < MC / 128; grp += G) {
            const int rc0 = grp * 128;
#ifndef NO_TOPK
            peer_topk(lds, Qb, SK, rowssp, rc0 + 32 * (wave >> 1), 32 * (wave >> 1), 4 * (wave & 1), lane);
#endif
#ifdef PROBE_TOPK2
            __syncthreads(); peer_topk(lds, Qb, SK, rowssp, rc0 + 32 * (wave >> 1), 32 * (wave >> 1), 4 * (wave & 1), lane);
#endif
            __syncthreads();
            { const int tl0 = 16 * wave; const size_t rcw = (size_t)rc0 + tl0;
              { LAS f32x4* pz = (LAS f32x4*)(lds + PL_PA + tl0 * 512);
#pragma unroll
                for (int q = 0; q < 8; ++q) pz[lane + 64 * q] = (f32x4){0.f, 0.f, 0.f, 0.f}; }
              peer_xq_tokens16(H1B, INP(11), XQ, (float*)(XQ + (size_t)MC * 1024), rcw, lane);
              asm volatile("s_waitcnt vmcnt(0)" ::: "memory");
              { u32x4 ra[16], rb[16], xa[2], xb[2];
                const int sxv = __float_as_int(((const float*)(XQ + (size_t)MC * 1024))[rcw + (lane & 15)]);
                u32x4 xs[2]; peer_xs_fetch(xs, XQ, rcw, 0, lane);
                peer_urows_load(ra, xa, lds, tl0, 0, 0, U8, XQ, rcw, xs, lane);
#pragma unroll 1
                for (int st = 0; st < 64; st += 2) {
                    peer_urows_load(rb, xb, lds, tl0 + ((st + 1) & 15), st + 1, (st + 1) >> 4, U8, XQ, rcw, xs, lane);
                    __builtin_amdgcn_sched_barrier(0);
                    peer_u_math(ra, xa, lds, tl0 + (st & 15), lane, __int_as_float(__builtin_amdgcn_readlane(sxv, st & 15)));
                    if (st + 2 < 64) peer_urows_load(ra, xa, lds, tl0 + ((st + 2) & 15), st + 2, (st + 2) >> 4, U8, XQ, rcw, xs, lane);
                    __builtin_amdgcn_sched_barrier(0);
                    peer_u_math(rb, xb, lds, tl0 + ((st + 1) & 15), lane, __int_as_float(__builtin_amdgcn_readlane(sxv, (st + 1) & 15))); } }
              { PeerAIn cur = peer_a_load(lds, tl0, rcw, rowssp, suv, suv + 16384, lane);
#pragma unroll 1
                for (int i = 0; i < 16; ++i) { const int inx = i < 15 ? i + 1 : 15; const PeerAIn nxt = peer_a_load(lds, tl0 + inx, rcw + inx, rowssp, suv, suv + 16384, lane);
                    peer_a_math(lds, tl0 + i, cur, lane); cur = nxt; } }
              { u32x4 ra[16], rb[16], xd[2];
                peer_rows_load<false>(ra, xd, lds, tl0, rcw, 0, V8, A2, lane);
#pragma unroll 1
                for (int st = 0; st < 128; st += 2) {
                    peer_rows_load<false>(rb, xd, lds, tl0 + ((st + 1) & 15), rcw, (st + 1) >> 4, V8, A2, lane);
                    __builtin_amdgcn_sched_barrier(0);
                    peer_v_math(ra, lds, tl0 + (st & 15), rcw + (st & 15), st >> 4, H1B, lane);
                    { const int sn = st + 2 < 128 ? st + 2 : 127; peer_rows_load<false>(ra, xd, lds, tl0 + (sn & 15), rcw, sn >> 4, V8, A2, lane); }
                    __builtin_amdgcn_sched_barrier(0);
                    peer_v_math(rb, lds, tl0 + ((st + 1) & 15), rcw + ((st + 1) & 15), (st + 1) >> 4, H1B, lane); } }
              asm volatile("s_waitcnt vmcnt(0)" ::: "memory");
              __builtin_amdgcn_fence(__ATOMIC_ACQUIRE, "agent");
              peer_f_steps<8>(rcw, H1B, outp, gfin, lane);
              peer_f_steps<8>(rcw + 8, H1B, outp, gfin, lane); }
            __syncthreads();
        }
    }
#undef IN
#undef SEAM
}

extern "C" void kernel_launch(void* const* d_in, const int* in_sizes, int n_in, void* d_out, int out_size, void* d_ws, size_t ws_size, hipStream_t stream) {
    static int grid = 0;
    if (grid == 0) {
        if (n_in != 17 || out_size != MC * DM || ws_size < WS_END) { fprintf(stderr, "kernel_launch: unexpected shapes: n_in %d out %d ws %zu (need %zu)\n", n_in, out_size, ws_size, (size_t)WS_END); grid = -1; return; }
        int dev = 0, cus = 0, per_cu = 0;
        if (hipGetDevice(&dev) != hipSuccess || hipDeviceGetAttribute(&cus, hipDeviceAttributeMultiprocessorCount, dev) != hipSuccess) { fprintf(stderr, "kernel_launch: device query failed\n"); grid = -1; return; }
        if (hipFuncSetAttribute((const void*)fwd_kernel, hipFuncAttributeMaxDynamicSharedMemorySize, LDS_BYTES) != hipSuccess) { fprintf(stderr, "kernel_launch: hipFuncSetAttribute failed\n"); grid = -1; return; }
        if (hipOccupancyMaxActiveBlocksPerMultiprocessor(&per_cu, (const void*)fwd_kernel, 512, LDS_BYTES) != hipSuccess || per_cu < 1) { fprintf(stderr, "kernel_launch: occupancy query says %d blocks per CU\n", per_cu); per_cu = 1; }
        (void)hipGetLastError();
        grid = cus;
        fprintf(stderr, "kernel_launch: grid %d (occupancy %d per CU)\n", grid, per_cu);
    }
    if (grid < 0) return;
    if (hipMemsetAsync((char*)d_ws + WS_CTL, 0, CTL_BYTES, stream) != hipSuccess) { fprintf(stderr, "kernel_launch: memset of the barrier words failed\n"); return; }
    Args a{};
    for (int i = 0; i < 17; ++i) a.in[i] = (const float*)d_in[i];
    a.out = (float*)d_out; a.ws = (unsigned char*)d_ws;
#if MK_ONE_LAUNCH
    a.ph_lo = 0; a.ph_hi = NPHASE;
    void* args[] = {&a};
    hipError_t e = hipLaunchCooperativeKernel((const void*)fwd_kernel, dim3(grid), dim3(512), args, LDS_BYTES, stream);
    if (e != hipSuccess) fprintf(stderr, "kernel_launch: cooperative launch failed: %s (grid %d)\n", hipGetErrorString(e), grid);
#else
#ifdef PROBE_SEQ
    const int seq[] = PROBE_SEQ;
    for (int p : seq) { a.ph_lo = p; a.ph_hi = p + 1; hipLaunchKernelGGL(fwd_kernel, dim3(grid), dim3(512), LDS_BYTES, stream, a); }
#else
    for (int p = 0; p < NPHASE; ++p) { a.ph_lo = p; a.ph_hi = p + 1; hipLaunchKernelGGL(fwd_kernel, dim3(grid), dim3(512), LDS_BYTES, stream, a); }
#endif
#endif
}
```
